# Optimizing an MI355X kernel written in HIP

```python
import jax, jax.numpy as jnp
from jax import lax
import numpy as np

D_MODEL = 1024
BATCH = 4
SEQ = 4096
DEPTH = 4

A_GROUPS = 8
A_GROUP_DIM = 64
A_WIDTH = A_GROUPS * A_GROUP_DIM
A_CHUNK = 128
B_HEADS = 8
B_HEAD_DIM = 64
B_WIDTH = B_HEADS * B_HEAD_DIM
B_BRANCHES = ((128, 1), (512, 4), (2048, 16))
B_BLOCK = 128
C_HEADS = 4
C_DK = 128
C_DV = 256
C_GATE_RANK = 16
C_TAU = 16.0
C_CHUNK = 64
D_FF = 2816
CONV_W = 3

EPS = 1e-6
NEG = -1e30
N_EVEN = (DEPTH + 1) // 2
N_ODD = DEPTH // 2
EVEN_IN = 2 * A_WIDTH + 3 * B_WIDTH
ODD_IN = 2 * C_HEADS * C_DK + 2 * C_HEADS * C_DV + C_GATE_RANK

kernel_name = "hybrid_gmlp_dilated_gla_convffn"


def rms_norm(x, g):
    xf = x.astype(jnp.float32)
    return xf * lax.rsqrt(jnp.mean(xf * xf, -1, keepdims=True) + EPS) * g.astype(jnp.float32)


def layer_norm(x, g, b):
    xf = x.astype(jnp.float32)
    mu = jnp.mean(xf, -1, keepdims=True)
    xc = xf - mu
    return xc * lax.rsqrt(jnp.mean(xc * xc, -1, keepdims=True) + EPS) * g + b


def causal_dwconv(h, w, b):
    S = h.shape[1]
    hp = jnp.pad(h, ((0, 0), (CONV_W - 1, 0), (0, 0)))
    out = b
    for k in range(CONV_W):
        out = out + hp[:, k:k + S] * w[k]
    return out


def chunked_gmlp(u, v, ln_g, ln_b, w_s, b_s):
    Bn, S, _ = u.shape
    nc = S // A_CHUNK
    vn = layer_norm(v, ln_g, ln_b).reshape(Bn, nc, A_CHUNK, A_GROUPS, A_GROUP_DIM)
    causal = jnp.tril(jnp.ones((A_CHUNK, A_CHUNK), dtype=bool))
    ws = jnp.where(causal[None], w_s.astype(jnp.float32), 0.0)
    mixed = jnp.einsum('gts,bnsgc->bntgc', ws, vn) + b_s.astype(jnp.float32).T[:, :, None]
    return u.astype(jnp.float32) * mixed.reshape(Bn, S, A_WIDTH)


def dilated_branch(q, k, v, window, dilation):
    Bn, H, S, hd = q.shape
    span = dilation * B_BLOCK
    Sp = -(-S // span) * span
    M = Sp // dilation
    nb = M // B_BLOCK
    n_back = window // dilation

    def to_blocks(t):
        t = jnp.pad(t, ((0, 0), (0, 0), (0, Sp - S), (0, 0)))
        t = t.reshape(Bn, H, M, dilation, hd)
        t = jnp.moveaxis(t, 3, 2)
        return t.reshape(Bn, H, dilation, nb, B_BLOCK, hd)

    def band(t):
        tp = jnp.pad(t, ((0, 0), (0, 0), (0, 0), (1, 0), (0, 0), (0, 0)))
        return jnp.concatenate([tp[:, :, :, :-1], tp[:, :, :, 1:]], axis=4)

    qb = to_blocks(q)
    kk = band(to_blocks(k))
    vv = band(to_blocks(v))

    i = jnp.arange(B_BLOCK)[:, None]
    j = jnp.arange(2 * B_BLOCK)[None, :]
    dist = B_BLOCK + i - j
    in_band = (dist >= 0) & (dist <= n_back)
    valid = in_band[None] & ((jnp.arange(nb) > 0)[:, None, None] | (j >= B_BLOCK)[None])

    s = jnp.einsum('bhrnic,bhrnjc->bhrnij', qb, kk) * (hd ** -0.5)
    s = jnp.where(valid, s, NEG)
    m = jnp.max(s, -1, keepdims=True)
    p = jnp.exp(s - m)
    den = jnp.sum(p, -1)
    o = jnp.einsum('bhrnij,bhrnjc->bhrnic', p, vv) / den[..., None]
    lse = m[..., 0] + jnp.log(den)

    def from_blocks(t):
        tail = t.shape[5:]
        t = t.reshape((Bn, H, dilation, M) + tail)
        t = jnp.moveaxis(t, 2, 3).reshape((Bn, H, Sp) + tail)
        return t[:, :, :S]

    return from_blocks(o), from_blocks(lse)


def even_mixer(h, w_in, a_ln_g, a_ln_b, a_ws, a_bs, q_g, k_g, w_out):
    Bn, S, _ = h.shape
    z = h @ w_in
    u, v, q, k, vb = jnp.split(
        z, [A_WIDTH, 2 * A_WIDTH, 2 * A_WIDTH + B_WIDTH, 2 * A_WIDTH + 2 * B_WIDTH], axis=-1)
    a_out = chunked_gmlp(jax.nn.gelu(u, approximate=False), jax.nn.gelu(v, approximate=False),
                         a_ln_g, a_ln_b, a_ws, a_bs)

    def heads(t):
        return t.reshape(Bn, S, B_HEADS, B_HEAD_DIM).transpose(0, 2, 1, 3)

    qh = rms_norm(heads(q), q_g)
    kh = rms_norm(heads(k), k_g)
    vh = heads(vb).astype(jnp.float32)
    outs, lses = [], []
    for window, dilation in B_BRANCHES:
        o_r, l_r = dilated_branch(qh, kh, vh, window, dilation)
        outs.append(o_r)
        lses.append(l_r)
    wts = jax.nn.softmax(jnp.stack(lses), axis=0)
    o = jnp.einsum('rbhs,rbhsc->bhsc', wts, jnp.stack(outs))
    b_out = o.transpose(0, 2, 1, 3).reshape(Bn, S, B_WIDTH)
    return jnp.concatenate([a_out, b_out], axis=-1).astype(h.dtype) @ w_out


def gla_chunked(q, k, v, log_a):
    Bn, H, S, dk = q.shape
    dv = v.shape[-1]
    nc = S // C_CHUNK

    def rs(t):
        return t.reshape(Bn, H, nc, C_CHUNK, t.shape[-1])

    q, k, v, log_a = rs(q), rs(k), rs(v), rs(log_a)
    b = jnp.cumsum(log_a, axis=3)
    b_last = b[:, :, :, -1:]
    q_t = q * jnp.exp(b)
    k_t = k * jnp.exp(-b)
    k_s = k * jnp.exp(b_last - b)
    causal = jnp.tril(jnp.ones((C_CHUNK, C_CHUNK), dtype=bool))
    attn = jnp.where(causal, jnp.einsum('bhnik,bhnjk->bhnij', q_t, k_t), 0.0)
    o_intra = jnp.einsum('bhnij,bhnjv->bhniv', attn, v)
    kv = jnp.einsum('bhnjk,bhnjv->bhnkv', k_s, v)
    decay = jnp.exp(b_last[:, :, :, 0])

    def step(state, inp):
        kv_n, d_n = inp
        return d_n[..., None] * state + kv_n, state

    init = jnp.zeros((Bn, H, dk, dv), jnp.float32)
    _, states = lax.scan(step, init, (jnp.moveaxis(kv, 2, 0), jnp.moveaxis(decay, 2, 0)))
    states = jnp.moveaxis(states, 0, 2)
    o_inter = jnp.einsum('bhnik,bhnkv->bhniv', q_t, states)
    return (o_intra + o_inter).reshape(Bn, H, S, dv)


def gla_mixer(h, w_in, w_a2, b_a, head_g, w_out):
    Bn, S, _ = h.shape
    hk, hv = C_HEADS * C_DK, C_HEADS * C_DV
    z = h @ w_in
    q, k, v, r, ga = jnp.split(z, [hk, 2 * hk, 2 * hk + hv, 2 * hk + 2 * hv], axis=-1)

    def heads(t, dh):
        return t.reshape(Bn, S, C_HEADS, dh).transpose(0, 2, 1, 3).astype(jnp.float32)

    log_a = jax.nn.log_sigmoid((ga @ w_a2 + b_a).astype(jnp.float32)) / C_TAU
    o = gla_chunked(heads(q, C_DK) * (C_DK ** -0.5), heads(k, C_DK), heads(v, C_DV),
                    heads(log_a, C_DK))
    o = rms_norm(o, head_g)
    o = o.transpose(0, 2, 1, 3).reshape(Bn, S, hv) * jax.nn.silu(r.astype(jnp.float32))
    return o.astype(h.dtype) @ w_out


def conv_ffn(h, w_gate, w_up, conv_w, conv_b, w_down):
    g = causal_dwconv(h @ w_gate, conv_w, conv_b)
    return (jax.nn.silu(g) * (h @ w_up)) @ w_down


def setup_inputs(seed: int = 0) -> dict:
    key = jax.random.key(seed)
    ks = iter(jax.random.split(key, 32))

    def nrm(shape, scale):
        return jax.random.normal(next(ks), shape, jnp.float32) * scale

    res = (2 * DEPTH) ** -0.5
    return {
        "x": nrm((BATCH, SEQ, D_MODEL), 1.0),
        "norm_mix_g": 1.0 + nrm((DEPTH, D_MODEL), 0.1),
        "norm_ffn_g": 1.0 + nrm((DEPTH, D_MODEL), 0.1),
        "ev_w_in": nrm((N_EVEN, D_MODEL, EVEN_IN), D_MODEL ** -0.5),
        "ev_a_ln_g": 1.0 + nrm((N_EVEN, A_WIDTH), 0.1),
        "ev_a_ln_b": nrm((N_EVEN, A_WIDTH), 0.02),
        "ev_a_ws": nrm((N_EVEN, A_GROUPS, A_CHUNK, A_CHUNK), A_CHUNK ** -0.5),
        "ev_a_bs": 1.0 + nrm((N_EVEN, A_GROUPS, A_CHUNK), 0.1),
        "ev_q_g": 1.0 + nrm((N_EVEN, B_HEAD_DIM), 0.1),
        "ev_k_g": 1.0 + nrm((N_EVEN, B_HEAD_DIM), 0.1),
        "ev_w_out": nrm((N_EVEN, A_WIDTH + B_WIDTH, D_MODEL), (A_WIDTH + B_WIDTH) ** -0.5 * res),
        "od_w_in": nrm((N_ODD, D_MODEL, ODD_IN), D_MODEL ** -0.5),
        "od_w_a2": nrm((N_ODD, C_GATE_RANK, C_HEADS * C_DK), C_GATE_RANK ** -0.5),
        "od_b_a": nrm((N_ODD, C_HEADS * C_DK), 0.5),
        "od_head_g": 1.0 + nrm((N_ODD, C_DV), 0.1),
        "od_w_out": nrm((N_ODD, C_HEADS * C_DV, D_MODEL), (C_HEADS * C_DV) ** -0.5 * res),
        "ffn_w_gate": nrm((DEPTH, D_MODEL, D_FF), D_MODEL ** -0.5),
        "ffn_w_up": nrm((DEPTH, D_MODEL, D_FF), D_MODEL ** -0.5),
        "ffn_conv_w": nrm((DEPTH, CONV_W, D_FF), CONV_W ** -0.5),
        "ffn_conv_b": nrm((DEPTH, D_FF), 0.02),
        "ffn_w_down": nrm((DEPTH, D_FF, D_MODEL), D_FF ** -0.5 * res),
    }


def reference(x, norm_mix_g, norm_ffn_g,
              ev_w_in, ev_a_ln_g, ev_a_ln_b, ev_a_ws, ev_a_bs, ev_q_g, ev_k_g, ev_w_out,
              od_w_in, od_w_a2, od_b_a, od_head_g, od_w_out,
              ffn_w_gate, ffn_w_up, ffn_conv_w, ffn_conv_b, ffn_w_down):
    for layer in range(DEPTH):
        h = rms_norm(x, norm_mix_g[layer]).astype(x.dtype)
        if layer % 2 == 0:
            e = layer // 2
            mix = even_mixer(h, ev_w_in[e], ev_a_ln_g[e], ev_a_ln_b[e], ev_a_ws[e], ev_a_bs[e],
                             ev_q_g[e], ev_k_g[e], ev_w_out[e])
        else:
            o = layer // 2
            mix = gla_mixer(h, od_w_in[o], od_w_a2[o], od_b_a[o], od_head_g[o], od_w_out[o])
        x = x + mix.astype(x.dtype)
        h = rms_norm(x, norm_ffn_g[layer]).astype(x.dtype)
        x = x + conv_ffn(h, ffn_w_gate[layer], ffn_w_up[layer], ffn_conv_w[layer],
                         ffn_conv_b[layer], ffn_w_down[layer]).astype(x.dtype)
    return x
```

```cpp
#include <hip/hip_runtime.h>
#include <cstdio>
#include <cstdint>

#define LAS __attribute__((address_space(3)))
#define GAS __attribute__((address_space(1)))
typedef unsigned short bf16_t;
typedef short bf16x8 __attribute__((ext_vector_type(8)));
typedef float f32x4 __attribute__((ext_vector_type(4)));
typedef float f32x2 __attribute__((ext_vector_type(2)));
typedef unsigned u32x4 __attribute__((ext_vector_type(4)));
typedef unsigned u32x2 __attribute__((ext_vector_type(2)));

constexpr int D = 1024, BATCH = 4, SEQ = 4096, M = BATCH * SEQ, DEPTH = 4;
constexpr int EV_N = 2560, OD_N = 3072, OD_NSRC = 3088, FF = 2816, GU_N = 2 * FF;
constexpr float EPS = 1e-6f;

constexpr size_t MiB = 1u << 20;
constexpr size_t WS_CTL = 0, CTL_ZERO_BYTES = 1 * MiB;
constexpr size_t WS_RSQ = 1 * MiB;
constexpr size_t WS_LNP = 2 * MiB;
constexpr size_t WS_GA = 3 * MiB;
constexpr size_t WS_HALO = 4 * MiB;
constexpr size_t WS_FIXP = 6 * MiB;
constexpr size_t WS_FIXU = 8 * MiB;
constexpr size_t WS_SMALLW = 10 * MiB;
constexpr size_t WS_WMIX = 12 * MiB;
constexpr size_t OFF_EVIN = 0, OFF_EVOUT = 10 * MiB, OFF_ODIN = 14 * MiB, OFF_ODOUT = 26 * MiB;
constexpr size_t WS_WFFN = 42 * MiB;
constexpr size_t OFF_WDOWN = 11 * MiB;
constexpr size_t WS_XB = 60 * MiB;
constexpr size_t WS_Z = 92 * MiB;
constexpr size_t WS_AUX = 188 * MiB;
constexpr size_t WS_END = 252 * MiB;
constexpr int CW_BAR = 4096;

__device__ __forceinline__ unsigned f2bf(float f) { unsigned u = __builtin_bit_cast(unsigned, f); return (u + 0x7fffu + ((u >> 16) & 1u)) >> 16; }
__device__ __forceinline__ unsigned pk2(float lo, float hi) { return f2bf(lo) | (f2bf(hi) << 16); }
__device__ __forceinline__ float bf2f(unsigned short h) { return __builtin_bit_cast(float, (unsigned)h << 16); }
__device__ __forceinline__ unsigned cvt_pk_bf16(float lo, float hi) { unsigned r; asm volatile("v_cvt_pk_bf16_f32 %0, %1, %2" : "=v"(r) : "v"(lo), "v"(hi)); return r; }
__device__ __forceinline__ float silu_f(float x) { return x * __builtin_amdgcn_rcpf(1.0f + __expf(-x)); }
__device__ __forceinline__ f32x2 gelu_pk(f32x2 v) {
    const f32x2 av = __builtin_elementwise_abs(v), d = av * 0.2316418882f + 1.0f;
    f32x2 t; t.x = __builtin_amdgcn_rcpf(d.x); t.y = __builtin_amdgcn_rcpf(d.y);
    f32x2 q = t * 0.5307027145f + (-0.7265760135f); q = q * t + 0.7107068705f; q = q * t + (-0.142248368f); q = q * t + 0.127414796f; q = q * t;
    const f32x2 s = (v * v) * (-0.72134752044f);
    f32x2 e; e.x = __builtin_amdgcn_exp2f(s.x); e.y = __builtin_amdgcn_exp2f(s.y);
    const f32x2 m = v * (q * e), r = v - m;
    f32x2 o; o.x = v.x < 0.f ? m.x : r.x; o.y = v.y < 0.f ? m.y : r.y; return o;
}
__device__ __forceinline__ f32x4 gelu4(f32x4 v) { f32x2 a = gelu_pk((f32x2){v[0], v[1]}), b = gelu_pk((f32x2){v[2], v[3]}); return (f32x4){a.x, a.y, b.x, b.y}; }
__device__ __forceinline__ float sum4(f32x4 v) { return (v[0] + v[1]) + (v[2] + v[3]); }
__device__ __forceinline__ float dot4(f32x4 v) { return (v[0] * v[0] + v[1] * v[1]) + (v[2] * v[2] + v[3] * v[3]); }
__device__ __forceinline__ u32x4 pack8(f32x4 a, f32x4 b) { u32x4 w; w.x = cvt_pk_bf16(a[0], a[1]); w.y = cvt_pk_bf16(a[2], a[3]); w.z = cvt_pk_bf16(b[0], b[1]); w.w = cvt_pk_bf16(b[2], b[3]); return w; }

namespace pg8 {
constexpr int BM = 256, BK = 64, HALF = 128, HTB = HALF * BK * 2, STAGE_BYTES = 8 * HTB, NXCD = 8, WGM = 8;
__host__ __device__ __forceinline__ int lds_byte(int r, int c) { const int st = (r >> 4) * 2 + (c >> 5), rr = r & 15, cc = c & 31, ob = rr * 64 + cc * 2; return st * 1024 + (ob ^ (((ob >> 9) & 1) << 5)); }
__host__ __device__ __forceinline__ void stage_rc(int b, int& R, int& C) { const int st = b / 1024, sb = b % 1024, swz = sb ^ (((sb >> 9) & 1) << 5); R = (st >> 1) * 16 + swz / 64; C = (st & 1) * 32 + (swz % 64) / 2; }
__host__ __device__ __forceinline__ int perm32(int rho) { const int n = rho >> 4, i = rho & 15; return 8 * (i >> 2) + 4 * n + (i & 3); }
struct Unit { int pm, pn; };
struct Gemm { const bf16_t* A; const bf16_t* Bt; int M, N, K, lda; };
struct StaticOrder {
    int nM, nN, nwg, G, c;
    __device__ void init(int M_, int N_, int G_, int c_) { nM = M_ / BM; nN = N_ / BM; nwg = nM * nN; G = G_; c = c_; }
    __device__ bool next(int i, Unit& u) const {
        const long L = (long)i * G + c; if (L >= nwg) return false;
        int wgid = (int)L; { const int q = nwg / NXCD, r = nwg % NXCD, xcd = wgid % NXCD, off = wgid / NXCD; wgid = (xcd < r ? xcd * (q + 1) : r * (q + 1) + (xcd - r) * q) + off; }
        const int nig = WGM * nN, gid = wgid / nig, fm = gid * WGM, gsz = (nM - fm) < WGM ? (nM - fm) : WGM;
        u.pm = fm + ((wgid % nig) % gsz); u.pn = (wgid % nig) / gsz; return true;
    }
};
template <class Epi>
__device__ __forceinline__ void gemm_phase(LAS unsigned char* lds, const Gemm g, const StaticOrder& S, const Epi& E, const int tid) {
    const int wid = __builtin_amdgcn_readfirstlane(tid >> 6), lane = tid & 63, wr = wid >> 2, wc = wid & 3, fr = lane & 15, fq = lane >> 4;
    const int K = g.K, nt = K / BK, lda = g.lda;
    unsigned voffA[2], voffB[2];
#pragma unroll
    for (int i = 0; i < 2; ++i) { int R, C; stage_rc(tid * 16 + i * 8192, R, C); const int Rb = (R & ~31) + perm32(R & 31);
        voffA[i] = (unsigned)(R * lda + C) * 2u; voffB[i] = (unsigned)(Rb * K + C) * 2u; }
    const size_t kstep = (size_t)(BK * 2);
    const size_t hstepA = (size_t)HALF * lda * 2, hstepB = (size_t)HALF * K * 2;
    const size_t tstepA = 2 * hstepA, tstepB = 2 * hstepB;
    const unsigned ldsw = (unsigned)wid * 1024u;
    const int aoff = lds_byte(wr * 64 + fr, fq * 8), boff = lds_byte(wc * 32 + fr, fq * 8);
#define PG8_SA(b, h) (((b) * 2 + (h)) * HTB)
#define PG8_SB(b, h) ((4 + (b) * 2 + (h)) * HTB)
#define PG8_STAGE(bufoff, gbase, voff) do { _Pragma("unroll") for (int _i = 0; _i < 2; ++_i) \
        __builtin_amdgcn_global_load_lds((const unsigned*)((const char*)(gbase) + (voff)[_i]), (LAS unsigned*)(lds + (bufoff) + ldsw + _i * 8192), 16, 0, 0); } while (0)
#define PG8_LDA(dst, b, h) do { _Pragma("unroll") for (int m = 0; m < 4; ++m) _Pragma("unroll") for (int k = 0; k < 2; ++k) dst[m][k] = *(const LAS bf16x8*)(lds + PG8_SA(b, h) + aoff + m * 2048 + k * 1024); } while (0)
#define PG8_LDB(dst, b, h) do { _Pragma("unroll") for (int n = 0; n < 2; ++n) _Pragma("unroll") for (int k = 0; k < 2; ++k) dst[n][k] = *(const LAS bf16x8*)(lds + PG8_SB(b, h) + boff + n * 2048 + k * 1024); } while (0)
#define PG8_MMA(ai, bj, At, Bt) do { __builtin_amdgcn_s_setprio(1); _Pragma("unroll") for (int m = 0; m < 4; ++m) _Pragma("unroll") for (int n = 0; n < 2; ++n) _Pragma("unroll") for (int k = 0; k < 2; ++k) \
        acc[ai][bj][m][n] = __builtin_amdgcn_mfma_f32_16x16x32_bf16(Bt[n][k], At[m][k], acc[ai][bj][m][n], 0, 0, 0); __builtin_amdgcn_s_setprio(0); } while (0)
#define PG8_WAIT_V(n) asm volatile("s_waitcnt vmcnt(" #n ")" ::: "memory")
#define PG8_WAIT_L(n) asm volatile("s_waitcnt lgkmcnt(" #n ")" ::: "memory")
#define PG8_BAR __builtin_amdgcn_s_barrier()
#define PG8_SCHED __builtin_amdgcn_sched_barrier(0)
    Unit cur, nxt; int ui = 0;
    if (!S.next(0, cur)) return;
    f32x4 acc[2][2][4][2];
#pragma unroll
    for (int a = 0; a < 2; ++a)
#pragma unroll
        for (int b = 0; b < 2; ++b)
#pragma unroll
            for (int m = 0; m < 4; ++m)
#pragma unroll
                for (int n = 0; n < 2; ++n) acc[a][b][m][n] = (f32x4){0.f, 0.f, 0.f, 0.f};
    bf16x8 At[4][2], B0[2][2], B1[2][2];
    const char* cA = (const char*)g.A + (size_t)cur.pm * tstepA; const char* cB = (const char*)g.Bt + (size_t)cur.pn * tstepB;
    PG8_STAGE(PG8_SB(0, 0), cB, voffB); PG8_STAGE(PG8_SB(0, 1), cB + hstepB, voffB); PG8_STAGE(PG8_SA(0, 0), cA, voffA); PG8_STAGE(PG8_SA(0, 1), cA + hstepA, voffA);
    if (wr == 1) PG8_BAR;
    PG8_WAIT_V(2); PG8_BAR;
    PG8_STAGE(PG8_SB(1, 0), cB + kstep, voffB); PG8_STAGE(PG8_SA(1, 0), cA + kstep, voffA); PG8_STAGE(PG8_SB(1, 1), cB + hstepB + kstep, voffB);
    PG8_WAIT_V(6); PG8_BAR;
    for (;;) {
        const bool has_next = S.next(ui + 1, nxt);
        const char* nA = has_next ? (const char*)g.A + (size_t)nxt.pm * tstepA : cA; const char* nB = has_next ? (const char*)g.Bt + (size_t)nxt.pn * tstepB : cB;
        for (int t = 0; t < nt; t += 2) {
            const bool last = (t == nt - 2);
            const char* a1 = cA + (size_t)(t + 1) * kstep;
            const char* a2 = last ? nA : cA + (size_t)(t + 2) * kstep; const char* b2 = last ? nB : cB + (size_t)(t + 2) * kstep;
            const char* a3 = a2 + kstep; const char* b3 = b2 + kstep;
            PG8_LDB(B0, 0, 0); PG8_LDB(B1, 0, 1); PG8_SCHED; PG8_LDA(At, 0, 0); PG8_STAGE(PG8_SA(1, 1), a1 + hstepA, voffA);
            PG8_WAIT_V(8); PG8_WAIT_L(0); PG8_BAR; PG8_MMA(0, 0, At, B0); PG8_MMA(0, 1, At, B1); PG8_BAR; PG8_SCHED;
            PG8_LDA(At, 0, 1); PG8_STAGE(PG8_SB(0, 0), b2, voffB); PG8_STAGE(PG8_SB(0, 1), b2 + hstepB, voffB); PG8_STAGE(PG8_SA(0, 0), a2, voffA);
            PG8_WAIT_V(8); PG8_WAIT_L(0); PG8_BAR; PG8_MMA(1, 0, At, B0); PG8_MMA(1, 1, At, B1); PG8_BAR; PG8_SCHED;
            PG8_LDB(B0, 1, 0); PG8_LDB(B1, 1, 1); PG8_SCHED; PG8_LDA(At, 1, 0); PG8_STAGE(PG8_SA(0, 1), a2 + hstepA, voffA);
            PG8_WAIT_V(8); PG8_WAIT_L(0); PG8_BAR; PG8_MMA(0, 0, At, B0); PG8_MMA(0, 1, At, B1); PG8_BAR; PG8_SCHED;
            PG8_LDA(At, 1, 1); PG8_STAGE(PG8_SB(1, 0), b3, voffB); PG8_STAGE(PG8_SB(1, 1), b3 + hstepB, voffB); PG8_STAGE(PG8_SA(1, 0), a3, voffA);
            PG8_WAIT_V(8); PG8_WAIT_L(0); PG8_BAR; PG8_MMA(1, 0, At, B0); PG8_MMA(1, 1, At, B1); PG8_BAR; PG8_SCHED;
        }
        if (wr == 0) PG8_BAR;
        E(acc, cur, wr, wc, fr, fq);
        if (!has_next) break;
#pragma unroll
        for (int a = 0; a < 2; ++a)
#pragma unroll
            for (int b = 0; b < 2; ++b)
#pragma unroll
                for (int m = 0; m < 4; ++m)
#pragma unroll
                    for (int n = 0; n < 2; ++n) acc[a][b][m][n] = (f32x4){0.f, 0.f, 0.f, 0.f};
        cur = nxt; cA = nA; cB = nB; ++ui;
        if (wr == 1) PG8_BAR;
    }
    PG8_WAIT_V(0);
    PG8_BAR;
#undef PG8_SA
#undef PG8_SB
#undef PG8_STAGE
#undef PG8_LDA
#undef PG8_LDB
#undef PG8_MMA
#undef PG8_WAIT_V
#undef PG8_WAIT_L
#undef PG8_BAR
#undef PG8_SCHED
}
}
using pg8::Unit;

__device__ __forceinline__ void row_rstd(const float* rsq, int rowb, int fq, float (&rs)[2][4]) {
#pragma unroll
    for (int ai = 0; ai < 2; ++ai)
#pragma unroll
        for (int m = 0; m < 4; ++m) {
            const int row = rowb + ai * 128 + m * 16;
            const f32x4 p = *(const f32x4*)(rsq + (size_t)row * 16 + 4 * fq);
            float s = sum4(p); s += __shfl_xor(s, 16); s += __shfl_xor(s, 32);
            rs[ai][m] = rsqrtf(s * (1.0f / 1024.0f) + EPS);
        }
}

struct EpiEvenIn {
    bf16_t* Z; const float* rsq; float* lnp; const float* qg; const float* kg;
    __device__ __forceinline__ void operator()(const f32x4 (&acc)[2][2][4][2], const Unit& u, int wr, int wc, int fr, int fq) const {
        const int rowb = u.pm * 256 + wr * 64 + fr, kind = u.pn >> 1;
        float rs[2][4]; row_rstd(rsq, rowb, fq, rs);
        if (kind == 1 || kind == 3) {
            const float* g = (kind == 1) ? qg : kg; const float sc = (kind == 1) ? 0.125f : 1.0f;
            f32x4 gv[2][2];
#pragma unroll
            for (int bj = 0; bj < 2; ++bj)
#pragma unroll
                for (int n = 0; n < 2; ++n) gv[bj][n] = *(const f32x4*)(g + 32 * bj + 8 * fq + 4 * n) * sc;
#pragma unroll
            for (int ai = 0; ai < 2; ++ai)
#pragma unroll
                for (int m = 0; m < 4; ++m) {
                    float ss = 0.f;
#pragma unroll
                    for (int bj = 0; bj < 2; ++bj)
#pragma unroll
                        for (int n = 0; n < 2; ++n) ss += dot4(acc[ai][bj][m][n]);
                    ss += __shfl_xor(ss, 16); ss += __shfl_xor(ss, 32);
                    const float r = rs[ai][m], rh = rsqrtf(ss * r * r * (1.0f / 64.0f) + EPS) * r;
                    bf16_t* rowp = Z + (size_t)(rowb + ai * 128 + m * 16) * EV_N + u.pn * 256 + 64 * wc + 8 * fq;
#pragma unroll
                    for (int bj = 0; bj < 2; ++bj) *(u32x4*)(rowp + 32 * bj) = pack8(acc[ai][bj][m][0] * rh * gv[bj][0], acc[ai][bj][m][1] * rh * gv[bj][1]);
                }
        } else {
#pragma unroll
            for (int ai = 0; ai < 2; ++ai)
#pragma unroll
                for (int m = 0; m < 4; ++m) {
                    const float r = rs[ai][m]; const int row = rowb + ai * 128 + m * 16;
                    bf16_t* rowp = Z + (size_t)row * EV_N + u.pn * 256 + 32 * wc + 8 * fq;
                    float s1 = 0.f, s2 = 0.f;
#pragma unroll
                    for (int bj = 0; bj < 2; ++bj) {
                        f32x4 v0 = acc[ai][bj][m][0] * r, v1 = acc[ai][bj][m][1] * r;
                        if (kind != 4) { v0 = gelu4(v0); v1 = gelu4(v1); }
                        if (kind == 2) { s1 += sum4(v0) + sum4(v1); s2 += dot4(v0) + dot4(v1); }
                        *(u32x4*)(rowp + 128 * bj) = pack8(v0, v1);
                    }
                    if (kind == 2) {
                        s1 += __shfl_xor(s1, 16); s1 += __shfl_xor(s1, 32); s2 += __shfl_xor(s2, 16); s2 += __shfl_xor(s2, 32);
                        if (fq == 0) *(f32x2*)(lnp + ((size_t)row * 8 + (u.pn & 1) * 4 + wc) * 2) = (f32x2){s1, s2};
                    }
                }
        }
    }
};

struct EpiOddIn {
    bf16_t* Z; const float* rsq;
    __device__ __forceinline__ void operator()(const f32x4 (&acc)[2][2][4][2], const Unit& u, int wr, int wc, int fr, int fq) const {
        const int rowb = u.pm * 256 + wr * 64 + fr;
        float rs[2][4]; row_rstd(rsq, rowb, fq, rs);
        const float sc = (u.pn < 2) ? 0.08838834764831845f : 1.0f; const bool act = (u.pn >= 8);
#pragma unroll
        for (int ai = 0; ai < 2; ++ai)
#pragma unroll
            for (int m = 0; m < 4; ++m) {
                const float r = rs[ai][m] * sc;
                bf16_t* rowp = Z + (size_t)(rowb + ai * 128 + m * 16) * OD_N + u.pn * 256 + 32 * wc + 8 * fq;
#pragma unroll
                for (int bj = 0; bj < 2; ++bj) {
                    f32x4 v0 = acc[ai][bj][m][0] * r, v1 = acc[ai][bj][m][1] * r;
                    if (act) {
#pragma unroll
                        for (int e = 0; e < 4; ++e) { v0[e] = silu_f(v0[e]); v1[e] = silu_f(v1[e]); }
                    }
                    *(u32x4*)(rowp + 128 * bj) = pack8(v0, v1);
                }
            }
    }
};

struct EpiRes {
    const float* xin; float* xout; bf16_t* xb; float* rsq;
    __device__ __forceinline__ void operator()(const f32x4 (&acc)[2][2][4][2], const Unit& u, int wr, int wc, int fr, int fq) const {
        const int rowb = u.pm * 256 + wr * 64 + fr;
#pragma unroll
        for (int ai = 0; ai < 2; ++ai)
#pragma unroll
            for (int m = 0; m < 4; ++m) {
                const int row = rowb + ai * 128 + m * 16; const size_t off = (size_t)row * D + u.pn * 256 + 32 * wc + 8 * fq;
                float ss = 0.f;
#pragma unroll
                for (int bj = 0; bj < 2; ++bj) {
                    const f32x4 o0 = *(const f32x4*)(xin + off + 128 * bj) + acc[ai][bj][m][0], o1 = *(const f32x4*)(xin + off + 128 * bj + 4) + acc[ai][bj][m][1];
                    *(f32x4*)(xout + off + 128 * bj) = o0; *(f32x4*)(xout + off + 128 * bj + 4) = o1;
                    *(u32x4*)(xb + off + 128 * bj) = pack8(o0, o1);
                    ss += dot4(o0) + dot4(o1);
                }
                ss += __shfl_xor(ss, 16); ss += __shfl_xor(ss, 32);
                if (fq == 0) rsq[(size_t)row * 16 + u.pn * 4 + wc] = ss;
            }
    }
};

#define DPP_MOV(old, src, ctrl, bc) __builtin_bit_cast(float, __builtin_amdgcn_update_dpp(__builtin_bit_cast(int, (float)(old)), __builtin_bit_cast(int, (float)(src)), (ctrl), 0xf, 0xf, (bc)))

struct EpiF1 {
    bf16_t* H; const float* rsq; const float* cw; const float* cb; float* halo; float* fixp; float* fixu; LAS float* ldsx;
    __device__ __forceinline__ void operator()(const f32x4 (&acc)[2][2][4][2], const Unit& u, int wr, int wc, int fr, int fq) const {
        const int rowb = u.pm * 256 + wr * 64 + fr, ch0 = u.pn * 128 + 32 * wc + 8 * fq, lc = 32 * wc + 8 * fq;
        float rs[2][4]; row_rstd(rsq, rowb, fq, rs);
        f32x4 w0[2], w1[2], w2[2], bb[2];
#pragma unroll
        for (int n = 0; n < 2; ++n) { w0[n] = *(const f32x4*)(cw + ch0 + 4 * n); w1[n] = *(const f32x4*)(cw + FF + ch0 + 4 * n); w2[n] = *(const f32x4*)(cw + 2 * FF + ch0 + 4 * n); bb[n] = *(const f32x4*)(cb + ch0 + 4 * n); }
        if (fr >= 14) {
#pragma unroll
            for (int ai = 0; ai < 2; ++ai)
#pragma unroll
                for (int n = 0; n < 2; ++n) {
                    const f32x4 gvl = acc[ai][0][3][n] * rs[ai][3];
                    *(LAS f32x4*)(ldsx + ((ai * 2 + wr) * 2 + (fr - 14)) * 128 + lc + 4 * n) = gvl;
                    if (ai == 1 && wr == 1) *(f32x4*)(halo + ((size_t)u.pm * 2 + (fr - 14)) * FF + ch0 + 4 * n) = gvl;
                }
        }
        asm volatile("s_waitcnt lgkmcnt(0)" ::: "memory"); __builtin_amdgcn_s_barrier(); asm volatile("" ::: "memory");
        const bool fix = (u.pm & 15) != 0;
#pragma unroll
        for (int ai = 0; ai < 2; ++ai) {
            const int blk = ai * 2 + wr;
            f32x4 pv[2];
#pragma unroll
            for (int n = 0; n < 2; ++n) {
                pv[n] = (f32x4){0.f, 0.f, 0.f, 0.f};
                if (blk > 0 && fr >= 14) pv[n] = *(const LAS f32x4*)(ldsx + ((blk - 1) * 2 + (fr - 14)) * 128 + lc + 4 * n);
            }
#pragma unroll
            for (int m = 0; m < 4; ++m) {
                const float r = rs[ai][m]; const int row = rowb + ai * 128 + m * 16;
                f32x4 hv[2], pre[2], upv[2], cur[2];
#pragma unroll
                for (int n = 0; n < 2; ++n) {
                    cur[n] = acc[ai][0][m][n] * r; upv[n] = acc[ai][1][m][n] * r;
#pragma unroll
                    for (int e = 0; e < 4; ++e) {
                        const float c = cur[n][e], p = pv[n][e];
                        const float t1 = DPP_MOV(0.f, p, 0x10F, true);
                        const float g1 = DPP_MOV(t1, c, 0x111, false);
                        const float t2 = DPP_MOV(0.f, p, 0x10E, true);
                        const float g2 = DPP_MOV(t2, c, 0x112, false);
                        const float pr = bb[n][e] + w2[n][e] * c + w1[n][e] * g1 + w0[n][e] * g2;
                        pre[n][e] = pr; hv[n][e] = silu_f(pr) * upv[n][e];
                    }
                }
                *(u32x4*)(H + (size_t)row * FF + ch0) = pack8(hv[0], hv[1]);
                if (fix && blk == 0 && m == 0 && fr < 2) {
#pragma unroll
                    for (int n = 0; n < 2; ++n) { *(f32x4*)(fixp + ((size_t)u.pm * 2 + fr) * FF + ch0 + 4 * n) = pre[n]; *(f32x4*)(fixu + ((size_t)u.pm * 2 + fr) * FF + ch0 + 4 * n) = upv[n]; }
                }
                pv[0] = cur[0]; pv[1] = cur[1];
            }
        }
    }
};

#define XB_TMO      128
#define XB_XCNT(j)  (256  + 64 * (j))
#define XB_XSUB(j)  (1280 + 64 * (j))
#define XB_XGEN(j)  (2304 + 64 * (j))
#define XB_TOP      3328
#define XB_TOPGEN   3392
#define XCD_BAR_WORDS 3456
#define XB_SPIN_CAP (1u << 18)
__device__ __forceinline__ unsigned xb_ld(unsigned* p)              { return __hip_atomic_load(p, __ATOMIC_RELAXED, __HIP_MEMORY_SCOPE_AGENT); }
__device__ __forceinline__ unsigned xb_add(unsigned* p, unsigned v) { return __hip_atomic_fetch_add(p, v, __ATOMIC_RELAXED, __HIP_MEMORY_SCOPE_AGENT); }
__device__ __forceinline__ unsigned xb_xcc_id() { return (unsigned)__builtin_amdgcn_s_getreg((3 << 11) | 20) & 0xFu; }
#define XB_SPIN(cond, bar) do { unsigned _sp = 0; while (cond) { __builtin_amdgcn_s_sleep(1); \
    if ((++_sp & 255u) == 0u) { if (xb_ld(&(bar)[XB_TMO])) break; if (_sp > XB_SPIN_CAP) { atomicAdd(&(bar)[XB_TMO], 1u); break; } } } } while (0)
struct XcdBarrier { unsigned* bar; unsigned x; volatile LAS unsigned* st; };
__device__ __forceinline__ XcdBarrier xcd_barrier_post(unsigned* bar, volatile LAS unsigned* st) {
    XcdBarrier b; b.bar = bar; b.x = xb_xcc_id(); b.st = st;
    if (threadIdx.x == 0) (void)xb_add(&bar[XB_XCNT(b.x)], 1u);
    return b;
}
__device__ __forceinline__ void xcd_barrier_complete(unsigned* bar, unsigned x, unsigned& nloc, unsigned& nx) {
    const unsigned G = gridDim.x * gridDim.y * gridDim.z;
    unsigned sum, cnt, mine, sp = 0u;
    for (;;) {
        sum = 0u; cnt = 0u; mine = 0u;
#pragma unroll
        for (unsigned j = 0; j < 16; ++j) { const unsigned c = xb_ld(&bar[XB_XCNT(j)]); sum += c; cnt += (c > 0u) ? 1u : 0u; mine = (j == x) ? c : mine; }
        if (sum == G) break;
        __builtin_amdgcn_s_sleep(1);
        if ((++sp & 255u) == 0u) { if (xb_ld(&bar[XB_TMO])) break; if (sp > XB_SPIN_CAP) { atomicAdd(&bar[XB_TMO], 1u); break; } }
    }
    nloc = mine > 0u ? mine : 1u; nx = cnt > 0u ? cnt : 1u;
}
__device__ __forceinline__ void xcd_barrier(const XcdBarrier& b) {
    asm volatile("s_waitcnt vmcnt(0)" ::: "memory");
    __syncthreads();
    if (threadIdx.x == 0) {
        unsigned* bar = b.bar;
        __builtin_amdgcn_s_waitcnt(0);
        unsigned nloc = b.st[0], nx = b.st[1];
        if (nloc == 0u) { xcd_barrier_complete(bar, b.x, nloc, nx); b.st[0] = nloc; b.st[1] = nx; }
        const unsigned old = xb_add(&bar[XB_XSUB(b.x)], 1u);
        const unsigned gen = old / nloc;
        if (old + 1u == (gen + 1u) * nloc) {
            __builtin_amdgcn_fence(__ATOMIC_RELEASE, "agent");
            asm volatile("s_waitcnt vmcnt(0)" ::: "memory");
            const unsigned og = xb_add(&bar[XB_TOP], 1u);
            const unsigned tg = og / nx;
            if (og + 1u == (tg + 1u) * nx) xb_add(&bar[XB_TOPGEN], 1u);
            else XB_SPIN(xb_ld(&bar[XB_TOPGEN]) == tg, bar);
            __builtin_amdgcn_fence(__ATOMIC_ACQUIRE, "agent");
            xb_add(&bar[XB_XGEN(b.x)], 1u);
            asm volatile("s_waitcnt vmcnt(0)" ::: "memory");
        } else {
            XB_SPIN(xb_ld(&bar[XB_XGEN(b.x)]) == gen, bar);
            __builtin_amdgcn_fence(__ATOMIC_ACQUIRE, "agent");
            asm volatile("s_waitcnt vmcnt(0)" ::: "memory");
        }
    }
    __syncthreads();
}

__device__ __forceinline__ void transpose_item(const float* W, int ldw, int col0, const float* gk, bf16_t* WT, int K, int dstrow0, int k0, LAS float* scr, int lane) {
#pragma unroll 8
    for (int i = 0; i < 32; ++i) { const int kk = 2 * i + (lane >> 5); float v = W[(size_t)(k0 + kk) * ldw + col0 + (lane & 31)]; if (gk) v *= gk[k0 + kk]; scr[kk * 33 + (lane & 31)] = v; }
    asm volatile("s_waitcnt lgkmcnt(0)" ::: "memory");
    const int c = lane & 7;
#pragma unroll
    for (int j = 0; j < 4; ++j) { const int n = (lane >> 3) + 8 * j; const LAS float* s = scr + (8 * c) * 33 + n;
        u32x4 o; o.x = pk2(s[0 * 33], s[1 * 33]); o.y = pk2(s[2 * 33], s[3 * 33]); o.z = pk2(s[4 * 33], s[5 * 33]); o.w = pk2(s[6 * 33], s[7 * 33]);
        *(u32x4*)(WT + (size_t)(dstrow0 + n) * K + k0 + 8 * c) = o; }
    asm volatile("s_waitcnt lgkmcnt(0)" ::: "memory");
}
__device__ __forceinline__ void conv_item(const float* W, const float* W2, int ldw, int K, int Ndst, const float* gk, bf16_t* WT, int map, int item, LAS float* scr, int lane) {
    const int nblk = Ndst / 32, kb = item / nblk, nb = item % nblk, dstrow0 = 32 * nb;
    const float* src = W; int col0 = dstrow0;
    if (map == 1) {
        const int pn = nb >> 3, j = nb & 7, bj = j >> 2, wc = j & 3, kind = pn >> 1, zc = 256 * pn + 64 * wc + 32 * bj;
        if (kind == 1) col0 = 1024 + (zc - 512);
        else if (kind == 2) col0 = 512 + (dstrow0 - 1024);
        else if (kind == 3) col0 = 1536 + (zc - 1536);
    } else if (map == 2) {
        const int pn = nb >> 3, j = nb & 7, bj = j >> 2;
        col0 = 128 * pn + 32 * (j & 3); src = bj ? W2 : W;
    }
    transpose_item(src, ldw, col0, gk, WT, K, dstrow0, 64 * kb, scr, lane);
}

constexpr int NWAVES = 8;
constexpr int RING_BYTES = 131072, LDSCTL_OFF = RING_BYTES, MISC_OFF = LDSCTL_OFF + 320, LDSX_OFF = RING_BYTES + 1024, LDS_BYTES = 147456;
constexpr int NPHASE = 1 + 8 * DEPTH;
struct Args { const float* in[21]; float* out; unsigned char* ws; int ph_lo, ph_hi, li, pad; };

__global__ void __launch_bounds__(NWAVES * 64, 2) mega(Args args) {
    extern __shared__ __attribute__((aligned(16))) unsigned char lds_raw[];
    LAS unsigned char* lds = (LAS unsigned char*)lds_raw;
    volatile LAS unsigned* MISC = (volatile LAS unsigned*)(lds + MISC_OFF);
    const int G = gridDim.x;
    unsigned* ctl = (unsigned*)(args.ws + WS_CTL);
    for (int u = threadIdx.x; u < (LDS_BYTES - LDSCTL_OFF) / 4; u += NWAVES * 64) ((LAS unsigned*)(lds + LDSCTL_OFF))[u] = 0u;
    __syncthreads();
    XcdBarrier bar = xcd_barrier_post(ctl + CW_BAR + args.li * XCD_BAR_WORDS, MISC + 8);

    typedef const float* cfp_t;
    const __attribute__((address_space(4))) cfp_t* inp0 = (const __attribute__((address_space(4))) cfp_t*)__builtin_amdgcn_kernarg_segment_ptr();

    for (int ph = args.ph_lo; ph < args.ph_hi; ++ph) {
        const __attribute__((address_space(4))) cfp_t* inp = inp0; asm volatile("" : "+s"(inp));
        unsigned char* ws = args.ws; asm volatile("" : "+s"(ws));
        int tid = threadIdx.x; asm volatile("" : "+v"(tid));
        const int lane = tid & 63, wave = __builtin_amdgcn_readfirstlane(tid >> 6);
        const int gw = blockIdx.x * NWAVES + wave, NGW = G * NWAVES;
        LAS float* scr = (LAS float*)(lds + wave * 16384);
        float* X = args.out; asm volatile("" : "+s"(X));
        bf16_t* XB = (bf16_t*)(ws + WS_XB); bf16_t* Z = (bf16_t*)(ws + WS_Z);
        float* RSQ = (float*)(ws + WS_RSQ); float* LNP = (float*)(ws + WS_LNP);
        float* HALO = (float*)(ws + WS_HALO); float* FIXP = (float*)(ws + WS_FIXP); float* FIXU = (float*)(ws + WS_FIXU);
        bf16_t* WGU = (bf16_t*)(ws + WS_WFFN); bf16_t* WDN = (bf16_t*)(ws + WS_WFFN + OFF_WDOWN);
        if (ph == 0) {
            constexpr int I_EVIN = 16 * (EV_N / 32), I_SQ = 16 * 32, I_ODIN = 16 * (OD_N / 32);
            constexpr int PER = I_EVIN + I_SQ + I_ODIN + I_SQ;
            for (int it = gw; it < 2 * PER; it += NGW) {
                const int e = it / PER; int r = it % PER;
                if (r < I_EVIN) { conv_item(inp[3] + (size_t)e * D * EV_N, nullptr, EV_N, D, EV_N, inp[1] + (size_t)(2 * e) * D, (bf16_t*)(ws + WS_WMIX + OFF_EVIN) + (size_t)e * EV_N * D, 1, r, scr, lane); continue; } r -= I_EVIN;
                if (r < I_SQ) { conv_item(inp[10] + (size_t)e * D * D, nullptr, D, D, D, nullptr, (bf16_t*)(ws + WS_WMIX + OFF_EVOUT) + (size_t)e * D * D, 0, r, scr, lane); continue; } r -= I_SQ;
                if (r < I_ODIN) { conv_item(inp[11] + (size_t)e * D * OD_NSRC, nullptr, OD_NSRC, D, OD_N, inp[1] + (size_t)(2 * e + 1) * D, (bf16_t*)(ws + WS_WMIX + OFF_ODIN) + (size_t)e * OD_N * D, 0, r, scr, lane); continue; } r -= I_ODIN;
                conv_item(inp[15] + (size_t)e * D * D, nullptr, D, D, D, nullptr, (bf16_t*)(ws + WS_WMIX + OFF_ODOUT) + (size_t)e * D * D, 0, r, scr, lane);
            }
            for (int m = gw; m < M; m += NGW) {
                const f32x4* xr = (const f32x4*)(inp[0] + (size_t)m * D) + lane; f32x4 v[4]; float s = 0.f;
#pragma unroll
                for (int j = 0; j < 4; ++j) { v[j] = xr[64 * j]; s += dot4(v[j]); }
#pragma unroll
                for (int o = 1; o < 64; o <<= 1) s += __shfl_xor(s, o);
                u32x2* o8 = (u32x2*)(XB + (size_t)m * D) + lane;
#pragma unroll
                for (int j = 0; j < 4; ++j) { u32x2 w; w.x = pk2(v[j][0], v[j][1]); w.y = pk2(v[j][2], v[j][3]); o8[64 * j] = w; }
                if (lane < 16) RSQ[(size_t)m * 16 + lane] = (lane == 0) ? s : 0.f;
            }
        } else {
            const int L = (ph - 1) >> 3, sub = (ph - 1) & 7, e = L >> 1; const bool even = (L & 1) == 0;
            if (sub == 0) {
                pg8::StaticOrder S;
                if (even) {
                    pg8::Gemm g{XB, (const bf16_t*)(ws + WS_WMIX + OFF_EVIN) + (size_t)e * EV_N * D, M, EV_N, D, D}; S.init(M, EV_N, G, (int)blockIdx.x);
                    EpiEvenIn E{Z, RSQ, LNP, inp[8] + e * 64, inp[9] + e * 64};
                    pg8::gemm_phase<EpiEvenIn>(lds, g, S, E, tid);
                } else {
                    pg8::Gemm g{XB, (const bf16_t*)(ws + WS_WMIX + OFF_ODIN) + (size_t)e * OD_N * D, M, OD_N, D, D}; S.init(M, OD_N, G, (int)blockIdx.x);
                    EpiOddIn E{Z, RSQ};
                    pg8::gemm_phase<EpiOddIn>(lds, g, S, E, tid);
                }
            } else if (sub == 4 || sub == 7) {
                if (sub == 4) {
                    constexpr int I_GU = 16 * (GU_N / 32), I_DN = (FF / 64) * 32;
                    const float* wg = inp[16] + (size_t)L * D * FF; const float* wu = inp[17] + (size_t)L * D * FF; const float* wd = inp[20] + (size_t)L * FF * D;
                    for (int it = gw; it < I_GU + I_DN; it += NGW) {
                        if (it < I_GU) conv_item(wg, wu, FF, D, GU_N, inp[2] + (size_t)L * D, WGU, 2, it, scr, lane);
                        else conv_item(wd, nullptr, D, FF, D, nullptr, WDN, 0, it - I_GU, scr, lane);
                    }
                    __syncthreads();
                }
                pg8::StaticOrder S; S.init(M, D, G, (int)blockIdx.x);
                pg8::Gemm g;
                if (sub == 7) g = pg8::Gemm{Z, WDN, M, D, FF, FF};
                else if (even) g = pg8::Gemm{Z, (const bf16_t*)(ws + WS_WMIX + OFF_EVOUT) + (size_t)e * D * D, M, D, D, EV_N};
                else g = pg8::Gemm{Z + 1024, (const bf16_t*)(ws + WS_WMIX + OFF_ODOUT) + (size_t)e * D * D, M, D, D, OD_N};
                const float* xin = (L == 0 && sub == 4) ? inp[0] : X;
                EpiRes E{xin, X, XB, RSQ};
                pg8::gemm_phase<EpiRes>(lds, g, S, E, tid);
            } else if (sub == 5) {
                pg8::StaticOrder S; S.init(M, GU_N, G, (int)blockIdx.x);
                pg8::Gemm g{XB, WGU, M, GU_N, D, D};
                EpiF1 E{Z, RSQ, inp[18] + (size_t)L * 3 * FF, inp[19] + (size_t)L * FF, HALO, FIXP, FIXU, (LAS float*)(lds + LDSX_OFF)};
                pg8::gemm_phase<EpiF1>(lds, g, S, E, tid);
            } else if (sub == 6) {
                const float* cw = inp[18] + (size_t)L * 3 * FF;
                for (int idx = blockIdx.x * (NWAVES * 64) + tid; idx < 64 * 2 * FF; idx += G * NWAVES * 64) {
                    const int pm = idx / (2 * FF), rem = idx % (2 * FF), j = rem / FF, c = rem % FF;
                    if ((pm & 15) == 0) continue;
                    const float h1 = HALO[((size_t)(pm - 1) * 2 + 1) * FF + c], h0 = HALO[((size_t)(pm - 1) * 2 + 0) * FF + c];
                    float pre = FIXP[((size_t)pm * 2 + j) * FF + c];
                    if (j == 0) pre += cw[FF + c] * h1 + cw[c] * h0; else pre += cw[c] * h1;
                    Z[(size_t)(pm * 256 + j) * FF + c] = (bf16_t)f2bf(silu_f(pre) * FIXU[((size_t)pm * 2 + j) * FF + c]);
                }
            }
        }
        if (ph + 1 < args.ph_hi) xcd_barrier(bar);
    }
}

__global__ void __launch_bounds__(256) naive_gmlp(bf16_t* Z, const float* LNP, const float* ln_g, const float* ln_b, const float* wsp, const float* bsp) {
    __shared__ float vn[128 * 64];
    const int chunk = blockIdx.x, g = blockIdx.y, tid = threadIdx.x;
    const int m0 = chunk * 128;
    for (int idx = tid; idx < 128 * 64; idx += 256) {
        const int s = idx >> 6, c = idx & 63; const size_t row = m0 + s;
        float s1 = 0.f, s2 = 0.f;
        for (int k = 0; k < 8; ++k) { s1 += LNP[(row * 8 + k) * 2]; s2 += LNP[(row * 8 + k) * 2 + 1]; }
        const float mean = s1 * (1.f / 512.f), var = s2 * (1.f / 512.f) - mean * mean, rstd = rsqrtf(var + EPS);
        const float gv = bf2f(Z[row * EV_N + 1024 + 64 * g + c]);
        vn[idx] = (gv - mean) * rstd * ln_g[64 * g + c] + ln_b[64 * g + c];
    }
    __syncthreads();
    for (int idx = tid; idx < 128 * 64; idx += 256) {
        const int t = idx >> 6, c = idx & 63; const size_t row = m0 + t;
        float a = bsp[g * 128 + t];
        const float* wr = wsp + ((size_t)g * 128 + t) * 128;
        for (int s = 0; s <= t; ++s) a += wr[s] * vn[s * 64 + c];
        const float gu = bf2f(Z[row * EV_N + 64 * g + c]);
        Z[row * EV_N + 64 * g + c] = (bf16_t)f2bf(gu * a);
    }
}

__global__ void __launch_bounds__(256) naive_attn(bf16_t* Z) {
    const int wv = blockIdx.x * 4 + (threadIdx.x >> 6), lane = threadIdx.x & 63;
    const int m = wv >> 3, h = wv & 7, t = m & (SEQ - 1), mb = m - t;
    const float q = bf2f(Z[(size_t)m * EV_N + 512 + 64 * h + lane]);
    float ms[3], ls[3], os[3];
    const int dil[3] = {1, 4, 16};
#pragma unroll
    for (int r = 0; r < 3; ++r) {
        float mx = -1e30f, l = 0.f, o = 0.f;
        for (int j = 0; j <= 128; ++j) {
            const int tk = t - j * dil[r]; if (tk < 0) break;
            const size_t kr = (size_t)(mb + tk) * EV_N;
            float s = q * bf2f(Z[kr + 1536 + 64 * h + lane]);
#pragma unroll
            for (int o2 = 1; o2 < 64; o2 <<= 1) s += __shfl_xor(s, o2);
            const float mn = fmaxf(mx, s), al = __expf(mx - mn), p = __expf(s - mn);
            l = l * al + p; o = o * al + p * bf2f(Z[kr + 2048 + 64 * h + lane]); mx = mn;
        }
        ms[r] = mx; ls[r] = l; os[r] = o / l;
    }
    const float l0 = ms[0] + __logf(ls[0]), l1 = ms[1] + __logf(ls[1]), l2 = ms[2] + __logf(ls[2]);
    const float mm = fmaxf(l0, fmaxf(l1, l2)), e0 = __expf(l0 - mm), e1 = __expf(l1 - mm), e2 = __expf(l2 - mm), inv = 1.f / (e0 + e1 + e2);
    const float out = (e0 * os[0] + e1 * os[1] + e2 * os[2]) * inv;
    Z[(size_t)m * EV_N + 512 + 64 * h + lane] = (bf16_t)f2bf(out);
}

__global__ void __launch_bounds__(256) naive_ga(const float* X, const float* RSQ, const float* gmix, const float* w_in  , float* GA) {
    const int m = blockIdx.x * 4 + (threadIdx.x >> 6), lane = threadIdx.x & 63;
    float acc[16];
#pragma unroll
    for (int j = 0; j < 16; ++j) acc[j] = 0.f;
    for (int i = 0; i < 16; ++i) {
        const int k = i * 64 + lane; const float xv = X[(size_t)m * D + k] * gmix[k];
        const f32x4* wr = (const f32x4*)(w_in + (size_t)k * OD_NSRC + 3072);
#pragma unroll
        for (int j4 = 0; j4 < 4; ++j4) { const f32x4 w = wr[j4]; acc[4 * j4] += xv * w[0]; acc[4 * j4 + 1] += xv * w[1]; acc[4 * j4 + 2] += xv * w[2]; acc[4 * j4 + 3] += xv * w[3]; }
    }
    float s = 0.f;
    for (int j = 0; j < 16; ++j) s += RSQ[(size_t)m * 16 + j];
    const float rstd = rsqrtf(s * (1.f / 1024.f) + EPS);
#pragma unroll
    for (int j = 0; j < 16; ++j) {
        float v = acc[j];
#pragma unroll
        for (int o = 1; o < 64; o <<= 1) v += __shfl_xor(v, o);
        if (lane == j) GA[(size_t)m * 16 + j] = v * rstd;
    }
}

__global__ void __launch_bounds__(256) naive_gla(const bf16_t* Z, const float* GA, const float* w_a2  , const float* b_a, float* ORAW) {
    __shared__ float sa[2][128], sk[2][128], sq[2][128];
    const int b = blockIdx.x >> 2, h = blockIdx.x & 3, v = threadIdx.x;
    float S[128];
#pragma unroll
    for (int k = 0; k < 128; ++k) S[k] = 0.f;
    float wa[16]; float ba = 0.f;
    if (v < 128) { for (int j = 0; j < 16; ++j) wa[j] = w_a2[j * 512 + h * 128 + v]; ba = b_a[h * 128 + v]; }
    for (int t = 0; t < SEQ; ++t) {
        const size_t m = (size_t)b * SEQ + t; const int buf = t & 1;
        if (v < 128) {
            float xg = ba;
            for (int j = 0; j < 16; ++j) xg += GA[m * 16 + j] * wa[j];
            const float ls = fminf(xg, 0.f) - log1pf(__expf(-fabsf(xg)));
            sa[buf][v] = __expf(ls * (1.f / 16.f));
            sk[buf][v] = bf2f(Z[m * OD_N + 512 + 128 * h + v]);
            sq[buf][v] = bf2f(Z[m * OD_N + 128 * h + v]);
        }
        __syncthreads();
        const float vv = bf2f(Z[m * OD_N + 1024 + 256 * h + v]);
        float o = 0.f;
#pragma unroll
        for (int k = 0; k < 128; ++k) { S[k] = sa[buf][k] * S[k] + sk[buf][k] * vv; o += sq[buf][k] * S[k]; }
        ORAW[m * 1024 + 256 * h + v] = o;
    }
}

__global__ void __launch_bounds__(256) naive_gla_post(bf16_t* Z, const float* ORAW, const float* head_g) {
    const int wv = blockIdx.x * 4 + (threadIdx.x >> 6), lane = threadIdx.x & 63;
    const int m = wv >> 2, h = wv & 3;
    const f32x4 o = *(const f32x4*)(ORAW + (size_t)m * 1024 + 256 * h + 4 * lane);
    float ss = dot4(o);
#pragma unroll
    for (int k = 1; k < 64; k <<= 1) ss += __shfl_xor(ss, k);
    const float rstd = rsqrtf(ss * (1.f / 256.f) + EPS);
    const f32x4 hg = *(const f32x4*)(head_g + 4 * lane);
    bf16_t* sr = Z + (size_t)m * OD_N + 2048 + 256 * h + 4 * lane;
    bf16_t* dst = Z + (size_t)m * OD_N + 1024 + 256 * h + 4 * lane;
    u32x2 w; w.x = pk2(o[0] * rstd * hg[0] * bf2f(sr[0]), o[1] * rstd * hg[1] * bf2f(sr[1])); w.y = pk2(o[2] * rstd * hg[2] * bf2f(sr[2]), o[3] * rstd * hg[3] * bf2f(sr[3]));
    *(u32x2*)dst = w;
}

extern "C" void kernel_launch(void* const* d_in, const int* in_sizes, int n_in, void* d_out, int out_size, void* d_ws, size_t ws_size, hipStream_t stream) {
    static int grid = 0;
    if (grid == 0) {
        if (n_in != 21 || out_size != M * D || ws_size < WS_END) { fprintf(stderr, "kernel_launch: unexpected shapes (n_in %d out %d ws %zu)\n", n_in, out_size, ws_size); grid = -1; return; }
        int dev = 0, cus = 0, per_cu = 0;
        hipGetDevice(&dev); hipDeviceGetAttribute(&cus, hipDeviceAttributeMultiprocessorCount, dev);
        hipFuncSetAttribute((const void*)mega, hipFuncAttributeMaxDynamicSharedMemorySize, LDS_BYTES);
        hipOccupancyMaxActiveBlocksPerMultiprocessor(&per_cu, (const void*)mega, NWAVES * 64, LDS_BYTES);
        (void)hipGetLastError();
        if (per_cu < 1) per_cu = 1;
        if (per_cu > 1) per_cu = 1;
        grid = cus * per_cu;
        fprintf(stderr, "kernel_launch: grid %d (cus %d), ws %zu\n", grid, cus, ws_size);
    }
    if (grid < 0) return;
    hipMemsetAsync((char*)d_ws + WS_CTL, 0, CTL_ZERO_BYTES, stream);
    Args a{};
    for (int i = 0; i < 21; ++i) a.in[i] = (const float*)d_in[i];
    a.out = (float*)d_out; a.ws = (unsigned char*)d_ws;
    unsigned char* ws = (unsigned char*)d_ws;
    bf16_t* Z = (bf16_t*)(ws + WS_Z);
    int li = 0;
    auto launch = [&](int lo, int hi) {
        a.ph_lo = lo; a.ph_hi = hi; a.li = li++;
        void* kargs[] = {&a};
        hipError_t e = hipLaunchCooperativeKernel((const void*)mega, dim3(grid), dim3(NWAVES * 64), kargs, LDS_BYTES, stream);
        if (e != hipSuccess) fprintf(stderr, "cooperative launch failed: %s\n", hipGetErrorString(e));
    };
    for (int L = 0; L < DEPTH; ++L) {
        const int base = 1 + 8 * L, e = L >> 1;
        launch(L == 0 ? 0 : base - 4, base + 1);
        if ((L & 1) == 0) {
            naive_gmlp<<<dim3(M / 128, 8), 256, 0, stream>>>(Z, (const float*)(ws + WS_LNP), a.in[4] + e * 512, a.in[5] + e * 512, a.in[6] + (size_t)e * 8 * 128 * 128, a.in[7] + e * 8 * 128);
            naive_attn<<<M * 8 / 4, 256, 0, stream>>>(Z);
        } else {
            naive_ga<<<M / 4, 256, 0, stream>>>((const float*)d_out, (const float*)(ws + WS_RSQ), a.in[1] + (size_t)L * D, a.in[11] + (size_t)e * D * OD_NSRC, (float*)(ws + WS_GA));
            naive_gla<<<16, 256, 0, stream>>>(Z, (const float*)(ws + WS_GA), a.in[12] + (size_t)e * 16 * 512, a.in[13] + e * 512, (float*)(ws + WS_AUX));
            naive_gla_post<<<M * 4 / 4, 256, 0, stream>>>(Z, (const float*)(ws + WS_AUX), a.in[14] + e * 256);
        }
    }
    launch(1 + 8 * 3 + 4, NPHASE);
}
```

```cpp
#include <hip/hip_runtime.h>
#include <cstdio>
#include <cstdint>

#define LAS __attribute__((address_space(3)))
#define GAS __attribute__((address_space(1)))
typedef unsigned short bf16_t;
typedef short bf16x8 __attribute__((ext_vector_type(8)));
typedef float f32x4 __attribute__((ext_vector_type(4)));
typedef float f32x2 __attribute__((ext_vector_type(2)));
typedef unsigned u32x4 __attribute__((ext_vector_type(4)));
typedef unsigned u32x2 __attribute__((ext_vector_type(2)));

constexpr int D = 1024, BATCH = 4, SEQ = 4096, M = BATCH * SEQ, DEPTH = 4;
constexpr int EV_N = 2560, OD_N = 3072, OD_NSRC = 3088, FF = 2816, GU_N = 2 * FF;
constexpr float EPS = 1e-6f;

constexpr size_t MiB = 1u << 20;
constexpr size_t WS_CTL = 0, CTL_ZERO_BYTES = 1 * MiB;
constexpr size_t WS_RSQ = 1 * MiB;
constexpr size_t WS_LNP = 2 * MiB;
constexpr size_t WS_GA = 3 * MiB;
constexpr size_t WS_HALO = 4 * MiB;
constexpr size_t WS_FIXP = 6 * MiB;
constexpr size_t WS_FIXU = 8 * MiB;
constexpr size_t WS_SMALLW = 10 * MiB;
constexpr size_t WS_WMIX = 12 * MiB;
constexpr size_t OFF_EVIN = 0, OFF_EVOUT = 10 * MiB, OFF_ODIN = 14 * MiB, OFF_ODOUT = 26 * MiB;
constexpr size_t WS_WFFN = 42 * MiB;
constexpr size_t OFF_WDOWN = 11 * MiB;
constexpr size_t WS_XB = 60 * MiB;
constexpr size_t WS_Z = 92 * MiB;
constexpr size_t WS_AUX = 188 * MiB;
constexpr size_t WS_END = 252 * MiB;
constexpr int CW_BAR = 4096;

constexpr int NWAVES = 8;
__device__ __forceinline__ unsigned f2bf(float f) { unsigned u = __builtin_bit_cast(unsigned, f); return (u + 0x7fffu + ((u >> 16) & 1u)) >> 16; }
__device__ __forceinline__ unsigned pk2(float lo, float hi) { return f2bf(lo) | (f2bf(hi) << 16); }
__device__ __forceinline__ float bf2f(unsigned short h) { return __builtin_bit_cast(float, (unsigned)h << 16); }
__device__ __forceinline__ unsigned cvt_pk_bf16(float lo, float hi) { unsigned r; asm volatile("v_cvt_pk_bf16_f32 %0, %1, %2" : "=v"(r) : "v"(lo), "v"(hi)); return r; }
__device__ __forceinline__ float silu_f(float x) { return x * __builtin_amdgcn_rcpf(1.0f + __expf(-x)); }
__device__ __forceinline__ f32x2 gelu_pk(f32x2 v) {
    const f32x2 av = __builtin_elementwise_abs(v), d = av * 0.2316418882f + 1.0f;
    f32x2 t; t.x = __builtin_amdgcn_rcpf(d.x); t.y = __builtin_amdgcn_rcpf(d.y);
    f32x2 q = t * 0.5307027145f + (-0.7265760135f); q = q * t + 0.7107068705f; q = q * t + (-0.142248368f); q = q * t + 0.127414796f; q = q * t;
    const f32x2 s = (v * v) * (-0.72134752044f);
    f32x2 e; e.x = __builtin_amdgcn_exp2f(s.x); e.y = __builtin_amdgcn_exp2f(s.y);
    const f32x2 m = v * (q * e), r = v - m;
    f32x2 o; o.x = v.x < 0.f ? m.x : r.x; o.y = v.y < 0.f ? m.y : r.y; return o;
}
__device__ __forceinline__ f32x4 gelu4(f32x4 v) { f32x2 a = gelu_pk((f32x2){v[0], v[1]}), b = gelu_pk((f32x2){v[2], v[3]}); return (f32x4){a.x, a.y, b.x, b.y}; }
__device__ __forceinline__ float sum4(f32x4 v) { return (v[0] + v[1]) + (v[2] + v[3]); }
__device__ __forceinline__ float dot4(f32x4 v) { return (v[0] * v[0] + v[1] * v[1]) + (v[2] * v[2] + v[3] * v[3]); }
__device__ __forceinline__ u32x4 pack8(f32x4 a, f32x4 b) { u32x4 w; w.x = cvt_pk_bf16(a[0], a[1]); w.y = cvt_pk_bf16(a[2], a[3]); w.z = cvt_pk_bf16(b[0], b[1]); w.w = cvt_pk_bf16(b[2], b[3]); return w; }

namespace pg8 {
constexpr int BM = 256, BK = 64, HALF = 128, HTB = HALF * BK * 2, STAGE_BYTES = 8 * HTB, NXCD = 8, WGM = 8;
__host__ __device__ __forceinline__ int lds_byte(int r, int c) { const int st = (r >> 4) * 2 + (c >> 5), rr = r & 15, cc = c & 31, ob = rr * 64 + cc * 2; return st * 1024 + (ob ^ (((ob >> 9) & 1) << 5)); }
__host__ __device__ __forceinline__ void stage_rc(int b, int& R, int& C) { const int st = b / 1024, sb = b % 1024, swz = sb ^ (((sb >> 9) & 1) << 5); R = (st >> 1) * 16 + swz / 64; C = (st & 1) * 32 + (swz % 64) / 2; }
__host__ __device__ __forceinline__ int perm32(int rho) { const int n = rho >> 4, i = rho & 15; return 8 * (i >> 2) + 4 * n + (i & 3); }
struct Unit { int pm, pn; };
struct Gemm { const bf16_t* A; const bf16_t* Bt; int M, N, K, lda; };
struct StaticOrder {
    int nM, nN, nwg, G, c;
    __device__ void init(int M_, int N_, int G_, int c_) { nM = M_ / BM; nN = N_ / BM; nwg = nM * nN; G = G_; c = c_; }
    __device__ bool next(int i, Unit& u) const {
        const long L = (long)i * G + c; if (L >= nwg) return false;
        int wgid = (int)L; { const int q = nwg / NXCD, r = nwg % NXCD, xcd = wgid % NXCD, off = wgid / NXCD; wgid = (xcd < r ? xcd * (q + 1) : r * (q + 1) + (xcd - r) * q) + off; }
        const int nig = WGM * nN, gid = wgid / nig, fm = gid * WGM, gsz = (nM - fm) < WGM ? (nM - fm) : WGM;
        u.pm = fm + ((wgid % nig) % gsz); u.pn = (wgid % nig) / gsz; return true;
    }
};
template <class Epi>
__device__ __forceinline__ void gemm_phase(LAS unsigned char* lds, const Gemm g, const StaticOrder& S, const Epi& E, const int tid) {
    const int wid = __builtin_amdgcn_readfirstlane(tid >> 6), lane = tid & 63, wr = wid >> 2, wc = wid & 3, fr = lane & 15, fq = lane >> 4;
    const int K = g.K, nt = K / BK, lda = g.lda;
    unsigned voffA[2], voffB[2];
#pragma unroll
    for (int i = 0; i < 2; ++i) { int R, C; stage_rc(tid * 16 + i * 8192, R, C); const int Rb = (R & ~31) + perm32(R & 31);
        voffA[i] = (unsigned)(R * lda + C) * 2u; voffB[i] = (unsigned)(Rb * K + C) * 2u; }
    const size_t kstep = (size_t)(BK * 2);
    const size_t hstepA = (size_t)HALF * lda * 2, hstepB = (size_t)HALF * K * 2;
    const size_t tstepA = 2 * hstepA, tstepB = 2 * hstepB;
    const unsigned ldsw = (unsigned)wid * 1024u;
    const int aoff = lds_byte(wr * 64 + fr, fq * 8), boff = lds_byte(wc * 32 + fr, fq * 8);
#define PG8_SA(b, h) (((b) * 2 + (h)) * HTB)
#define PG8_SB(b, h) ((4 + (b) * 2 + (h)) * HTB)
#define PG8_STAGE(bufoff, gbase, voff) do { _Pragma("unroll") for (int _i = 0; _i < 2; ++_i) \
        __builtin_amdgcn_global_load_lds((const unsigned*)((const char*)(gbase) + (voff)[_i]), (LAS unsigned*)(lds + (bufoff) + ldsw + _i * 8192), 16, 0, 0); } while (0)
#define PG8_LDA(dst, b, h) do { _Pragma("unroll") for (int m = 0; m < 4; ++m) _Pragma("unroll") for (int k = 0; k < 2; ++k) dst[m][k] = *(const LAS bf16x8*)(lds + PG8_SA(b, h) + aoff + m * 2048 + k * 1024); } while (0)
#define PG8_LDB(dst, b, h) do { _Pragma("unroll") for (int n = 0; n < 2; ++n) _Pragma("unroll") for (int k = 0; k < 2; ++k) dst[n][k] = *(const LAS bf16x8*)(lds + PG8_SB(b, h) + boff + n * 2048 + k * 1024); } while (0)
#define PG8_MMA(ai, bj, At, Bt) do { __builtin_amdgcn_s_setprio(1); _Pragma("unroll") for (int m = 0; m < 4; ++m) _Pragma("unroll") for (int n = 0; n < 2; ++n) _Pragma("unroll") for (int k = 0; k < 2; ++k) \
        acc[ai][bj][m][n] = __builtin_amdgcn_mfma_f32_16x16x32_bf16(Bt[n][k], At[m][k], acc[ai][bj][m][n], 0, 0, 0); __builtin_amdgcn_s_setprio(0); } while (0)
#define PG8_WAIT_V(n) asm volatile("s_waitcnt vmcnt(" #n ")" ::: "memory")
#define PG8_WAIT_L(n) asm volatile("s_waitcnt lgkmcnt(" #n ")" ::: "memory")
#define PG8_BAR __builtin_amdgcn_s_barrier()
#define PG8_SCHED __builtin_amdgcn_sched_barrier(0)
    Unit cur, nxt; int ui = 0;
    if (!S.next(0, cur)) return;
    f32x4 acc[2][2][4][2];
#pragma unroll
    for (int a = 0; a < 2; ++a)
#pragma unroll
        for (int b = 0; b < 2; ++b)
#pragma unroll
            for (int m = 0; m < 4; ++m)
#pragma unroll
                for (int n = 0; n < 2; ++n) acc[a][b][m][n] = (f32x4){0.f, 0.f, 0.f, 0.f};
    bf16x8 At[4][2], B0[2][2], B1[2][2];
    const char* cA = (const char*)g.A + (size_t)cur.pm * tstepA; const char* cB = (const char*)g.Bt + (size_t)cur.pn * tstepB;
    PG8_STAGE(PG8_SB(0, 0), cB, voffB); PG8_STAGE(PG8_SB(0, 1), cB + hstepB, voffB); PG8_STAGE(PG8_SA(0, 0), cA, voffA); PG8_STAGE(PG8_SA(0, 1), cA + hstepA, voffA);
    if (wr == 1) PG8_BAR;
    PG8_WAIT_V(2); PG8_BAR;
    PG8_STAGE(PG8_SB(1, 0), cB + kstep, voffB); PG8_STAGE(PG8_SA(1, 0), cA + kstep, voffA); PG8_STAGE(PG8_SB(1, 1), cB + hstepB + kstep, voffB);
    PG8_WAIT_V(6); PG8_BAR;
    for (;;) {
        const bool has_next = S.next(ui + 1, nxt);
        const char* nA = has_next ? (const char*)g.A + (size_t)nxt.pm * tstepA : cA; const char* nB = has_next ? (const char*)g.Bt + (size_t)nxt.pn * tstepB : cB;
        for (int t = 0; t < nt; t += 2) {
            const bool last = (t == nt - 2);
            const char* a1 = cA + (size_t)(t + 1) * kstep;
            const char* a2 = last ? nA : cA + (size_t)(t + 2) * kstep; const char* b2 = last ? nB : cB + (size_t)(t + 2) * kstep;
            const char* a3 = a2 + kstep; const char* b3 = b2 + kstep;
            PG8_LDB(B0, 0, 0); PG8_LDB(B1, 0, 1); PG8_SCHED; PG8_LDA(At, 0, 0); PG8_STAGE(PG8_SA(1, 1), a1 + hstepA, voffA);
            PG8_WAIT_V(8); PG8_WAIT_L(0); PG8_BAR; PG8_MMA(0, 0, At, B0); PG8_MMA(0, 1, At, B1); PG8_BAR; PG8_SCHED;
            PG8_LDA(At, 0, 1); PG8_STAGE(PG8_SB(0, 0), b2, voffB); PG8_STAGE(PG8_SB(0, 1), b2 + hstepB, voffB); PG8_STAGE(PG8_SA(0, 0), a2, voffA);
            PG8_WAIT_V(8); PG8_WAIT_L(0); PG8_BAR; PG8_MMA(1, 0, At, B0); PG8_MMA(1, 1, At, B1); PG8_BAR; PG8_SCHED;
            PG8_LDB(B0, 1, 0); PG8_LDB(B1, 1, 1); PG8_SCHED; PG8_LDA(At, 1, 0); PG8_STAGE(PG8_SA(0, 1), a2 + hstepA, voffA);
            PG8_WAIT_V(8); PG8_WAIT_L(0); PG8_BAR; PG8_MMA(0, 0, At, B0); PG8_MMA(0, 1, At, B1); PG8_BAR; PG8_SCHED;
            PG8_LDA(At, 1, 1); PG8_STAGE(PG8_SB(1, 0), b3, voffB); PG8_STAGE(PG8_SB(1, 1), b3 + hstepB, voffB); PG8_STAGE(PG8_SA(1, 0), a3, voffA);
            PG8_WAIT_V(8); PG8_WAIT_L(0); PG8_BAR; PG8_MMA(1, 0, At, B0); PG8_MMA(1, 1, At, B1); PG8_BAR; PG8_SCHED;
        }
        if (wr == 0) PG8_BAR;
        E(acc, cur, wr, wc, fr, fq);
        if (!has_next) break;
#pragma unroll
        for (int a = 0; a < 2; ++a)
#pragma unroll
            for (int b = 0; b < 2; ++b)
#pragma unroll
                for (int m = 0; m < 4; ++m)
#pragma unroll
                    for (int n = 0; n < 2; ++n) acc[a][b][m][n] = (f32x4){0.f, 0.f, 0.f, 0.f};
        cur = nxt; cA = nA; cB = nB; ++ui;
        if (wr == 1) PG8_BAR;
    }
    PG8_WAIT_V(0);
    PG8_BAR;
#undef PG8_SA
#undef PG8_SB
#undef PG8_STAGE
#undef PG8_LDA
#undef PG8_LDB
#undef PG8_MMA
#undef PG8_WAIT_V
#undef PG8_WAIT_L
#undef PG8_BAR
#undef PG8_SCHED
}
}
using pg8::Unit;

__device__ __forceinline__ void row_rstd(const float* rsq, int rowb, int fq, float (&rs)[2][4]) {
#pragma unroll
    for (int ai = 0; ai < 2; ++ai)
#pragma unroll
        for (int m = 0; m < 4; ++m) {
            const int row = rowb + ai * 128 + m * 16;
            const f32x4 p = *(const f32x4*)(rsq + (size_t)row * 16 + 4 * fq);
            float s = sum4(p); s += __shfl_xor(s, 16); s += __shfl_xor(s, 32);
            rs[ai][m] = rsqrtf(s * (1.0f / 1024.0f) + EPS);
        }
}

struct EpiEvenIn {
    bf16_t* Z; const float* rsq; float* lnp; const float* qg; const float* kg;
    __device__ __forceinline__ void operator()(const f32x4 (&acc)[2][2][4][2], const Unit& u, int wr, int wc, int fr, int fq) const {
        const int rowb = u.pm * 256 + wr * 64 + fr, kind = u.pn >> 1;
        float rs[2][4]; row_rstd(rsq, rowb, fq, rs);
        if (kind == 1 || kind == 3) {
            const float* g = (kind == 1) ? qg : kg; const float sc = (kind == 1) ? 0.125f : 1.0f;
            f32x4 gv[2][2];
#pragma unroll
            for (int bj = 0; bj < 2; ++bj)
#pragma unroll
                for (int n = 0; n < 2; ++n) gv[bj][n] = *(const f32x4*)(g + 32 * bj + 8 * fq + 4 * n) * sc;
#pragma unroll
            for (int ai = 0; ai < 2; ++ai)
#pragma unroll
                for (int m = 0; m < 4; ++m) {
                    float ss = 0.f;
#pragma unroll
                    for (int bj = 0; bj < 2; ++bj)
#pragma unroll
                        for (int n = 0; n < 2; ++n) ss += dot4(acc[ai][bj][m][n]);
                    ss += __shfl_xor(ss, 16); ss += __shfl_xor(ss, 32);
                    const float r = rs[ai][m], rh = rsqrtf(ss * r * r * (1.0f / 64.0f) + EPS) * r;
                    bf16_t* rowp = Z + (size_t)(rowb + ai * 128 + m * 16) * EV_N + u.pn * 256 + 64 * wc + 8 * fq;
#pragma unroll
                    for (int bj = 0; bj < 2; ++bj) *(u32x4*)(rowp + 32 * bj) = pack8(acc[ai][bj][m][0] * rh * gv[bj][0], acc[ai][bj][m][1] * rh * gv[bj][1]);
                }
        } else {
#pragma unroll
            for (int ai = 0; ai < 2; ++ai)
#pragma unroll
                for (int m = 0; m < 4; ++m) {
                    const float r = rs[ai][m]; const int row = rowb + ai * 128 + m * 16;
                    bf16_t* rowp = Z + (size_t)row * EV_N + u.pn * 256 + 32 * wc + 8 * fq;
                    float s1 = 0.f, s2 = 0.f;
#pragma unroll
                    for (int bj = 0; bj < 2; ++bj) {
                        f32x4 v0 = acc[ai][bj][m][0] * r, v1 = acc[ai][bj][m][1] * r;
                        if (kind != 4) { v0 = gelu4(v0); v1 = gelu4(v1); }
                        if (kind == 2) { s1 += sum4(v0) + sum4(v1); s2 += dot4(v0) + dot4(v1); }
                        *(u32x4*)(rowp + 128 * bj) = pack8(v0, v1);
                    }
                    if (kind == 2) {
                        s1 += __shfl_xor(s1, 16); s1 += __shfl_xor(s1, 32); s2 += __shfl_xor(s2, 16); s2 += __shfl_xor(s2, 32);
                        if (fq == 0) *(f32x2*)(lnp + ((size_t)row * 8 + (u.pn & 1) * 4 + wc) * 2) = (f32x2){s1, s2};
                    }
                }
        }
    }
};

struct EpiOddIn {
    bf16_t* Z; const float* rsq;
    __device__ __forceinline__ void operator()(const f32x4 (&acc)[2][2][4][2], const Unit& u, int wr, int wc, int fr, int fq) const {
        const int rowb = u.pm * 256 + wr * 64 + fr;
        float rs[2][4]; row_rstd(rsq, rowb, fq, rs);
        const float sc = (u.pn < 2) ? 0.08838834764831845f : 1.0f; const bool act = (u.pn >= 8);
#pragma unroll
        for (int ai = 0; ai < 2; ++ai)
#pragma unroll
            for (int m = 0; m < 4; ++m) {
                const float r = rs[ai][m] * sc;
                bf16_t* rowp = Z + (size_t)(rowb + ai * 128 + m * 16) * OD_N + u.pn * 256 + 32 * wc + 8 * fq;
#pragma unroll
                for (int bj = 0; bj < 2; ++bj) {
                    f32x4 v0 = acc[ai][bj][m][0] * r, v1 = acc[ai][bj][m][1] * r;
                    if (act) {
#pragma unroll
                        for (int e = 0; e < 4; ++e) { v0[e] = silu_f(v0[e]); v1[e] = silu_f(v1[e]); }
                    }
                    *(u32x4*)(rowp + 128 * bj) = pack8(v0, v1);
                }
            }
    }
};

struct EpiRes {
    const float* xin; float* xout; bf16_t* xb; float* rsq;
    __device__ __forceinline__ void operator()(const f32x4 (&acc)[2][2][4][2], const Unit& u, int wr, int wc, int fr, int fq) const {
        const int rowb = u.pm * 256 + wr * 64 + fr;
#pragma unroll
        for (int ai = 0; ai < 2; ++ai)
#pragma unroll
            for (int m = 0; m < 4; ++m) {
                const int row = rowb + ai * 128 + m * 16; const size_t off = (size_t)row * D + u.pn * 256 + 32 * wc + 8 * fq;
                float ss = 0.f;
#pragma unroll
                for (int bj = 0; bj < 2; ++bj) {
                    const f32x4 o0 = *(const f32x4*)(xin + off + 128 * bj) + acc[ai][bj][m][0], o1 = *(const f32x4*)(xin + off + 128 * bj + 4) + acc[ai][bj][m][1];
                    *(f32x4*)(xout + off + 128 * bj) = o0; *(f32x4*)(xout + off + 128 * bj + 4) = o1;
                    *(u32x4*)(xb + off + 128 * bj) = pack8(o0, o1);
                    ss += dot4(o0) + dot4(o1);
                }
                ss += __shfl_xor(ss, 16); ss += __shfl_xor(ss, 32);
                if (fq == 0) rsq[(size_t)row * 16 + u.pn * 4 + wc] = ss;
            }
    }
};

#define DPP_MOV(old, src, ctrl, bc) __builtin_bit_cast(float, __builtin_amdgcn_update_dpp(__builtin_bit_cast(int, (float)(old)), __builtin_bit_cast(int, (float)(src)), (ctrl), 0xf, 0xf, (bc)))

struct EpiF1 {
    bf16_t* H; const float* rsq; const float* cw; const float* cb; float* halo; float* fixp; float* fixu; LAS float* ldsx;
    __device__ __forceinline__ void operator()(const f32x4 (&acc)[2][2][4][2], const Unit& u, int wr, int wc, int fr, int fq) const {
        const int rowb = u.pm * 256 + wr * 64 + fr, ch0 = u.pn * 128 + 32 * wc + 8 * fq, lc = 32 * wc + 8 * fq;
        float rs[2][4]; row_rstd(rsq, rowb, fq, rs);
        f32x4 w0[2], w1[2], w2[2], bb[2];
#pragma unroll
        for (int n = 0; n < 2; ++n) { w0[n] = *(const f32x4*)(cw + ch0 + 4 * n); w1[n] = *(const f32x4*)(cw + FF + ch0 + 4 * n); w2[n] = *(const f32x4*)(cw + 2 * FF + ch0 + 4 * n); bb[n] = *(const f32x4*)(cb + ch0 + 4 * n); }
        if (fr >= 14) {
#pragma unroll
            for (int ai = 0; ai < 2; ++ai)
#pragma unroll
                for (int n = 0; n < 2; ++n) {
                    const f32x4 gvl = acc[ai][0][3][n] * rs[ai][3];
                    *(LAS f32x4*)(ldsx + ((ai * 2 + wr) * 2 + (fr - 14)) * 128 + lc + 4 * n) = gvl;
                    if (ai == 1 && wr == 1) *(f32x4*)(halo + ((size_t)u.pm * 2 + (fr - 14)) * FF + ch0 + 4 * n) = gvl;
                }
        }
        asm volatile("s_waitcnt lgkmcnt(0)" ::: "memory"); __builtin_amdgcn_s_barrier(); asm volatile("" ::: "memory");
        const bool fix = (u.pm & 15) != 0;
#pragma unroll
        for (int ai = 0; ai < 2; ++ai) {
            const int blk = ai * 2 + wr;
            f32x4 pv[2];
#pragma unroll
            for (int n = 0; n < 2; ++n) {
                pv[n] = (f32x4){0.f, 0.f, 0.f, 0.f};
                if (blk > 0 && fr >= 14) pv[n] = *(const LAS f32x4*)(ldsx + ((blk - 1) * 2 + (fr - 14)) * 128 + lc + 4 * n);
            }
#pragma unroll
            for (int m = 0; m < 4; ++m) {
                const float r = rs[ai][m]; const int row = rowb + ai * 128 + m * 16;
                f32x4 hv[2], pre[2], upv[2], cur[2];
#pragma unroll
                for (int n = 0; n < 2; ++n) {
                    cur[n] = acc[ai][0][m][n] * r; upv[n] = acc[ai][1][m][n] * r;
#pragma unroll
                    for (int e = 0; e < 4; ++e) {
                        const float c = cur[n][e], p = pv[n][e];
                        const float t1 = DPP_MOV(0.f, p, 0x10F, true);
                        const float g1 = DPP_MOV(t1, c, 0x111, false);
                        const float t2 = DPP_MOV(0.f, p, 0x10E, true);
                        const float g2 = DPP_MOV(t2, c, 0x112, false);
                        const float pr = bb[n][e] + w2[n][e] * c + w1[n][e] * g1 + w0[n][e] * g2;
                        pre[n][e] = pr; hv[n][e] = silu_f(pr) * upv[n][e];
                    }
                }
                *(u32x4*)(H + (size_t)row * FF + ch0) = pack8(hv[0], hv[1]);
                if (fix && blk == 0 && m == 0 && fr < 2) {
#pragma unroll
                    for (int n = 0; n < 2; ++n) { *(f32x4*)(fixp + ((size_t)u.pm * 2 + fr) * FF + ch0 + 4 * n) = pre[n]; *(f32x4*)(fixu + ((size_t)u.pm * 2 + fr) * FF + ch0 + 4 * n) = upv[n]; }
                }
                pv[0] = cur[0]; pv[1] = cur[1];
            }
        }
    }
};

#define XB_TMO      128
#define XB_XCNT(j)  (256  + 64 * (j))
#define XB_XSUB(j)  (1280 + 64 * (j))
#define XB_XGEN(j)  (2304 + 64 * (j))
#define XB_TOP      3328
#define XB_TOPGEN   3392
#define XCD_BAR_WORDS 3456
#define XB_SPIN_CAP (1u << 18)
__device__ __forceinline__ unsigned xb_ld(unsigned* p)              { return __hip_atomic_load(p, __ATOMIC_RELAXED, __HIP_MEMORY_SCOPE_AGENT); }
__device__ __forceinline__ unsigned xb_add(unsigned* p, unsigned v) { return __hip_atomic_fetch_add(p, v, __ATOMIC_RELAXED, __HIP_MEMORY_SCOPE_AGENT); }
__device__ __forceinline__ unsigned xb_xcc_id() { return (unsigned)__builtin_amdgcn_s_getreg((3 << 11) | 20) & 0xFu; }
#define XB_SPIN(cond, bar) do { unsigned _sp = 0; while (cond) { __builtin_amdgcn_s_sleep(1); \
    if ((++_sp & 255u) == 0u) { if (xb_ld(&(bar)[XB_TMO])) break; if (_sp > XB_SPIN_CAP) { atomicAdd(&(bar)[XB_TMO], 1u); break; } } } } while (0)
struct XcdBarrier { unsigned* bar; unsigned x; volatile LAS unsigned* st; };
__device__ __forceinline__ XcdBarrier xcd_barrier_post(unsigned* bar, volatile LAS unsigned* st) {
    XcdBarrier b; b.bar = bar; b.x = xb_xcc_id(); b.st = st;
    if (threadIdx.x == 0) (void)xb_add(&bar[XB_XCNT(b.x)], 1u);
    return b;
}
__device__ __forceinline__ void xcd_barrier_complete(unsigned* bar, unsigned x, unsigned& nloc, unsigned& nx) {
    const unsigned G = gridDim.x * gridDim.y * gridDim.z;
    unsigned sum, cnt, mine, sp = 0u;
    for (;;) {
        sum = 0u; cnt = 0u; mine = 0u;
#pragma unroll
        for (unsigned j = 0; j < 16; ++j) { const unsigned c = xb_ld(&bar[XB_XCNT(j)]); sum += c; cnt += (c > 0u) ? 1u : 0u; mine = (j == x) ? c : mine; }
        if (sum == G) break;
        __builtin_amdgcn_s_sleep(1);
        if ((++sp & 255u) == 0u) { if (xb_ld(&bar[XB_TMO])) break; if (sp > XB_SPIN_CAP) { atomicAdd(&bar[XB_TMO], 1u); break; } }
    }
    nloc = mine > 0u ? mine : 1u; nx = cnt > 0u ? cnt : 1u;
}
__device__ __forceinline__ void xcd_barrier(const XcdBarrier& b) {
    asm volatile("s_waitcnt vmcnt(0)" ::: "memory");
    __syncthreads();
    if (threadIdx.x == 0) {
        unsigned* bar = b.bar;
        __builtin_amdgcn_s_waitcnt(0);
        unsigned nloc = b.st[0], nx = b.st[1];
        if (nloc == 0u) { xcd_barrier_complete(bar, b.x, nloc, nx); b.st[0] = nloc; b.st[1] = nx; }
        const unsigned old = xb_add(&bar[XB_XSUB(b.x)], 1u);
        const unsigned gen = old / nloc;
        if (old + 1u == (gen + 1u) * nloc) {
            __builtin_amdgcn_fence(__ATOMIC_RELEASE, "agent");
            asm volatile("s_waitcnt vmcnt(0)" ::: "memory");
            const unsigned og = xb_add(&bar[XB_TOP], 1u);
            const unsigned tg = og / nx;
            if (og + 1u == (tg + 1u) * nx) xb_add(&bar[XB_TOPGEN], 1u);
            else XB_SPIN(xb_ld(&bar[XB_TOPGEN]) == tg, bar);
            __builtin_amdgcn_fence(__ATOMIC_ACQUIRE, "agent");
            xb_add(&bar[XB_XGEN(b.x)], 1u);
            asm volatile("s_waitcnt vmcnt(0)" ::: "memory");
        } else {
            XB_SPIN(xb_ld(&bar[XB_XGEN(b.x)]) == gen, bar);
            __builtin_amdgcn_fence(__ATOMIC_ACQUIRE, "agent");
            asm volatile("s_waitcnt vmcnt(0)" ::: "memory");
        }
    }
    __syncthreads();
}

__device__ __forceinline__ void transpose_item(const float* W, int ldw, int col0, const float* gk, bf16_t* WT, int K, int dstrow0, int k0, LAS float* scr, int lane) {
#pragma unroll 8
    for (int i = 0; i < 32; ++i) { const int kk = 2 * i + (lane >> 5); float v = W[(size_t)(k0 + kk) * ldw + col0 + (lane & 31)]; if (gk) v *= gk[k0 + kk]; scr[kk * 33 + (lane & 31)] = v; }
    asm volatile("s_waitcnt lgkmcnt(0)" ::: "memory");
    const int c = lane & 7;
#pragma unroll
    for (int j = 0; j < 4; ++j) { const int n = (lane >> 3) + 8 * j; const LAS float* s = scr + (8 * c) * 33 + n;
        u32x4 o; o.x = pk2(s[0 * 33], s[1 * 33]); o.y = pk2(s[2 * 33], s[3 * 33]); o.z = pk2(s[4 * 33], s[5 * 33]); o.w = pk2(s[6 * 33], s[7 * 33]);
        *(u32x4*)(WT + (size_t)(dstrow0 + n) * K + k0 + 8 * c) = o; }
    asm volatile("s_waitcnt lgkmcnt(0)" ::: "memory");
}
__device__ __forceinline__ void conv_item(const float* W, const float* W2, int ldw, int K, int Ndst, const float* gk, bf16_t* WT, int map, int item, LAS float* scr, int lane) {
    const int nblk = Ndst / 32, kb = item / nblk, nb = item % nblk, dstrow0 = 32 * nb;
    const float* src = W; int col0 = dstrow0;
    if (map == 1) {
        const int pn = nb >> 3, j = nb & 7, bj = j >> 2, wc = j & 3, kind = pn >> 1, zc = 256 * pn + 64 * wc + 32 * bj;
        if (kind == 1) col0 = 1024 + (zc - 512);
        else if (kind == 2) col0 = 512 + (dstrow0 - 1024);
        else if (kind == 3) col0 = 1536 + (zc - 1536);
    } else if (map == 2) {
        const int pn = nb >> 3, j = nb & 7, bj = j >> 2;
        col0 = 128 * pn + 32 * (j & 3); src = bj ? W2 : W;
    }
    transpose_item(src, ldw, col0, gk, WT, K, dstrow0, 64 * kb, scr, lane);
}


__device__ __forceinline__ void ph_gmlp_simple(LAS unsigned char* lds, bf16_t* Z, const float* LNP, const float* ln_g, const float* ln_b, const float* wsp, const float* bsp, int tid, int G) {
    LAS float* vn = (LAS float*)lds;
    for (int item = blockIdx.x; item < (M / 128) * 8; item += G) {
        const int chunk = item >> 3, g = item & 7, m0 = chunk * 128;
        for (int idx = tid; idx < 128 * 64; idx += NWAVES * 64) {
            const int s = idx >> 6, c = idx & 63; const size_t row = m0 + s;
            float s1 = 0.f, s2 = 0.f;
            for (int k = 0; k < 8; ++k) { s1 += LNP[(row * 8 + k) * 2]; s2 += LNP[(row * 8 + k) * 2 + 1]; }
            const float mean = s1 * (1.f / 512.f), var = s2 * (1.f / 512.f) - mean * mean, rstd = rsqrtf(var + EPS);
            const float gv = bf2f(Z[row * EV_N + 1024 + 64 * g + c]);
            vn[idx] = (gv - mean) * rstd * ln_g[64 * g + c] + ln_b[64 * g + c];
        }
        __syncthreads();
        for (int idx = tid; idx < 128 * 64; idx += NWAVES * 64) {
            const int t = idx >> 6, c = idx & 63; const size_t row = m0 + t;
            float a = bsp[g * 128 + t];
            const float* wr = wsp + ((size_t)g * 128 + t) * 128;
            for (int s2 = 0; s2 <= t; ++s2) a += wr[s2] * vn[s2 * 64 + c];
            const float gu = bf2f(Z[row * EV_N + 64 * g + c]);
            Z[row * EV_N + 64 * g + c] = (bf16_t)f2bf(gu * a);
        }
        __syncthreads();
    }
}
__device__ __forceinline__ void ph_attn_simple(bf16_t* Z, int gw, int NGW, int lane) {
    for (int wv = gw; wv < M * 8; wv += NGW) {
        const int m = wv >> 3, h = wv & 7, t = m & (SEQ - 1), mb = m - t;
        const float q = bf2f(Z[(size_t)m * EV_N + 512 + 64 * h + lane]);
        float ms[3], ls[3], os[3];
#pragma unroll
        for (int r = 0; r < 3; ++r) {
            const int dil = (r == 0) ? 1 : (r == 1) ? 4 : 16;
            float mx = -1e30f, l = 0.f, o = 0.f;
            for (int j = 0; j <= 128; ++j) {
                const int tk = t - j * dil; if (tk < 0) break;
                const size_t kr = (size_t)(mb + tk) * EV_N;
                float sc = q * bf2f(Z[kr + 1536 + 64 * h + lane]);
#pragma unroll
                for (int o2 = 1; o2 < 64; o2 <<= 1) sc += __shfl_xor(sc, o2);
                const float mn = fmaxf(mx, sc), al = __expf(mx - mn), p = __expf(sc - mn);
                l = l * al + p; o = o * al + p * bf2f(Z[kr + 2048 + 64 * h + lane]); mx = mn;
            }
            ms[r] = mx; ls[r] = l; os[r] = o / l;
        }
        const float l0 = ms[0] + __logf(ls[0]), l1 = ms[1] + __logf(ls[1]), l2 = ms[2] + __logf(ls[2]);
        const float mm = fmaxf(l0, fmaxf(l1, l2)), e0 = __expf(l0 - mm), e1 = __expf(l1 - mm), e2 = __expf(l2 - mm), inv = 1.f / (e0 + e1 + e2);
        Z[(size_t)m * EV_N + 512 + 64 * h + lane] = (bf16_t)f2bf((e0 * os[0] + e1 * os[1] + e2 * os[2]) * inv);
    }
}
__device__ __forceinline__ void ph_ga_simple(const float* X, const float* RSQ, const float* gmix, const float* w_in, float* GA, int gw, int NGW, int lane) {
    for (int m = gw; m < M; m += NGW) {
        float acc[16];
#pragma unroll
        for (int j = 0; j < 16; ++j) acc[j] = 0.f;
        for (int i = 0; i < 16; ++i) {
            const int k = i * 64 + lane; const float xv = X[(size_t)m * D + k] * gmix[k];
            const f32x4* wr = (const f32x4*)(w_in + (size_t)k * OD_NSRC + 3072);
#pragma unroll
            for (int j4 = 0; j4 < 4; ++j4) { const f32x4 w = wr[j4]; acc[4 * j4] += xv * w[0]; acc[4 * j4 + 1] += xv * w[1]; acc[4 * j4 + 2] += xv * w[2]; acc[4 * j4 + 3] += xv * w[3]; }
        }
        float s = 0.f;
        for (int j = 0; j < 16; ++j) s += RSQ[(size_t)m * 16 + j];
        const float rstd = rsqrtf(s * (1.f / 1024.f) + EPS);
#pragma unroll
        for (int j = 0; j < 16; ++j) {
            float v = acc[j];
#pragma unroll
            for (int o = 1; o < 64; o <<= 1) v += __shfl_xor(v, o);
            if (lane == j) GA[(size_t)m * 16 + j] = v * rstd;
        }
    }
}
__device__ __forceinline__ void ph_gla_simple(LAS unsigned char* lds, const bf16_t* Z, const float* GA, const float* w_a2, const float* b_a, float* ORAW, int tid, int G) {
    LAS float* sa = (LAS float*)lds; LAS float* sk = sa + 256; LAS float* sq = sk + 256;
    for (int item = blockIdx.x; item < 16; item += G) {
        const int b = item >> 2, h = item & 3, v = tid;
        float S[128];
#pragma unroll
        for (int k = 0; k < 128; ++k) S[k] = 0.f;
        float wa[16]; float ba = 0.f;
#pragma unroll
        for (int j = 0; j < 16; ++j) wa[j] = 0.f;
        if (v < 128) {
#pragma unroll
            for (int j = 0; j < 16; ++j) wa[j] = w_a2[j * 512 + h * 128 + v];
            ba = b_a[h * 128 + v]; }
        for (int t = 0; t < SEQ; ++t) {
            const size_t m = (size_t)b * SEQ + t; const int buf = (t & 1) * 128;
            if (v < 128) {
                float xg = ba;
#pragma unroll
                for (int j = 0; j < 16; ++j) xg += GA[m * 16 + j] * wa[j];
                const float ls = fminf(xg, 0.f) - log1pf(__expf(-fabsf(xg)));
                sa[buf + v] = __expf(ls * (1.f / 16.f));
                sk[buf + v] = bf2f(Z[m * OD_N + 512 + 128 * h + v]);
                sq[buf + v] = bf2f(Z[m * OD_N + 128 * h + v]);
            }
            __syncthreads();
            if (v < 256) {
                const float vv = bf2f(Z[m * OD_N + 1024 + 256 * h + v]);
                float o = 0.f;
#pragma unroll
                for (int k = 0; k < 128; ++k) { S[k] = sa[buf + k] * S[k] + sk[buf + k] * vv; o += sq[buf + k] * S[k]; }
                ORAW[m * 1024 + 256 * h + v] = o;
            }
        }
        __syncthreads();
    }
}
__device__ __forceinline__ void ph_gla_post_simple(bf16_t* Z, const float* ORAW, const float* head_g, int gw, int NGW, int lane) {
    for (int wv = gw; wv < M * 4; wv += NGW) {
        const int m = wv >> 2, h = wv & 3;
        const f32x4 o = *(const f32x4*)(ORAW + (size_t)m * 1024 + 256 * h + 4 * lane);
        float ss = dot4(o);
#pragma unroll
        for (int k = 1; k < 64; k <<= 1) ss += __shfl_xor(ss, k);
        const float rstd = rsqrtf(ss * (1.f / 256.f) + EPS);
        const f32x4 hg = *(const f32x4*)(head_g + 4 * lane);
        bf16_t* sr = Z + (size_t)m * OD_N + 2048 + 256 * h + 4 * lane;
        bf16_t* dst = Z + (size_t)m * OD_N + 1024 + 256 * h + 4 * lane;
        u32x2 w; w.x = pk2(o[0] * rstd * hg[0] * bf2f(sr[0]), o[1] * rstd * hg[1] * bf2f(sr[1])); w.y = pk2(o[2] * rstd * hg[2] * bf2f(sr[2]), o[3] * rstd * hg[3] * bf2f(sr[3]));
        *(u32x2*)dst = w;
    }
}

constexpr int RING_BYTES = 131072, LDSCTL_OFF = RING_BYTES, MISC_OFF = LDSCTL_OFF + 320, LDSX_OFF = RING_BYTES + 1024, LDS_BYTES = 147456;
constexpr int NPHASE = 1 + 8 * DEPTH;
struct Args { const float* in[21]; float* out; unsigned char* ws; int ph_lo, ph_hi, li, pad; };

__global__ void __launch_bounds__(NWAVES * 64, 2) mega(Args args) {
    extern __shared__ __attribute__((aligned(16))) unsigned char lds_raw[];
    LAS unsigned char* lds = (LAS unsigned char*)lds_raw;
    volatile LAS unsigned* MISC = (volatile LAS unsigned*)(lds + MISC_OFF);
    const int G = gridDim.x;
    unsigned* ctl = (unsigned*)(args.ws + WS_CTL);
    for (int u = threadIdx.x; u < (LDS_BYTES - LDSCTL_OFF) / 4; u += NWAVES * 64) ((LAS unsigned*)(lds + LDSCTL_OFF))[u] = 0u;
    __syncthreads();
    XcdBarrier bar = xcd_barrier_post(ctl + CW_BAR + args.li * XCD_BAR_WORDS, MISC + 8);

    typedef const float* cfp_t;
    const __attribute__((address_space(4))) cfp_t* inp0 = (const __attribute__((address_space(4))) cfp_t*)__builtin_amdgcn_kernarg_segment_ptr();

    bool first = true;
    for (int ph = args.ph_lo; ph < args.ph_hi; ++ph) {
        if (ph > 0) { const int L_ = (ph - 1) >> 3, sub_ = (ph - 1) & 7; if ((L_ & 1) == 0 && (sub_ == 2 || sub_ == 3)) continue; }
        if (!first) xcd_barrier(bar);
        first = false;
        const __attribute__((address_space(4))) cfp_t* inp = inp0; asm volatile("" : "+s"(inp));
        unsigned char* ws = args.ws; asm volatile("" : "+s"(ws));
        int tid = threadIdx.x; asm volatile("" : "+v"(tid));
        const int lane = tid & 63, wave = __builtin_amdgcn_readfirstlane(tid >> 6);
        const int gw = blockIdx.x * NWAVES + wave, NGW = G * NWAVES;
        LAS float* scr = (LAS float*)(lds + wave * 16384);
        float* X = args.out; asm volatile("" : "+s"(X));
        bf16_t* XB = (bf16_t*)(ws + WS_XB); bf16_t* Z = (bf16_t*)(ws + WS_Z);
        float* RSQ = (float*)(ws + WS_RSQ); float* LNP = (float*)(ws + WS_LNP);
        float* HALO = (float*)(ws + WS_HALO); float* FIXP = (float*)(ws + WS_FIXP); float* FIXU = (float*)(ws + WS_FIXU);
        bf16_t* WGU = (bf16_t*)(ws + WS_WFFN); bf16_t* WDN = (bf16_t*)(ws + WS_WFFN + OFF_WDOWN);
        if (ph == 0) {
            constexpr int I_EVIN = 16 * (EV_N / 32), I_SQ = 16 * 32, I_ODIN = 16 * (OD_N / 32);
            constexpr int PER = I_EVIN + I_SQ + I_ODIN + I_SQ;
            for (int it = gw; it < 2 * PER; it += NGW) {
                const int e = it / PER; int r = it % PER;
                if (r < I_EVIN) { conv_item(inp[3] + (size_t)e * D * EV_N, nullptr, EV_N, D, EV_N, inp[1] + (size_t)(2 * e) * D, (bf16_t*)(ws + WS_WMIX + OFF_EVIN) + (size_t)e * EV_N * D, 1, r, scr, lane); continue; } r -= I_EVIN;
                if (r < I_SQ) { conv_item(inp[10] + (size_t)e * D * D, nullptr, D, D, D, nullptr, (bf16_t*)(ws + WS_WMIX + OFF_EVOUT) + (size_t)e * D * D, 0, r, scr, lane); continue; } r -= I_SQ;
                if (r < I_ODIN) { conv_item(inp[11] + (size_t)e * D * OD_NSRC, nullptr, OD_NSRC, D, OD_N, inp[1] + (size_t)(2 * e + 1) * D, (bf16_t*)(ws + WS_WMIX + OFF_ODIN) + (size_t)e * OD_N * D, 0, r, scr, lane); continue; } r -= I_ODIN;
                conv_item(inp[15] + (size_t)e * D * D, nullptr, D, D, D, nullptr, (bf16_t*)(ws + WS_WMIX + OFF_ODOUT) + (size_t)e * D * D, 0, r, scr, lane);
            }
            for (int m = gw; m < M; m += NGW) {
                const f32x4* xr = (const f32x4*)(inp[0] + (size_t)m * D) + lane; f32x4 v[4]; float s = 0.f;
#pragma unroll
                for (int j = 0; j < 4; ++j) { v[j] = xr[64 * j]; s += dot4(v[j]); }
#pragma unroll
                for (int o = 1; o < 64; o <<= 1) s += __shfl_xor(s, o);
                u32x2* o8 = (u32x2*)(XB + (size_t)m * D) + lane;
#pragma unroll
                for (int j = 0; j < 4; ++j) { u32x2 w; w.x = pk2(v[j][0], v[j][1]); w.y = pk2(v[j][2], v[j][3]); o8[64 * j] = w; }
                if (lane < 16) RSQ[(size_t)m * 16 + lane] = (lane == 0) ? s : 0.f;
            }
        } else {
            const int L = (ph - 1) >> 3, sub = (ph - 1) & 7, e = L >> 1; const bool even = (L & 1) == 0;
            if (sub == 0) {
                pg8::StaticOrder S;
                if (even) {
                    pg8::Gemm g{XB, (const bf16_t*)(ws + WS_WMIX + OFF_EVIN) + (size_t)e * EV_N * D, M, EV_N, D, D}; S.init(M, EV_N, G, (int)blockIdx.x);
                    EpiEvenIn E{Z, RSQ, LNP, inp[8] + e * 64, inp[9] + e * 64};
                    pg8::gemm_phase<EpiEvenIn>(lds, g, S, E, tid);
                } else {
                    pg8::Gemm g{XB, (const bf16_t*)(ws + WS_WMIX + OFF_ODIN) + (size_t)e * OD_N * D, M, OD_N, D, D}; S.init(M, OD_N, G, (int)blockIdx.x);
                    EpiOddIn E{Z, RSQ};
                    pg8::gemm_phase<EpiOddIn>(lds, g, S, E, tid);
                }
            } else if (sub == 1) {
                if (even) {
                    ph_gmlp_simple(lds, Z, LNP, inp[4] + e * 512, inp[5] + e * 512, inp[6] + (size_t)e * 8 * 128 * 128, inp[7] + e * 8 * 128, tid, G);
                    ph_attn_simple(Z, gw, NGW, lane);
                } else {
                    ph_ga_simple(X, RSQ, inp[1] + (size_t)L * D, inp[11] + (size_t)e * D * OD_NSRC, (float*)(ws + WS_GA), gw, NGW, lane);
                }
            } else if (sub == 2) {
                ph_gla_simple(lds, Z, (const float*)(ws + WS_GA), inp[12] + (size_t)e * 16 * 512, inp[13] + e * 512, (float*)(ws + WS_AUX), tid, G);
            } else if (sub == 3) {
                ph_gla_post_simple(Z, (const float*)(ws + WS_AUX), inp[14] + e * 256, gw, NGW, lane);
            } else if (sub == 4 || sub == 7) {
                if (sub == 4) {
                    constexpr int I_GU = 16 * (GU_N / 32), I_DN = (FF / 64) * 32;
                    const float* wg = inp[16] + (size_t)L * D * FF; const float* wu = inp[17] + (size_t)L * D * FF; const float* wd = inp[20] + (size_t)L * FF * D;
                    for (int it = gw; it < I_GU + I_DN; it += NGW) {
                        if (it < I_GU) conv_item(wg, wu, FF, D, GU_N, inp[2] + (size_t)L * D, WGU, 2, it, scr, lane);
                        else conv_item(wd, nullptr, D, FF, D, nullptr, WDN, 0, it - I_GU, scr, lane);
                    }
                    __syncthreads();
                }
                pg8::StaticOrder S; S.init(M, D, G, (int)blockIdx.x);
                pg8::Gemm g;
                if (sub == 7) g = pg8::Gemm{Z, WDN, M, D, FF, FF};
                else if (even) g = pg8::Gemm{Z, (const bf16_t*)(ws + WS_WMIX + OFF_EVOUT) + (size_t)e * D * D, M, D, D, EV_N};
                else g = pg8::Gemm{Z + 1024, (const bf16_t*)(ws + WS_WMIX + OFF_ODOUT) + (size_t)e * D * D, M, D, D, OD_N};
                const float* xin = (L == 0 && sub == 4) ? inp[0] : X;
                EpiRes E{xin, X, XB, RSQ};
                pg8::gemm_phase<EpiRes>(lds, g, S, E, tid);
            } else if (sub == 5) {
                pg8::StaticOrder S; S.init(M, GU_N, G, (int)blockIdx.x);
                pg8::Gemm g{XB, WGU, M, GU_N, D, D};
                EpiF1 E{Z, RSQ, inp[18] + (size_t)L * 3 * FF, inp[19] + (size_t)L * FF, HALO, FIXP, FIXU, (LAS float*)(lds + LDSX_OFF)};
                pg8::gemm_phase<EpiF1>(lds, g, S, E, tid);
            } else if (sub == 6) {
                const float* cw = inp[18] + (size_t)L * 3 * FF;
                for (int idx = blockIdx.x * (NWAVES * 64) + tid; idx < 64 * 2 * FF; idx += G * NWAVES * 64) {
                    const int pm = idx / (2 * FF), rem = idx % (2 * FF), j = rem / FF, c = rem % FF;
                    if ((pm & 15) == 0) continue;
                    const float h1 = HALO[((size_t)(pm - 1) * 2 + 1) * FF + c], h0 = HALO[((size_t)(pm - 1) * 2 + 0) * FF + c];
                    float pre = FIXP[((size_t)pm * 2 + j) * FF + c];
                    if (j == 0) pre += cw[FF + c] * h1 + cw[c] * h0; else pre += cw[c] * h1;
                    Z[(size_t)(pm * 256 + j) * FF + c] = (bf16_t)f2bf(silu_f(pre) * FIXU[((size_t)pm * 2 + j) * FF + c]);
                }
            }
        }
    }
}

extern "C" void kernel_launch(void* const* d_in, const int* in_sizes, int n_in, void* d_out, int out_size, void* d_ws, size_t ws_size, hipStream_t stream) {
    static int grid = 0;
    if (grid == 0) {
        if (n_in != 21 || out_size != M * D || ws_size < WS_END) { fprintf(stderr, "kernel_launch: unexpected shapes (n_in %d out %d ws %zu)\n", n_in, out_size, ws_size); grid = -1; return; }
        int dev = 0, cus = 0, per_cu = 0;
        hipGetDevice(&dev); hipDeviceGetAttribute(&cus, hipDeviceAttributeMultiprocessorCount, dev);
        hipFuncSetAttribute((const void*)mega, hipFuncAttributeMaxDynamicSharedMemorySize, LDS_BYTES);
        hipOccupancyMaxActiveBlocksPerMultiprocessor(&per_cu, (const void*)mega, NWAVES * 64, LDS_BYTES);
        (void)hipGetLastError();
        if (per_cu < 1) per_cu = 1;
        if (per_cu > 1) per_cu = 1;
        grid = cus * per_cu;
        fprintf(stderr, "kernel_launch: grid %d (cus %d), ws %zu\n", grid, cus, ws_size);
    }
    if (grid < 0) return;
    hipMemsetAsync((char*)d_ws + WS_CTL, 0, CTL_ZERO_BYTES, stream);
    Args a{};
    for (int i = 0; i < 21; ++i) a.in[i] = (const float*)d_in[i];
    a.out = (float*)d_out; a.ws = (unsigned char*)d_ws;
    a.ph_lo = 0; a.ph_hi = NPHASE; a.li = 0;
    void* kargs[] = {&a};
    hipError_t le = hipLaunchCooperativeKernel((const void*)mega, dim3(grid), dim3(NWAVES * 64), kargs, LDS_BYTES, stream);
    if (le != hipSuccess) fprintf(stderr, "cooperative launch failed: %s\n", hipGetErrorString(le));
}
```

```cpp
#include <hip/hip_runtime.h>
#include <cstdio>
#include <cstdint>

#define LAS __attribute__((address_space(3)))
#define GAS __attribute__((address_space(1)))
typedef unsigned short bf16_t;
typedef short bf16x8 __attribute__((ext_vector_type(8)));
typedef float f32x4 __attribute__((ext_vector_type(4)));
typedef float f32x2 __attribute__((ext_vector_type(2)));
typedef unsigned u32x4 __attribute__((ext_vector_type(4)));
typedef unsigned u32x2 __attribute__((ext_vector_type(2)));

constexpr int D = 1024, BATCH = 4, SEQ = 4096, M = BATCH * SEQ, DEPTH = 4;
constexpr int EV_N = 2560, OD_N = 3072, OD_NSRC = 3088, FF = 2816, GU_N = 2 * FF;
constexpr float EPS = 1e-6f;

constexpr size_t MiB = 1u << 20;
constexpr size_t WS_CTL = 0, CTL_ZERO_BYTES = 1 * MiB;
constexpr size_t WS_RSQ = 1 * MiB;
constexpr size_t WS_LNP = 2 * MiB;
constexpr size_t WS_GA = 3 * MiB;
constexpr size_t WS_HALO = 4 * MiB;
constexpr size_t WS_FIXP = 6 * MiB;
constexpr size_t WS_FIXU = 8 * MiB;
constexpr size_t WS_SMALLW = 10 * MiB;
constexpr size_t WS_WMIX = 12 * MiB;
constexpr size_t OFF_EVIN = 0, OFF_EVOUT = 10 * MiB, OFF_ODIN = 14 * MiB, OFF_ODOUT = 26 * MiB;
constexpr size_t WS_WFFN = 42 * MiB;
constexpr size_t OFF_WDOWN = 11 * MiB;
constexpr size_t WS_XB = 60 * MiB;
constexpr size_t WS_Z = 92 * MiB;
constexpr size_t WS_AUX = 188 * MiB;
constexpr size_t WS_END = 252 * MiB;
constexpr int CW_BAR = 4096;

constexpr int NWAVES = 8;
__device__ __forceinline__ unsigned f2bf(float f) { unsigned u = __builtin_bit_cast(unsigned, f); return (u + 0x7fffu + ((u >> 16) & 1u)) >> 16; }
__device__ __forceinline__ unsigned pk2(float lo, float hi) { return f2bf(lo) | (f2bf(hi) << 16); }
__device__ __forceinline__ float bf2f(unsigned short h) { return __builtin_bit_cast(float, (unsigned)h << 16); }
typedef __bf16 bf2_t __attribute__((ext_vector_type(2)));
__device__ __forceinline__ unsigned cvt_pk_bf16(float lo, float hi) { const bf2_t r = __builtin_convertvector((f32x2){lo, hi}, bf2_t); return __builtin_bit_cast(unsigned, r); }
__device__ __forceinline__ float silu_f(float x) { return x * __builtin_amdgcn_rcpf(1.0f + __expf(-x)); }
__device__ __forceinline__ f32x2 gelu_pk(f32x2 v) {
    const f32x2 av = __builtin_elementwise_abs(v), d = av * 0.2316418882f + 1.0f;
    f32x2 t; t.x = __builtin_amdgcn_rcpf(d.x); t.y = __builtin_amdgcn_rcpf(d.y);
    f32x2 q = t * 0.5307027145f + (-0.7265760135f); q = q * t + 0.7107068705f; q = q * t + (-0.142248368f); q = q * t + 0.127414796f; q = q * t;
    const f32x2 s = (v * v) * (-0.72134752044f);
    f32x2 e; e.x = __builtin_amdgcn_exp2f(s.x); e.y = __builtin_amdgcn_exp2f(s.y);
    const f32x2 m = v * (q * e), r = v - m;
    f32x2 o; o.x = v.x < 0.f ? m.x : r.x; o.y = v.y < 0.f ? m.y : r.y; return o;
}
__device__ __forceinline__ f32x4 gelu4(f32x4 v) { f32x2 a = gelu_pk((f32x2){v[0], v[1]}), b = gelu_pk((f32x2){v[2], v[3]}); return (f32x4){a.x, a.y, b.x, b.y}; }
__device__ __forceinline__ float sum4(f32x4 v) { return (v[0] + v[1]) + (v[2] + v[3]); }
__device__ __forceinline__ float dot4(f32x4 v) { return (v[0] * v[0] + v[1] * v[1]) + (v[2] * v[2] + v[3] * v[3]); }
__device__ __forceinline__ u32x4 pack8(f32x4 a, f32x4 b) { u32x4 w; w.x = cvt_pk_bf16(a[0], a[1]); w.y = cvt_pk_bf16(a[2], a[3]); w.z = cvt_pk_bf16(b[0], b[1]); w.w = cvt_pk_bf16(b[2], b[3]); return w; }

namespace pg8 {
constexpr int BM = 256, BK = 64, HALF = 128, HTB = HALF * BK * 2, STAGE_BYTES = 8 * HTB, NXCD = 8, WGM = 8;
__host__ __device__ __forceinline__ int lds_byte(int r, int c) { const int st = (r >> 4) * 2 + (c >> 5), rr = r & 15, cc = c & 31, ob = rr * 64 + cc * 2; return st * 1024 + (ob ^ (((ob >> 9) & 1) << 5)); }
__host__ __device__ __forceinline__ void stage_rc(int b, int& R, int& C) { const int st = b / 1024, sb = b % 1024, swz = sb ^ (((sb >> 9) & 1) << 5); R = (st >> 1) * 16 + swz / 64; C = (st & 1) * 32 + (swz % 64) / 2; }
__host__ __device__ __forceinline__ int perm32(int rho) { const int n = rho >> 4, i = rho & 15; return 8 * (i >> 2) + 4 * n + (i & 3); }
struct Unit { int pm, pn; };
struct Gemm { const bf16_t* A; const bf16_t* Bt; int M, N, K, lda; };
struct StaticOrder {
    int nM, nN, nwg, G, c;
    __device__ void init(int M_, int N_, int G_, int c_) { nM = M_ / BM; nN = N_ / BM; nwg = nM * nN; G = G_; c = c_; }
    __device__ bool next(int i, Unit& u) const {
        const long L = (long)i * G + c; if (L >= nwg) return false;
        int wgid = (int)L; { const int q = nwg / NXCD, r = nwg % NXCD, xcd = wgid % NXCD, off = wgid / NXCD; wgid = (xcd < r ? xcd * (q + 1) : r * (q + 1) + (xcd - r) * q) + off; }
        const int nig = WGM * nN, gid = wgid / nig, fm = gid * WGM, gsz = (nM - fm) < WGM ? (nM - fm) : WGM;
        u.pm = fm + ((wgid % nig) % gsz); u.pn = (wgid % nig) / gsz; return true;
    }
};
template <class Epi>
__device__ __forceinline__ void gemm_phase(LAS unsigned char* lds, const Gemm g, const StaticOrder& S, const Epi& E, const int tid) {
    const int wid = __builtin_amdgcn_readfirstlane(tid >> 6), lane = tid & 63, wr = wid >> 2, wc = wid & 3, fr = lane & 15, fq = lane >> 4;
    const int K = g.K, nt = K / BK, lda = g.lda;
    unsigned voffA[2], voffB[2];
#pragma unroll
    for (int i = 0; i < 2; ++i) { int R, C; stage_rc(tid * 16 + i * 8192, R, C); const int Rb = (R & ~31) + perm32(R & 31);
        voffA[i] = (unsigned)(R * lda + C) * 2u; voffB[i] = (unsigned)(Rb * K + C) * 2u; }
    const size_t kstep = (size_t)(BK * 2);
    const size_t hstepA = (size_t)HALF * lda * 2, hstepB = (size_t)HALF * K * 2;
    const size_t tstepA = 2 * hstepA, tstepB = 2 * hstepB;
    const unsigned ldsw = (unsigned)wid * 1024u;
    const int aoff = lds_byte(wr * 64 + fr, fq * 8), boff = lds_byte(wc * 32 + fr, fq * 8);
#define PG8_SA(b, h) (((b) * 2 + (h)) * HTB)
#define PG8_SB(b, h) ((4 + (b) * 2 + (h)) * HTB)
#define PG8_STAGE(bufoff, gbase, voff) do { _Pragma("unroll") for (int _i = 0; _i < 2; ++_i) \
        __builtin_amdgcn_global_load_lds((const unsigned*)((const char*)(gbase) + (voff)[_i]), (LAS unsigned*)(lds + (bufoff) + ldsw + _i * 8192), 16, 0, 0); } while (0)
#define PG8_LDA(dst, b, h) do { _Pragma("unroll") for (int m = 0; m < 4; ++m) _Pragma("unroll") for (int k = 0; k < 2; ++k) dst[m][k] = *(const LAS bf16x8*)(lds + PG8_SA(b, h) + aoff + m * 2048 + k * 1024); } while (0)
#define PG8_LDB(dst, b, h) do { _Pragma("unroll") for (int n = 0; n < 2; ++n) _Pragma("unroll") for (int k = 0; k < 2; ++k) dst[n][k] = *(const LAS bf16x8*)(lds + PG8_SB(b, h) + boff + n * 2048 + k * 1024); } while (0)
#define PG8_MMA(ai, bj, At, Bt) do { __builtin_amdgcn_s_setprio(1); _Pragma("unroll") for (int m = 0; m < 4; ++m) _Pragma("unroll") for (int n = 0; n < 2; ++n) _Pragma("unroll") for (int k = 0; k < 2; ++k) \
        acc[ai][bj][m][n] = __builtin_amdgcn_mfma_f32_16x16x32_bf16(Bt[n][k], At[m][k], acc[ai][bj][m][n], 0, 0, 0); __builtin_amdgcn_s_setprio(0); } while (0)
#define PG8_WAIT_V(n) asm volatile("s_waitcnt vmcnt(" #n ")" ::: "memory")
#define PG8_WAIT_L(n) asm volatile("s_waitcnt lgkmcnt(" #n ")" ::: "memory")
#define PG8_BAR __builtin_amdgcn_s_barrier()
#define PG8_SCHED __builtin_amdgcn_sched_barrier(0)
    Unit cur, nxt; int ui = 0;
    if (!S.next(0, cur)) return;
    f32x4 acc[2][2][4][2];
#pragma unroll
    for (int a = 0; a < 2; ++a)
#pragma unroll
        for (int b = 0; b < 2; ++b)
#pragma unroll
            for (int m = 0; m < 4; ++m)
#pragma unroll
                for (int n = 0; n < 2; ++n) acc[a][b][m][n] = (f32x4){0.f, 0.f, 0.f, 0.f};
    bf16x8 At[4][2], B0[2][2], B1[2][2];
    const char* cA = (const char*)g.A + (size_t)cur.pm * tstepA; const char* cB = (const char*)g.Bt + (size_t)cur.pn * tstepB;
    PG8_STAGE(PG8_SB(0, 0), cB, voffB); PG8_STAGE(PG8_SB(0, 1), cB + hstepB, voffB); PG8_STAGE(PG8_SA(0, 0), cA, voffA); PG8_STAGE(PG8_SA(0, 1), cA + hstepA, voffA);
    if (wr == 1) PG8_BAR;
    PG8_WAIT_V(2); PG8_BAR;
    PG8_STAGE(PG8_SB(1, 0), cB + kstep, voffB); PG8_STAGE(PG8_SA(1, 0), cA + kstep, voffA); PG8_STAGE(PG8_SB(1, 1), cB + hstepB + kstep, voffB);
    PG8_WAIT_V(6); PG8_BAR;
    for (;;) {
        const bool has_next = S.next(ui + 1, nxt);
        const char* nA = has_next ? (const char*)g.A + (size_t)nxt.pm * tstepA : cA; const char* nB = has_next ? (const char*)g.Bt + (size_t)nxt.pn * tstepB : cB;
        for (int t = 0; t < nt; t += 2) {
            const bool last = (t == nt - 2);
            const char* a1 = cA + (size_t)(t + 1) * kstep;
            const char* a2 = last ? nA : cA + (size_t)(t + 2) * kstep; const char* b2 = last ? nB : cB + (size_t)(t + 2) * kstep;
            const char* a3 = a2 + kstep; const char* b3 = b2 + kstep;
            PG8_LDB(B0, 0, 0); PG8_LDB(B1, 0, 1); PG8_SCHED; PG8_LDA(At, 0, 0); PG8_STAGE(PG8_SA(1, 1), a1 + hstepA, voffA);
            PG8_WAIT_V(8); PG8_WAIT_L(0); PG8_BAR; PG8_MMA(0, 0, At, B0); PG8_MMA(0, 1, At, B1); PG8_BAR; PG8_SCHED;
            PG8_LDA(At, 0, 1); PG8_STAGE(PG8_SB(0, 0), b2, voffB); PG8_STAGE(PG8_SB(0, 1), b2 + hstepB, voffB); PG8_STAGE(PG8_SA(0, 0), a2, voffA);
            PG8_WAIT_V(8); PG8_WAIT_L(0); PG8_BAR; PG8_MMA(1, 0, At, B0); PG8_MMA(1, 1, At, B1); PG8_BAR; PG8_SCHED;
            PG8_LDB(B0, 1, 0); PG8_LDB(B1, 1, 1); PG8_SCHED; PG8_LDA(At, 1, 0); PG8_STAGE(PG8_SA(0, 1), a2 + hstepA, voffA);
            PG8_WAIT_V(8); PG8_WAIT_L(0); PG8_BAR; PG8_MMA(0, 0, At, B0); PG8_MMA(0, 1, At, B1); PG8_BAR; PG8_SCHED;
            PG8_LDA(At, 1, 1); PG8_STAGE(PG8_SB(1, 0), b3, voffB); PG8_STAGE(PG8_SB(1, 1), b3 + hstepB, voffB); PG8_STAGE(PG8_SA(1, 0), a3, voffA);
            PG8_WAIT_V(8); PG8_WAIT_L(0); PG8_BAR; PG8_MMA(1, 0, At, B0); PG8_MMA(1, 1, At, B1); PG8_BAR; PG8_SCHED;
        }
        if (wr == 0) PG8_BAR;
        E(acc, cur, wr, wc, fr, fq);
        if (!has_next) break;
#pragma unroll
        for (int a = 0; a < 2; ++a)
#pragma unroll
            for (int b = 0; b < 2; ++b)
#pragma unroll
                for (int m = 0; m < 4; ++m)
#pragma unroll
                    for (int n = 0; n < 2; ++n) acc[a][b][m][n] = (f32x4){0.f, 0.f, 0.f, 0.f};
        cur = nxt; cA = nA; cB = nB; ++ui;
        if (wr == 1) PG8_BAR;
    }
    PG8_WAIT_V(0);
    PG8_BAR;
#undef PG8_SA
#undef PG8_SB
#undef PG8_STAGE
#undef PG8_LDA
#undef PG8_LDB
#undef PG8_MMA
#undef PG8_WAIT_V
#undef PG8_WAIT_L
#undef PG8_BAR
#undef PG8_SCHED
}
}
using pg8::Unit;

__device__ __forceinline__ void row_rstd(const float* rsq, int rowb, int fq, float (&rs)[2][4]) {
#pragma unroll
    for (int ai = 0; ai < 2; ++ai)
#pragma unroll
        for (int m = 0; m < 4; ++m) {
            const int row = rowb + ai * 128 + m * 16;
            const f32x4 p = *(const f32x4*)(rsq + (size_t)row * 16 + 4 * fq);
            float s = sum4(p); s += __shfl_xor(s, 16); s += __shfl_xor(s, 32);
            rs[ai][m] = rsqrtf(s * (1.0f / 1024.0f) + EPS);
        }
}

struct EpiEvenIn {
    bf16_t* Z; const float* rsq; float* lnp; const float* qg; const float* kg;
    __device__ __forceinline__ void operator()(const f32x4 (&acc)[2][2][4][2], const Unit& u, int wr, int wc, int fr, int fq) const {
        asm volatile("" : "+v"(fr), "+v"(fq));
        const int rowb = u.pm * 256 + wr * 64 + fr, kind = u.pn >> 1;
        float rs[2][4]; row_rstd(rsq, rowb, fq, rs);
        if (kind == 1 || kind == 3) {
            const float* g = (kind == 1) ? qg : kg; const float sc = (kind == 1) ? 0.125f : 1.0f;
            f32x4 gv[2][2];
#pragma unroll
            for (int bj = 0; bj < 2; ++bj)
#pragma unroll
                for (int n = 0; n < 2; ++n) gv[bj][n] = *(const f32x4*)(g + 32 * bj + 8 * fq + 4 * n) * sc;
#pragma unroll
            for (int ai = 0; ai < 2; ++ai)
#pragma unroll
                for (int m = 0; m < 4; ++m) {
                    float ss = 0.f;
#pragma unroll
                    for (int bj = 0; bj < 2; ++bj)
#pragma unroll
                        for (int n = 0; n < 2; ++n) ss += dot4(acc[ai][bj][m][n]);
                    ss += __shfl_xor(ss, 16); ss += __shfl_xor(ss, 32);
                    const float r = rs[ai][m], rh = rsqrtf(ss * r * r * (1.0f / 64.0f) + EPS) * r;
                    bf16_t* rowp = Z + (size_t)(rowb + ai * 128 + m * 16) * EV_N + u.pn * 256 + 64 * wc + 8 * fq;
#pragma unroll
                    for (int bj = 0; bj < 2; ++bj) *(u32x4*)(rowp + 32 * bj) = pack8(acc[ai][bj][m][0] * rh * gv[bj][0], acc[ai][bj][m][1] * rh * gv[bj][1]);
                }
        } else {
#pragma unroll
            for (int ai = 0; ai < 2; ++ai)
#pragma unroll
                for (int m = 0; m < 4; ++m) {
                    const float r = rs[ai][m]; const int row = rowb + ai * 128 + m * 16;
                    bf16_t* rowp = Z + (size_t)row * EV_N + u.pn * 256 + 32 * wc + 8 * fq;
                    float s1 = 0.f, s2 = 0.f;
#pragma unroll
                    for (int bj = 0; bj < 2; ++bj) {
                        f32x4 v0 = acc[ai][bj][m][0] * r, v1 = acc[ai][bj][m][1] * r;
                        if (kind != 4) { v0 = gelu4(v0); v1 = gelu4(v1); }
                        if (kind == 2) { s1 += sum4(v0) + sum4(v1); s2 += dot4(v0) + dot4(v1); }
                        *(u32x4*)(rowp + 128 * bj) = pack8(v0, v1);
                    }
                    if (kind == 2) {
                        s1 += __shfl_xor(s1, 16); s1 += __shfl_xor(s1, 32); s2 += __shfl_xor(s2, 16); s2 += __shfl_xor(s2, 32);
                        if (fq == 0) *(f32x2*)(lnp + ((size_t)row * 8 + (u.pn & 1) * 4 + wc) * 2) = (f32x2){s1, s2};
                    }
                }
        }
    }
};

struct EpiOddIn {
    bf16_t* Z; const float* rsq;
    __device__ __forceinline__ void operator()(const f32x4 (&acc)[2][2][4][2], const Unit& u, int wr, int wc, int fr, int fq) const {
        asm volatile("" : "+v"(fr), "+v"(fq));
        const int rowb = u.pm * 256 + wr * 64 + fr;
        float rs[2][4]; row_rstd(rsq, rowb, fq, rs);
        const float sc = (u.pn < 2) ? 0.08838834764831845f : 1.0f; const bool act = (u.pn >= 8);
#pragma unroll
        for (int ai = 0; ai < 2; ++ai)
#pragma unroll
            for (int m = 0; m < 4; ++m) {
                const float r = rs[ai][m] * sc;
                bf16_t* rowp = Z + (size_t)(rowb + ai * 128 + m * 16) * OD_N + u.pn * 256 + 32 * wc + 8 * fq;
#pragma unroll
                for (int bj = 0; bj < 2; ++bj) {
                    f32x4 v0 = acc[ai][bj][m][0] * r, v1 = acc[ai][bj][m][1] * r;
                    if (act) {
#pragma unroll
                        for (int e = 0; e < 4; ++e) { v0[e] = silu_f(v0[e]); v1[e] = silu_f(v1[e]); }
                    }
                    *(u32x4*)(rowp + 128 * bj) = pack8(v0, v1);
                }
            }
    }
};

struct EpiRes {
    const float* xin; float* xout; bf16_t* xb; float* rsq;
    __device__ __forceinline__ void operator()(const f32x4 (&acc)[2][2][4][2], const Unit& u, int wr, int wc, int fr, int fq) const {
        asm volatile("" : "+v"(fr), "+v"(fq));
        const int rowb = u.pm * 256 + wr * 64 + fr;
#pragma unroll
        for (int ai = 0; ai < 2; ++ai)
#pragma unroll
            for (int m = 0; m < 4; ++m) {
                const int row = rowb + ai * 128 + m * 16; const size_t off = (size_t)row * D + u.pn * 256 + 32 * wc + 8 * fq;
                float ss = 0.f;
#pragma unroll
                for (int bj = 0; bj < 2; ++bj) {
                    const f32x4 o0 = *(const f32x4*)(xin + off + 128 * bj) + acc[ai][bj][m][0], o1 = *(const f32x4*)(xin + off + 128 * bj + 4) + acc[ai][bj][m][1];
                    *(f32x4*)(xout + off + 128 * bj) = o0; *(f32x4*)(xout + off + 128 * bj + 4) = o1;
                    *(u32x4*)(xb + off + 128 * bj) = pack8(o0, o1);
                    ss += dot4(o0) + dot4(o1);
                }
                ss += __shfl_xor(ss, 16); ss += __shfl_xor(ss, 32);
                if (fq == 0) rsq[(size_t)row * 16 + u.pn * 4 + wc] = ss;
            }
    }
};

#define DPP_MOV(old, src, ctrl, bc) __builtin_bit_cast(float, __builtin_amdgcn_update_dpp(__builtin_bit_cast(int, (float)(old)), __builtin_bit_cast(int, (float)(src)), (ctrl), 0xf, 0xf, (bc)))

struct EpiF1 {
    bf16_t* H; const float* rsq; const float* cw; const float* cb; float* halo; float* fixp; float* fixu; LAS float* ldsx;
    __device__ __forceinline__ void operator()(const f32x4 (&acc)[2][2][4][2], const Unit& u, int wr, int wc, int fr, int fq) const {
        asm volatile("" : "+v"(fr), "+v"(fq));
        const int rowb = u.pm * 256 + wr * 64 + fr, ch0 = u.pn * 128 + 32 * wc + 8 * fq, lc = 32 * wc + 8 * fq;
        float rs[2][4]; row_rstd(rsq, rowb, fq, rs);
        f32x4 w0[2], w1[2], w2[2], bb[2];
#pragma unroll
        for (int n = 0; n < 2; ++n) { w0[n] = *(const f32x4*)(cw + ch0 + 4 * n); w1[n] = *(const f32x4*)(cw + FF + ch0 + 4 * n); w2[n] = *(const f32x4*)(cw + 2 * FF + ch0 + 4 * n); bb[n] = *(const f32x4*)(cb + ch0 + 4 * n); }
        if (fr >= 14) {
#pragma unroll
            for (int ai = 0; ai < 2; ++ai)
#pragma unroll
                for (int n = 0; n < 2; ++n) {
                    const f32x4 gvl = acc[ai][0][3][n] * rs[ai][3];
                    *(LAS f32x4*)(ldsx + ((ai * 2 + wr) * 2 + (fr - 14)) * 128 + lc + 4 * n) = gvl;
                    if (ai == 1 && wr == 1) *(f32x4*)(halo + ((size_t)u.pm * 2 + (fr - 14)) * FF + ch0 + 4 * n) = gvl;
                }
        }
        asm volatile("s_waitcnt lgkmcnt(0)" ::: "memory"); __builtin_amdgcn_s_barrier(); asm volatile("" ::: "memory");
        const bool fix = (u.pm & 15) != 0;
#pragma unroll
        for (int ai = 0; ai < 2; ++ai) {
            const int blk = ai * 2 + wr;
            f32x4 pv[2];
#pragma unroll
            for (int n = 0; n < 2; ++n) {
                pv[n] = (f32x4){0.f, 0.f, 0.f, 0.f};
                if (blk > 0 && fr >= 14) pv[n] = *(const LAS f32x4*)(ldsx + ((blk - 1) * 2 + (fr - 14)) * 128 + lc + 4 * n);
            }
#pragma unroll
            for (int m = 0; m < 4; ++m) {
                const float r = rs[ai][m]; const int row = rowb + ai * 128 + m * 16;
                f32x4 hv[2], pre[2], upv[2], cur[2];
#pragma unroll
                for (int n = 0; n < 2; ++n) {
                    cur[n] = acc[ai][0][m][n] * r; upv[n] = acc[ai][1][m][n] * r;
#pragma unroll
                    for (int e = 0; e < 4; ++e) {
                        const float c = cur[n][e], p = pv[n][e];
                        const float t1 = DPP_MOV(0.f, p, 0x10F, true);
                        const float g1 = DPP_MOV(t1, c, 0x111, false);
                        const float t2 = DPP_MOV(0.f, p, 0x10E, true);
                        const float g2 = DPP_MOV(t2, c, 0x112, false);
                        const float pr = bb[n][e] + w2[n][e] * c + w1[n][e] * g1 + w0[n][e] * g2;
                        pre[n][e] = pr; hv[n][e] = silu_f(pr) * upv[n][e];
                    }
                }
                *(u32x4*)(H + (size_t)row * FF + ch0) = pack8(hv[0], hv[1]);
                if (fix && blk == 0 && m == 0 && fr < 2) {
#pragma unroll
                    for (int n = 0; n < 2; ++n) { *(f32x4*)(fixp + ((size_t)u.pm * 2 + fr) * FF + ch0 + 4 * n) = pre[n]; *(f32x4*)(fixu + ((size_t)u.pm * 2 + fr) * FF + ch0 + 4 * n) = upv[n]; }
                }
                pv[0] = cur[0]; pv[1] = cur[1];
            }
        }
    }
};

#define XB_TMO      128
#define XB_XCNT(j)  (256  + 64 * (j))
#define XB_XSUB(j)  (1280 + 64 * (j))
#define XB_XGEN(j)  (2304 + 64 * (j))
#define XB_TOP      3328
#define XB_TOPGEN   3392
#define XCD_BAR_WORDS 3456
#define XB_SPIN_CAP (1u << 18)
__device__ __forceinline__ unsigned xb_ld(unsigned* p)              { return __hip_atomic_load(p, __ATOMIC_RELAXED, __HIP_MEMORY_SCOPE_AGENT); }
__device__ __forceinline__ unsigned xb_add(unsigned* p, unsigned v) { return __hip_atomic_fetch_add(p, v, __ATOMIC_RELAXED, __HIP_MEMORY_SCOPE_AGENT); }
__device__ __forceinline__ unsigned xb_xcc_id() { return (unsigned)__builtin_amdgcn_s_getreg((3 << 11) | 20) & 0xFu; }
#define XB_SPIN(cond, bar) do { unsigned _sp = 0; while (cond) { __builtin_amdgcn_s_sleep(1); \
    if ((++_sp & 255u) == 0u) { if (xb_ld(&(bar)[XB_TMO])) break; if (_sp > XB_SPIN_CAP) { atomicAdd(&(bar)[XB_TMO], 1u); break; } } } } while (0)
struct XcdBarrier { unsigned* bar; unsigned x; volatile LAS unsigned* st; };
__device__ __forceinline__ XcdBarrier xcd_barrier_post(unsigned* bar, volatile LAS unsigned* st) {
    XcdBarrier b; b.bar = bar; b.x = xb_xcc_id(); b.st = st;
    if (threadIdx.x == 0) (void)xb_add(&bar[XB_XCNT(b.x)], 1u);
    return b;
}
__device__ __forceinline__ void xcd_barrier_complete(unsigned* bar, unsigned x, unsigned& nloc, unsigned& nx) {
    const unsigned G = gridDim.x * gridDim.y * gridDim.z;
    unsigned sum, cnt, mine, sp = 0u;
    for (;;) {
        sum = 0u; cnt = 0u; mine = 0u;
#pragma unroll
        for (unsigned j = 0; j < 16; ++j) { const unsigned c = xb_ld(&bar[XB_XCNT(j)]); sum += c; cnt += (c > 0u) ? 1u : 0u; mine = (j == x) ? c : mine; }
        if (sum == G) break;
        __builtin_amdgcn_s_sleep(1);
        if ((++sp & 255u) == 0u) { if (xb_ld(&bar[XB_TMO])) break; if (sp > XB_SPIN_CAP) { atomicAdd(&bar[XB_TMO], 1u); break; } }
    }
    nloc = mine > 0u ? mine : 1u; nx = cnt > 0u ? cnt : 1u;
}
__device__ __forceinline__ void xcd_barrier(const XcdBarrier& b) {
    asm volatile("s_waitcnt vmcnt(0)" ::: "memory");
    __syncthreads();
    if (threadIdx.x == 0) {
        unsigned* bar = b.bar;
        __builtin_amdgcn_s_waitcnt(0);
        unsigned nloc = b.st[0], nx = b.st[1];
        if (nloc == 0u) { xcd_barrier_complete(bar, b.x, nloc, nx); b.st[0] = nloc; b.st[1] = nx; }
        const unsigned old = xb_add(&bar[XB_XSUB(b.x)], 1u);
        const unsigned gen = old / nloc;
        if (old + 1u == (gen + 1u) * nloc) {
            __builtin_amdgcn_fence(__ATOMIC_RELEASE, "agent");
            asm volatile("s_waitcnt vmcnt(0)" ::: "memory");
            const unsigned og = xb_add(&bar[XB_TOP], 1u);
            const unsigned tg = og / nx;
            if (og + 1u == (tg + 1u) * nx) xb_add(&bar[XB_TOPGEN], 1u);
            else XB_SPIN(xb_ld(&bar[XB_TOPGEN]) == tg, bar);
            __builtin_amdgcn_fence(__ATOMIC_ACQUIRE, "agent");
            xb_add(&bar[XB_XGEN(b.x)], 1u);
            asm volatile("s_waitcnt vmcnt(0)" ::: "memory");
        } else {
            XB_SPIN(xb_ld(&bar[XB_XGEN(b.x)]) == gen, bar);
            __builtin_amdgcn_fence(__ATOMIC_ACQUIRE, "agent");
            asm volatile("s_waitcnt vmcnt(0)" ::: "memory");
        }
    }
    __syncthreads();
}

__device__ __forceinline__ void transpose_item(const float* W, int ldw, int col0, const float* gk, bf16_t* WT, int K, int dstrow0, int k0, LAS float* scr, int lane) {
#pragma unroll 8
    for (int i = 0; i < 32; ++i) { const int kk = 2 * i + (lane >> 5); float v = W[(size_t)(k0 + kk) * ldw + col0 + (lane & 31)]; if (gk) v *= gk[k0 + kk]; scr[kk * 33 + (lane & 31)] = v; }
    asm volatile("s_waitcnt lgkmcnt(0)" ::: "memory");
    const int c = lane & 7;
#pragma unroll
    for (int j = 0; j < 4; ++j) { const int n = (lane >> 3) + 8 * j; const LAS float* s = scr + (8 * c) * 33 + n;
        u32x4 o; o.x = pk2(s[0 * 33], s[1 * 33]); o.y = pk2(s[2 * 33], s[3 * 33]); o.z = pk2(s[4 * 33], s[5 * 33]); o.w = pk2(s[6 * 33], s[7 * 33]);
        *(u32x4*)(WT + (size_t)(dstrow0 + n) * K + k0 + 8 * c) = o; }
    asm volatile("s_waitcnt lgkmcnt(0)" ::: "memory");
}
__device__ __forceinline__ void conv_item(const float* W, const float* W2, int ldw, int K, int Ndst, const float* gk, bf16_t* WT, int map, int item, LAS float* scr, int lane) {
    const int nblk = Ndst / 32, kb = item / nblk, nb = item % nblk, dstrow0 = 32 * nb;
    const float* src = W; int col0 = dstrow0;
    if (map == 1) {
        const int pn = nb >> 3, j = nb & 7, bj = j >> 2, wc = j & 3, kind = pn >> 1, zc = 256 * pn + 64 * wc + 32 * bj;
        if (kind == 1) col0 = 1024 + (zc - 512);
        else if (kind == 2) col0 = 512 + (dstrow0 - 1024);
        else if (kind == 3) col0 = 1536 + (zc - 1536);
    } else if (map == 2) {
        const int pn = nb >> 3, j = nb & 7, bj = j >> 2;
        col0 = 128 * pn + 32 * (j & 3); src = bj ? W2 : W;
    }
    transpose_item(src, ldw, col0, gk, WT, K, dstrow0, 64 * kb, scr, lane);
}


__device__ __forceinline__ void ph_gmlp_simple(LAS unsigned char* lds, bf16_t* Z, const float* LNP, const float* ln_g, const float* ln_b, const float* wsp, const float* bsp, int tid, int G) {
    LAS float* vn = (LAS float*)lds;
    for (int item = blockIdx.x; item < (M / 128) * 8; item += G) {
        const int chunk = item >> 3, g = item & 7, m0 = chunk * 128;
        for (int idx = tid; idx < 128 * 64; idx += NWAVES * 64) {
            const int s = idx >> 6, c = idx & 63; const size_t row = m0 + s;
            float s1 = 0.f, s2 = 0.f;
            for (int k = 0; k < 8; ++k) { s1 += LNP[(row * 8 + k) * 2]; s2 += LNP[(row * 8 + k) * 2 + 1]; }
            const float mean = s1 * (1.f / 512.f), var = s2 * (1.f / 512.f) - mean * mean, rstd = rsqrtf(var + EPS);
            const float gv = bf2f(Z[row * EV_N + 1024 + 64 * g + c]);
            vn[idx] = (gv - mean) * rstd * ln_g[64 * g + c] + ln_b[64 * g + c];
        }
        __syncthreads();
        for (int idx = tid; idx < 128 * 64; idx += NWAVES * 64) {
            const int t = idx >> 6, c = idx & 63; const size_t row = m0 + t;
            float a = bsp[g * 128 + t];
            const float* wr = wsp + ((size_t)g * 128 + t) * 128;
            for (int s2 = 0; s2 <= t; ++s2) a += wr[s2] * vn[s2 * 64 + c];
            const float gu = bf2f(Z[row * EV_N + 64 * g + c]);
            Z[row * EV_N + 64 * g + c] = (bf16_t)f2bf(gu * a);
        }
        __syncthreads();
    }
}
__device__ __forceinline__ void ph_attn_simple(bf16_t* Z, int gw, int NGW, int lane) {
    for (int wv = gw; wv < M * 8; wv += NGW) {
        const int m = wv >> 3, h = wv & 7, t = m & (SEQ - 1), mb = m - t;
        const float q = bf2f(Z[(size_t)m * EV_N + 512 + 64 * h + lane]);
        float ms[3], ls[3], os[3];
#pragma unroll
        for (int r = 0; r < 3; ++r) {
            const int dil = (r == 0) ? 1 : (r == 1) ? 4 : 16;
            float mx = -1e30f, l = 0.f, o = 0.f;
            for (int j = 0; j <= 128; ++j) {
                const int tk = t - j * dil; if (tk < 0) break;
                const size_t kr = (size_t)(mb + tk) * EV_N;
                float sc = q * bf2f(Z[kr + 1536 + 64 * h + lane]);
#pragma unroll
                for (int o2 = 1; o2 < 64; o2 <<= 1) sc += __shfl_xor(sc, o2);
                const float mn = fmaxf(mx, sc), al = __expf(mx - mn), p = __expf(sc - mn);
                l = l * al + p; o = o * al + p * bf2f(Z[kr + 2048 + 64 * h + lane]); mx = mn;
            }
            ms[r] = mx; ls[r] = l; os[r] = o / l;
        }
        const float l0 = ms[0] + __logf(ls[0]), l1 = ms[1] + __logf(ls[1]), l2 = ms[2] + __logf(ls[2]);
        const float mm = fmaxf(l0, fmaxf(l1, l2)), e0 = __expf(l0 - mm), e1 = __expf(l1 - mm), e2 = __expf(l2 - mm), inv = 1.f / (e0 + e1 + e2);
        Z[(size_t)m * EV_N + 512 + 64 * h + lane] = (bf16_t)f2bf((e0 * os[0] + e1 * os[1] + e2 * os[2]) * inv);
    }
}
__device__ __forceinline__ void ph_ga_simple(const float* X, const float* RSQ, const float* gmix, const float* w_in, float* GA, int gw, int NGW, int lane) {
    for (int m = gw; m < M; m += NGW) {
        float acc[16];
#pragma unroll
        for (int j = 0; j < 16; ++j) acc[j] = 0.f;
        for (int i = 0; i < 16; ++i) {
            const int k = i * 64 + lane; const float xv = X[(size_t)m * D + k] * gmix[k];
            const f32x4* wr = (const f32x4*)(w_in + (size_t)k * OD_NSRC + 3072);
#pragma unroll
            for (int j4 = 0; j4 < 4; ++j4) { const f32x4 w = wr[j4]; acc[4 * j4] += xv * w[0]; acc[4 * j4 + 1] += xv * w[1]; acc[4 * j4 + 2] += xv * w[2]; acc[4 * j4 + 3] += xv * w[3]; }
        }
        float s = 0.f;
        for (int j = 0; j < 16; ++j) s += RSQ[(size_t)m * 16 + j];
        const float rstd = rsqrtf(s * (1.f / 1024.f) + EPS);
#pragma unroll
        for (int j = 0; j < 16; ++j) {
            float v = acc[j];
#pragma unroll
            for (int o = 1; o < 64; o <<= 1) v += __shfl_xor(v, o);
            if (lane == j) GA[(size_t)m * 16 + j] = v * rstd;
        }
    }
}
__device__ __forceinline__ void ph_gla_simple(LAS unsigned char* lds, const bf16_t* Z, const float* GA, const float* w_a2, const float* b_a, float* ORAW, int tid, int G) {
    LAS float* sa = (LAS float*)lds; LAS float* sk = sa + 256; LAS float* sq = sk + 256;
    for (int item = blockIdx.x; item < 16; item += G) {
        const int b = item >> 2, h = item & 3, v = tid;
        float S[128];
#pragma unroll
        for (int k = 0; k < 128; ++k) S[k] = 0.f;
        float wa[16]; float ba = 0.f;
#pragma unroll
        for (int j = 0; j < 16; ++j) wa[j] = 0.f;
        if (v < 128) {
#pragma unroll
            for (int j = 0; j < 16; ++j) wa[j] = w_a2[j * 512 + h * 128 + v];
            ba = b_a[h * 128 + v]; }
        for (int t = 0; t < SEQ; ++t) {
            const size_t m = (size_t)b * SEQ + t; const int buf = (t & 1) * 128;
            if (v < 128) {
                float xg = ba;
#pragma unroll
                for (int j = 0; j < 16; ++j) xg += GA[m * 16 + j] * wa[j];
                const float ls = fminf(xg, 0.f) - log1pf(__expf(-fabsf(xg)));
                sa[buf + v] = __expf(ls * (1.f / 16.f));
                sk[buf + v] = bf2f(Z[m * OD_N + 512 + 128 * h + v]);
                sq[buf + v] = bf2f(Z[m * OD_N + 128 * h + v]);
            }
            __syncthreads();
            if (v < 256) {
                const float vv = bf2f(Z[m * OD_N + 1024 + 256 * h + v]);
                float o = 0.f;
#pragma unroll
                for (int k = 0; k < 128; ++k) { S[k] = sa[buf + k] * S[k] + sk[buf + k] * vv; o += sq[buf + k] * S[k]; }
                ORAW[m * 1024 + 256 * h + v] = o;
            }
        }
        __syncthreads();
    }
}
__device__ __forceinline__ void ph_gla_post_simple(bf16_t* Z, const float* ORAW, const float* head_g, int gw, int NGW, int lane) {
    for (int wv = gw; wv < M * 4; wv += NGW) {
        const int m = wv >> 2, h = wv & 3;
        const f32x4 o = *(const f32x4*)(ORAW + (size_t)m * 1024 + 256 * h + 4 * lane);
        float ss = dot4(o);
#pragma unroll
        for (int k = 1; k < 64; k <<= 1) ss += __shfl_xor(ss, k);
        const float rstd = rsqrtf(ss * (1.f / 256.f) + EPS);
        const f32x4 hg = *(const f32x4*)(head_g + 4 * lane);
        bf16_t* sr = Z + (size_t)m * OD_N + 2048 + 256 * h + 4 * lane;
        bf16_t* dst = Z + (size_t)m * OD_N + 1024 + 256 * h + 4 * lane;
        u32x2 w; w.x = pk2(o[0] * rstd * hg[0] * bf2f(sr[0]), o[1] * rstd * hg[1] * bf2f(sr[1])); w.y = pk2(o[2] * rstd * hg[2] * bf2f(sr[2]), o[3] * rstd * hg[3] * bf2f(sr[3]));
        *(u32x2*)dst = w;
    }
}


typedef short s16x4 __attribute__((ext_vector_type(4)));
__device__ __forceinline__ bf16x8 tr_pair(const LAS unsigned char* p0, const LAS unsigned char* p1) {
    const s16x4 lo = __builtin_amdgcn_ds_read_tr16_b64_v4i16((LAS s16x4*)p0), hi = __builtin_amdgcn_ds_read_tr16_b64_v4i16((LAS s16x4*)p1);
    return __builtin_shufflevector(lo, hi, 0, 1, 2, 3, 4, 5, 6, 7);
}
constexpr int AT_KSTR = 144, AT_VSTR = 160, AT_VOFF = 256 * AT_KSTR;
__device__ __forceinline__ void attn_item(LAS unsigned char* lds, bf16_t* Z, const int dlog, const int idx, const bool final, bf16_t* Pout, float* Lout,
                                          const bf16_t* P1, const bf16_t* P2, const float* L1, const float* L2, const int tid) {
    const int lane = tid & 63, w = __builtin_amdgcn_readfirstlane(tid >> 6), fr = lane & 15, g = lane >> 4;
    const int nbl = 5 - dlog, bh = idx >> 5, b = bh >> 3, h = bh & 7, rn = idx & 31, r = rn >> nbl, n = rn & ((1 << nbl) - 1);
    const size_t mb = (size_t)b * SEQ;
#pragma unroll
    for (int pass = 0; pass < 4; ++pass) {
        const int row = pass * 64 + (tid >> 3), ch = tid & 7, tok = (((128 * (n - 1) + row)) << dlog) + r;
        u32x4 kv = (u32x4){0u, 0u, 0u, 0u}, vv = (u32x4){0u, 0u, 0u, 0u};
        if (tok >= 0) { const bf16_t* src = Z + (mb + tok) * EV_N + 64 * h + 8 * ch; kv = *(const u32x4*)(src + 1536); vv = *(const u32x4*)(src + 2048); }
        *(LAS u32x4*)(lds + row * AT_KSTR + 16 * ch) = kv;
        *(LAS u32x4*)(lds + AT_VOFF + row * AT_VSTR + 16 * ch) = vv;
    }
    const int tq = ((128 * n + 16 * w + fr) << dlog) + r;
    const bf16_t* qp = Z + (mb + tq) * EV_N + 512 + 64 * h;
    const bf16x8 q0 = *(const bf16x8*)(qp + 8 * g), q1 = *(const bf16x8*)(qp + 32 + 8 * g);
    __syncthreads();
    f32x4 st[9];
#pragma unroll
    for (int kt = 0; kt < 9; ++kt) {
        const LAS unsigned char* kr = lds + (16 * w + 16 * kt + fr) * AT_KSTR + 16 * g;
        const bf16x8 a0 = *(const LAS bf16x8*)kr, a1 = *(const LAS bf16x8*)(kr + 64);
        f32x4 c = (f32x4){0.f, 0.f, 0.f, 0.f};
        c = __builtin_amdgcn_mfma_f32_16x16x32_bf16(a0, q0, c, 0, 0, 0);
        c = __builtin_amdgcn_mfma_f32_16x16x32_bf16(a1, q1, c, 0, 0, 0);
        st[kt] = c;
    }
    float mx = -1e30f;
#pragma unroll
    for (int kt = 0; kt < 9; ++kt) {
        const bool tv = (n > 0) || (kt >= 8 - w);
#pragma unroll
        for (int e = 0; e < 4; ++e) {
            const int jj = 4 * g + e;
            bool ok = tv; if (kt == 0) ok = ok && (jj >= fr); if (kt == 8) ok = ok && (jj <= fr);
            const float sv = ok ? st[kt][e] : -1e30f; st[kt][e] = sv; mx = fmaxf(mx, sv);
        }
    }
    mx = fmaxf(mx, __shfl_xor(mx, 16)); mx = fmaxf(mx, __shfl_xor(mx, 32));
    float l = 0.f;
#pragma unroll
    for (int kt = 0; kt < 9; ++kt)
#pragma unroll
        for (int e = 0; e < 4; ++e) { const float p = __expf(st[kt][e] - mx); st[kt][e] = p; l += p; }
    l += __shfl_xor(l, 16); l += __shfl_xor(l, 32);
    f32x4 ot[4];
#pragma unroll
    for (int dt = 0; dt < 4; ++dt) ot[dt] = (f32x4){0.f, 0.f, 0.f, 0.f};
    const int qq = fr >> 2, pp = fr & 3;
#pragma unroll
    for (int ks2 = 0; ks2 < 5; ++ks2) {
        const int T0 = 2 * ks2, T1 = (ks2 < 4) ? 2 * ks2 + 1 : 2 * ks2;
        u32x4 pb; pb.x = cvt_pk_bf16(st[T0][0], st[T0][1]); pb.y = cvt_pk_bf16(st[T0][2], st[T0][3]);
        if (ks2 < 4) { pb.z = cvt_pk_bf16(st[T1][0], st[T1][1]); pb.w = cvt_pk_bf16(st[T1][2], st[T1][3]); } else { pb.z = 0u; pb.w = 0u; }
        const bf16x8 bfrag = __builtin_bit_cast(bf16x8, pb);
        const LAS unsigned char* v0 = lds + AT_VOFF + (16 * w + 16 * T0 + 4 * g + qq) * AT_VSTR + 8 * pp;
        const LAS unsigned char* v1 = lds + AT_VOFF + (16 * w + 16 * T1 + 4 * g + qq) * AT_VSTR + 8 * pp;
#pragma unroll
        for (int dt = 0; dt < 4; ++dt) ot[dt] = __builtin_amdgcn_mfma_f32_16x16x32_bf16(tr_pair(v0 + 32 * dt, v1 + 32 * dt), bfrag, ot[dt], 0, 0, 0);
    }
    const float inv = 1.0f / l, lse = mx + __logf(l);
    if (!final) {
        bf16_t* op = Pout + (mb + tq) * 512 + 64 * h + 4 * g;
#pragma unroll
        for (int dt = 0; dt < 4; ++dt) { u32x2 o; o.x = cvt_pk_bf16(ot[dt][0] * inv, ot[dt][1] * inv); o.y = cvt_pk_bf16(ot[dt][2] * inv, ot[dt][3] * inv); *(u32x2*)(op + 16 * dt) = o; }
        if (g == 0) Lout[(mb + tq) * 8 + h] = lse;
    } else {
        const float l1 = L1[(mb + tq) * 8 + h], l2 = L2[(mb + tq) * 8 + h];
        const float mm = fmaxf(lse, fmaxf(l1, l2)), e0 = __expf(lse - mm), e1 = __expf(l1 - mm), e2 = __expf(l2 - mm), rs = 1.0f / (e0 + e1 + e2);
        const float w0 = e0 * rs * inv, w1 = e1 * rs, w2 = e2 * rs;
        const bf16_t* p1 = P1 + (mb + tq) * 512 + 64 * h + 4 * g; const bf16_t* p2 = P2 + (mb + tq) * 512 + 64 * h + 4 * g;
        bf16_t* op = Z + (mb + tq) * EV_N + 512 + 64 * h + 4 * g;
#pragma unroll
        for (int dt = 0; dt < 4; ++dt) {
            const u32x2 a = *(const u32x2*)(p1 + 16 * dt), c = *(const u32x2*)(p2 + 16 * dt);
            const float r0 = w0 * ot[dt][0] + w1 * bf2f((unsigned short)(a.x & 0xffffu)) + w2 * bf2f((unsigned short)(c.x & 0xffffu));
            const float r1 = w0 * ot[dt][1] + w1 * bf2f((unsigned short)(a.x >> 16)) + w2 * bf2f((unsigned short)(c.x >> 16));
            const float r2 = w0 * ot[dt][2] + w1 * bf2f((unsigned short)(a.y & 0xffffu)) + w2 * bf2f((unsigned short)(c.y & 0xffffu));
            const float r3 = w0 * ot[dt][3] + w1 * bf2f((unsigned short)(a.y >> 16)) + w2 * bf2f((unsigned short)(c.y >> 16));
            u32x2 o; o.x = cvt_pk_bf16(r0, r1); o.y = cvt_pk_bf16(r2, r3); *(u32x2*)(op + 16 * dt) = o;
        }
    }
    __syncthreads();
}
constexpr int GM_STR = 160;
__device__ __forceinline__ void gmlp_item(LAS unsigned char* lds, bf16_t* Z, const float* LNP, const float* ln_g, const float* ln_b, const bf16_t* Wbf, const float* bs, const int item, const int tid) {
    const int lane = tid & 63, w = __builtin_amdgcn_readfirstlane(tid >> 6), fr = lane & 15, g4 = lane >> 4;
    const int chunk = item >> 3, g = item & 7, m0 = chunk * 128;
    {
        const int s = tid >> 2, c0 = (tid & 3) * 16; const size_t row = m0 + s;
        float s1 = 0.f, s2 = 0.f;
#pragma unroll
        for (int k = 0; k < 4; ++k) { const f32x4 p = *(const f32x4*)(LNP + row * 16 + 4 * k); s1 += p[0] + p[2]; s2 += p[1] + p[3]; }
        const float mean = s1 * (1.f / 512.f), var = s2 * (1.f / 512.f) - mean * mean, rstd = rsqrtf(var + EPS);
        const bf16_t* gp = Z + row * EV_N + 1024 + 64 * g + c0;
#pragma unroll
        for (int hh = 0; hh < 2; ++hh) {
            const u32x4 raw = *(const u32x4*)(gp + 8 * hh);
            const f32x4 la = *(const f32x4*)(ln_g + 64 * g + c0 + 8 * hh), lb = *(const f32x4*)(ln_g + 64 * g + c0 + 8 * hh + 4);
            const f32x4 ba = *(const f32x4*)(ln_b + 64 * g + c0 + 8 * hh), bb = *(const f32x4*)(ln_b + 64 * g + c0 + 8 * hh + 4);
            f32x4 x0, x1;
            x0[0] = bf2f((unsigned short)(raw.x & 0xffffu)); x0[1] = bf2f((unsigned short)(raw.x >> 16)); x0[2] = bf2f((unsigned short)(raw.y & 0xffffu)); x0[3] = bf2f((unsigned short)(raw.y >> 16));
            x1[0] = bf2f((unsigned short)(raw.z & 0xffffu)); x1[1] = bf2f((unsigned short)(raw.z >> 16)); x1[2] = bf2f((unsigned short)(raw.w & 0xffffu)); x1[3] = bf2f((unsigned short)(raw.w >> 16));
            x0 = (x0 - mean) * rstd * la + ba; x1 = (x1 - mean) * rstd * lb + bb;
            *(LAS u32x4*)(lds + s * GM_STR + (c0 + 8 * hh) * 2) = pack8(x0, x1);
        }
    }
    __syncthreads();
    f32x4 acc[4];
#pragma unroll
    for (int ct = 0; ct < 4; ++ct) acc[ct] = (f32x4){0.f, 0.f, 0.f, 0.f};
    const int t = 16 * w + fr, qq = fr >> 2, pp = fr & 3;
    const bf16_t* wrow = Wbf + ((size_t)g * 128 + t) * 128 + 8 * g4;
#pragma unroll
    for (int ks = 0; ks < 4; ++ks) {
        if (32 * ks <= 16 * w + 15) {
            const bf16x8 bfr = *(const bf16x8*)(wrow + 32 * ks);
            const LAS unsigned char* a0 = lds + (32 * ks + 8 * g4 + qq) * GM_STR + 8 * pp;
#pragma unroll
            for (int ct = 0; ct < 4; ++ct) acc[ct] = __builtin_amdgcn_mfma_f32_16x16x32_bf16(tr_pair(a0 + 32 * ct, a0 + 4 * GM_STR + 32 * ct), bfr, acc[ct], 0, 0, 0);
        }
    }
    const float bias = bs[g * 128 + t];
    bf16_t* up = Z + (size_t)(m0 + t) * EV_N + 64 * g + 4 * g4;
#pragma unroll
    for (int ct = 0; ct < 4; ++ct) {
        const u32x2 a = *(const u32x2*)(up + 16 * ct);
        u32x2 o; o.x = cvt_pk_bf16(bf2f((unsigned short)(a.x & 0xffffu)) * (acc[ct][0] + bias), bf2f((unsigned short)(a.x >> 16)) * (acc[ct][1] + bias));
        o.y = cvt_pk_bf16(bf2f((unsigned short)(a.y & 0xffffu)) * (acc[ct][2] + bias), bf2f((unsigned short)(a.y >> 16)) * (acc[ct][3] + bias));
        *(u32x2*)(up + 16 * ct) = o;
    }
    __syncthreads();
}


constexpr int GL_GAL = 0, GL_SEG = 4096, GL_A = 8192;
constexpr int G1_KSSTR = 144, G1_V = GL_A + 128 * G1_KSSTR, GL_VSTR = 544;
constexpr int G3_QSTR = 272, G3_KT = GL_A + 64 * G3_QSTR, G3_V = G3_KT + 64 * G3_QSTR, G3_SSQ = G3_V + 64 * GL_VSTR;
__device__ __forceinline__ void gla_decay(LAS unsigned char* lds, const float* GA, const float* w_a2, const float* b_a, const int h, const size_t m0, const int tid, float (&bl)[2][8], float (&tot)[2]) {
    LAS float* gal = (LAS float*)(lds + GL_GAL); LAS float* seg = (LAS float*)(lds + GL_SEG);
    const int kp = tid & 63, s8 = tid >> 6;
    if (tid < 256) *(LAS f32x4*)(gal + 4 * tid) = *(const f32x4*)(GA + m0 * 16 + 4 * tid);
    float wa[2][16], ba[2];
#pragma unroll
    for (int c = 0; c < 2; ++c) {
#pragma unroll
        for (int j = 0; j < 16; ++j) wa[c][j] = w_a2[j * 512 + 128 * h + 2 * kp + c];
        ba[c] = b_a[128 * h + 2 * kp + c]; }
    __syncthreads();
    float run[2] = {0.f, 0.f};
#pragma unroll
    for (int i = 0; i < 8; ++i) {
        const LAS f32x4* gr = (const LAS f32x4*)(gal + (8 * s8 + i) * 16);
        const f32x4 g0 = gr[0], g1 = gr[1], g2 = gr[2], g3 = gr[3];
#pragma unroll
        for (int c = 0; c < 2; ++c) {
            float x = ba[c];
#pragma unroll
            for (int j = 0; j < 4; ++j) x += g0[j] * wa[c][j] + g1[j] * wa[c][4 + j] + g2[j] * wa[c][8 + j] + g3[j] * wa[c][12 + j];
            const float ls = fminf(x, 0.f) - __logf(1.0f + __expf(-fabsf(x)));
            run[c] += ls * (1.0f / 16.0f); bl[c][i] = run[c];
        }
    }
    *(LAS f32x2*)(seg + s8 * 128 + 2 * kp) = (f32x2){run[0], run[1]};
    __syncthreads();
    float pre[2] = {0.f, 0.f}; tot[0] = 0.f; tot[1] = 0.f;
#pragma unroll
    for (int q = 0; q < 8; ++q) { const f32x2 sv = *(const LAS f32x2*)(seg + q * 128 + 2 * kp); if (q < s8) { pre[0] += sv.x; pre[1] += sv.y; } tot[0] += sv.x; tot[1] += sv.y; }
#pragma unroll
    for (int i = 0; i < 8; ++i) { bl[0][i] += pre[0]; bl[1][i] += pre[1]; }
}
__device__ __forceinline__ void gla_stage_v(LAS unsigned char* vl, const bf16_t* Z, const int h, const size_t m0, const int tid) {
#pragma unroll
    for (int p = 0; p < 4; ++p) { const int idx = p * 512 + tid, t = idx >> 5, ch = idx & 31;
        *(LAS u32x4*)(vl + t * GL_VSTR + 16 * ch) = *(const u32x4*)(Z + (m0 + t) * OD_N + 1024 + 256 * h + 8 * ch); }
}
__device__ __forceinline__ void gla_g1_item(LAS unsigned char* lds, const bf16_t* Z, const float* GA, const float* w_a2, const float* b_a, bf16_t* KVT, float* DEC, const int item, const int tid) {
    const int lane = tid & 63, w = __builtin_amdgcn_readfirstlane(tid >> 6), fr = lane & 15, g = lane >> 4;
    const int bh = item >> 6, n = item & 63, h = bh & 3; const size_t m0 = (size_t)(bh >> 2) * SEQ + 64 * n;
    float bl[2][8], tot[2];
    gla_decay(lds, GA, w_a2, b_a, h, m0, tid, bl, tot);
    const int kp = tid & 63, s8 = tid >> 6;
    {
        float ks[2][8];
#pragma unroll
        for (int i = 0; i < 8; ++i) {
            const unsigned kk = *(const unsigned*)(Z + (m0 + 8 * s8 + i) * OD_N + 512 + 128 * h + 2 * kp);
            ks[0][i] = bf2f((unsigned short)(kk & 0xffffu)) * __expf(tot[0] - bl[0][i]); ks[1][i] = bf2f((unsigned short)(kk >> 16)) * __expf(tot[1] - bl[1][i]);
        }
#pragma unroll
        for (int c = 0; c < 2; ++c)
            *(LAS u32x4*)(lds + GL_A + (2 * kp + c) * G1_KSSTR + 16 * s8) = pack8((f32x4){ks[c][0], ks[c][1], ks[c][2], ks[c][3]}, (f32x4){ks[c][4], ks[c][5], ks[c][6], ks[c][7]});
        if (s8 == 0) *(f32x2*)(DEC + (size_t)item * 128 + 2 * kp) = (f32x2){__expf(tot[0]), __expf(tot[1])};
    }
    gla_stage_v(lds + G1_V, Z, h, m0, tid);
    __syncthreads();
    const LAS unsigned char* ar = lds + GL_A + (16 * w + fr) * G1_KSSTR + 16 * g;
    const bf16x8 a0 = *(const LAS bf16x8*)ar, a1 = *(const LAS bf16x8*)(ar + 64);
    const int qq = fr >> 2, pp = fr & 3;
    const LAS unsigned char* vb = lds + G1_V + (8 * g + qq) * GL_VSTR + 8 * pp;
    bf16_t* outp = KVT + (size_t)item * 32768 + (size_t)fr * 128 + 16 * w + 4 * g;
#pragma unroll
    for (int vt = 0; vt < 16; ++vt) {
        f32x4 c = (f32x4){0.f, 0.f, 0.f, 0.f};
        c = __builtin_amdgcn_mfma_f32_16x16x32_bf16(a0, tr_pair(vb + 32 * vt, vb + 4 * GL_VSTR + 32 * vt), c, 0, 0, 0);
        c = __builtin_amdgcn_mfma_f32_16x16x32_bf16(a1, tr_pair(vb + 32 * GL_VSTR + 32 * vt, vb + 36 * GL_VSTR + 32 * vt), c, 0, 0, 0);
        u32x2 o; o.x = cvt_pk_bf16(c[0], c[1]); o.y = cvt_pk_bf16(c[2], c[3]);
        *(u32x2*)(outp + (size_t)vt * 16 * 128) = o;
    }
    __syncthreads();
}
__device__ __forceinline__ void gla_scan(bf16_t* KVT, const float* DEC, const int tid, const int G) {
    for (int gid = blockIdx.x * (NWAVES * 64) + tid; gid < 16 * 8192; gid += G * NWAVES * 64) {
        const int bh = gid >> 13, off = (gid & 8191) * 4, k4 = gid & 31;
        bf16_t* p = KVT + (size_t)bh * 64 * 32768 + off; const float* dp = DEC + (size_t)bh * 64 * 128 + 4 * k4;
        f32x4 S = (f32x4){0.f, 0.f, 0.f, 0.f};
        for (int n0 = 0; n0 < 64; n0 += 8) {
            u32x2 kv[8]; f32x4 dc[8];
#pragma unroll
            for (int i = 0; i < 8; ++i) { kv[i] = *(const u32x2*)(p + (size_t)(n0 + i) * 32768); dc[i] = *(const f32x4*)(dp + (n0 + i) * 128); }
#pragma unroll
            for (int i = 0; i < 8; ++i) {
                u32x2 o; o.x = cvt_pk_bf16(S[0], S[1]); o.y = cvt_pk_bf16(S[2], S[3]);
                *(u32x2*)(p + (size_t)(n0 + i) * 32768) = o;
                S[0] = dc[i][0] * S[0] + bf2f((unsigned short)(kv[i].x & 0xffffu)); S[1] = dc[i][1] * S[1] + bf2f((unsigned short)(kv[i].x >> 16));
                S[2] = dc[i][2] * S[2] + bf2f((unsigned short)(kv[i].y & 0xffffu)); S[3] = dc[i][3] * S[3] + bf2f((unsigned short)(kv[i].y >> 16));
            }
        }
    }
}
__device__ __forceinline__ void gla_g3_item(LAS unsigned char* lds, bf16_t* Z, const float* GA, const float* w_a2, const float* b_a, const bf16_t* KVT, const float* head_g, const int item, const int tid) {
    const int lane = tid & 63, w = __builtin_amdgcn_readfirstlane(tid >> 6), fr = lane & 15, g = lane >> 4;
    const int bh = item >> 6, n = item & 63, h = bh & 3; const size_t m0 = (size_t)(bh >> 2) * SEQ + 64 * n;
    float bl[2][8], tot[2];
    gla_decay(lds, GA, w_a2, b_a, h, m0, tid, bl, tot);
    const int kp = tid & 63, s8 = tid >> 6;
#pragma unroll
    for (int i = 0; i < 8; ++i) {
        const int t = 8 * s8 + i;
        const unsigned qv = *(const unsigned*)(Z + (m0 + t) * OD_N + 128 * h + 2 * kp), kv = *(const unsigned*)(Z + (m0 + t) * OD_N + 512 + 128 * h + 2 * kp);
        const float e0 = __expf(bl[0][i]), e1 = __expf(bl[1][i]), f0 = __expf(-bl[0][i]), f1 = __expf(-bl[1][i]);
        *(LAS unsigned*)(lds + GL_A + t * G3_QSTR + 4 * kp) = cvt_pk_bf16(bf2f((unsigned short)(qv & 0xffffu)) * e0, bf2f((unsigned short)(qv >> 16)) * e1);
        *(LAS unsigned*)(lds + G3_KT + t * G3_QSTR + 4 * kp) = cvt_pk_bf16(bf2f((unsigned short)(kv & 0xffffu)) * f0, bf2f((unsigned short)(kv >> 16)) * f1);
    }
    gla_stage_v(lds + G3_V, Z, h, m0, tid);
    __syncthreads();
    u32x4 pb[4][2];
#pragma unroll
    for (int tt = 0; tt < 4; ++tt) {
        bf16x8 qf[4];
#pragma unroll
        for (int ks = 0; ks < 4; ++ks) qf[ks] = *(const LAS bf16x8*)(lds + GL_A + (16 * tt + fr) * G3_QSTR + 64 * ks + 16 * g);
        u32x2 pk[4];
#pragma unroll
        for (int jt = 0; jt < 4; ++jt) {
            if (jt <= tt) {
                f32x4 c = (f32x4){0.f, 0.f, 0.f, 0.f};
#pragma unroll
                for (int ks = 0; ks < 4; ++ks) c = __builtin_amdgcn_mfma_f32_16x16x32_bf16(*(const LAS bf16x8*)(lds + G3_KT + (16 * jt + fr) * G3_QSTR + 64 * ks + 16 * g), qf[ks], c, 0, 0, 0);
                if (jt == tt) {
#pragma unroll
                    for (int e = 0; e < 4; ++e) c[e] = (4 * g + e <= fr) ? c[e] : 0.f;
                }
                pk[jt].x = cvt_pk_bf16(c[0], c[1]); pk[jt].y = cvt_pk_bf16(c[2], c[3]);
            } else { pk[jt].x = 0u; pk[jt].y = 0u; }
        }
        pb[tt][0] = (u32x4){pk[0].x, pk[0].y, pk[1].x, pk[1].y}; pb[tt][1] = (u32x4){pk[2].x, pk[2].y, pk[3].x, pk[3].y};
    }
    const int qq = fr >> 2, pp = fr & 3;
    f32x4 acc[2][4];
    float ssq[4] = {0.f, 0.f, 0.f, 0.f};
#pragma unroll
    for (int vi = 0; vi < 2; ++vi) {
        const int vt = 2 * w + vi;
        bf16x8 sf[4];
        const bf16_t* sp = KVT + (size_t)item * 32768 + (size_t)(16 * vt + fr) * 128 + 8 * g;
#pragma unroll
        for (int ks = 0; ks < 4; ++ks) sf[ks] = *(const bf16x8*)(sp + 32 * ks);
        const LAS unsigned char* vb = lds + G3_V + (4 * g + qq) * GL_VSTR + 32 * vt + 8 * pp;
        const bf16x8 va = tr_pair(vb, vb + 16 * GL_VSTR), vc = tr_pair(vb + 32 * GL_VSTR, vb + 48 * GL_VSTR);
#pragma unroll
        for (int tt = 0; tt < 4; ++tt) {
            f32x4 c = (f32x4){0.f, 0.f, 0.f, 0.f};
#pragma unroll
            for (int ks = 0; ks < 4; ++ks) c = __builtin_amdgcn_mfma_f32_16x16x32_bf16(sf[ks], *(const LAS bf16x8*)(lds + GL_A + (16 * tt + fr) * G3_QSTR + 64 * ks + 16 * g), c, 0, 0, 0);
            c = __builtin_amdgcn_mfma_f32_16x16x32_bf16(va, __builtin_bit_cast(bf16x8, pb[tt][0]), c, 0, 0, 0);
            if (tt >= 2) c = __builtin_amdgcn_mfma_f32_16x16x32_bf16(vc, __builtin_bit_cast(bf16x8, pb[tt][1]), c, 0, 0, 0);
            acc[vi][tt] = c; ssq[tt] += dot4(c);
        }
    }
    LAS float* sl = (LAS float*)(lds + G3_SSQ);
#pragma unroll
    for (int tt = 0; tt < 4; ++tt) { float v = ssq[tt]; v += __shfl_xor(v, 16); v += __shfl_xor(v, 32); if (g == 0) sl[w * 64 + 16 * tt + fr] = v; }
    __syncthreads();
#pragma unroll
    for (int tt = 0; tt < 4; ++tt) {
        float tsum = 0.f;
#pragma unroll
        for (int q = 0; q < 8; ++q) tsum += sl[q * 64 + 16 * tt + fr];
        const float rstd = rsqrtf(tsum * (1.0f / 256.0f) + EPS);
#pragma unroll
        for (int vi = 0; vi < 2; ++vi) {
            const int vc0 = 32 * w + 16 * vi + 4 * g;
            const f32x4 hg = *(const f32x4*)(head_g + vc0);
            bf16_t* row = Z + (m0 + 16 * tt + fr) * OD_N + 256 * h + vc0;
            const u32x2 sr = *(const u32x2*)(row + 2048);
            const f32x4 c = acc[vi][tt];
            u32x2 o; o.x = cvt_pk_bf16(c[0] * rstd * hg[0] * bf2f((unsigned short)(sr.x & 0xffffu)), c[1] * rstd * hg[1] * bf2f((unsigned short)(sr.x >> 16)));
            o.y = cvt_pk_bf16(c[2] * rstd * hg[2] * bf2f((unsigned short)(sr.y & 0xffffu)), c[3] * rstd * hg[3] * bf2f((unsigned short)(sr.y >> 16)));
            *(u32x2*)(row + 1024) = o;
        }
    }
    __syncthreads();
}
__device__ __forceinline__ void ga_group(LAS unsigned char* lds, const bf16_t* XB, const float* RSQ, const bf16_t* WGA, float* GA, const int grp, const int tid) {
    const int lane = tid & 63, w = __builtin_amdgcn_readfirstlane(tid >> 6), fr = lane & 15, g = lane >> 4, tt = w & 3, kh = w >> 2;
    const bf16_t* ap = XB + (size_t)(64 * grp + 16 * tt + fr) * D + 512 * kh + 8 * g; const bf16_t* bp = WGA + (size_t)fr * D + 512 * kh + 8 * g;
    f32x4 c = (f32x4){0.f, 0.f, 0.f, 0.f};
#pragma unroll 4
    for (int ks = 0; ks < 16; ++ks) c = __builtin_amdgcn_mfma_f32_16x16x32_bf16(*(const bf16x8*)(ap + 32 * ks), *(const bf16x8*)(bp + 32 * ks), c, 0, 0, 0);
    LAS float* pl = (LAS float*)lds;
#pragma unroll
    for (int e = 0; e < 4; ++e) pl[(kh * 64 + 16 * tt + 4 * g + e) * 16 + fr] = c[e];
    __syncthreads();
    for (int i = tid; i < 64 * 16; i += NWAVES * 64) {
        const int t = i >> 4; const size_t row = (size_t)64 * grp + t;
        float s = 0.f;
#pragma unroll
        for (int q = 0; q < 4; ++q) s += sum4(*(const f32x4*)(RSQ + row * 16 + 4 * q));
        GA[row * 16 + (i & 15)] = (pl[i] + pl[1024 + i]) * rsqrtf(s * (1.0f / 1024.0f) + EPS);
    }
    __syncthreads();
}

constexpr int RING_BYTES = 131072, LDSCTL_OFF = RING_BYTES, MISC_OFF = LDSCTL_OFF + 320, LDSX_OFF = RING_BYTES + 1024, LDS_BYTES = 147456;
constexpr int NPHASE = 1 + 8 * DEPTH;
struct Args { const float* in[21]; float* out; unsigned char* ws; int ph_lo, ph_hi, li, pad; };

__global__ void __launch_bounds__(NWAVES * 64, 2) mega(Args args) {
    extern __shared__ __attribute__((aligned(16))) unsigned char lds_raw[];
    LAS unsigned char* lds = (LAS unsigned char*)lds_raw;
    volatile LAS unsigned* MISC = (volatile LAS unsigned*)(lds + MISC_OFF);
    const int G = gridDim.x;
    unsigned* ctl = (unsigned*)(args.ws + WS_CTL);
    for (int u = threadIdx.x; u < (LDS_BYTES - LDSCTL_OFF) / 4; u += NWAVES * 64) ((LAS unsigned*)(lds + LDSCTL_OFF))[u] = 0u;
    __syncthreads();
    XcdBarrier bar = xcd_barrier_post(ctl + CW_BAR + args.li * XCD_BAR_WORDS, MISC + 8);

    typedef const float* cfp_t;
    const __attribute__((address_space(4))) cfp_t* inp0 = (const __attribute__((address_space(4))) cfp_t*)__builtin_amdgcn_kernarg_segment_ptr();

    bool first = true;
    for (int ph = args.ph_lo; ph < args.ph_hi; ++ph) {
        if (ph > 0) { const int L_ = (ph - 1) >> 3, sub_ = (ph - 1) & 7; if ((L_ & 1) == 0 && sub_ == 3) continue; }
        if (!first) xcd_barrier(bar);
        first = false;
        const __attribute__((address_space(4))) cfp_t* inp = inp0; asm volatile("" : "+s"(inp));
        unsigned char* ws = args.ws; asm volatile("" : "+s"(ws));
        int tid = threadIdx.x; asm volatile("" : "+v"(tid));
        const int lane = tid & 63, wave = __builtin_amdgcn_readfirstlane(tid >> 6);
        const int gw = blockIdx.x * NWAVES + wave, NGW = G * NWAVES;
        LAS float* scr = (LAS float*)(lds + wave * 16384);
        float* X = args.out; asm volatile("" : "+s"(X));
        bf16_t* XB = (bf16_t*)(ws + WS_XB); bf16_t* Z = (bf16_t*)(ws + WS_Z);
        float* RSQ = (float*)(ws + WS_RSQ); float* LNP = (float*)(ws + WS_LNP);
        float* HALO = (float*)(ws + WS_HALO); float* FIXP = (float*)(ws + WS_FIXP); float* FIXU = (float*)(ws + WS_FIXU);
        bf16_t* WGU = (bf16_t*)(ws + WS_WFFN); bf16_t* WDN = (bf16_t*)(ws + WS_WFFN + OFF_WDOWN);
        if (ph == 0) {
            constexpr int I_EVIN = 16 * (EV_N / 32), I_SQ = 16 * 32, I_ODIN = 16 * (OD_N / 32);
            constexpr int PER = I_EVIN + I_SQ + I_ODIN + I_SQ;
            for (int it = gw; it < 2 * PER; it += NGW) {
                const int e = it / PER; int r = it % PER;
                if (r < I_EVIN) { conv_item(inp[3] + (size_t)e * D * EV_N, nullptr, EV_N, D, EV_N, inp[1] + (size_t)(2 * e) * D, (bf16_t*)(ws + WS_WMIX + OFF_EVIN) + (size_t)e * EV_N * D, 1, r, scr, lane); continue; } r -= I_EVIN;
                if (r < I_SQ) { conv_item(inp[10] + (size_t)e * D * D, nullptr, D, D, D, nullptr, (bf16_t*)(ws + WS_WMIX + OFF_EVOUT) + (size_t)e * D * D, 0, r, scr, lane); continue; } r -= I_SQ;
                if (r < I_ODIN) { conv_item(inp[11] + (size_t)e * D * OD_NSRC, nullptr, OD_NSRC, D, OD_N, inp[1] + (size_t)(2 * e + 1) * D, (bf16_t*)(ws + WS_WMIX + OFF_ODIN) + (size_t)e * OD_N * D, 0, r, scr, lane); continue; } r -= I_ODIN;
                conv_item(inp[15] + (size_t)e * D * D, nullptr, D, D, D, nullptr, (bf16_t*)(ws + WS_WMIX + OFF_ODOUT) + (size_t)e * D * D, 0, r, scr, lane);
            }
            for (int i = blockIdx.x * (NWAVES * 64) + tid; i < 2 * 8 * 128 * 128; i += G * NWAVES * 64) {
                const int tt = (i >> 7) & 127, ss = i & 127;
                ((bf16_t*)(ws + WS_SMALLW))[i] = (bf16_t)((ss <= tt) ? f2bf(inp[6][i]) : 0u);
            }
            for (int i = blockIdx.x * (NWAVES * 64) + tid; i < 2 * 16 * 1024; i += G * NWAVES * 64) {
                const int o = i >> 14, j = (i >> 10) & 15, k = i & 1023;
                ((bf16_t*)(ws + WS_SMALLW + 512 * 1024))[i] = (bf16_t)f2bf(inp[11][((size_t)o * D + k) * OD_NSRC + 3072 + j] * inp[1][(size_t)(2 * o + 1) * D + k]);
            }
            for (int m = gw; m < M; m += NGW) {
                const f32x4* xr = (const f32x4*)(inp[0] + (size_t)m * D) + lane; f32x4 v[4]; float s = 0.f;
#pragma unroll
                for (int j = 0; j < 4; ++j) { v[j] = xr[64 * j]; s += dot4(v[j]); }
#pragma unroll
                for (int o = 1; o < 64; o <<= 1) s += __shfl_xor(s, o);
                u32x2* o8 = (u32x2*)(XB + (size_t)m * D) + lane;
#pragma unroll
                for (int j = 0; j < 4; ++j) { u32x2 w; w.x = pk2(v[j][0], v[j][1]); w.y = pk2(v[j][2], v[j][3]); o8[64 * j] = w; }
                if (lane < 16) RSQ[(size_t)m * 16 + lane] = (lane == 0) ? s : 0.f;
            }
        } else {
            const int L = (ph - 1) >> 3, sub = (ph - 1) & 7, e = L >> 1; const bool even = (L & 1) == 0;
            if (sub == 0) {
                pg8::StaticOrder S;
                if (even) {
                    pg8::Gemm g{XB, (const bf16_t*)(ws + WS_WMIX + OFF_EVIN) + (size_t)e * EV_N * D, M, EV_N, D, D}; S.init(M, EV_N, G, (int)blockIdx.x);
                    EpiEvenIn E{Z, RSQ, LNP, inp[8] + e * 64, inp[9] + e * 64};
                    pg8::gemm_phase<EpiEvenIn>(lds, g, S, E, tid);
                } else {
                    pg8::Gemm g{XB, (const bf16_t*)(ws + WS_WMIX + OFF_ODIN) + (size_t)e * OD_N * D, M, OD_N, D, D}; S.init(M, OD_N, G, (int)blockIdx.x);
                    EpiOddIn E{Z, RSQ};
                    pg8::gemm_phase<EpiOddIn>(lds, g, S, E, tid);
                    for (int grp = blockIdx.x; grp < M / 64; grp += G) ga_group(lds, XB, RSQ, (const bf16_t*)(ws + WS_SMALLW + 512 * 1024) + (size_t)e * 16 * D, (float*)(ws + WS_GA), grp, tid);
                }
            } else if (sub == 1) {
                if (even) {
                    bf16_t* P1 = (bf16_t*)(ws + WS_AUX); bf16_t* P2 = (bf16_t*)(ws + WS_AUX + 16 * MiB); float* L1 = (float*)(ws + WS_AUX + 32 * MiB); float* L2 = L1 + (size_t)M * 8;
                    for (int it = blockIdx.x; it < 3072; it += G) {
                        if (it < 1024) attn_item(lds, Z, 0, it, false, P1, L1, nullptr, nullptr, nullptr, nullptr, tid);
                        else if (it < 2048) attn_item(lds, Z, 2, it - 1024, false, P2, L2, nullptr, nullptr, nullptr, nullptr, tid);
                        else gmlp_item(lds, Z, LNP, inp[4] + e * 512, inp[5] + e * 512, (const bf16_t*)(ws + WS_SMALLW) + (size_t)e * 8 * 128 * 128, inp[7] + e * 8 * 128, it - 2048, tid);
                    }
                } else {
                    for (int it = blockIdx.x; it < 1024; it += G) gla_g1_item(lds, Z, (const float*)(ws + WS_GA), inp[12] + (size_t)e * 16 * 512, inp[13] + e * 512, (bf16_t*)(ws + WS_AUX), LNP, it, tid);
                }
            } else if (sub == 2 && even) {
                const bf16_t* P1 = (const bf16_t*)(ws + WS_AUX); const bf16_t* P2 = (const bf16_t*)(ws + WS_AUX + 16 * MiB); const float* L1 = (const float*)(ws + WS_AUX + 32 * MiB); const float* L2 = L1 + (size_t)M * 8;
                for (int it = blockIdx.x; it < 1024; it += G) attn_item(lds, Z, 4, it, true, nullptr, nullptr, P1, P2, L1, L2, tid);
            } else if (sub == 2) {
                gla_scan((bf16_t*)(ws + WS_AUX), LNP, tid, G);
            } else if (sub == 3) {
                for (int it = blockIdx.x; it < 1024; it += G) gla_g3_item(lds, Z, (const float*)(ws + WS_GA), inp[12] + (size_t)e * 16 * 512, inp[13] + e * 512, (const bf16_t*)(ws + WS_AUX), inp[14] + e * 256, it, tid);
            } else if (sub == 4 || sub == 7) {
                if (sub == 4) {
                    constexpr int I_GU = 16 * (GU_N / 32), I_DN = (FF / 64) * 32;
                    const float* wg = inp[16] + (size_t)L * D * FF; const float* wu = inp[17] + (size_t)L * D * FF; const float* wd = inp[20] + (size_t)L * FF * D;
                    for (int it = gw; it < I_GU + I_DN; it += NGW) {
                        if (it < I_GU) conv_item(wg, wu, FF, D, GU_N, inp[2] + (size_t)L * D, WGU, 2, it, scr, lane);
                        else conv_item(wd, nullptr, D, FF, D, nullptr, WDN, 0, it - I_GU, scr, lane);
                    }
                    __syncthreads();
                }
                pg8::StaticOrder S; S.init(M, D, G, (int)blockIdx.x);
                pg8::Gemm g;
                if (sub == 7) g = pg8::Gemm{Z, WDN, M, D, FF, FF};
                else if (even) g = pg8::Gemm{Z, (const bf16_t*)(ws + WS_WMIX + OFF_EVOUT) + (size_t)e * D * D, M, D, D, EV_N};
                else g = pg8::Gemm{Z + 1024, (const bf16_t*)(ws + WS_WMIX + OFF_ODOUT) + (size_t)e * D * D, M, D, D, OD_N};
                const float* xin = (L == 0 && sub == 4) ? inp[0] : X;
                EpiRes E{xin, X, XB, RSQ};
                pg8::gemm_phase<EpiRes>(lds, g, S, E, tid);
            } else if (sub == 5) {
                pg8::StaticOrder S; S.init(M, GU_N, G, (int)blockIdx.x);
                pg8::Gemm g{XB, WGU, M, GU_N, D, D};
                EpiF1 E{Z, RSQ, inp[18] + (size_t)L * 3 * FF, inp[19] + (size_t)L * FF, HALO, FIXP, FIXU, (LAS float*)(lds + LDSX_OFF)};
                pg8::gemm_phase<EpiF1>(lds, g, S, E, tid);
            } else if (sub == 6) {
                const float* cw = inp[18] + (size_t)L * 3 * FF;
                for (int idx = blockIdx.x * (NWAVES * 64) + tid; idx < 64 * 2 * FF; idx += G * NWAVES * 64) {
                    const int pm = idx / (2 * FF), rem = idx % (2 * FF), j = rem / FF, c = rem % FF;
                    if ((pm & 15) == 0) continue;
                    const float h1 = HALO[((size_t)(pm - 1) * 2 + 1) * FF + c], h0 = HALO[((size_t)(pm - 1) * 2 + 0) * FF + c];
                    float pre = FIXP[((size_t)pm * 2 + j) * FF + c];
                    if (j == 0) pre += cw[FF + c] * h1 + cw[c] * h0; else pre += cw[c] * h1;
                    Z[(size_t)(pm * 256 + j) * FF + c] = (bf16_t)f2bf(silu_f(pre) * FIXU[((size_t)pm * 2 + j) * FF + c]);
                }
            }
        }
    }
}

extern "C" void kernel_launch(void* const* d_in, const int* in_sizes, int n_in, void* d_out, int out_size, void* d_ws, size_t ws_size, hipStream_t stream) {
    static int grid = 0;
    if (grid == 0) {
        if (n_in != 21 || out_size != M * D || ws_size < WS_END) { fprintf(stderr, "kernel_launch: unexpected shapes (n_in %d out %d ws %zu)\n", n_in, out_size, ws_size); grid = -1; return; }
        int dev = 0, cus = 0, per_cu = 0;
        hipGetDevice(&dev); hipDeviceGetAttribute(&cus, hipDeviceAttributeMultiprocessorCount, dev);
        hipFuncSetAttribute((const void*)mega, hipFuncAttributeMaxDynamicSharedMemorySize, LDS_BYTES);
        hipOccupancyMaxActiveBlocksPerMultiprocessor(&per_cu, (const void*)mega, NWAVES * 64, LDS_BYTES);
        (void)hipGetLastError();
        if (per_cu < 1) per_cu = 1;
        if (per_cu > 1) per_cu = 1;
        grid = cus * per_cu;
        fprintf(stderr, "kernel_launch: grid %d (cus %d), ws %zu\n", grid, cus, ws_size);
    }
    if (grid < 0) return;
    hipMemsetAsync((char*)d_ws + WS_CTL, 0, CTL_ZERO_BYTES, stream);
    Args a{};
    for (int i = 0; i < 21; ++i) a.in[i] = (const float*)d_in[i];
    a.out = (float*)d_out; a.ws = (unsigned char*)d_ws;
    a.ph_lo = 0; a.ph_hi = NPHASE; a.li = 0;
    void* kargs[] = {&a};
    hipError_t le = hipLaunchCooperativeKernel((const void*)mega, dim3(grid), dim3(NWAVES * 64), kargs, LDS_BYTES, stream);
    if (le != hipSuccess) fprintf(stderr, "cooperative launch failed: %s\n", hipGetErrorString(le));
}
```

```cpp
#include <hip/hip_runtime.h>
#include <cstdio>
#include <cstdint>

#define LAS __attribute__((address_space(3)))
#define GAS __attribute__((address_space(1)))
typedef unsigned short bf16_t;
typedef short bf16x8 __attribute__((ext_vector_type(8)));
typedef float f32x4 __attribute__((ext_vector_type(4)));
typedef float f32x2 __attribute__((ext_vector_type(2)));
typedef unsigned u32x4 __attribute__((ext_vector_type(4)));
typedef unsigned u32x2 __attribute__((ext_vector_type(2)));

constexpr int D = 1024, BATCH = 4, SEQ = 4096, M = BATCH * SEQ, DEPTH = 4;
constexpr int EV_N = 2560, OD_N = 3072, OD_NSRC = 3088, FF = 2816, GU_N = 2 * FF;
constexpr float EPS = 1e-6f;

constexpr size_t MiB = 1u << 20;
constexpr size_t WS_CTL = 0, CTL_ZERO_BYTES = 1 * MiB;
constexpr size_t WS_RSQ = 1 * MiB;
constexpr size_t WS_LNP = 2 * MiB;
constexpr size_t WS_GA = 3 * MiB;
constexpr size_t WS_HALO = 4 * MiB;
constexpr size_t WS_FIXP = 6 * MiB;
constexpr size_t WS_FIXU = 8 * MiB;
constexpr size_t WS_SMALLW = 10 * MiB;
constexpr size_t WS_WMIX = 12 * MiB;
constexpr size_t OFF_EVIN = 0, OFF_EVOUT = 10 * MiB, OFF_ODIN = 14 * MiB, OFF_ODOUT = 26 * MiB;
constexpr size_t WS_WFFN = 42 * MiB;
constexpr size_t OFF_WDOWN = 11 * MiB;
constexpr size_t WS_XB = 60 * MiB;
constexpr size_t WS_Z = 92 * MiB;
constexpr size_t WS_AUX = 188 * MiB;
constexpr size_t WS_END = 252 * MiB;
constexpr int CW_BAR = 4096;

constexpr int NWAVES = 8;
__device__ __forceinline__ unsigned f2bf(float f) { unsigned u = __builtin_bit_cast(unsigned, f); return (u + 0x7fffu + ((u >> 16) & 1u)) >> 16; }
__device__ __forceinline__ unsigned pk2(float lo, float hi) { return f2bf(lo) | (f2bf(hi) << 16); }
__device__ __forceinline__ float bf2f(unsigned short h) { return __builtin_bit_cast(float, (unsigned)h << 16); }
typedef __bf16 bf2_t __attribute__((ext_vector_type(2)));
__device__ __forceinline__ unsigned cvt_pk_bf16(float lo, float hi) { const bf2_t r = __builtin_convertvector((f32x2){lo, hi}, bf2_t); return __builtin_bit_cast(unsigned, r); }
__device__ __forceinline__ float silu_f(float x) { return x * __builtin_amdgcn_rcpf(1.0f + __expf(-x)); }
__device__ __forceinline__ f32x2 gelu_pk(f32x2 v) {
    const f32x2 av = __builtin_elementwise_abs(v), d = av * 0.2316418882f + 1.0f;
    f32x2 t; t.x = __builtin_amdgcn_rcpf(d.x); t.y = __builtin_amdgcn_rcpf(d.y);
    f32x2 q = t * 0.5307027145f + (-0.7265760135f); q = q * t + 0.7107068705f; q = q * t + (-0.142248368f); q = q * t + 0.127414796f; q = q * t;
    const f32x2 s = (v * v) * (-0.72134752044f);
    f32x2 e; e.x = __builtin_amdgcn_exp2f(s.x); e.y = __builtin_amdgcn_exp2f(s.y);
    const f32x2 m = v * (q * e), r = v - m;
    f32x2 o; o.x = v.x < 0.f ? m.x : r.x; o.y = v.y < 0.f ? m.y : r.y; return o;
}
__device__ __forceinline__ f32x4 gelu4(f32x4 v) { f32x2 a = gelu_pk((f32x2){v[0], v[1]}), b = gelu_pk((f32x2){v[2], v[3]}); return (f32x4){a.x, a.y, b.x, b.y}; }
__device__ __forceinline__ float sum4(f32x4 v) { return (v[0] + v[1]) + (v[2] + v[3]); }
__device__ __forceinline__ float dot4(f32x4 v) { return (v[0] * v[0] + v[1] * v[1]) + (v[2] * v[2] + v[3] * v[3]); }
__device__ __forceinline__ u32x4 pack8(f32x4 a, f32x4 b) { u32x4 w; w.x = cvt_pk_bf16(a[0], a[1]); w.y = cvt_pk_bf16(a[2], a[3]); w.z = cvt_pk_bf16(b[0], b[1]); w.w = cvt_pk_bf16(b[2], b[3]); return w; }

namespace pg8 {
constexpr int BM = 256, BK = 64, HALF = 128, HTB = HALF * BK * 2, STAGE_BYTES = 8 * HTB, NXCD = 8, WGM = 8;
__host__ __device__ __forceinline__ int lds_byte(int r, int c) { const int st = (r >> 4) * 2 + (c >> 5), rr = r & 15, cc = c & 31, ob = rr * 64 + cc * 2; return st * 1024 + (ob ^ (((ob >> 9) & 1) << 5)); }
__host__ __device__ __forceinline__ void stage_rc(int b, int& R, int& C) { const int st = b / 1024, sb = b % 1024, swz = sb ^ (((sb >> 9) & 1) << 5); R = (st >> 1) * 16 + swz / 64; C = (st & 1) * 32 + (swz % 64) / 2; }
__host__ __device__ __forceinline__ int perm32(int rho) { const int n = rho >> 4, i = rho & 15; return 8 * (i >> 2) + 4 * n + (i & 3); }
struct Unit { int pm, pn; };
struct Gemm { const bf16_t* A; const bf16_t* Bt; int M, N, K, lda; };
struct StaticOrder {
    int nM, nN, nwg, G, c;
    __device__ void init(int M_, int N_, int G_, int c_) { nM = M_ / BM; nN = N_ / BM; nwg = nM * nN; G = G_; c = c_; }
    __device__ bool next(int i, Unit& u) const {
        const long L = (long)i * G + c; if (L >= nwg) return false;
        int wgid = (int)L; { const int q = nwg / NXCD, r = nwg % NXCD, xcd = wgid % NXCD, off = wgid / NXCD; wgid = (xcd < r ? xcd * (q + 1) : r * (q + 1) + (xcd - r) * q) + off; }
        const int nig = WGM * nN, gid = wgid / nig, fm = gid * WGM, gsz = (nM - fm) < WGM ? (nM - fm) : WGM;
        u.pm = fm + ((wgid % nig) % gsz); u.pn = (wgid % nig) / gsz; return true;
    }
};
template <class Epi>
__device__ __forceinline__ void gemm_phase(LAS unsigned char* lds, const Gemm g, const StaticOrder& S, const Epi& E, const int tid) {
    const int wid = __builtin_amdgcn_readfirstlane(tid >> 6), lane = tid & 63, wr = wid >> 2, wc = wid & 3, fr = lane & 15, fq = lane >> 4;
    const int K = g.K, nt = K / BK, lda = g.lda;
    unsigned voffA[2], voffB[2];
#pragma unroll
    for (int i = 0; i < 2; ++i) { int R, C; stage_rc(tid * 16 + i * 8192, R, C); const int Rb = (R & ~31) + perm32(R & 31);
        voffA[i] = (unsigned)(R * lda + C) * 2u; voffB[i] = (unsigned)(Rb * K + C) * 2u; }
    const size_t kstep = (size_t)(BK * 2);
    const size_t hstepA = (size_t)HALF * lda * 2, hstepB = (size_t)HALF * K * 2;
    const size_t tstepA = 2 * hstepA, tstepB = 2 * hstepB;
    const unsigned ldsw = (unsigned)wid * 1024u;
    const int aoff = lds_byte(wr * 64 + fr, fq * 8), boff = lds_byte(wc * 32 + fr, fq * 8);
#define PG8_SA(b, h) (((b) * 2 + (h)) * HTB)
#define PG8_SB(b, h) ((4 + (b) * 2 + (h)) * HTB)
#define PG8_STAGE(bufoff, gbase, voff) do { _Pragma("unroll") for (int _i = 0; _i < 2; ++_i) \
        __builtin_amdgcn_global_load_lds((const unsigned*)((const char*)(gbase) + (voff)[_i]), (LAS unsigned*)(lds + (bufoff) + ldsw + _i * 8192), 16, 0, 0); } while (0)
#define PG8_LDA(dst, b, h) do { _Pragma("unroll") for (int m = 0; m < 4; ++m) _Pragma("unroll") for (int k = 0; k < 2; ++k) dst[m][k] = *(const LAS bf16x8*)(lds + PG8_SA(b, h) + aoff + m * 2048 + k * 1024); } while (0)
#define PG8_LDB(dst, b, h) do { _Pragma("unroll") for (int n = 0; n < 2; ++n) _Pragma("unroll") for (int k = 0; k < 2; ++k) dst[n][k] = *(const LAS bf16x8*)(lds + PG8_SB(b, h) + boff + n * 2048 + k * 1024); } while (0)
#define PG8_MMA(ai, bj, At, Bt) do { __builtin_amdgcn_s_setprio(1); _Pragma("unroll") for (int m = 0; m < 4; ++m) _Pragma("unroll") for (int n = 0; n < 2; ++n) _Pragma("unroll") for (int k = 0; k < 2; ++k) \
        acc[ai][bj][m][n] = __builtin_amdgcn_mfma_f32_16x16x32_bf16(Bt[n][k], At[m][k], acc[ai][bj][m][n], 0, 0, 0); __builtin_amdgcn_s_setprio(0); } while (0)
#define PG8_WAIT_V(n) asm volatile("s_waitcnt vmcnt(" #n ")" ::: "memory")
#define PG8_WAIT_L(n) asm volatile("s_waitcnt lgkmcnt(" #n ")" ::: "memory")
#define PG8_BAR __builtin_amdgcn_s_barrier()
#define PG8_SCHED __builtin_amdgcn_sched_barrier(0)
    Unit cur, nxt; int ui = 0;
    if (!S.next(0, cur)) return;
    f32x4 acc[2][2][4][2];
#pragma unroll
    for (int a = 0; a < 2; ++a)
#pragma unroll
        for (int b = 0; b < 2; ++b)
#pragma unroll
            for (int m = 0; m < 4; ++m)
#pragma unroll
                for (int n = 0; n < 2; ++n) acc[a][b][m][n] = (f32x4){0.f, 0.f, 0.f, 0.f};
    bf16x8 At[4][2], B0[2][2], B1[2][2];
    const char* cA = (const char*)g.A + (size_t)cur.pm * tstepA; const char* cB = (const char*)g.Bt + (size_t)cur.pn * tstepB;
    PG8_STAGE(PG8_SB(0, 0), cB, voffB); PG8_STAGE(PG8_SB(0, 1), cB + hstepB, voffB); PG8_STAGE(PG8_SA(0, 0), cA, voffA); PG8_STAGE(PG8_SA(0, 1), cA + hstepA, voffA);
    if (wr == 1) PG8_BAR;
    PG8_WAIT_V(2); PG8_BAR;
    PG8_STAGE(PG8_SB(1, 0), cB + kstep, voffB); PG8_STAGE(PG8_SA(1, 0), cA + kstep, voffA); PG8_STAGE(PG8_SB(1, 1), cB + hstepB + kstep, voffB);
    PG8_WAIT_V(6); PG8_BAR;
    for (;;) {
        const bool has_next = S.next(ui + 1, nxt);
        const char* nA = has_next ? (const char*)g.A + (size_t)nxt.pm * tstepA : cA; const char* nB = has_next ? (const char*)g.Bt + (size_t)nxt.pn * tstepB : cB;
        for (int t = 0; t < nt; t += 2) {
            const bool last = (t == nt - 2);
            const char* a1 = cA + (size_t)(t + 1) * kstep;
            const char* a2 = last ? nA : cA + (size_t)(t + 2) * kstep; const char* b2 = last ? nB : cB + (size_t)(t + 2) * kstep;
            const char* a3 = a2 + kstep; const char* b3 = b2 + kstep;
            PG8_LDB(B0, 0, 0); PG8_LDB(B1, 0, 1); PG8_SCHED; PG8_LDA(At, 0, 0); PG8_STAGE(PG8_SA(1, 1), a1 + hstepA, voffA);
            PG8_WAIT_V(8); PG8_WAIT_L(0); PG8_BAR; PG8_MMA(0, 0, At, B0); PG8_MMA(0, 1, At, B1); PG8_BAR; PG8_SCHED;
            PG8_LDA(At, 0, 1); PG8_STAGE(PG8_SB(0, 0), b2, voffB); PG8_STAGE(PG8_SB(0, 1), b2 + hstepB, voffB); PG8_STAGE(PG8_SA(0, 0), a2, voffA);
            PG8_WAIT_V(8); PG8_WAIT_L(0); PG8_BAR; PG8_MMA(1, 0, At, B0); PG8_MMA(1, 1, At, B1); PG8_BAR; PG8_SCHED;
            PG8_LDB(B0, 1, 0); PG8_LDB(B1, 1, 1); PG8_SCHED; PG8_LDA(At, 1, 0); PG8_STAGE(PG8_SA(0, 1), a2 + hstepA, voffA);
            PG8_WAIT_V(8); PG8_WAIT_L(0); PG8_BAR; PG8_MMA(0, 0, At, B0); PG8_MMA(0, 1, At, B1); PG8_BAR; PG8_SCHED;
            PG8_LDA(At, 1, 1); PG8_STAGE(PG8_SB(1, 0), b3, voffB); PG8_STAGE(PG8_SB(1, 1), b3 + hstepB, voffB); PG8_STAGE(PG8_SA(1, 0), a3, voffA);
            PG8_WAIT_V(8); PG8_WAIT_L(0); PG8_BAR; PG8_MMA(1, 0, At, B0); PG8_MMA(1, 1, At, B1); PG8_BAR; PG8_SCHED;
        }
        if (wr == 0) PG8_BAR;
        E(acc, cur, wr, wc, fr, fq);
        if (!has_next) break;
#pragma unroll
        for (int a = 0; a < 2; ++a)
#pragma unroll
            for (int b = 0; b < 2; ++b)
#pragma unroll
                for (int m = 0; m < 4; ++m)
#pragma unroll
                    for (int n = 0; n < 2; ++n) acc[a][b][m][n] = (f32x4){0.f, 0.f, 0.f, 0.f};
        cur = nxt; cA = nA; cB = nB; ++ui;
        if (wr == 1) PG8_BAR;
    }
    PG8_WAIT_V(0);
    PG8_BAR;
#undef PG8_SA
#undef PG8_SB
#undef PG8_STAGE
#undef PG8_LDA
#undef PG8_LDB
#undef PG8_MMA
#undef PG8_WAIT_V
#undef PG8_WAIT_L
#undef PG8_BAR
#undef PG8_SCHED
}
}
using pg8::Unit;

__device__ __forceinline__ void row_rstd(const GAS float* rsq, int rowb, int fq, float (&rs)[2][4]) {
#pragma unroll
    for (int ai = 0; ai < 2; ++ai)
#pragma unroll
        for (int m = 0; m < 4; ++m) {
            const int row = rowb + ai * 128 + m * 16;
            const f32x4 p = *(const GAS f32x4*)(rsq + (size_t)row * 16 + 4 * fq);
            float s = sum4(p); s += __shfl_xor(s, 16); s += __shfl_xor(s, 32);
            rs[ai][m] = rsqrtf(s * (1.0f / 1024.0f) + EPS);
        }
}

struct EpiEvenIn {
    GAS bf16_t* Z; const GAS float* rsq; GAS float* lnp; const GAS float* qg; const GAS float* kg;
    __device__ __forceinline__ void operator()(const f32x4 (&acc)[2][2][4][2], const Unit& u, int wr, int wc, int fr, int fq) const {
        asm volatile("" : "+v"(fr), "+v"(fq));
        const int rowb = u.pm * 256 + wr * 64 + fr, kind = u.pn >> 1;
        float rs[2][4]; row_rstd(rsq, rowb, fq, rs);
        if (kind == 1 || kind == 3) {
            const GAS float* g = (kind == 1) ? qg : kg; const float sc = (kind == 1) ? 0.125f : 1.0f;
            f32x4 gv[2][2];
#pragma unroll
            for (int bj = 0; bj < 2; ++bj)
#pragma unroll
                for (int n = 0; n < 2; ++n) gv[bj][n] = *(const GAS f32x4*)(g + 32 * bj + 8 * fq + 4 * n) * sc;
#pragma unroll
            for (int ai = 0; ai < 2; ++ai)
#pragma unroll
                for (int m = 0; m < 4; ++m) {
                    float ss = 0.f;
#pragma unroll
                    for (int bj = 0; bj < 2; ++bj)
#pragma unroll
                        for (int n = 0; n < 2; ++n) ss += dot4(acc[ai][bj][m][n]);
                    ss += __shfl_xor(ss, 16); ss += __shfl_xor(ss, 32);
                    const float r = rs[ai][m], rh = rsqrtf(ss * r * r * (1.0f / 64.0f) + EPS) * r;
                    GAS bf16_t* rowp = Z + (size_t)(rowb + ai * 128 + m * 16) * EV_N + u.pn * 256 + 64 * wc + 8 * fq;
#pragma unroll
                    for (int bj = 0; bj < 2; ++bj) *(GAS u32x4*)(rowp + 32 * bj) = pack8(acc[ai][bj][m][0] * rh * gv[bj][0], acc[ai][bj][m][1] * rh * gv[bj][1]);
                }
        } else {
#pragma unroll
            for (int ai = 0; ai < 2; ++ai)
#pragma unroll
                for (int m = 0; m < 4; ++m) {
                    const float r = rs[ai][m]; const int row = rowb + ai * 128 + m * 16;
                    GAS bf16_t* rowp = Z + (size_t)row * EV_N + u.pn * 256 + 32 * wc + 8 * fq;
                    float s1 = 0.f, s2 = 0.f;
#pragma unroll
                    for (int bj = 0; bj < 2; ++bj) {
                        f32x4 v0 = acc[ai][bj][m][0] * r, v1 = acc[ai][bj][m][1] * r;
                        if (kind != 4) { v0 = gelu4(v0); v1 = gelu4(v1); }
                        if (kind == 2) { s1 += sum4(v0) + sum4(v1); s2 += dot4(v0) + dot4(v1); }
                        *(GAS u32x4*)(rowp + 128 * bj) = pack8(v0, v1);
                    }
                    if (kind == 2) {
                        s1 += __shfl_xor(s1, 16); s1 += __shfl_xor(s1, 32); s2 += __shfl_xor(s2, 16); s2 += __shfl_xor(s2, 32);
                        if (fq == 0) *(GAS f32x2*)(lnp + ((size_t)row * 8 + (u.pn & 1) * 4 + wc) * 2) = (f32x2){s1, s2};
                    }
                }
        }
    }
};

struct EpiOddIn {
    GAS bf16_t* Z; const GAS float* rsq;
    __device__ __forceinline__ void operator()(const f32x4 (&acc)[2][2][4][2], const Unit& u, int wr, int wc, int fr, int fq) const {
        asm volatile("" : "+v"(fr), "+v"(fq));
        const int rowb = u.pm * 256 + wr * 64 + fr;
        float rs[2][4]; row_rstd(rsq, rowb, fq, rs);
        const float sc = (u.pn < 2) ? 0.08838834764831845f : 1.0f; const bool act = (u.pn >= 8);
#pragma unroll
        for (int ai = 0; ai < 2; ++ai)
#pragma unroll
            for (int m = 0; m < 4; ++m) {
                const float r = rs[ai][m] * sc;
                GAS bf16_t* rowp = Z + (size_t)(rowb + ai * 128 + m * 16) * OD_N + u.pn * 256 + 32 * wc + 8 * fq;
#pragma unroll
                for (int bj = 0; bj < 2; ++bj) {
                    f32x4 v0 = acc[ai][bj][m][0] * r, v1 = acc[ai][bj][m][1] * r;
                    if (act) {
#pragma unroll
                        for (int e = 0; e < 4; ++e) { v0[e] = silu_f(v0[e]); v1[e] = silu_f(v1[e]); }
                    }
                    *(GAS u32x4*)(rowp + 128 * bj) = pack8(v0, v1);
                }
            }
    }
};

struct EpiRes {
    const GAS float* xin; GAS float* xout; GAS bf16_t* xb; GAS float* rsq;
    __device__ __forceinline__ void operator()(const f32x4 (&acc)[2][2][4][2], const Unit& u, int wr, int wc, int fr, int fq) const {
        asm volatile("" : "+v"(fr), "+v"(fq));
        const int rowb = u.pm * 256 + wr * 64 + fr;
#pragma unroll
        for (int ai = 0; ai < 2; ++ai)
#pragma unroll
            for (int m = 0; m < 4; ++m) {
                const int row = rowb + ai * 128 + m * 16; const size_t off = (size_t)row * D + u.pn * 256 + 32 * wc + 8 * fq;
                float ss = 0.f;
#pragma unroll
                for (int bj = 0; bj < 2; ++bj) {
                    const f32x4 o0 = *(const GAS f32x4*)(xin + off + 128 * bj) + acc[ai][bj][m][0], o1 = *(const GAS f32x4*)(xin + off + 128 * bj + 4) + acc[ai][bj][m][1];
                    *(GAS f32x4*)(xout + off + 128 * bj) = o0; *(GAS f32x4*)(xout + off + 128 * bj + 4) = o1;
                    *(GAS u32x4*)(xb + off + 128 * bj) = pack8(o0, o1);
                    ss += dot4(o0) + dot4(o1);
                }
                ss += __shfl_xor(ss, 16); ss += __shfl_xor(ss, 32);
                if (fq == 0) rsq[(size_t)row * 16 + u.pn * 4 + wc] = ss;
            }
    }
};

#define DPP_MOV(old, src, ctrl, bc) __builtin_bit_cast(float, __builtin_amdgcn_update_dpp(__builtin_bit_cast(int, (float)(old)), __builtin_bit_cast(int, (float)(src)), (ctrl), 0xf, 0xf, (bc)))

struct EpiF1 {
    GAS bf16_t* H; const GAS float* rsq; const GAS float* cw; const GAS float* cb; GAS float* halo; GAS float* fixp; GAS float* fixu; LAS float* ldsx;
    __device__ __forceinline__ void operator()(const f32x4 (&acc)[2][2][4][2], const Unit& u, int wr, int wc, int fr, int fq) const {
        asm volatile("" : "+v"(fr), "+v"(fq));
        const int rowb = u.pm * 256 + wr * 64 + fr, ch0 = u.pn * 128 + 32 * wc + 8 * fq, lc = 32 * wc + 8 * fq;
        float rs[2][4]; row_rstd(rsq, rowb, fq, rs);
        f32x4 w0[2], w1[2], w2[2], bb[2];
#pragma unroll
        for (int n = 0; n < 2; ++n) { w0[n] = *(const GAS f32x4*)(cw + ch0 + 4 * n); w1[n] = *(const GAS f32x4*)(cw + FF + ch0 + 4 * n); w2[n] = *(const GAS f32x4*)(cw + 2 * FF + ch0 + 4 * n); bb[n] = *(const GAS f32x4*)(cb + ch0 + 4 * n); }
        if (fr >= 14) {
#pragma unroll
            for (int ai = 0; ai < 2; ++ai)
#pragma unroll
                for (int n = 0; n < 2; ++n) {
                    const f32x4 gvl = acc[ai][0][3][n] * rs[ai][3];
                    *(LAS f32x4*)(ldsx + ((ai * 2 + wr) * 2 + (fr - 14)) * 128 + lc + 4 * n) = gvl;
                    if (ai == 1 && wr == 1) *(GAS f32x4*)(halo + ((size_t)u.pm * 2 + (fr - 14)) * FF + ch0 + 4 * n) = gvl;
                }
        }
        asm volatile("s_waitcnt lgkmcnt(0)" ::: "memory"); __builtin_amdgcn_s_barrier(); asm volatile("" ::: "memory");
        const bool fix = (u.pm & 15) != 0;
#pragma unroll
        for (int ai = 0; ai < 2; ++ai) {
            const int blk = ai * 2 + wr;
            f32x4 pv[2];
#pragma unroll
            for (int n = 0; n < 2; ++n) {
                pv[n] = (f32x4){0.f, 0.f, 0.f, 0.f};
                if (blk > 0 && fr >= 14) pv[n] = *(const LAS f32x4*)(ldsx + ((blk - 1) * 2 + (fr - 14)) * 128 + lc + 4 * n);
            }
#pragma unroll
            for (int m = 0; m < 4; ++m) {
                const float r = rs[ai][m]; const int row = rowb + ai * 128 + m * 16;
                f32x4 hv[2], pre[2], upv[2], cur[2];
#pragma unroll
                for (int n = 0; n < 2; ++n) {
                    cur[n] = acc[ai][0][m][n] * r; upv[n] = acc[ai][1][m][n] * r;
#pragma unroll
                    for (int e = 0; e < 4; ++e) {
                        const float c = cur[n][e], p = pv[n][e];
                        const float t1 = DPP_MOV(0.f, p, 0x10F, true);
                        const float g1 = DPP_MOV(t1, c, 0x111, false);
                        const float t2 = DPP_MOV(0.f, p, 0x10E, true);
                        const float g2 = DPP_MOV(t2, c, 0x112, false);
                        const float pr = bb[n][e] + w2[n][e] * c + w1[n][e] * g1 + w0[n][e] * g2;
                        pre[n][e] = pr; hv[n][e] = silu_f(pr) * upv[n][e];
                    }
                }
                *(GAS u32x4*)(H + (size_t)row * FF + ch0) = pack8(hv[0], hv[1]);
                if (fix && blk == 0 && m == 0 && fr < 2) {
#pragma unroll
                    for (int n = 0; n < 2; ++n) { *(GAS f32x4*)(fixp + ((size_t)u.pm * 2 + fr) * FF + ch0 + 4 * n) = pre[n]; *(GAS f32x4*)(fixu + ((size_t)u.pm * 2 + fr) * FF + ch0 + 4 * n) = upv[n]; }
                }
                pv[0] = cur[0]; pv[1] = cur[1];
            }
        }
    }
};

#define XB_TMO      128
#define XB_XCNT(j)  (256  + 64 * (j))
#define XB_XSUB(j)  (1280 + 64 * (j))
#define XB_XGEN(j)  (2304 + 64 * (j))
#define XB_TOP      3328
#define XB_TOPGEN   3392
#define XCD_BAR_WORDS 3456
#define XB_SPIN_CAP (1u << 18)
__device__ __forceinline__ unsigned xb_ld(unsigned* p)              { return __hip_atomic_load(p, __ATOMIC_RELAXED, __HIP_MEMORY_SCOPE_AGENT); }
__device__ __forceinline__ unsigned xb_add(unsigned* p, unsigned v) { return __hip_atomic_fetch_add(p, v, __ATOMIC_RELAXED, __HIP_MEMORY_SCOPE_AGENT); }
__device__ __forceinline__ unsigned xb_xcc_id() { return (unsigned)__builtin_amdgcn_s_getreg((3 << 11) | 20) & 0xFu; }
#define XB_SPIN(cond, bar) do { unsigned _sp = 0; while (cond) { __builtin_amdgcn_s_sleep(1); \
    if ((++_sp & 255u) == 0u) { if (xb_ld(&(bar)[XB_TMO])) break; if (_sp > XB_SPIN_CAP) { atomicAdd(&(bar)[XB_TMO], 1u); break; } } } } while (0)
struct XcdBarrier { unsigned* bar; unsigned x; volatile LAS unsigned* st; };
__device__ __forceinline__ XcdBarrier xcd_barrier_post(unsigned* bar, volatile LAS unsigned* st) {
    XcdBarrier b; b.bar = bar; b.x = xb_xcc_id(); b.st = st;
    if (threadIdx.x == 0) (void)xb_add(&bar[XB_XCNT(b.x)], 1u);
    return b;
}
__device__ __forceinline__ void xcd_barrier_complete(unsigned* bar, unsigned x, unsigned& nloc, unsigned& nx) {
    const unsigned G = gridDim.x * gridDim.y * gridDim.z;
    unsigned sum, cnt, mine, sp = 0u;
    for (;;) {
        sum = 0u; cnt = 0u; mine = 0u;
#pragma unroll
        for (unsigned j = 0; j < 16; ++j) { const unsigned c = xb_ld(&bar[XB_XCNT(j)]); sum += c; cnt += (c > 0u) ? 1u : 0u; mine = (j == x) ? c : mine; }
        if (sum == G) break;
        __builtin_amdgcn_s_sleep(1);
        if ((++sp & 255u) == 0u) { if (xb_ld(&bar[XB_TMO])) break; if (sp > XB_SPIN_CAP) { atomicAdd(&bar[XB_TMO], 1u); break; } }
    }
    nloc = mine > 0u ? mine : 1u; nx = cnt > 0u ? cnt : 1u;
}
__device__ __forceinline__ void xcd_barrier(const XcdBarrier& b) {
    asm volatile("s_waitcnt vmcnt(0)" ::: "memory");
    __syncthreads();
    if (threadIdx.x == 0) {
        unsigned* bar = b.bar;
        __builtin_amdgcn_s_waitcnt(0);
        unsigned nloc = b.st[0], nx = b.st[1];
        if (nloc == 0u) { xcd_barrier_complete(bar, b.x, nloc, nx); b.st[0] = nloc; b.st[1] = nx; }
        const unsigned old = xb_add(&bar[XB_XSUB(b.x)], 1u);
        const unsigned gen = old / nloc;
        if (old + 1u == (gen + 1u) * nloc) {
            __builtin_amdgcn_fence(__ATOMIC_RELEASE, "agent");
            asm volatile("s_waitcnt vmcnt(0)" ::: "memory");
            const unsigned og = xb_add(&bar[XB_TOP], 1u);
            const unsigned tg = og / nx;
            if (og + 1u == (tg + 1u) * nx) xb_add(&bar[XB_TOPGEN], 1u);
            else XB_SPIN(xb_ld(&bar[XB_TOPGEN]) == tg, bar);
            __builtin_amdgcn_fence(__ATOMIC_ACQUIRE, "agent");
            xb_add(&bar[XB_XGEN(b.x)], 1u);
            asm volatile("s_waitcnt vmcnt(0)" ::: "memory");
        } else {
            XB_SPIN(xb_ld(&bar[XB_XGEN(b.x)]) == gen, bar);
            __builtin_amdgcn_fence(__ATOMIC_ACQUIRE, "agent");
            asm volatile("s_waitcnt vmcnt(0)" ::: "memory");
        }
    }
    __syncthreads();
}

__device__ __forceinline__ int conv_srccol(const int map, const int nd, bool& second) {
    const int nb = nd >> 5, r = nd & 31; second = false;
    if (map == 1) {
        const int pn = nb >> 3, j = nb & 7, bj = j >> 2, wc = j & 3, kind = pn >> 1, zc = 256 * pn + 64 * wc + 32 * bj;
        if (kind == 1) return 1024 + (zc - 512) + r;
        if (kind == 2) return 512 + (nd - 1024);
        if (kind == 3) return zc + r;
        return nd;
    } else if (map == 2) {
        const int pn = nb >> 3, j = nb & 7; second = (j >> 2) != 0;
        return 128 * pn + 32 * (j & 3) + r;
    }
    return nd;
}
constexpr int CV_STR = 65;
__device__ __forceinline__ void conv_block_item(LAS unsigned char* lds, const GAS float* W, const GAS float* W2, const int ldw, const int K, const int Ndst, const GAS float* gk, GAS bf16_t* WT, const int map, const int item, const int tid) {
    const int nblk = Ndst >> 7, kb = item / nblk, nb = item % nblk, k0 = kb << 7, n0 = nb << 7;
    const int l32 = tid & 31, rg = tid >> 5;
    bool second; const int sc = conv_srccol(map, n0 + 4 * l32, second);
    const GAS float* src = (second ? W2 : W) + (size_t)(k0 + 8 * rg) * ldw + sc;
    f32x4 v[8];
#pragma unroll
    for (int i = 0; i < 8; ++i) v[i] = *(const GAS f32x4*)(src + (size_t)i * ldw);
    if (gk) {
        const f32x4 g0 = *(const GAS f32x4*)(gk + k0 + 8 * rg), g1 = *(const GAS f32x4*)(gk + k0 + 8 * rg + 4);
#pragma unroll
        for (int i = 0; i < 4; ++i) { v[i] = v[i] * g0[i]; v[4 + i] = v[4 + i] * g1[i]; }
    }
    LAS unsigned* T = (LAS unsigned*)lds;
#pragma unroll
    for (int i = 0; i < 4; ++i)
#pragma unroll
        for (int e = 0; e < 4; ++e) T[(4 * l32 + e) * CV_STR + 4 * rg + i] = cvt_pk_bf16(v[2 * i][e], v[2 * i + 1][e]);
    __syncthreads();
    const int c = tid & 15;
#pragma unroll
    for (int p = 0; p < 4; ++p) {
        const int n = (tid >> 4) + 32 * p; const LAS unsigned* r = T + n * CV_STR + 4 * c;
        u32x4 o; o.x = r[0]; o.y = r[1]; o.z = r[2]; o.w = r[3];
        *(GAS u32x4*)(WT + (size_t)(n0 + n) * K + k0 + 8 * c) = o;
    }
    __syncthreads();
}

__device__ __forceinline__ void ph_gmlp_simple(LAS unsigned char* lds, bf16_t* Z, const float* LNP, const float* ln_g, const float* ln_b, const float* wsp, const float* bsp, int tid, int G) {
    LAS float* vn = (LAS float*)lds;
    for (int item = blockIdx.x; item < (M / 128) * 8; item += G) {
        const int chunk = item >> 3, g = item & 7, m0 = chunk * 128;
        for (int idx = tid; idx < 128 * 64; idx += NWAVES * 64) {
            const int s = idx >> 6, c = idx & 63; const size_t row = m0 + s;
            float s1 = 0.f, s2 = 0.f;
            for (int k = 0; k < 8; ++k) { s1 += LNP[(row * 8 + k) * 2]; s2 += LNP[(row * 8 + k) * 2 + 1]; }
            const float mean = s1 * (1.f / 512.f), var = s2 * (1.f / 512.f) - mean * mean, rstd = rsqrtf(var + EPS);
            const float gv = bf2f(Z[row * EV_N + 1024 + 64 * g + c]);
            vn[idx] = (gv - mean) * rstd * ln_g[64 * g + c] + ln_b[64 * g + c];
        }
        __syncthreads();
        for (int idx = tid; idx < 128 * 64; idx += NWAVES * 64) {
            const int t = idx >> 6, c = idx & 63; const size_t row = m0 + t;
            float a = bsp[g * 128 + t];
            const float* wr = wsp + ((size_t)g * 128 + t) * 128;
            for (int s2 = 0; s2 <= t; ++s2) a += wr[s2] * vn[s2 * 64 + c];
            const float gu = bf2f(Z[row * EV_N + 64 * g + c]);
            Z[row * EV_N + 64 * g + c] = (bf16_t)f2bf(gu * a);
        }
        __syncthreads();
    }
}
__device__ __forceinline__ void ph_attn_simple(bf16_t* Z, int gw, int NGW, int lane) {
    for (int wv = gw; wv < M * 8; wv += NGW) {
        const int m = wv >> 3, h = wv & 7, t = m & (SEQ - 1), mb = m - t;
        const float q = bf2f(Z[(size_t)m * EV_N + 512 + 64 * h + lane]);
        float ms[3], ls[3], os[3];
#pragma unroll
        for (int r = 0; r < 3; ++r) {
            const int dil = (r == 0) ? 1 : (r == 1) ? 4 : 16;
            float mx = -1e30f, l = 0.f, o = 0.f;
            for (int j = 0; j <= 128; ++j) {
                const int tk = t - j * dil; if (tk < 0) break;
                const size_t kr = (size_t)(mb + tk) * EV_N;
                float sc = q * bf2f(Z[kr + 1536 + 64 * h + lane]);
#pragma unroll
                for (int o2 = 1; o2 < 64; o2 <<= 1) sc += __shfl_xor(sc, o2);
                const float mn = fmaxf(mx, sc), al = __expf(mx - mn), p = __expf(sc - mn);
                l = l * al + p; o = o * al + p * bf2f(Z[kr + 2048 + 64 * h + lane]); mx = mn;
            }
            ms[r] = mx; ls[r] = l; os[r] = o / l;
        }
        const float l0 = ms[0] + __logf(ls[0]), l1 = ms[1] + __logf(ls[1]), l2 = ms[2] + __logf(ls[2]);
        const float mm = fmaxf(l0, fmaxf(l1, l2)), e0 = __expf(l0 - mm), e1 = __expf(l1 - mm), e2 = __expf(l2 - mm), inv = 1.f / (e0 + e1 + e2);
        Z[(size_t)m * EV_N + 512 + 64 * h + lane] = (bf16_t)f2bf((e0 * os[0] + e1 * os[1] + e2 * os[2]) * inv);
    }
}
__device__ __forceinline__ void ph_ga_simple(const float* X, const float* RSQ, const float* gmix, const float* w_in, float* GA, int gw, int NGW, int lane) {
    for (int m = gw; m < M; m += NGW) {
        float acc[16];
#pragma unroll
        for (int j = 0; j < 16; ++j) acc[j] = 0.f;
        for (int i = 0; i < 16; ++i) {
            const int k = i * 64 + lane; const float xv = X[(size_t)m * D + k] * gmix[k];
            const f32x4* wr = (const f32x4*)(w_in + (size_t)k * OD_NSRC + 3072);
#pragma unroll
            for (int j4 = 0; j4 < 4; ++j4) { const f32x4 w = wr[j4]; acc[4 * j4] += xv * w[0]; acc[4 * j4 + 1] += xv * w[1]; acc[4 * j4 + 2] += xv * w[2]; acc[4 * j4 + 3] += xv * w[3]; }
        }
        float s = 0.f;
        for (int j = 0; j < 16; ++j) s += RSQ[(size_t)m * 16 + j];
        const float rstd = rsqrtf(s * (1.f / 1024.f) + EPS);
#pragma unroll
        for (int j = 0; j < 16; ++j) {
            float v = acc[j];
#pragma unroll
            for (int o = 1; o < 64; o <<= 1) v += __shfl_xor(v, o);
            if (lane == j) GA[(size_t)m * 16 + j] = v * rstd;
        }
    }
}
__device__ __forceinline__ void ph_gla_simple(LAS unsigned char* lds, const bf16_t* Z, const float* GA, const float* w_a2, const float* b_a, float* ORAW, int tid, int G) {
    LAS float* sa = (LAS float*)lds; LAS float* sk = sa + 256; LAS float* sq = sk + 256;
    for (int item = blockIdx.x; item < 16; item += G) {
        const int b = item >> 2, h = item & 3, v = tid;
        float S[128];
#pragma unroll
        for (int k = 0; k < 128; ++k) S[k] = 0.f;
        float wa[16]; float ba = 0.f;
#pragma unroll
        for (int j = 0; j < 16; ++j) wa[j] = 0.f;
        if (v < 128) {
#pragma unroll
            for (int j = 0; j < 16; ++j) wa[j] = w_a2[j * 512 + h * 128 + v];
            ba = b_a[h * 128 + v]; }
        for (int t = 0; t < SEQ; ++t) {
            const size_t m = (size_t)b * SEQ + t; const int buf = (t & 1) * 128;
            if (v < 128) {
                float xg = ba;
#pragma unroll
                for (int j = 0; j < 16; ++j) xg += GA[m * 16 + j] * wa[j];
                const float ls = fminf(xg, 0.f) - log1pf(__expf(-fabsf(xg)));
                sa[buf + v] = __expf(ls * (1.f / 16.f));
                sk[buf + v] = bf2f(Z[m * OD_N + 512 + 128 * h + v]);
                sq[buf + v] = bf2f(Z[m * OD_N + 128 * h + v]);
            }
            __syncthreads();
            if (v < 256) {
                const float vv = bf2f(Z[m * OD_N + 1024 + 256 * h + v]);
                float o = 0.f;
#pragma unroll
                for (int k = 0; k < 128; ++k) { S[k] = sa[buf + k] * S[k] + sk[buf + k] * vv; o += sq[buf + k] * S[k]; }
                ORAW[m * 1024 + 256 * h + v] = o;
            }
        }
        __syncthreads();
    }
}
__device__ __forceinline__ void ph_gla_post_simple(bf16_t* Z, const float* ORAW, const float* head_g, int gw, int NGW, int lane) {
    for (int wv = gw; wv < M * 4; wv += NGW) {
        const int m = wv >> 2, h = wv & 3;
        const f32x4 o = *(const f32x4*)(ORAW + (size_t)m * 1024 + 256 * h + 4 * lane);
        float ss = dot4(o);
#pragma unroll
        for (int k = 1; k < 64; k <<= 1) ss += __shfl_xor(ss, k);
        const float rstd = rsqrtf(ss * (1.f / 256.f) + EPS);
        const f32x4 hg = *(const f32x4*)(head_g + 4 * lane);
        bf16_t* sr = Z + (size_t)m * OD_N + 2048 + 256 * h + 4 * lane;
        bf16_t* dst = Z + (size_t)m * OD_N + 1024 + 256 * h + 4 * lane;
        u32x2 w; w.x = pk2(o[0] * rstd * hg[0] * bf2f(sr[0]), o[1] * rstd * hg[1] * bf2f(sr[1])); w.y = pk2(o[2] * rstd * hg[2] * bf2f(sr[2]), o[3] * rstd * hg[3] * bf2f(sr[3]));
        *(u32x2*)dst = w;
    }
}


typedef short s16x4 __attribute__((ext_vector_type(4)));
__device__ __forceinline__ bf16x8 tr_pair(const LAS unsigned char* p0, const LAS unsigned char* p1) {
    const s16x4 lo = __builtin_amdgcn_ds_read_tr16_b64_v4i16((LAS s16x4*)p0), hi = __builtin_amdgcn_ds_read_tr16_b64_v4i16((LAS s16x4*)p1);
    return __builtin_shufflevector(lo, hi, 0, 1, 2, 3, 4, 5, 6, 7);
}
constexpr int AT_KSTR = 144, AT_VSTR = 160, AT_VOFF = 256 * AT_KSTR;
__device__ __forceinline__ void attn_item(LAS unsigned char* lds, GAS bf16_t* Z, const int dlog, const int idx, const bool final, GAS bf16_t* Pout, GAS float* Lout,
                                          const GAS bf16_t* P1, const GAS bf16_t* P2, const GAS float* L1, const GAS float* L2, const int tid) {
    const int lane = tid & 63, w = __builtin_amdgcn_readfirstlane(tid >> 6), fr = lane & 15, g = lane >> 4;
    const int nbl = 5 - dlog, bh = idx >> 5, b = bh >> 3, h = bh & 7, rn = idx & 31, r = rn >> nbl, n = rn & ((1 << nbl) - 1);
    const size_t mb = (size_t)b * SEQ;
#pragma unroll
    for (int pass = 0; pass < 4; ++pass) {
        const int row = pass * 64 + (tid >> 3), ch = tid & 7, tok = (((128 * (n - 1) + row)) << dlog) + r;
        u32x4 kv = (u32x4){0u, 0u, 0u, 0u}, vv = (u32x4){0u, 0u, 0u, 0u};
        if (tok >= 0) { const GAS bf16_t* src = Z + (mb + tok) * EV_N + 64 * h + 8 * ch; kv = *(const GAS u32x4*)(src + 1536); vv = *(const GAS u32x4*)(src + 2048); }
        *(LAS u32x4*)(lds + row * AT_KSTR + 16 * ch) = kv;
        *(LAS u32x4*)(lds + AT_VOFF + row * AT_VSTR + 16 * ch) = vv;
    }
    const int tq = ((128 * n + 16 * w + fr) << dlog) + r;
    const GAS bf16_t* qp = Z + (mb + tq) * EV_N + 512 + 64 * h;
    const bf16x8 q0 = *(const GAS bf16x8*)(qp + 8 * g), q1 = *(const GAS bf16x8*)(qp + 32 + 8 * g);
    __syncthreads();
    f32x4 st[9];
#pragma unroll
    for (int kt = 0; kt < 9; ++kt) {
        const LAS unsigned char* kr = lds + (16 * w + 16 * kt + fr) * AT_KSTR + 16 * g;
        const bf16x8 a0 = *(const LAS bf16x8*)kr, a1 = *(const LAS bf16x8*)(kr + 64);
        f32x4 c = (f32x4){0.f, 0.f, 0.f, 0.f};
        c = __builtin_amdgcn_mfma_f32_16x16x32_bf16(a0, q0, c, 0, 0, 0);
        c = __builtin_amdgcn_mfma_f32_16x16x32_bf16(a1, q1, c, 0, 0, 0);
        st[kt] = c;
    }
    float mx = -1e30f;
#pragma unroll
    for (int kt = 0; kt < 9; ++kt) {
        const bool tv = (n > 0) || (kt >= 8 - w);
#pragma unroll
        for (int e = 0; e < 4; ++e) {
            const int jj = 4 * g + e;
            bool ok = tv; if (kt == 0) ok = ok && (jj >= fr); if (kt == 8) ok = ok && (jj <= fr);
            const float sv = ok ? st[kt][e] : -1e30f; st[kt][e] = sv; mx = fmaxf(mx, sv);
        }
    }
    mx = fmaxf(mx, __shfl_xor(mx, 16)); mx = fmaxf(mx, __shfl_xor(mx, 32));
    float l = 0.f;
#pragma unroll
    for (int kt = 0; kt < 9; ++kt)
#pragma unroll
        for (int e = 0; e < 4; ++e) { const float p = __expf(st[kt][e] - mx); st[kt][e] = p; l += p; }
    l += __shfl_xor(l, 16); l += __shfl_xor(l, 32);
    f32x4 ot[4];
#pragma unroll
    for (int dt = 0; dt < 4; ++dt) ot[dt] = (f32x4){0.f, 0.f, 0.f, 0.f};
    const int qq = fr >> 2, pp = fr & 3;
#pragma unroll
    for (int ks2 = 0; ks2 < 5; ++ks2) {
        const int T0 = 2 * ks2, T1 = (ks2 < 4) ? 2 * ks2 + 1 : 2 * ks2;
        u32x4 pb; pb.x = cvt_pk_bf16(st[T0][0], st[T0][1]); pb.y = cvt_pk_bf16(st[T0][2], st[T0][3]);
        if (ks2 < 4) { pb.z = cvt_pk_bf16(st[T1][0], st[T1][1]); pb.w = cvt_pk_bf16(st[T1][2], st[T1][3]); } else { pb.z = 0u; pb.w = 0u; }
        const bf16x8 bfrag = __builtin_bit_cast(bf16x8, pb);
        const LAS unsigned char* v0 = lds + AT_VOFF + (16 * w + 16 * T0 + 4 * g + qq) * AT_VSTR + 8 * pp;
        const LAS unsigned char* v1 = lds + AT_VOFF + (16 * w + 16 * T1 + 4 * g + qq) * AT_VSTR + 8 * pp;
#pragma unroll
        for (int dt = 0; dt < 4; ++dt) ot[dt] = __builtin_amdgcn_mfma_f32_16x16x32_bf16(tr_pair(v0 + 32 * dt, v1 + 32 * dt), bfrag, ot[dt], 0, 0, 0);
    }
    const float inv = 1.0f / l, lse = mx + __logf(l);
    if (!final) {
        GAS bf16_t* op = Pout + (mb + tq) * 512 + 64 * h + 4 * g;
#pragma unroll
        for (int dt = 0; dt < 4; ++dt) { u32x2 o; o.x = cvt_pk_bf16(ot[dt][0] * inv, ot[dt][1] * inv); o.y = cvt_pk_bf16(ot[dt][2] * inv, ot[dt][3] * inv); *(GAS u32x2*)(op + 16 * dt) = o; }
        if (g == 0) Lout[(mb + tq) * 8 + h] = lse;
    } else {
        const float l1 = L1[(mb + tq) * 8 + h], l2 = L2[(mb + tq) * 8 + h];
        const float mm = fmaxf(lse, fmaxf(l1, l2)), e0 = __expf(lse - mm), e1 = __expf(l1 - mm), e2 = __expf(l2 - mm), rs = 1.0f / (e0 + e1 + e2);
        const float w0 = e0 * rs * inv, w1 = e1 * rs, w2 = e2 * rs;
        const GAS bf16_t* p1 = P1 + (mb + tq) * 512 + 64 * h + 4 * g; const GAS bf16_t* p2 = P2 + (mb + tq) * 512 + 64 * h + 4 * g;
        GAS bf16_t* op = Z + (mb + tq) * EV_N + 512 + 64 * h + 4 * g;
#pragma unroll
        for (int dt = 0; dt < 4; ++dt) {
            const u32x2 a = *(const GAS u32x2*)(p1 + 16 * dt), c = *(const GAS u32x2*)(p2 + 16 * dt);
            const float r0 = w0 * ot[dt][0] + w1 * bf2f((unsigned short)(a.x & 0xffffu)) + w2 * bf2f((unsigned short)(c.x & 0xffffu));
            const float r1 = w0 * ot[dt][1] + w1 * bf2f((unsigned short)(a.x >> 16)) + w2 * bf2f((unsigned short)(c.x >> 16));
            const float r2 = w0 * ot[dt][2] + w1 * bf2f((unsigned short)(a.y & 0xffffu)) + w2 * bf2f((unsigned short)(c.y & 0xffffu));
            const float r3 = w0 * ot[dt][3] + w1 * bf2f((unsigned short)(a.y >> 16)) + w2 * bf2f((unsigned short)(c.y >> 16));
            u32x2 o; o.x = cvt_pk_bf16(r0, r1); o.y = cvt_pk_bf16(r2, r3); *(GAS u32x2*)(op + 16 * dt) = o;
        }
    }
    __syncthreads();
}
constexpr int GM_STR = 160;
__device__ __forceinline__ void gmlp_item(LAS unsigned char* lds, GAS bf16_t* Z, const GAS float* LNP, const GAS float* ln_g, const GAS float* ln_b, const GAS bf16_t* Wbf, const GAS float* bs, const int item, const int tid) {
    const int lane = tid & 63, w = __builtin_amdgcn_readfirstlane(tid >> 6), fr = lane & 15, g4 = lane >> 4;
    const int chunk = item >> 3, g = item & 7, m0 = chunk * 128;
    {
        const int s = tid >> 2, c0 = (tid & 3) * 16; const size_t row = m0 + s;
        float s1 = 0.f, s2 = 0.f;
#pragma unroll
        for (int k = 0; k < 4; ++k) { const f32x4 p = *(const GAS f32x4*)(LNP + row * 16 + 4 * k); s1 += p[0] + p[2]; s2 += p[1] + p[3]; }
        const float mean = s1 * (1.f / 512.f), var = s2 * (1.f / 512.f) - mean * mean, rstd = rsqrtf(var + EPS);
        const GAS bf16_t* gp = Z + row * EV_N + 1024 + 64 * g + c0;
#pragma unroll
        for (int hh = 0; hh < 2; ++hh) {
            const u32x4 raw = *(const GAS u32x4*)(gp + 8 * hh);
            const f32x4 la = *(const GAS f32x4*)(ln_g + 64 * g + c0 + 8 * hh), lb = *(const GAS f32x4*)(ln_g + 64 * g + c0 + 8 * hh + 4);
            const f32x4 ba = *(const GAS f32x4*)(ln_b + 64 * g + c0 + 8 * hh), bb = *(const GAS f32x4*)(ln_b + 64 * g + c0 + 8 * hh + 4);
            f32x4 x0, x1;
            x0[0] = bf2f((unsigned short)(raw.x & 0xffffu)); x0[1] = bf2f((unsigned short)(raw.x >> 16)); x0[2] = bf2f((unsigned short)(raw.y & 0xffffu)); x0[3] = bf2f((unsigned short)(raw.y >> 16));
            x1[0] = bf2f((unsigned short)(raw.z & 0xffffu)); x1[1] = bf2f((unsigned short)(raw.z >> 16)); x1[2] = bf2f((unsigned short)(raw.w & 0xffffu)); x1[3] = bf2f((unsigned short)(raw.w >> 16));
            x0 = (x0 - mean) * rstd * la + ba; x1 = (x1 - mean) * rstd * lb + bb;
            *(LAS u32x4*)(lds + s * GM_STR + (c0 + 8 * hh) * 2) = pack8(x0, x1);
        }
    }
    __syncthreads();
    f32x4 acc[4];
#pragma unroll
    for (int ct = 0; ct < 4; ++ct) acc[ct] = (f32x4){0.f, 0.f, 0.f, 0.f};
    const int t = 16 * w + fr, qq = fr >> 2, pp = fr & 3;
    const GAS bf16_t* wrow = Wbf + ((size_t)g * 128 + t) * 128 + 8 * g4;
#pragma unroll
    for (int ks = 0; ks < 4; ++ks) {
        if (32 * ks <= 16 * w + 15) {
            const bf16x8 bfr = *(const GAS bf16x8*)(wrow + 32 * ks);
            const LAS unsigned char* a0 = lds + (32 * ks + 8 * g4 + qq) * GM_STR + 8 * pp;
#pragma unroll
            for (int ct = 0; ct < 4; ++ct) acc[ct] = __builtin_amdgcn_mfma_f32_16x16x32_bf16(tr_pair(a0 + 32 * ct, a0 + 4 * GM_STR + 32 * ct), bfr, acc[ct], 0, 0, 0);
        }
    }
    const float bias = bs[g * 128 + t];
    GAS bf16_t* up = Z + (size_t)(m0 + t) * EV_N + 64 * g + 4 * g4;
#pragma unroll
    for (int ct = 0; ct < 4; ++ct) {
        const u32x2 a = *(const GAS u32x2*)(up + 16 * ct);
        u32x2 o; o.x = cvt_pk_bf16(bf2f((unsigned short)(a.x & 0xffffu)) * (acc[ct][0] + bias), bf2f((unsigned short)(a.x >> 16)) * (acc[ct][1] + bias));
        o.y = cvt_pk_bf16(bf2f((unsigned short)(a.y & 0xffffu)) * (acc[ct][2] + bias), bf2f((unsigned short)(a.y >> 16)) * (acc[ct][3] + bias));
        *(GAS u32x2*)(up + 16 * ct) = o;
    }
    __syncthreads();
}


constexpr int GL_GAL = 0, GL_SEG = 4096, GL_A = 8192;
constexpr int G1_KSSTR = 144, G1_V = GL_A + 128 * G1_KSSTR, GL_VSTR = 544;
constexpr int G3_QSTR = 272, G3_KT = GL_A + 64 * G3_QSTR, G3_V = G3_KT + 64 * G3_QSTR, G3_SSQ = G3_V + 64 * GL_VSTR;
__device__ __forceinline__ void gla_decay(LAS unsigned char* lds, const GAS float* GA, const GAS float* w_a2, const GAS float* b_a, const int h, const size_t m0, const int tid, float (&bl)[2][8], float (&tot)[2]) {
    LAS float* gal = (LAS float*)(lds + GL_GAL); LAS float* seg = (LAS float*)(lds + GL_SEG);
    const int kp = tid & 63, s8 = tid >> 6;
    if (tid < 256) *(LAS f32x4*)(gal + 4 * tid) = *(const GAS f32x4*)(GA + m0 * 16 + 4 * tid);
    float wa[2][16], ba[2];
#pragma unroll
    for (int c = 0; c < 2; ++c) {
#pragma unroll
        for (int j = 0; j < 16; ++j) wa[c][j] = w_a2[j * 512 + 128 * h + 2 * kp + c];
        ba[c] = b_a[128 * h + 2 * kp + c]; }
    __syncthreads();
    float run[2] = {0.f, 0.f};
#pragma unroll
    for (int i = 0; i < 8; ++i) {
        const LAS f32x4* gr = (const LAS f32x4*)(gal + (8 * s8 + i) * 16);
        const f32x4 g0 = gr[0], g1 = gr[1], g2 = gr[2], g3 = gr[3];
#pragma unroll
        for (int c = 0; c < 2; ++c) {
            float x = ba[c];
#pragma unroll
            for (int j = 0; j < 4; ++j) x += g0[j] * wa[c][j] + g1[j] * wa[c][4 + j] + g2[j] * wa[c][8 + j] + g3[j] * wa[c][12 + j];
            const float ls = fminf(x, 0.f) - __logf(1.0f + __expf(-fabsf(x)));
            run[c] += ls * (1.0f / 16.0f); bl[c][i] = run[c];
        }
    }
    *(LAS f32x2*)(seg + s8 * 128 + 2 * kp) = (f32x2){run[0], run[1]};
    __syncthreads();
    float pre[2] = {0.f, 0.f}; tot[0] = 0.f; tot[1] = 0.f;
#pragma unroll
    for (int q = 0; q < 8; ++q) { const f32x2 sv = *(const LAS f32x2*)(seg + q * 128 + 2 * kp); if (q < s8) { pre[0] += sv.x; pre[1] += sv.y; } tot[0] += sv.x; tot[1] += sv.y; }
#pragma unroll
    for (int i = 0; i < 8; ++i) { bl[0][i] += pre[0]; bl[1][i] += pre[1]; }
}
__device__ __forceinline__ void gla_stage_v(LAS unsigned char* vl, const GAS bf16_t* Z, const int h, const size_t m0, const int tid) {
#pragma unroll
    for (int p = 0; p < 4; ++p) { const int idx = p * 512 + tid, t = idx >> 5, ch = idx & 31;
        *(LAS u32x4*)(vl + t * GL_VSTR + 16 * ch) = *(const GAS u32x4*)(Z + (m0 + t) * OD_N + 1024 + 256 * h + 8 * ch); }
}
__device__ __forceinline__ void gla_g1_item(LAS unsigned char* lds, const GAS bf16_t* Z, const GAS float* GA, const GAS float* w_a2, const GAS float* b_a, GAS bf16_t* KVT, GAS float* DEC, const int item, const int tid) {
    const int lane = tid & 63, w = __builtin_amdgcn_readfirstlane(tid >> 6), fr = lane & 15, g = lane >> 4;
    const int bh = item >> 6, n = item & 63, h = bh & 3; const size_t m0 = (size_t)(bh >> 2) * SEQ + 64 * n;
    float bl[2][8], tot[2];
    gla_decay(lds, GA, w_a2, b_a, h, m0, tid, bl, tot);
    const int kp = tid & 63, s8 = tid >> 6;
    {
        float ks[2][8];
#pragma unroll
        for (int i = 0; i < 8; ++i) {
            const unsigned kk = *(const GAS unsigned*)(Z + (m0 + 8 * s8 + i) * OD_N + 512 + 128 * h + 2 * kp);
            ks[0][i] = bf2f((unsigned short)(kk & 0xffffu)) * __expf(tot[0] - bl[0][i]); ks[1][i] = bf2f((unsigned short)(kk >> 16)) * __expf(tot[1] - bl[1][i]);
        }
#pragma unroll
        for (int c = 0; c < 2; ++c)
            *(LAS u32x4*)(lds + GL_A + (2 * kp + c) * G1_KSSTR + 16 * s8) = pack8((f32x4){ks[c][0], ks[c][1], ks[c][2], ks[c][3]}, (f32x4){ks[c][4], ks[c][5], ks[c][6], ks[c][7]});
        if (s8 == 0) *(GAS f32x2*)(DEC + (size_t)item * 128 + 2 * kp) = (f32x2){__expf(tot[0]), __expf(tot[1])};
    }
    gla_stage_v(lds + G1_V, Z, h, m0, tid);
    __syncthreads();
    const LAS unsigned char* ar = lds + GL_A + (16 * w + fr) * G1_KSSTR + 16 * g;
    const bf16x8 a0 = *(const LAS bf16x8*)ar, a1 = *(const LAS bf16x8*)(ar + 64);
    const int qq = fr >> 2, pp = fr & 3;
    const LAS unsigned char* vb = lds + G1_V + (8 * g + qq) * GL_VSTR + 8 * pp;
    GAS bf16_t* outp = KVT + (size_t)item * 32768 + (size_t)fr * 128 + 16 * w + 4 * g;
#pragma unroll
    for (int vt = 0; vt < 16; ++vt) {
        f32x4 c = (f32x4){0.f, 0.f, 0.f, 0.f};
        c = __builtin_amdgcn_mfma_f32_16x16x32_bf16(a0, tr_pair(vb + 32 * vt, vb + 4 * GL_VSTR + 32 * vt), c, 0, 0, 0);
        c = __builtin_amdgcn_mfma_f32_16x16x32_bf16(a1, tr_pair(vb + 32 * GL_VSTR + 32 * vt, vb + 36 * GL_VSTR + 32 * vt), c, 0, 0, 0);
        u32x2 o; o.x = cvt_pk_bf16(c[0], c[1]); o.y = cvt_pk_bf16(c[2], c[3]);
        *(GAS u32x2*)(outp + (size_t)vt * 16 * 128) = o;
    }
    __syncthreads();
}
__device__ __forceinline__ void gla_scan(GAS bf16_t* KVT, const GAS float* DEC, const int tid, const int G) {
    for (int gid = blockIdx.x * (NWAVES * 64) + tid; gid < 16 * 8192; gid += G * NWAVES * 64) {
        const int bh = gid >> 13, off = (gid & 8191) * 4, k4 = gid & 31;
        GAS bf16_t* p = KVT + (size_t)bh * 64 * 32768 + off; const GAS float* dp = DEC + (size_t)bh * 64 * 128 + 4 * k4;
        f32x4 S = (f32x4){0.f, 0.f, 0.f, 0.f};
        for (int n0 = 0; n0 < 64; n0 += 8) {
            u32x2 kv[8]; f32x4 dc[8];
#pragma unroll
            for (int i = 0; i < 8; ++i) { kv[i] = *(const GAS u32x2*)(p + (size_t)(n0 + i) * 32768); dc[i] = *(const GAS f32x4*)(dp + (n0 + i) * 128); }
#pragma unroll
            for (int i = 0; i < 8; ++i) {
                u32x2 o; o.x = cvt_pk_bf16(S[0], S[1]); o.y = cvt_pk_bf16(S[2], S[3]);
                *(GAS u32x2*)(p + (size_t)(n0 + i) * 32768) = o;
                S[0] = dc[i][0] * S[0] + bf2f((unsigned short)(kv[i].x & 0xffffu)); S[1] = dc[i][1] * S[1] + bf2f((unsigned short)(kv[i].x >> 16));
                S[2] = dc[i][2] * S[2] + bf2f((unsigned short)(kv[i].y & 0xffffu)); S[3] = dc[i][3] * S[3] + bf2f((unsigned short)(kv[i].y >> 16));
            }
        }
    }
}
__device__ __forceinline__ void gla_g3_item(LAS unsigned char* lds, GAS bf16_t* Z, const GAS float* GA, const GAS float* w_a2, const GAS float* b_a, const GAS bf16_t* KVT, const GAS float* head_g, const int item, const int tid) {
    const int lane = tid & 63, w = __builtin_amdgcn_readfirstlane(tid >> 6), fr = lane & 15, g = lane >> 4;
    const int bh = item >> 6, n = item & 63, h = bh & 3; const size_t m0 = (size_t)(bh >> 2) * SEQ + 64 * n;
    float bl[2][8], tot[2];
    gla_decay(lds, GA, w_a2, b_a, h, m0, tid, bl, tot);
    const int kp = tid & 63, s8 = tid >> 6;
#pragma unroll
    for (int i = 0; i < 8; ++i) {
        const int t = 8 * s8 + i;
        const unsigned qv = *(const GAS unsigned*)(Z + (m0 + t) * OD_N + 128 * h + 2 * kp), kv = *(const GAS unsigned*)(Z + (m0 + t) * OD_N + 512 + 128 * h + 2 * kp);
        const float e0 = __expf(bl[0][i]), e1 = __expf(bl[1][i]), f0 = __expf(-bl[0][i]), f1 = __expf(-bl[1][i]);
        *(LAS unsigned*)(lds + GL_A + t * G3_QSTR + 4 * kp) = cvt_pk_bf16(bf2f((unsigned short)(qv & 0xffffu)) * e0, bf2f((unsigned short)(qv >> 16)) * e1);
        *(LAS unsigned*)(lds + G3_KT + t * G3_QSTR + 4 * kp) = cvt_pk_bf16(bf2f((unsigned short)(kv & 0xffffu)) * f0, bf2f((unsigned short)(kv >> 16)) * f1);
    }
    gla_stage_v(lds + G3_V, Z, h, m0, tid);
    __syncthreads();
    u32x4 pb[4][2];
#pragma unroll
    for (int tt = 0; tt < 4; ++tt) {
        bf16x8 qf[4];
#pragma unroll
        for (int ks = 0; ks < 4; ++ks) qf[ks] = *(const LAS bf16x8*)(lds + GL_A + (16 * tt + fr) * G3_QSTR + 64 * ks + 16 * g);
        u32x2 pk[4];
#pragma unroll
        for (int jt = 0; jt < 4; ++jt) {
            if (jt <= tt) {
                f32x4 c = (f32x4){0.f, 0.f, 0.f, 0.f};
#pragma unroll
                for (int ks = 0; ks < 4; ++ks) c = __builtin_amdgcn_mfma_f32_16x16x32_bf16(*(const LAS bf16x8*)(lds + G3_KT + (16 * jt + fr) * G3_QSTR + 64 * ks + 16 * g), qf[ks], c, 0, 0, 0);
                if (jt == tt) {
#pragma unroll
                    for (int e = 0; e < 4; ++e) c[e] = (4 * g + e <= fr) ? c[e] : 0.f;
                }
                pk[jt].x = cvt_pk_bf16(c[0], c[1]); pk[jt].y = cvt_pk_bf16(c[2], c[3]);
            } else { pk[jt].x = 0u; pk[jt].y = 0u; }
        }
        pb[tt][0] = (u32x4){pk[0].x, pk[0].y, pk[1].x, pk[1].y}; pb[tt][1] = (u32x4){pk[2].x, pk[2].y, pk[3].x, pk[3].y};
    }
    const int qq = fr >> 2, pp = fr & 3;
    f32x4 acc[2][4];
    float ssq[4] = {0.f, 0.f, 0.f, 0.f};
#pragma unroll
    for (int vi = 0; vi < 2; ++vi) {
        const int vt = 2 * w + vi;
        bf16x8 sf[4];
        const GAS bf16_t* sp = KVT + (size_t)item * 32768 + (size_t)(16 * vt + fr) * 128 + 8 * g;
#pragma unroll
        for (int ks = 0; ks < 4; ++ks) sf[ks] = *(const GAS bf16x8*)(sp + 32 * ks);
        const LAS unsigned char* vb = lds + G3_V + (4 * g + qq) * GL_VSTR + 32 * vt + 8 * pp;
        const bf16x8 va = tr_pair(vb, vb + 16 * GL_VSTR), vc = tr_pair(vb + 32 * GL_VSTR, vb + 48 * GL_VSTR);
#pragma unroll
        for (int tt = 0; tt < 4; ++tt) {
            f32x4 c = (f32x4){0.f, 0.f, 0.f, 0.f};
#pragma unroll
            for (int ks = 0; ks < 4; ++ks) c = __builtin_amdgcn_mfma_f32_16x16x32_bf16(sf[ks], *(const LAS bf16x8*)(lds + GL_A + (16 * tt + fr) * G3_QSTR + 64 * ks + 16 * g), c, 0, 0, 0);
            c = __builtin_amdgcn_mfma_f32_16x16x32_bf16(va, __builtin_bit_cast(bf16x8, pb[tt][0]), c, 0, 0, 0);
            if (tt >= 2) c = __builtin_amdgcn_mfma_f32_16x16x32_bf16(vc, __builtin_bit_cast(bf16x8, pb[tt][1]), c, 0, 0, 0);
            acc[vi][tt] = c; ssq[tt] += dot4(c);
        }
    }
    LAS float* sl = (LAS float*)(lds + G3_SSQ);
#pragma unroll
    for (int tt = 0; tt < 4; ++tt) { float v = ssq[tt]; v += __shfl_xor(v, 16); v += __shfl_xor(v, 32); if (g == 0) sl[w * 64 + 16 * tt + fr] = v; }
    __syncthreads();
#pragma unroll
    for (int tt = 0; tt < 4; ++tt) {
        float tsum = 0.f;
#pragma unroll
        for (int q = 0; q < 8; ++q) tsum += sl[q * 64 + 16 * tt + fr];
        const float rstd = rsqrtf(tsum * (1.0f / 256.0f) + EPS);
#pragma unroll
        for (int vi = 0; vi < 2; ++vi) {
            const int vc0 = 32 * w + 16 * vi + 4 * g;
            const f32x4 hg = *(const GAS f32x4*)(head_g + vc0);
            GAS bf16_t* row = Z + (m0 + 16 * tt + fr) * OD_N + 256 * h + vc0;
            const u32x2 sr = *(const GAS u32x2*)(row + 2048);
            const f32x4 c = acc[vi][tt];
            u32x2 o; o.x = cvt_pk_bf16(c[0] * rstd * hg[0] * bf2f((unsigned short)(sr.x & 0xffffu)), c[1] * rstd * hg[1] * bf2f((unsigned short)(sr.x >> 16)));
            o.y = cvt_pk_bf16(c[2] * rstd * hg[2] * bf2f((unsigned short)(sr.y & 0xffffu)), c[3] * rstd * hg[3] * bf2f((unsigned short)(sr.y >> 16)));
            *(GAS u32x2*)(row + 1024) = o;
        }
    }
    __syncthreads();
}
__device__ __forceinline__ void ga_group(LAS unsigned char* lds, const GAS bf16_t* XB, const GAS float* RSQ, const GAS bf16_t* WGA, GAS float* GA, const int grp, const int tid) {
    const int lane = tid & 63, w = __builtin_amdgcn_readfirstlane(tid >> 6), fr = lane & 15, g = lane >> 4, tt = w & 3, kh = w >> 2;
    const GAS bf16_t* ap = XB + (size_t)(64 * grp + 16 * tt + fr) * D + 512 * kh + 8 * g; const GAS bf16_t* bp = WGA + (size_t)fr * D + 512 * kh + 8 * g;
    f32x4 c = (f32x4){0.f, 0.f, 0.f, 0.f};
#pragma unroll 4
    for (int ks = 0; ks < 16; ++ks) c = __builtin_amdgcn_mfma_f32_16x16x32_bf16(*(const GAS bf16x8*)(ap + 32 * ks), *(const GAS bf16x8*)(bp + 32 * ks), c, 0, 0, 0);
    LAS float* pl = (LAS float*)lds;
#pragma unroll
    for (int e = 0; e < 4; ++e) pl[(kh * 64 + 16 * tt + 4 * g + e) * 16 + fr] = c[e];
    __syncthreads();
    for (int i = tid; i < 64 * 16; i += NWAVES * 64) {
        const int t = i >> 4; const size_t row = (size_t)64 * grp + t;
        float s = 0.f;
#pragma unroll
        for (int q = 0; q < 4; ++q) s += sum4(*(const GAS f32x4*)(RSQ + row * 16 + 4 * q));
        GA[row * 16 + (i & 15)] = (pl[i] + pl[1024 + i]) * rsqrtf(s * (1.0f / 1024.0f) + EPS);
    }
    __syncthreads();
}

constexpr int RING_BYTES = 131072, LDSCTL_OFF = RING_BYTES, MISC_OFF = LDSCTL_OFF + 320, LDSX_OFF = RING_BYTES + 1024, LDS_BYTES = 147456;
constexpr int NPHASE = 1 + 8 * DEPTH;
struct Args { const float* in[21]; float* out; unsigned char* ws; int ph_lo, ph_hi, li, pad; };

#define GIN(i) ((const GAS float*)inp[i])
__global__ void __launch_bounds__(NWAVES * 64, 2) mega(Args args) {
    extern __shared__ __attribute__((aligned(16))) unsigned char lds_raw[];
    LAS unsigned char* lds = (LAS unsigned char*)lds_raw;
    volatile LAS unsigned* MISC = (volatile LAS unsigned*)(lds + MISC_OFF);
    const int G = gridDim.x;
    unsigned* ctl = (unsigned*)(args.ws + WS_CTL);
    for (int u = threadIdx.x; u < (LDS_BYTES - LDSCTL_OFF) / 4; u += NWAVES * 64) ((LAS unsigned*)(lds + LDSCTL_OFF))[u] = 0u;
    __syncthreads();
    XcdBarrier bar = xcd_barrier_post(ctl + CW_BAR + args.li * XCD_BAR_WORDS, MISC + 8);

    typedef const float* cfp_t;
    const __attribute__((address_space(4))) cfp_t* inp0 = (const __attribute__((address_space(4))) cfp_t*)__builtin_amdgcn_kernarg_segment_ptr();

    bool first = true;
    for (int ph = args.ph_lo; ph < args.ph_hi; ++ph) {
        if (ph > 0) { const int L_ = (ph - 1) >> 3, sub_ = (ph - 1) & 7; if (sub_ == 6 || ((L_ & 1) == 0 && sub_ == 3)) continue; }
        if (!first) xcd_barrier(bar);
        first = false;
        const __attribute__((address_space(4))) cfp_t* inp = inp0; asm volatile("" : "+s"(inp));
        unsigned char* ws = args.ws; asm volatile("" : "+s"(ws));
        int tid = threadIdx.x; asm volatile("" : "+v"(tid));
        const int lane = tid & 63, wave = __builtin_amdgcn_readfirstlane(tid >> 6);
        const int gw = blockIdx.x * NWAVES + wave, NGW = G * NWAVES;
        LAS float* scr = (LAS float*)(lds + wave * 16384);
        GAS float* X = (GAS float*)args.out; asm volatile("" : "+s"(X));
        GAS bf16_t* XB = (GAS bf16_t*)(ws + WS_XB); GAS bf16_t* Z = (GAS bf16_t*)(ws + WS_Z);
        GAS float* RSQ = (GAS float*)(ws + WS_RSQ); GAS float* LNP = (GAS float*)(ws + WS_LNP);
        GAS float* HALO = (GAS float*)(ws + WS_HALO); GAS float* FIXP = (GAS float*)(ws + WS_FIXP); GAS float* FIXU = (GAS float*)(ws + WS_FIXU);
        GAS bf16_t* WGU = (GAS bf16_t*)(ws + WS_WFFN); GAS bf16_t* WDN = (GAS bf16_t*)(ws + WS_WFFN + OFF_WDOWN);
        if (ph == 0) {
            constexpr int I_EVIN = 8 * (EV_N / 128), I_SQ = 8 * 8, I_ODIN = 8 * (OD_N / 128);
            constexpr int PER = I_EVIN + I_SQ + I_ODIN + I_SQ;
            for (int it = blockIdx.x; it < 2 * PER; it += G) {
                const int e = it / PER; int r = it % PER;
                if (r < I_EVIN) { conv_block_item(lds, GIN(3) + (size_t)e * D * EV_N, nullptr, EV_N, D, EV_N, GIN(1) + (size_t)(2 * e) * D, (GAS bf16_t*)(ws + WS_WMIX + OFF_EVIN) + (size_t)e * EV_N * D, 1, r, tid); continue; } r -= I_EVIN;
                if (r < I_SQ) { conv_block_item(lds, GIN(10) + (size_t)e * D * D, nullptr, D, D, D, nullptr, (GAS bf16_t*)(ws + WS_WMIX + OFF_EVOUT) + (size_t)e * D * D, 0, r, tid); continue; } r -= I_SQ;
                if (r < I_ODIN) { conv_block_item(lds, GIN(11) + (size_t)e * D * OD_NSRC, nullptr, OD_NSRC, D, OD_N, GIN(1) + (size_t)(2 * e + 1) * D, (GAS bf16_t*)(ws + WS_WMIX + OFF_ODIN) + (size_t)e * OD_N * D, 0, r, tid); continue; } r -= I_ODIN;
                conv_block_item(lds, GIN(15) + (size_t)e * D * D, nullptr, D, D, D, nullptr, (GAS bf16_t*)(ws + WS_WMIX + OFF_ODOUT) + (size_t)e * D * D, 0, r, tid);
            }
            for (int i = blockIdx.x * (NWAVES * 64) + tid; i < 2 * 8 * 128 * 128; i += G * NWAVES * 64) {
                const int tt = (i >> 7) & 127, ss = i & 127;
                ((GAS bf16_t*)(ws + WS_SMALLW))[i] = (bf16_t)((ss <= tt) ? f2bf(GIN(6)[i]) : 0u);
            }
            for (int i = blockIdx.x * (NWAVES * 64) + tid; i < 2 * 16 * 1024; i += G * NWAVES * 64) {
                const int o = i >> 14, j = (i >> 10) & 15, k = i & 1023;
                ((GAS bf16_t*)(ws + WS_SMALLW + 512 * 1024))[i] = (bf16_t)f2bf(GIN(11)[((size_t)o * D + k) * OD_NSRC + 3072 + j] * GIN(1)[(size_t)(2 * o + 1) * D + k]);
            }
            for (int m = gw; m < M; m += NGW) {
                const f32x4* xr = (const f32x4*)(GIN(0) + (size_t)m * D) + lane; f32x4 v[4]; float s = 0.f;
#pragma unroll
                for (int j = 0; j < 4; ++j) { v[j] = xr[64 * j]; s += dot4(v[j]); }
#pragma unroll
                for (int o = 1; o < 64; o <<= 1) s += __shfl_xor(s, o);
                u32x2* o8 = (u32x2*)(XB + (size_t)m * D) + lane;
#pragma unroll
                for (int j = 0; j < 4; ++j) { u32x2 w; w.x = pk2(v[j][0], v[j][1]); w.y = pk2(v[j][2], v[j][3]); o8[64 * j] = w; }
                if (lane < 16) RSQ[(size_t)m * 16 + lane] = (lane == 0) ? s : 0.f;
            }
        } else {
            const int L = (ph - 1) >> 3, sub = (ph - 1) & 7, e = L >> 1; const bool even = (L & 1) == 0;
            if (sub == 0) {
                pg8::StaticOrder S;
                if (even) {
                    pg8::Gemm g{(const bf16_t*)XB, (const bf16_t*)(ws + WS_WMIX + OFF_EVIN) + (size_t)e * EV_N * D, M, EV_N, D, D}; S.init(M, EV_N, G, (int)blockIdx.x);
                    EpiEvenIn E{Z, RSQ, LNP, GIN(8) + e * 64, GIN(9) + e * 64};
                    pg8::gemm_phase<EpiEvenIn>(lds, g, S, E, tid);
                } else {
                    pg8::Gemm g{(const bf16_t*)XB, (const bf16_t*)(ws + WS_WMIX + OFF_ODIN) + (size_t)e * OD_N * D, M, OD_N, D, D}; S.init(M, OD_N, G, (int)blockIdx.x);
                    EpiOddIn E{Z, RSQ};
                    pg8::gemm_phase<EpiOddIn>(lds, g, S, E, tid);
                    for (int grp = blockIdx.x; grp < M / 64; grp += G) ga_group(lds, XB, RSQ, (const GAS bf16_t*)(ws + WS_SMALLW + 512 * 1024) + (size_t)e * 16 * D, (GAS float*)(ws + WS_GA), grp, tid);
                }
            } else if (sub == 1) {
                if (even) {
                    GAS bf16_t* P1 = (GAS bf16_t*)(ws + WS_AUX); GAS bf16_t* P2 = (GAS bf16_t*)(ws + WS_AUX + 16 * MiB); GAS float* L1 = (GAS float*)(ws + WS_AUX + 32 * MiB); GAS float* L2 = L1 + (size_t)M * 8;
                    for (int it = blockIdx.x; it < 3072; it += G) {
                        if (it < 1024) attn_item(lds, Z, 0, it, false, P1, L1, nullptr, nullptr, nullptr, nullptr, tid);
                        else if (it < 2048) attn_item(lds, Z, 2, it - 1024, false, P2, L2, nullptr, nullptr, nullptr, nullptr, tid);
                        else gmlp_item(lds, Z, LNP, GIN(4) + e * 512, GIN(5) + e * 512, (const GAS bf16_t*)(ws + WS_SMALLW) + (size_t)e * 8 * 128 * 128, GIN(7) + e * 8 * 128, it - 2048, tid);
                    }
                } else {
                    for (int it = blockIdx.x; it < 1024; it += G) gla_g1_item(lds, Z, (const GAS float*)(ws + WS_GA), GIN(12) + (size_t)e * 16 * 512, GIN(13) + e * 512, (GAS bf16_t*)(ws + WS_AUX), LNP, it, tid);
                }
            } else if (sub == 2 && even) {
                const GAS bf16_t* P1 = (const GAS bf16_t*)(ws + WS_AUX); const GAS bf16_t* P2 = (const GAS bf16_t*)(ws + WS_AUX + 16 * MiB); const GAS float* L1 = (const GAS float*)(ws + WS_AUX + 32 * MiB); const GAS float* L2 = L1 + (size_t)M * 8;
                for (int it = blockIdx.x; it < 1024; it += G) attn_item(lds, Z, 4, it, true, nullptr, nullptr, P1, P2, L1, L2, tid);
            } else if (sub == 2) {
                gla_scan((GAS bf16_t*)(ws + WS_AUX), LNP, tid, G);
            } else if (sub == 3) {
                for (int it = blockIdx.x; it < 1024; it += G) gla_g3_item(lds, Z, (const GAS float*)(ws + WS_GA), GIN(12) + (size_t)e * 16 * 512, GIN(13) + e * 512, (const GAS bf16_t*)(ws + WS_AUX), GIN(14) + e * 256, it, tid);
            } else if (sub == 4 || sub == 7) {
                if (sub == 4) {
                    constexpr int I_GU = 8 * (GU_N / 128), I_DN = (FF / 128) * 8;
                    const GAS float* wg = GIN(16) + (size_t)L * D * FF; const GAS float* wu = GIN(17) + (size_t)L * D * FF; const GAS float* wd = GIN(20) + (size_t)L * FF * D;
                    for (int it = blockIdx.x; it < I_GU + I_DN; it += G) {
                        if (it < I_GU) conv_block_item(lds, wg, wu, FF, D, GU_N, GIN(2) + (size_t)L * D, WGU, 2, it, tid);
                        else conv_block_item(lds, wd, nullptr, D, FF, D, nullptr, WDN, 0, it - I_GU, tid);
                    }
                    __syncthreads();
                }
                pg8::StaticOrder S; S.init(M, D, G, (int)blockIdx.x);
                if (sub == 7) {
                    const GAS float* cw = GIN(18) + (size_t)L * 3 * FF; Unit fu;
                    for (int i = 0; S.next(i, fu); ++i) {
                        const int pm = fu.pm; if ((pm & 15) == 0) continue;
                        for (int idx = tid; idx < 2 * FF; idx += NWAVES * 64) {
                            const int j = idx / FF, c = idx % FF;
                            const float h1 = HALO[((size_t)(pm - 1) * 2 + 1) * FF + c], h0 = HALO[((size_t)(pm - 1) * 2 + 0) * FF + c];
                            float pre = FIXP[((size_t)pm * 2 + j) * FF + c];
                            if (j == 0) pre += cw[FF + c] * h1 + cw[c] * h0; else pre += cw[c] * h1;
                            Z[(size_t)(pm * 256 + j) * FF + c] = (bf16_t)f2bf(silu_f(pre) * FIXU[((size_t)pm * 2 + j) * FF + c]);
                        }
                    }
                    asm volatile("s_waitcnt vmcnt(0)" ::: "memory"); __syncthreads();
                }
                pg8::Gemm g;
                if (sub == 7) g = pg8::Gemm{(const bf16_t*)Z, (const bf16_t*)WDN, M, D, FF, FF};
                else if (even) g = pg8::Gemm{(const bf16_t*)Z, (const bf16_t*)(ws + WS_WMIX + OFF_EVOUT) + (size_t)e * D * D, M, D, D, EV_N};
                else g = pg8::Gemm{(const bf16_t*)(Z + 1024), (const bf16_t*)(ws + WS_WMIX + OFF_ODOUT) + (size_t)e * D * D, M, D, D, OD_N};
                const GAS float* xin = (L == 0 && sub == 4) ? GIN(0) : (const GAS float*)X;
                EpiRes E{xin, X, XB, RSQ};
                pg8::gemm_phase<EpiRes>(lds, g, S, E, tid);
            } else if (sub == 5) {
                pg8::StaticOrder S; S.init(M, GU_N, G, (int)blockIdx.x);
                pg8::Gemm g{(const bf16_t*)XB, (const bf16_t*)WGU, M, GU_N, D, D};
                EpiF1 E{Z, RSQ, GIN(18) + (size_t)L * 3 * FF, GIN(19) + (size_t)L * FF, HALO, FIXP, FIXU, (LAS float*)(lds + LDSX_OFF)};
                pg8::gemm_phase<EpiF1>(lds, g, S, E, tid);
            }
        }
    }
}

extern "C" void kernel_launch(void* const* d_in, const int* in_sizes, int n_in, void* d_out, int out_size, void* d_ws, size_t ws_size, hipStream_t stream) {
    static int grid = 0;
    if (grid == 0) {
        if (n_in != 21 || out_size != M * D || ws_size < WS_END) { fprintf(stderr, "kernel_launch: unexpected shapes (n_in %d out %d ws %zu)\n", n_in, out_size, ws_size); grid = -1; return; }
        int dev = 0, cus = 0, per_cu = 0;
        hipGetDevice(&dev); hipDeviceGetAttribute(&cus, hipDeviceAttributeMultiprocessorCount, dev);
        hipFuncSetAttribute((const void*)mega, hipFuncAttributeMaxDynamicSharedMemorySize, LDS_BYTES);
        hipOccupancyMaxActiveBlocksPerMultiprocessor(&per_cu, (const void*)mega, NWAVES * 64, LDS_BYTES);
        (void)hipGetLastError();
        if (per_cu < 1) per_cu = 1;
        if (per_cu > 1) per_cu = 1;
        grid = cus * per_cu;
        fprintf(stderr, "kernel_launch: grid %d (cus %d), ws %zu\n", grid, cus, ws_size);
    }
    if (grid < 0) return;
    hipMemsetAsync((char*)d_ws + WS_CTL, 0, CTL_ZERO_BYTES, stream);
    Args a{};
    for (int i = 0; i < 21; ++i) a.in[i] = (const float*)d_in[i];
    a.out = (float*)d_out; a.ws = (unsigned char*)d_ws;
    a.ph_lo = 0; a.ph_hi = NPHASE; a.li = 0;
    void* kargs[] = {&a};
    hipError_t le = hipLaunchCooperativeKernel((const void*)mega, dim3(grid), dim3(NWAVES * 64), kargs, LDS_BYTES, stream);
    if (le != hipSuccess) fprintf(stderr, "cooperative launch failed: %s\n", hipGetErrorString(le));
}
```

```cpp
#include <hip/hip_runtime.h>
#include <cstdio>
#include <cstdint>

#define LAS __attribute__((address_space(3)))
#define GAS __attribute__((address_space(1)))
typedef unsigned short bf16_t;
typedef short bf16x8 __attribute__((ext_vector_type(8)));
typedef float f32x4 __attribute__((ext_vector_type(4)));
typedef float f32x2 __attribute__((ext_vector_type(2)));
typedef unsigned u32x4 __attribute__((ext_vector_type(4)));
typedef unsigned u32x2 __attribute__((ext_vector_type(2)));

constexpr int D = 1024, BATCH = 4, SEQ = 4096, M = BATCH * SEQ, DEPTH = 4;
constexpr int EV_N = 2560, OD_N = 3072, OD_NSRC = 3088, FF = 2816, GU_N = 2 * FF;
constexpr float EPS = 1e-6f;

constexpr size_t MiB = 1u << 20;
constexpr size_t WS_CTL = 0, CTL_ZERO_BYTES = 1 * MiB;
constexpr size_t WS_RSQ = 1 * MiB;
constexpr size_t WS_LNP = 2 * MiB;
constexpr size_t WS_GA = 3 * MiB;
constexpr size_t WS_HALO = 4 * MiB;
constexpr size_t WS_FIXP = 6 * MiB;
constexpr size_t WS_FIXU = 8 * MiB;
constexpr size_t WS_SMALLW = 10 * MiB;
constexpr size_t WS_WMIX = 12 * MiB;
constexpr size_t OFF_EVIN = 0, OFF_EVOUT = 10 * MiB, OFF_ODIN = 14 * MiB, OFF_ODOUT = 26 * MiB;
constexpr size_t WS_WFFN = 42 * MiB;
constexpr size_t OFF_WDOWN = 11 * MiB;
constexpr size_t WS_XB = 60 * MiB;
constexpr size_t WS_Z = 92 * MiB;
constexpr size_t WS_AUX = 188 * MiB;
constexpr size_t WS_END = 252 * MiB;
constexpr int CW_BAR = 4096;

constexpr int NWAVES = 8;
constexpr int RSTD_OFF_ = 131072 + 5120, PAR_OFF_ = 131072 + 13312;
__device__ __forceinline__ unsigned f2bf(float f) { unsigned u = __builtin_bit_cast(unsigned, f); return (u + 0x7fffu + ((u >> 16) & 1u)) >> 16; }
__device__ __forceinline__ unsigned pk2(float lo, float hi) { return f2bf(lo) | (f2bf(hi) << 16); }
__device__ __forceinline__ float bf2f(unsigned short h) { return __builtin_bit_cast(float, (unsigned)h << 16); }
typedef __bf16 bf2_t __attribute__((ext_vector_type(2)));
__device__ __forceinline__ unsigned cvt_pk_bf16(float lo, float hi) { const bf2_t r = __builtin_convertvector((f32x2){lo, hi}, bf2_t); return __builtin_bit_cast(unsigned, r); }
__device__ __forceinline__ float silu_f(float x) { return x * __builtin_amdgcn_rcpf(1.0f + __expf(-x)); }
__device__ __forceinline__ f32x2 gelu_pk(f32x2 v) {
    const f32x2 av = __builtin_elementwise_abs(v), d = av * 0.2316418882f + 1.0f;
    f32x2 t; t.x = __builtin_amdgcn_rcpf(d.x); t.y = __builtin_amdgcn_rcpf(d.y);
    f32x2 q = t * 0.5307027145f + (-0.7265760135f); q = q * t + 0.7107068705f; q = q * t + (-0.142248368f); q = q * t + 0.127414796f; q = q * t;
    const f32x2 s = (v * v) * (-0.72134752044f);
    f32x2 e; e.x = __builtin_amdgcn_exp2f(s.x); e.y = __builtin_amdgcn_exp2f(s.y);
    const f32x2 m = v * (q * e), r = v - m;
    f32x2 o; o.x = v.x < 0.f ? m.x : r.x; o.y = v.y < 0.f ? m.y : r.y; return o;
}
__device__ __forceinline__ f32x4 gelu4(f32x4 v) { f32x2 a = gelu_pk((f32x2){v[0], v[1]}), b = gelu_pk((f32x2){v[2], v[3]}); return (f32x4){a.x, a.y, b.x, b.y}; }
__device__ __forceinline__ float sum4(f32x4 v) { return (v[0] + v[1]) + (v[2] + v[3]); }
__device__ __forceinline__ float dot4(f32x4 v) { return (v[0] * v[0] + v[1] * v[1]) + (v[2] * v[2] + v[3] * v[3]); }
__device__ __forceinline__ u32x4 pack8(f32x4 a, f32x4 b) { u32x4 w; w.x = cvt_pk_bf16(a[0], a[1]); w.y = cvt_pk_bf16(a[2], a[3]); w.z = cvt_pk_bf16(b[0], b[1]); w.w = cvt_pk_bf16(b[2], b[3]); return w; }

namespace pg8 {
constexpr int BM = 256, BK = 64, HALF = 128, HTB = HALF * BK * 2, STAGE_BYTES = 8 * HTB, NXCD = 8, WGM = 8;
__host__ __device__ __forceinline__ int lds_byte(int r, int c) { const int st = (r >> 4) * 2 + (c >> 5), rr = r & 15, cc = c & 31, ob = rr * 64 + cc * 2; return st * 1024 + (ob ^ (((ob >> 9) & 1) << 5)); }
__host__ __device__ __forceinline__ void stage_rc(int b, int& R, int& C) { const int st = b / 1024, sb = b % 1024, swz = sb ^ (((sb >> 9) & 1) << 5); R = (st >> 1) * 16 + swz / 64; C = (st & 1) * 32 + (swz % 64) / 2; }
__host__ __device__ __forceinline__ int perm32(int rho) { const int n = rho >> 4, i = rho & 15; return 8 * (i >> 2) + 4 * n + (i & 3); }
struct Unit { int pm, pn, ui; };
struct Gemm { const bf16_t* A; const bf16_t* Bt; int M, N, K, lda; };
struct StaticOrder {
    int nM, nN, nwg, G, c;
    __device__ void init(int M_, int N_, int G_, int c_) { nM = M_ / BM; nN = N_ / BM; nwg = nM * nN; G = G_; c = c_; }
    __device__ bool next(int i, Unit& u) const {
        const long L = (long)i * G + c; if (L >= nwg) return false;
        int wgid = (int)L; { const int q = nwg / NXCD, r = nwg % NXCD, xcd = wgid % NXCD, off = wgid / NXCD; wgid = (xcd < r ? xcd * (q + 1) : r * (q + 1) + (xcd - r) * q) + off; }
        const int nig = WGM * nN, gid = wgid / nig, fm = gid * WGM, gsz = (nM - fm) < WGM ? (nM - fm) : WGM;
        u.pm = fm + ((wgid % nig) % gsz); u.pn = (wgid % nig) / gsz; u.ui = i; return true;
    }
};
template <class Epi>
__device__ __forceinline__ void gemm_phase(LAS unsigned char* lds, const Gemm g, const StaticOrder& S, const Epi& E, const int tid) {
    const int wid = __builtin_amdgcn_readfirstlane(tid >> 6), lane = tid & 63, wr = wid >> 2, wc = wid & 3, fr = lane & 15, fq = lane >> 4;
    const int K = g.K, nt = K / BK, lda = g.lda;
    unsigned voffA[2], voffB[2];
#pragma unroll
    for (int i = 0; i < 2; ++i) { int R, C; stage_rc(tid * 16 + i * 8192, R, C); const int Rb = (R & ~31) + perm32(R & 31);
        voffA[i] = (unsigned)(R * lda + C) * 2u; voffB[i] = (unsigned)(Rb * K + C) * 2u; }
    const size_t kstep = (size_t)(BK * 2);
    const size_t hstepA = (size_t)HALF * lda * 2, hstepB = (size_t)HALF * K * 2;
    const size_t tstepA = 2 * hstepA, tstepB = 2 * hstepB;
    const unsigned ldsw = (unsigned)wid * 1024u;
    const int aoff = lds_byte(wr * 64 + fr, fq * 8), boff = lds_byte(wc * 32 + fr, fq * 8);
#define PG8_SA(b, h) (((b) * 2 + (h)) * HTB)
#define PG8_SB(b, h) ((4 + (b) * 2 + (h)) * HTB)
#define PG8_STAGE(bufoff, gbase, voff) do { _Pragma("unroll") for (int _i = 0; _i < 2; ++_i) \
        __builtin_amdgcn_global_load_lds((const unsigned*)((const char*)(gbase) + (voff)[_i]), (LAS unsigned*)(lds + (bufoff) + ldsw + _i * 8192), 16, 0, 0); } while (0)
#define PG8_LDA(dst, b, h) do { _Pragma("unroll") for (int m = 0; m < 4; ++m) _Pragma("unroll") for (int k = 0; k < 2; ++k) dst[m][k] = *(const LAS bf16x8*)(lds + PG8_SA(b, h) + aoff + m * 2048 + k * 1024); } while (0)
#define PG8_LDB(dst, b, h) do { _Pragma("unroll") for (int n = 0; n < 2; ++n) _Pragma("unroll") for (int k = 0; k < 2; ++k) dst[n][k] = *(const LAS bf16x8*)(lds + PG8_SB(b, h) + boff + n * 2048 + k * 1024); } while (0)
#define PG8_MMA(ai, bj, At, Bt) do { __builtin_amdgcn_s_setprio(1); _Pragma("unroll") for (int m = 0; m < 4; ++m) _Pragma("unroll") for (int n = 0; n < 2; ++n) _Pragma("unroll") for (int k = 0; k < 2; ++k) \
        acc[ai][bj][m][n] = __builtin_amdgcn_mfma_f32_16x16x32_bf16(Bt[n][k], At[m][k], acc[ai][bj][m][n], 0, 0, 0); __builtin_amdgcn_s_setprio(0); } while (0)
#define PG8_WAIT_V(n) asm volatile("s_waitcnt vmcnt(" #n ")" ::: "memory")
#define PG8_WAIT_L(n) asm volatile("s_waitcnt lgkmcnt(" #n ")" ::: "memory")
#define PG8_BAR __builtin_amdgcn_s_barrier()
#define PG8_SCHED __builtin_amdgcn_sched_barrier(0)
    Unit cur, nxt; int ui = 0;
    if (!S.next(0, cur)) return;
    f32x4 acc[2][2][4][2];
#pragma unroll
    for (int a = 0; a < 2; ++a)
#pragma unroll
        for (int b = 0; b < 2; ++b)
#pragma unroll
            for (int m = 0; m < 4; ++m)
#pragma unroll
                for (int n = 0; n < 2; ++n) acc[a][b][m][n] = (f32x4){0.f, 0.f, 0.f, 0.f};
    bf16x8 At[4][2], B0[2][2], B1[2][2];
    const char* cA = (const char*)g.A + (size_t)cur.pm * tstepA; const char* cB = (const char*)g.Bt + (size_t)cur.pn * tstepB;
    PG8_STAGE(PG8_SB(0, 0), cB, voffB); PG8_STAGE(PG8_SB(0, 1), cB + hstepB, voffB); PG8_STAGE(PG8_SA(0, 0), cA, voffA); PG8_STAGE(PG8_SA(0, 1), cA + hstepA, voffA);
    if (wr == 1) PG8_BAR;
    PG8_WAIT_V(2); PG8_BAR;
    PG8_STAGE(PG8_SB(1, 0), cB + kstep, voffB); PG8_STAGE(PG8_SA(1, 0), cA + kstep, voffA); PG8_STAGE(PG8_SB(1, 1), cB + hstepB + kstep, voffB);
    PG8_WAIT_V(6); PG8_BAR;
    for (;;) {
        const bool has_next = S.next(ui + 1, nxt);
        const char* nA = has_next ? (const char*)g.A + (size_t)nxt.pm * tstepA : cA; const char* nB = has_next ? (const char*)g.Bt + (size_t)nxt.pn * tstepB : cB;
        for (int t = 0; t < nt; t += 2) {
            const bool last = (t == nt - 2);
            const char* a1 = cA + (size_t)(t + 1) * kstep;
            const char* a2 = last ? nA : cA + (size_t)(t + 2) * kstep; const char* b2 = last ? nB : cB + (size_t)(t + 2) * kstep;
            const char* a3 = a2 + kstep; const char* b3 = b2 + kstep;
            PG8_LDB(B0, 0, 0); PG8_LDB(B1, 0, 1); PG8_SCHED; PG8_LDA(At, 0, 0); PG8_STAGE(PG8_SA(1, 1), a1 + hstepA, voffA);
            PG8_WAIT_V(8); PG8_WAIT_L(0); PG8_BAR; PG8_MMA(0, 0, At, B0); PG8_MMA(0, 1, At, B1); PG8_BAR; PG8_SCHED;
            PG8_LDA(At, 0, 1); PG8_STAGE(PG8_SB(0, 0), b2, voffB); PG8_STAGE(PG8_SB(0, 1), b2 + hstepB, voffB); PG8_STAGE(PG8_SA(0, 0), a2, voffA);
            PG8_WAIT_V(8); PG8_WAIT_L(0); PG8_BAR; PG8_MMA(1, 0, At, B0); PG8_MMA(1, 1, At, B1); PG8_BAR; PG8_SCHED;
            PG8_LDB(B0, 1, 0); PG8_LDB(B1, 1, 1); PG8_SCHED; PG8_LDA(At, 1, 0); PG8_STAGE(PG8_SA(0, 1), a2 + hstepA, voffA);
            PG8_WAIT_V(8); PG8_WAIT_L(0); PG8_BAR; PG8_MMA(0, 0, At, B0); PG8_MMA(0, 1, At, B1); PG8_BAR; PG8_SCHED;
            PG8_LDA(At, 1, 1); PG8_STAGE(PG8_SB(1, 0), b3, voffB); PG8_STAGE(PG8_SB(1, 1), b3 + hstepB, voffB); PG8_STAGE(PG8_SA(1, 0), a3, voffA);
            PG8_WAIT_V(8); PG8_WAIT_L(0); PG8_BAR; PG8_MMA(1, 0, At, B0); PG8_MMA(1, 1, At, B1); PG8_BAR; PG8_SCHED;
        }
        if (wr == 0) PG8_BAR;
        E(acc, cur, wr, wc, fr, fq);
        if (!has_next) break;
#pragma unroll
        for (int a = 0; a < 2; ++a)
#pragma unroll
            for (int b = 0; b < 2; ++b)
#pragma unroll
                for (int m = 0; m < 4; ++m)
#pragma unroll
                    for (int n = 0; n < 2; ++n) acc[a][b][m][n] = (f32x4){0.f, 0.f, 0.f, 0.f};
        cur = nxt; cA = nA; cB = nB; ++ui;
        if (wr == 1) PG8_BAR;
    }
    PG8_WAIT_V(0);
    PG8_BAR;
#undef PG8_SA
#undef PG8_SB
#undef PG8_STAGE
#undef PG8_LDA
#undef PG8_LDB
#undef PG8_MMA
#undef PG8_WAIT_V
#undef PG8_WAIT_L
#undef PG8_BAR
#undef PG8_SCHED
}
}
using pg8::Unit;

__device__ __forceinline__ void row_rstd(const LAS float* rstd, int lrow, float (&rs)[2][4]) {
#pragma unroll
    for (int ai = 0; ai < 2; ++ai)
#pragma unroll
        for (int m = 0; m < 4; ++m) rs[ai][m] = rstd[lrow + ai * 128 + m * 16];
}
__device__ __forceinline__ void stage_rstd(LAS unsigned char* lds, const GAS float* rsq, const int tid, const int extra) {
    LAS float* out = (LAS float*)(lds + RSTD_OFF_);
    const size_t r0 = (size_t)2048 * (blockIdx.x & 7);
    f32x4 p[4][4];
#pragma unroll
    for (int j = 0; j < 4; ++j)
#pragma unroll
        for (int q = 0; q < 4; ++q) p[j][q] = *(const GAS f32x4*)(rsq + (r0 + tid + 512 * j) * 16 + 4 * q);
#pragma unroll
    for (int j = 0; j < 4; ++j) out[tid + 512 * j] = rsqrtf(((sum4(p[j][0]) + sum4(p[j][1])) + (sum4(p[j][2]) + sum4(p[j][3]))) * (1.0f / 1024.0f) + EPS);
    (void)extra;
}

struct EpiEvenIn {
    GAS bf16_t* Z; const LAS float* rstd; GAS float* lnp; const LAS float* qkg;
    __device__ __forceinline__ void operator()(const f32x4 (&acc)[2][2][4][2], const Unit& u, int wr, int wc, int fr, int fq) const {
        asm volatile("" : "+v"(fr), "+v"(fq));
        const int rowb = u.pm * 256 + wr * 64 + fr, kind = u.pn >> 1;
        float rs[2][4]; row_rstd(rstd, (u.pm & 7) * 256 + wr * 64 + fr, rs);
        if (kind == 1 || kind == 3) {
            const LAS float* g = qkg + ((kind == 1) ? 0 : 64);
            f32x4 gv[2][2];
#pragma unroll
            for (int bj = 0; bj < 2; ++bj)
#pragma unroll
                for (int n = 0; n < 2; ++n) gv[bj][n] = *(const LAS f32x4*)(g + 32 * bj + 8 * fq + 4 * n);
#pragma unroll
            for (int ai = 0; ai < 2; ++ai)
#pragma unroll
                for (int m = 0; m < 4; ++m) {
                    float ss = 0.f;
#pragma unroll
                    for (int bj = 0; bj < 2; ++bj)
#pragma unroll
                        for (int n = 0; n < 2; ++n) ss += dot4(acc[ai][bj][m][n]);
                    ss += __shfl_xor(ss, 16); ss += __shfl_xor(ss, 32);
                    const float r = rs[ai][m], rh = rsqrtf(ss * r * r * (1.0f / 64.0f) + EPS) * r;
                    GAS bf16_t* rowp = Z + (size_t)(rowb + ai * 128 + m * 16) * EV_N + u.pn * 256 + 64 * wc + 8 * fq;
#pragma unroll
                    for (int bj = 0; bj < 2; ++bj) *(GAS u32x4*)(rowp + 32 * bj) = pack8(acc[ai][bj][m][0] * rh * gv[bj][0], acc[ai][bj][m][1] * rh * gv[bj][1]);
                }
        } else {
#pragma unroll
            for (int ai = 0; ai < 2; ++ai)
#pragma unroll
                for (int m = 0; m < 4; ++m) {
                    const float r = rs[ai][m]; const int row = rowb + ai * 128 + m * 16;
                    GAS bf16_t* rowp = Z + (size_t)row * EV_N + u.pn * 256 + 32 * wc + 8 * fq;
                    float s1 = 0.f, s2 = 0.f;
#pragma unroll
                    for (int bj = 0; bj < 2; ++bj) {
                        f32x4 v0 = acc[ai][bj][m][0] * r, v1 = acc[ai][bj][m][1] * r;
                        if (kind != 4) { v0 = gelu4(v0); v1 = gelu4(v1); }
                        if (kind == 2) { s1 += sum4(v0) + sum4(v1); s2 += dot4(v0) + dot4(v1); }
                        *(GAS u32x4*)(rowp + 128 * bj) = pack8(v0, v1);
                    }
                    if (kind == 2) {
                        s1 += __shfl_xor(s1, 16); s1 += __shfl_xor(s1, 32); s2 += __shfl_xor(s2, 16); s2 += __shfl_xor(s2, 32);
                        if (fq == 0) *(GAS f32x2*)(lnp + ((size_t)row * 8 + (u.pn & 1) * 4 + wc) * 2) = (f32x2){s1, s2};
                    }
                }
        }
    }
};

struct EpiOddIn {
    GAS bf16_t* Z; const LAS float* rstd;
    __device__ __forceinline__ void operator()(const f32x4 (&acc)[2][2][4][2], const Unit& u, int wr, int wc, int fr, int fq) const {
        asm volatile("" : "+v"(fr), "+v"(fq));
        const int rowb = u.pm * 256 + wr * 64 + fr;
        float rs[2][4]; row_rstd(rstd, (u.pm & 7) * 256 + wr * 64 + fr, rs);
        const float sc = (u.pn < 2) ? 0.08838834764831845f : 1.0f; const bool act = (u.pn >= 8);
#pragma unroll
        for (int ai = 0; ai < 2; ++ai)
#pragma unroll
            for (int m = 0; m < 4; ++m) {
                const float r = rs[ai][m] * sc;
                GAS bf16_t* rowp = Z + (size_t)(rowb + ai * 128 + m * 16) * OD_N + u.pn * 256 + 32 * wc + 8 * fq;
#pragma unroll
                for (int bj = 0; bj < 2; ++bj) {
                    f32x4 v0 = acc[ai][bj][m][0] * r, v1 = acc[ai][bj][m][1] * r;
                    if (act) {
#pragma unroll
                        for (int e = 0; e < 4; ++e) { v0[e] = silu_f(v0[e]); v1[e] = silu_f(v1[e]); }
                    }
                    *(GAS u32x4*)(rowp + 128 * bj) = pack8(v0, v1);
                }
            }
    }
};

struct EpiRes {
    const GAS float* xin; GAS float* xout; GAS bf16_t* xb; GAS float* rsq;
    __device__ __forceinline__ void operator()(const f32x4 (&acc)[2][2][4][2], const Unit& u, int wr, int wc, int fr, int fq) const {
        asm volatile("" : "+v"(fr), "+v"(fq));
        const int rowb = u.pm * 256 + wr * 64 + fr;
#pragma unroll
        for (int ai = 0; ai < 2; ++ai)
#pragma unroll
            for (int m = 0; m < 4; ++m) {
                const int row = rowb + ai * 128 + m * 16; const size_t off = (size_t)row * D + u.pn * 256 + 32 * wc + 8 * fq;
                float ss = 0.f;
#pragma unroll
                for (int bj = 0; bj < 2; ++bj) {
                    const f32x4 o0 = *(const GAS f32x4*)(xin + off + 128 * bj) + acc[ai][bj][m][0], o1 = *(const GAS f32x4*)(xin + off + 128 * bj + 4) + acc[ai][bj][m][1];
                    *(GAS f32x4*)(xout + off + 128 * bj) = o0; *(GAS f32x4*)(xout + off + 128 * bj + 4) = o1;
                    *(GAS u32x4*)(xb + off + 128 * bj) = pack8(o0, o1);
                    ss += dot4(o0) + dot4(o1);
                }
                ss += __shfl_xor(ss, 16); ss += __shfl_xor(ss, 32);
                if (fq == 0) rsq[(size_t)row * 16 + u.pn * 4 + wc] = ss;
            }
    }
};

#define DPP_MOV(old, src, ctrl, bc) __builtin_bit_cast(float, __builtin_amdgcn_update_dpp(__builtin_bit_cast(int, (float)(old)), __builtin_bit_cast(int, (float)(src)), (ctrl), 0xf, 0xf, (bc)))

struct EpiF1 {
    GAS bf16_t* H; const LAS float* rstd; const LAS float* par; GAS float* halo; GAS float* fixp; GAS float* fixu; LAS float* ldsx;
    __device__ __forceinline__ void operator()(const f32x4 (&acc)[2][2][4][2], const Unit& u, int wr, int wc, int fr, int fq) const {
        asm volatile("" : "+v"(fr), "+v"(fq));
        const int rowb = u.pm * 256 + wr * 64 + fr, ch0 = u.pn * 128 + 32 * wc + 8 * fq, lc = 32 * wc + 8 * fq;
        float rs[2][4]; row_rstd(rstd, (u.pm & 7) * 256 + wr * 64 + fr, rs);
        f32x4 w0[2], w1[2], w2[2], bb[2];
        const LAS float* pp = par + u.ui * 512 + lc;
#pragma unroll
        for (int n = 0; n < 2; ++n) { w0[n] = *(const LAS f32x4*)(pp + 4 * n); w1[n] = *(const LAS f32x4*)(pp + 128 + 4 * n); w2[n] = *(const LAS f32x4*)(pp + 256 + 4 * n); bb[n] = *(const LAS f32x4*)(pp + 384 + 4 * n); }
        if (fr >= 14) {
#pragma unroll
            for (int ai = 0; ai < 2; ++ai)
#pragma unroll
                for (int n = 0; n < 2; ++n) {
                    const f32x4 gvl = acc[ai][0][3][n] * rs[ai][3];
                    *(LAS f32x4*)(ldsx + ((ai * 2 + wr) * 2 + (fr - 14)) * 128 + lc + 4 * n) = gvl;
                    if (ai == 1 && wr == 1) *(GAS f32x4*)(halo + ((size_t)u.pm * 2 + (fr - 14)) * FF + ch0 + 4 * n) = gvl;
                }
        }
        asm volatile("s_waitcnt lgkmcnt(0)" ::: "memory"); __builtin_amdgcn_s_barrier(); asm volatile("" ::: "memory");
        const bool fix = (u.pm & 15) != 0;
#pragma unroll
        for (int ai = 0; ai < 2; ++ai) {
            const int blk = ai * 2 + wr;
            f32x4 pv[2];
#pragma unroll
            for (int n = 0; n < 2; ++n) {
                pv[n] = (f32x4){0.f, 0.f, 0.f, 0.f};
                if (blk > 0 && fr >= 14) pv[n] = *(const LAS f32x4*)(ldsx + ((blk - 1) * 2 + (fr - 14)) * 128 + lc + 4 * n);
            }
#pragma unroll
            for (int m = 0; m < 4; ++m) {
                const float r = rs[ai][m]; const int row = rowb + ai * 128 + m * 16;
                f32x4 hv[2], pre[2], upv[2], cur[2];
#pragma unroll
                for (int n = 0; n < 2; ++n) {
                    cur[n] = acc[ai][0][m][n] * r; upv[n] = acc[ai][1][m][n] * r;
#pragma unroll
                    for (int e = 0; e < 4; ++e) {
                        const float c = cur[n][e], p = pv[n][e];
                        const float t1 = DPP_MOV(0.f, p, 0x10F, true);
                        const float g1 = DPP_MOV(t1, c, 0x111, false);
                        const float t2 = DPP_MOV(0.f, p, 0x10E, true);
                        const float g2 = DPP_MOV(t2, c, 0x112, false);
                        const float pr = bb[n][e] + w2[n][e] * c + w1[n][e] * g1 + w0[n][e] * g2;
                        pre[n][e] = pr; hv[n][e] = silu_f(pr) * upv[n][e];
                    }
                }
                *(GAS u32x4*)(H + (size_t)row * FF + ch0) = pack8(hv[0], hv[1]);
                if (fix && blk == 0 && m == 0 && fr < 2) {
#pragma unroll
                    for (int n = 0; n < 2; ++n) { *(GAS f32x4*)(fixp + ((size_t)u.pm * 2 + fr) * FF + ch0 + 4 * n) = pre[n]; *(GAS f32x4*)(fixu + ((size_t)u.pm * 2 + fr) * FF + ch0 + 4 * n) = upv[n]; }
                }
                pv[0] = cur[0]; pv[1] = cur[1];
            }
        }
    }
};

#define XB_TMO      128
#define XB_XCNT(j)  (256  + 64 * (j))
#define XB_XSUB(j)  (1280 + 64 * (j))
#define XB_XGEN(j)  (2304 + 64 * (j))
#define XB_TOP      3328
#define XB_TOPGEN   3392
#define XCD_BAR_WORDS 3456
#define XB_SPIN_CAP (1u << 18)
__device__ __forceinline__ unsigned xb_ld(unsigned* p)              { return __hip_atomic_load(p, __ATOMIC_RELAXED, __HIP_MEMORY_SCOPE_AGENT); }
__device__ __forceinline__ unsigned xb_add(unsigned* p, unsigned v) { return __hip_atomic_fetch_add(p, v, __ATOMIC_RELAXED, __HIP_MEMORY_SCOPE_AGENT); }
__device__ __forceinline__ unsigned xb_xcc_id() { return (unsigned)__builtin_amdgcn_s_getreg((3 << 11) | 20) & 0xFu; }
#define XB_SPIN(cond, bar) do { unsigned _sp = 0; while (cond) { __builtin_amdgcn_s_sleep(1); \
    if ((++_sp & 255u) == 0u) { if (xb_ld(&(bar)[XB_TMO])) break; if (_sp > XB_SPIN_CAP) { atomicAdd(&(bar)[XB_TMO], 1u); break; } } } } while (0)
struct XcdBarrier { unsigned* bar; unsigned x; volatile LAS unsigned* st; };
__device__ __forceinline__ XcdBarrier xcd_barrier_post(unsigned* bar, volatile LAS unsigned* st) {
    XcdBarrier b; b.bar = bar; b.x = xb_xcc_id(); b.st = st;
    if (threadIdx.x == 0) (void)xb_add(&bar[XB_XCNT(b.x)], 1u);
    return b;
}
__device__ __forceinline__ void xcd_barrier_complete(unsigned* bar, unsigned x, unsigned& nloc, unsigned& nx) {
    const unsigned G = gridDim.x * gridDim.y * gridDim.z;
    unsigned sum, cnt, mine, sp = 0u;
    for (;;) {
        sum = 0u; cnt = 0u; mine = 0u;
#pragma unroll
        for (unsigned j = 0; j < 16; ++j) { const unsigned c = xb_ld(&bar[XB_XCNT(j)]); sum += c; cnt += (c > 0u) ? 1u : 0u; mine = (j == x) ? c : mine; }
        if (sum == G) break;
        __builtin_amdgcn_s_sleep(1);
        if ((++sp & 255u) == 0u) { if (xb_ld(&bar[XB_TMO])) break; if (sp > XB_SPIN_CAP) { atomicAdd(&bar[XB_TMO], 1u); break; } }
    }
    nloc = mine > 0u ? mine : 1u; nx = cnt > 0u ? cnt : 1u;
}
__device__ __forceinline__ void xcd_barrier(const XcdBarrier& b) {
    asm volatile("s_waitcnt vmcnt(0)" ::: "memory");
    __syncthreads();
    if (threadIdx.x == 0) {
        unsigned* bar = b.bar;
        __builtin_amdgcn_s_waitcnt(0);
        unsigned nloc = b.st[0], nx = b.st[1];
        if (nloc == 0u) { xcd_barrier_complete(bar, b.x, nloc, nx); b.st[0] = nloc; b.st[1] = nx; }
        const unsigned old = xb_add(&bar[XB_XSUB(b.x)], 1u);
        const unsigned gen = old / nloc;
        if (old + 1u == (gen + 1u) * nloc) {
            __builtin_amdgcn_fence(__ATOMIC_RELEASE, "agent");
            asm volatile("s_waitcnt vmcnt(0)" ::: "memory");
            const unsigned og = xb_add(&bar[XB_TOP], 1u);
            const unsigned tg = og / nx;
            if (og + 1u == (tg + 1u) * nx) xb_add(&bar[XB_TOPGEN], 1u);
            else XB_SPIN(xb_ld(&bar[XB_TOPGEN]) == tg, bar);
            __builtin_amdgcn_fence(__ATOMIC_ACQUIRE, "agent");
            xb_add(&bar[XB_XGEN(b.x)], 1u);
            asm volatile("s_waitcnt vmcnt(0)" ::: "memory");
        } else {
            XB_SPIN(xb_ld(&bar[XB_XGEN(b.x)]) == gen, bar);
            __builtin_amdgcn_fence(__ATOMIC_ACQUIRE, "agent");
            asm volatile("s_waitcnt vmcnt(0)" ::: "memory");
        }
    }
    __syncthreads();
}

__device__ __forceinline__ int conv_srccol(const int map, const int nd, bool& second) {
    const int nb = nd >> 5, r = nd & 31; second = false;
    if (map == 1) {
        const int pn = nb >> 3, j = nb & 7, bj = j >> 2, wc = j & 3, kind = pn >> 1, zc = 256 * pn + 64 * wc + 32 * bj;
        if (kind == 1) return 1024 + (zc - 512) + r;
        if (kind == 2) return 512 + (nd - 1024);
        if (kind == 3) return zc + r;
        return nd;
    } else if (map == 2) {
        const int pn = nb >> 3, j = nb & 7; second = (j >> 2) != 0;
        return 128 * pn + 32 * (j & 3) + r;
    }
    return nd;
}
constexpr int CV_STR = 65;
__device__ __forceinline__ void conv_block_item(LAS unsigned char* lds, const GAS float* W, const GAS float* W2, const int ldw, const int K, const int Ndst, const GAS float* gk, GAS bf16_t* WT, const int map, const int item, const int tid) {
    const int nblk = Ndst >> 7, kb = item / nblk, nb = item % nblk, k0 = kb << 7, n0 = nb << 7;
    const int l32 = tid & 31, rg = tid >> 5;
    bool second; const int sc = conv_srccol(map, n0 + 4 * l32, second);
    const GAS float* src = (second ? W2 : W) + (size_t)(k0 + 8 * rg) * ldw + sc;
    f32x4 v[8];
#pragma unroll
    for (int i = 0; i < 8; ++i) v[i] = *(const GAS f32x4*)(src + (size_t)i * ldw);
    if (gk) {
        const f32x4 g0 = *(const GAS f32x4*)(gk + k0 + 8 * rg), g1 = *(const GAS f32x4*)(gk + k0 + 8 * rg + 4);
#pragma unroll
        for (int i = 0; i < 4; ++i) { v[i] = v[i] * g0[i]; v[4 + i] = v[4 + i] * g1[i]; }
    }
    LAS unsigned* T = (LAS unsigned*)lds;
#pragma unroll
    for (int i = 0; i < 4; ++i)
#pragma unroll
        for (int e = 0; e < 4; ++e) T[(4 * l32 + e) * CV_STR + 4 * rg + i] = cvt_pk_bf16(v[2 * i][e], v[2 * i + 1][e]);
    __syncthreads();
    const int c = tid & 15;
#pragma unroll
    for (int p = 0; p < 4; ++p) {
        const int n = (tid >> 4) + 32 * p; const LAS unsigned* r = T + n * CV_STR + 4 * c;
        u32x4 o; o.x = r[0]; o.y = r[1]; o.z = r[2]; o.w = r[3];
        *(GAS u32x4*)(WT + (size_t)(n0 + n) * K + k0 + 8 * c) = o;
    }
    __syncthreads();
}

__device__ __forceinline__ void ph_gmlp_simple(LAS unsigned char* lds, bf16_t* Z, const float* LNP, const float* ln_g, const float* ln_b, const float* wsp, const float* bsp, int tid, int G) {
    LAS float* vn = (LAS float*)lds;
    for (int item = blockIdx.x; item < (M / 128) * 8; item += G) {
        const int chunk = item >> 3, g = item & 7, m0 = chunk * 128;
        for (int idx = tid; idx < 128 * 64; idx += NWAVES * 64) {
            const int s = idx >> 6, c = idx & 63; const size_t row = m0 + s;
            float s1 = 0.f, s2 = 0.f;
            for (int k = 0; k < 8; ++k) { s1 += LNP[(row * 8 + k) * 2]; s2 += LNP[(row * 8 + k) * 2 + 1]; }
            const float mean = s1 * (1.f / 512.f), var = s2 * (1.f / 512.f) - mean * mean, rstd = rsqrtf(var + EPS);
            const float gv = bf2f(Z[row * EV_N + 1024 + 64 * g + c]);
            vn[idx] = (gv - mean) * rstd * ln_g[64 * g + c] + ln_b[64 * g + c];
        }
        __syncthreads();
        for (int idx = tid; idx < 128 * 64; idx += NWAVES * 64) {
            const int t = idx >> 6, c = idx & 63; const size_t row = m0 + t;
            float a = bsp[g * 128 + t];
            const float* wr = wsp + ((size_t)g * 128 + t) * 128;
            for (int s2 = 0; s2 <= t; ++s2) a += wr[s2] * vn[s2 * 64 + c];
            const float gu = bf2f(Z[row * EV_N + 64 * g + c]);
            Z[row * EV_N + 64 * g + c] = (bf16_t)f2bf(gu * a);
        }
        __syncthreads();
    }
}
__device__ __forceinline__ void ph_attn_simple(bf16_t* Z, int gw, int NGW, int lane) {
    for (int wv = gw; wv < M * 8; wv += NGW) {
        const int m = wv >> 3, h = wv & 7, t = m & (SEQ - 1), mb = m - t;
        const float q = bf2f(Z[(size_t)m * EV_N + 512 + 64 * h + lane]);
        float ms[3], ls[3], os[3];
#pragma unroll
        for (int r = 0; r < 3; ++r) {
            const int dil = (r == 0) ? 1 : (r == 1) ? 4 : 16;
            float mx = -1e30f, l = 0.f, o = 0.f;
            for (int j = 0; j <= 128; ++j) {
                const int tk = t - j * dil; if (tk < 0) break;
                const size_t kr = (size_t)(mb + tk) * EV_N;
                float sc = q * bf2f(Z[kr + 1536 + 64 * h + lane]);
#pragma unroll
                for (int o2 = 1; o2 < 64; o2 <<= 1) sc += __shfl_xor(sc, o2);
                const float mn = fmaxf(mx, sc), al = __expf(mx - mn), p = __expf(sc - mn);
                l = l * al + p; o = o * al + p * bf2f(Z[kr + 2048 + 64 * h + lane]); mx = mn;
            }
            ms[r] = mx; ls[r] = l; os[r] = o / l;
        }
        const float l0 = ms[0] + __logf(ls[0]), l1 = ms[1] + __logf(ls[1]), l2 = ms[2] + __logf(ls[2]);
        const float mm = fmaxf(l0, fmaxf(l1, l2)), e0 = __expf(l0 - mm), e1 = __expf(l1 - mm), e2 = __expf(l2 - mm), inv = 1.f / (e0 + e1 + e2);
        Z[(size_t)m * EV_N + 512 + 64 * h + lane] = (bf16_t)f2bf((e0 * os[0] + e1 * os[1] + e2 * os[2]) * inv);
    }
}
__device__ __forceinline__ void ph_ga_simple(const float* X, const float* RSQ, const float* gmix, const float* w_in, float* GA, int gw, int NGW, int lane) {
    for (int m = gw; m < M; m += NGW) {
        float acc[16];
#pragma unroll
        for (int j = 0; j < 16; ++j) acc[j] = 0.f;
        for (int i = 0; i < 16; ++i) {
            const int k = i * 64 + lane; const float xv = X[(size_t)m * D + k] * gmix[k];
            const f32x4* wr = (const f32x4*)(w_in + (size_t)k * OD_NSRC + 3072);
#pragma unroll
            for (int j4 = 0; j4 < 4; ++j4) { const f32x4 w = wr[j4]; acc[4 * j4] += xv * w[0]; acc[4 * j4 + 1] += xv * w[1]; acc[4 * j4 + 2] += xv * w[2]; acc[4 * j4 + 3] += xv * w[3]; }
        }
        float s = 0.f;
        for (int j = 0; j < 16; ++j) s += RSQ[(size_t)m * 16 + j];
        const float rstd = rsqrtf(s * (1.f / 1024.f) + EPS);
#pragma unroll
        for (int j = 0; j < 16; ++j) {
            float v = acc[j];
#pragma unroll
            for (int o = 1; o < 64; o <<= 1) v += __shfl_xor(v, o);
            if (lane == j) GA[(size_t)m * 16 + j] = v * rstd;
        }
    }
}
__device__ __forceinline__ void ph_gla_simple(LAS unsigned char* lds, const bf16_t* Z, const float* GA, const float* w_a2, const float* b_a, float* ORAW, int tid, int G) {
    LAS float* sa = (LAS float*)lds; LAS float* sk = sa + 256; LAS float* sq = sk + 256;
    for (int item = blockIdx.x; item < 16; item += G) {
        const int b = item >> 2, h = item & 3, v = tid;
        float S[128];
#pragma unroll
        for (int k = 0; k < 128; ++k) S[k] = 0.f;
        float wa[16]; float ba = 0.f;
#pragma unroll
        for (int j = 0; j < 16; ++j) wa[j] = 0.f;
        if (v < 128) {
#pragma unroll
            for (int j = 0; j < 16; ++j) wa[j] = w_a2[j * 512 + h * 128 + v];
            ba = b_a[h * 128 + v]; }
        for (int t = 0; t < SEQ; ++t) {
            const size_t m = (size_t)b * SEQ + t; const int buf = (t & 1) * 128;
            if (v < 128) {
                float xg = ba;
#pragma unroll
                for (int j = 0; j < 16; ++j) xg += GA[m * 16 + j] * wa[j];
                const float ls = fminf(xg, 0.f) - log1pf(__expf(-fabsf(xg)));
                sa[buf + v] = __expf(ls * (1.f / 16.f));
                sk[buf + v] = bf2f(Z[m * OD_N + 512 + 128 * h + v]);
                sq[buf + v] = bf2f(Z[m * OD_N + 128 * h + v]);
            }
            __syncthreads();
            if (v < 256) {
                const float vv = bf2f(Z[m * OD_N + 1024 + 256 * h + v]);
                float o = 0.f;
#pragma unroll
                for (int k = 0; k < 128; ++k) { S[k] = sa[buf + k] * S[k] + sk[buf + k] * vv; o += sq[buf + k] * S[k]; }
                ORAW[m * 1024 + 256 * h + v] = o;
            }
        }
        __syncthreads();
    }
}
__device__ __forceinline__ void ph_gla_post_simple(bf16_t* Z, const float* ORAW, const float* head_g, int gw, int NGW, int lane) {
    for (int wv = gw; wv < M * 4; wv += NGW) {
        const int m = wv >> 2, h = wv & 3;
        const f32x4 o = *(const f32x4*)(ORAW + (size_t)m * 1024 + 256 * h + 4 * lane);
        float ss = dot4(o);
#pragma unroll
        for (int k = 1; k < 64; k <<= 1) ss += __shfl_xor(ss, k);
        const float rstd = rsqrtf(ss * (1.f / 256.f) + EPS);
        const f32x4 hg = *(const f32x4*)(head_g + 4 * lane);
        bf16_t* sr = Z + (size_t)m * OD_N + 2048 + 256 * h + 4 * lane;
        bf16_t* dst = Z + (size_t)m * OD_N + 1024 + 256 * h + 4 * lane;
        u32x2 w; w.x = pk2(o[0] * rstd * hg[0] * bf2f(sr[0]), o[1] * rstd * hg[1] * bf2f(sr[1])); w.y = pk2(o[2] * rstd * hg[2] * bf2f(sr[2]), o[3] * rstd * hg[3] * bf2f(sr[3]));
        *(u32x2*)dst = w;
    }
}


typedef short s16x4 __attribute__((ext_vector_type(4)));
__device__ __forceinline__ bf16x8 tr_pair(const LAS unsigned char* p0, const LAS unsigned char* p1) {
    const s16x4 lo = __builtin_amdgcn_ds_read_tr16_b64_v4i16((LAS s16x4*)p0), hi = __builtin_amdgcn_ds_read_tr16_b64_v4i16((LAS s16x4*)p1);
    return __builtin_shufflevector(lo, hi, 0, 1, 2, 3, 4, 5, 6, 7);
}
constexpr int AT_KSTR = 144, AT_VSTR = 160, AT_VOFF = 256 * AT_KSTR;
struct AttnPre { u32x4 k[4], v[4]; bf16x8 q0, q1; };
__device__ __forceinline__ void attn_load(const GAS bf16_t* Z, const int dlog, const int idx, const int tid, AttnPre& P) {
    const int lane = tid & 63, w = tid >> 6, fr = lane & 15, g = lane >> 4;
    const int nbl = 5 - dlog, bh = idx >> 5, b = bh >> 3, h = bh & 7, rn = idx & 31, r = rn >> nbl, n = rn & ((1 << nbl) - 1);
    const size_t mb = (size_t)b * SEQ;
#pragma unroll
    for (int pass = 0; pass < 4; ++pass) {
        const int row = pass * 64 + (tid >> 3), ch = tid & 7, tok = (((128 * (n - 1) + row)) << dlog) + r;
        P.k[pass] = (u32x4){0u, 0u, 0u, 0u}; P.v[pass] = (u32x4){0u, 0u, 0u, 0u};
        if (tok >= 0) { const GAS bf16_t* src = Z + (mb + tok) * EV_N + 64 * h + 8 * ch; P.k[pass] = *(const GAS u32x4*)(src + 1536); P.v[pass] = *(const GAS u32x4*)(src + 2048); }
    }
    const int tq = ((128 * n + 16 * w + fr) << dlog) + r;
    const GAS bf16_t* qp = Z + (mb + tq) * EV_N + 512 + 64 * h;
    P.q0 = *(const GAS bf16x8*)(qp + 8 * g); P.q1 = *(const GAS bf16x8*)(qp + 32 + 8 * g);
}
template <bool FINAL>
__device__ __forceinline__ void attn_run(LAS unsigned char* lds, GAS bf16_t* Z, const int dlog, const int idx0, const int count, const int stride, GAS bf16_t* Pout, GAS float* Lout,
                                         const GAS bf16_t* P1, const GAS bf16_t* P2, const GAS float* L1, const GAS float* L2, const int tid) {
    constexpr bool final = FINAL;
    const int lane = tid & 63, w = __builtin_amdgcn_readfirstlane(tid >> 6), fr = lane & 15, g = lane >> 4;
    AttnPre P;
    if (count > 0) attn_load(Z, dlog, idx0, tid, P);
    for (int it_ = 0; it_ < count; ++it_) {
    const int idx = idx0 + it_ * stride;
    const int nbl = 5 - dlog, bh = idx >> 5, b = bh >> 3, h = bh & 7, rn = idx & 31, r = rn >> nbl, n = rn & ((1 << nbl) - 1);
    const size_t mb = (size_t)b * SEQ;
#pragma unroll
    for (int pass = 0; pass < 4; ++pass) {
        const int row = pass * 64 + (tid >> 3), ch = tid & 7;
        *(LAS u32x4*)(lds + row * AT_KSTR + 16 * ch) = P.k[pass];
        *(LAS u32x4*)(lds + AT_VOFF + row * AT_VSTR + 16 * ch) = P.v[pass];
    }
    const bf16x8 q0 = P.q0, q1 = P.q1;
    const int tq = ((128 * n + 16 * w + fr) << dlog) + r;
    __syncthreads();
    if (it_ + 1 < count) attn_load(Z, dlog, idx + stride, tid, P);
    f32x4 st[9];
#pragma unroll
    for (int kt = 0; kt < 9; ++kt) {
        const LAS unsigned char* kr = lds + (16 * w + 16 * kt + fr) * AT_KSTR + 16 * g;
        const bf16x8 a0 = *(const LAS bf16x8*)kr, a1 = *(const LAS bf16x8*)(kr + 64);
        f32x4 c = (f32x4){0.f, 0.f, 0.f, 0.f};
        c = __builtin_amdgcn_mfma_f32_16x16x32_bf16(a0, q0, c, 0, 0, 0);
        c = __builtin_amdgcn_mfma_f32_16x16x32_bf16(a1, q1, c, 0, 0, 0);
        st[kt] = c;
    }
    float mx = -1e30f;
#pragma unroll
    for (int kt = 0; kt < 9; ++kt) {
        const bool tv = (n > 0) || (kt >= 8 - w);
#pragma unroll
        for (int e = 0; e < 4; ++e) {
            const int jj = 4 * g + e;
            bool ok = tv; if (kt == 0) ok = ok && (jj >= fr); if (kt == 8) ok = ok && (jj <= fr);
            const float sv = ok ? st[kt][e] : -1e30f; st[kt][e] = sv; mx = fmaxf(mx, sv);
        }
    }
    mx = fmaxf(mx, __shfl_xor(mx, 16)); mx = fmaxf(mx, __shfl_xor(mx, 32));
    float l = 0.f;
#pragma unroll
    for (int kt = 0; kt < 9; ++kt)
#pragma unroll
        for (int e = 0; e < 4; ++e) { const float p = __expf(st[kt][e] - mx); st[kt][e] = p; l += p; }
    l += __shfl_xor(l, 16); l += __shfl_xor(l, 32);
    f32x4 ot[4];
#pragma unroll
    for (int dt = 0; dt < 4; ++dt) ot[dt] = (f32x4){0.f, 0.f, 0.f, 0.f};
    const int qq = fr >> 2, pp = fr & 3;
#pragma unroll
    for (int ks2 = 0; ks2 < 5; ++ks2) {
        const int T0 = 2 * ks2, T1 = (ks2 < 4) ? 2 * ks2 + 1 : 2 * ks2;
        u32x4 pb; pb.x = cvt_pk_bf16(st[T0][0], st[T0][1]); pb.y = cvt_pk_bf16(st[T0][2], st[T0][3]);
        if (ks2 < 4) { pb.z = cvt_pk_bf16(st[T1][0], st[T1][1]); pb.w = cvt_pk_bf16(st[T1][2], st[T1][3]); } else { pb.z = 0u; pb.w = 0u; }
        const bf16x8 bfrag = __builtin_bit_cast(bf16x8, pb);
        const LAS unsigned char* v0 = lds + AT_VOFF + (16 * w + 16 * T0 + 4 * g + qq) * AT_VSTR + 8 * pp;
        const LAS unsigned char* v1 = lds + AT_VOFF + (16 * w + 16 * T1 + 4 * g + qq) * AT_VSTR + 8 * pp;
#pragma unroll
        for (int dt = 0; dt < 4; ++dt) ot[dt] = __builtin_amdgcn_mfma_f32_16x16x32_bf16(tr_pair(v0 + 32 * dt, v1 + 32 * dt), bfrag, ot[dt], 0, 0, 0);
    }
    const float inv = 1.0f / l, lse = mx + __logf(l);
    if (!final) {
        GAS bf16_t* op = Pout + (mb + tq) * 512 + 64 * h + 4 * g;
#pragma unroll
        for (int dt = 0; dt < 4; ++dt) { u32x2 o; o.x = cvt_pk_bf16(ot[dt][0] * inv, ot[dt][1] * inv); o.y = cvt_pk_bf16(ot[dt][2] * inv, ot[dt][3] * inv); *(GAS u32x2*)(op + 16 * dt) = o; }
        if (g == 0) Lout[(mb + tq) * 8 + h] = lse;
    } else {
        const float l1 = L1[(mb + tq) * 8 + h], l2 = L2[(mb + tq) * 8 + h];
        const float mm = fmaxf(lse, fmaxf(l1, l2)), e0 = __expf(lse - mm), e1 = __expf(l1 - mm), e2 = __expf(l2 - mm), rs = 1.0f / (e0 + e1 + e2);
        const float w0 = e0 * rs * inv, w1 = e1 * rs, w2 = e2 * rs;
        const GAS bf16_t* p1 = P1 + (mb + tq) * 512 + 64 * h + 4 * g; const GAS bf16_t* p2 = P2 + (mb + tq) * 512 + 64 * h + 4 * g;
        GAS bf16_t* op = Z + (mb + tq) * EV_N + 512 + 64 * h + 4 * g;
#pragma unroll
        for (int dt = 0; dt < 4; ++dt) {
            const u32x2 a = *(const GAS u32x2*)(p1 + 16 * dt), c = *(const GAS u32x2*)(p2 + 16 * dt);
            const float r0 = w0 * ot[dt][0] + w1 * bf2f((unsigned short)(a.x & 0xffffu)) + w2 * bf2f((unsigned short)(c.x & 0xffffu));
            const float r1 = w0 * ot[dt][1] + w1 * bf2f((unsigned short)(a.x >> 16)) + w2 * bf2f((unsigned short)(c.x >> 16));
            const float r2 = w0 * ot[dt][2] + w1 * bf2f((unsigned short)(a.y & 0xffffu)) + w2 * bf2f((unsigned short)(c.y & 0xffffu));
            const float r3 = w0 * ot[dt][3] + w1 * bf2f((unsigned short)(a.y >> 16)) + w2 * bf2f((unsigned short)(c.y >> 16));
            u32x2 o; o.x = cvt_pk_bf16(r0, r1); o.y = cvt_pk_bf16(r2, r3); *(GAS u32x2*)(op + 16 * dt) = o;
        }
    }
    __syncthreads();
    }
}
constexpr int GM_STR = 160;
__device__ __forceinline__ void gmlp_item(LAS unsigned char* lds, GAS bf16_t* Z, const GAS float* LNP, const GAS float* ln_g, const GAS float* ln_b, const GAS bf16_t* Wbf, const GAS float* bs, const int item, const int tid) {
    const int lane = tid & 63, w = __builtin_amdgcn_readfirstlane(tid >> 6), fr = lane & 15, g4 = lane >> 4;
    const int chunk = item >> 3, g = item & 7, m0 = chunk * 128;
    {
        const int s = tid >> 2, c0 = (tid & 3) * 16; const size_t row = m0 + s;
        float s1 = 0.f, s2 = 0.f;
#pragma unroll
        for (int k = 0; k < 4; ++k) { const f32x4 p = *(const GAS f32x4*)(LNP + row * 16 + 4 * k); s1 += p[0] + p[2]; s2 += p[1] + p[3]; }
        const float mean = s1 * (1.f / 512.f), var = s2 * (1.f / 512.f) - mean * mean, rstd = rsqrtf(var + EPS);
        const GAS bf16_t* gp = Z + row * EV_N + 1024 + 64 * g + c0;
#pragma unroll
        for (int hh = 0; hh < 2; ++hh) {
            const u32x4 raw = *(const GAS u32x4*)(gp + 8 * hh);
            const f32x4 la = *(const GAS f32x4*)(ln_g + 64 * g + c0 + 8 * hh), lb = *(const GAS f32x4*)(ln_g + 64 * g + c0 + 8 * hh + 4);
            const f32x4 ba = *(const GAS f32x4*)(ln_b + 64 * g + c0 + 8 * hh), bb = *(const GAS f32x4*)(ln_b + 64 * g + c0 + 8 * hh + 4);
            f32x4 x0, x1;
            x0[0] = bf2f((unsigned short)(raw.x & 0xffffu)); x0[1] = bf2f((unsigned short)(raw.x >> 16)); x0[2] = bf2f((unsigned short)(raw.y & 0xffffu)); x0[3] = bf2f((unsigned short)(raw.y >> 16));
            x1[0] = bf2f((unsigned short)(raw.z & 0xffffu)); x1[1] = bf2f((unsigned short)(raw.z >> 16)); x1[2] = bf2f((unsigned short)(raw.w & 0xffffu)); x1[3] = bf2f((unsigned short)(raw.w >> 16));
            x0 = (x0 - mean) * rstd * la + ba; x1 = (x1 - mean) * rstd * lb + bb;
            *(LAS u32x4*)(lds + s * GM_STR + (c0 + 8 * hh) * 2) = pack8(x0, x1);
        }
    }
    __syncthreads();
    f32x4 acc[4];
#pragma unroll
    for (int ct = 0; ct < 4; ++ct) acc[ct] = (f32x4){0.f, 0.f, 0.f, 0.f};
    const int t = 16 * w + fr, qq = fr >> 2, pp = fr & 3;
    const GAS bf16_t* wrow = Wbf + ((size_t)g * 128 + t) * 128 + 8 * g4;
#pragma unroll
    for (int ks = 0; ks < 4; ++ks) {
        if (32 * ks <= 16 * w + 15) {
            const bf16x8 bfr = *(const GAS bf16x8*)(wrow + 32 * ks);
            const LAS unsigned char* a0 = lds + (32 * ks + 8 * g4 + qq) * GM_STR + 8 * pp;
#pragma unroll
            for (int ct = 0; ct < 4; ++ct) acc[ct] = __builtin_amdgcn_mfma_f32_16x16x32_bf16(tr_pair(a0 + 32 * ct, a0 + 4 * GM_STR + 32 * ct), bfr, acc[ct], 0, 0, 0);
        }
    }
    const float bias = bs[g * 128 + t];
    GAS bf16_t* up = Z + (size_t)(m0 + t) * EV_N + 64 * g + 4 * g4;
#pragma unroll
    for (int ct = 0; ct < 4; ++ct) {
        const u32x2 a = *(const GAS u32x2*)(up + 16 * ct);
        u32x2 o; o.x = cvt_pk_bf16(bf2f((unsigned short)(a.x & 0xffffu)) * (acc[ct][0] + bias), bf2f((unsigned short)(a.x >> 16)) * (acc[ct][1] + bias));
        o.y = cvt_pk_bf16(bf2f((unsigned short)(a.y & 0xffffu)) * (acc[ct][2] + bias), bf2f((unsigned short)(a.y >> 16)) * (acc[ct][3] + bias));
        *(GAS u32x2*)(up + 16 * ct) = o;
    }
    __syncthreads();
}


constexpr int GL_GAL = 0, GL_SEG = 4096, GL_A = 8192;
constexpr int G1_KSSTR = 144, G1_V = GL_A + 128 * G1_KSSTR, GL_VSTR = 544;
constexpr int G3_QSTR = 272, G3_KT = GL_A + 64 * G3_QSTR, G3_V = G3_KT + 64 * G3_QSTR, G3_SSQ = G3_V + 64 * GL_VSTR;
__device__ __forceinline__ void gla_decay(LAS unsigned char* lds, const GAS float* GA, const GAS float* w_a2, const GAS float* b_a, const int h, const size_t m0, const int tid, float (&bl)[2][8], float (&tot)[2]) {
    LAS float* gal = (LAS float*)(lds + GL_GAL); LAS float* seg = (LAS float*)(lds + GL_SEG);
    const int kp = tid & 63, s8 = tid >> 6;
    if (tid < 256) *(LAS f32x4*)(gal + 4 * tid) = *(const GAS f32x4*)(GA + m0 * 16 + 4 * tid);
    float wa[2][16], ba[2];
#pragma unroll
    for (int c = 0; c < 2; ++c) {
#pragma unroll
        for (int j = 0; j < 16; ++j) wa[c][j] = w_a2[j * 512 + 128 * h + 2 * kp + c];
        ba[c] = b_a[128 * h + 2 * kp + c]; }
    __syncthreads();
    float run[2] = {0.f, 0.f};
#pragma unroll
    for (int i = 0; i < 8; ++i) {
        const LAS f32x4* gr = (const LAS f32x4*)(gal + (8 * s8 + i) * 16);
        const f32x4 g0 = gr[0], g1 = gr[1], g2 = gr[2], g3 = gr[3];
#pragma unroll
        for (int c = 0; c < 2; ++c) {
            float x = ba[c];
#pragma unroll
            for (int j = 0; j < 4; ++j) x += g0[j] * wa[c][j] + g1[j] * wa[c][4 + j] + g2[j] * wa[c][8 + j] + g3[j] * wa[c][12 + j];
            const float ls = fminf(x, 0.f) - __logf(1.0f + __expf(-fabsf(x)));
            run[c] += ls * (1.0f / 16.0f); bl[c][i] = run[c];
        }
    }
    *(LAS f32x2*)(seg + s8 * 128 + 2 * kp) = (f32x2){run[0], run[1]};
    __syncthreads();
    float pre[2] = {0.f, 0.f}; tot[0] = 0.f; tot[1] = 0.f;
#pragma unroll
    for (int q = 0; q < 8; ++q) { const f32x2 sv = *(const LAS f32x2*)(seg + q * 128 + 2 * kp); if (q < s8) { pre[0] += sv.x; pre[1] += sv.y; } tot[0] += sv.x; tot[1] += sv.y; }
#pragma unroll
    for (int i = 0; i < 8; ++i) { bl[0][i] += pre[0]; bl[1][i] += pre[1]; }
}
__device__ __forceinline__ void gla_stage_v(LAS unsigned char* vl, const GAS bf16_t* Z, const int h, const size_t m0, const int tid) {
#pragma unroll
    for (int p = 0; p < 4; ++p) { const int idx = p * 512 + tid, t = idx >> 5, ch = idx & 31;
        *(LAS u32x4*)(vl + t * GL_VSTR + 16 * ch) = *(const GAS u32x4*)(Z + (m0 + t) * OD_N + 1024 + 256 * h + 8 * ch); }
}
__device__ __forceinline__ void gla_g1_item(LAS unsigned char* lds, const GAS bf16_t* Z, const GAS float* GA, const GAS float* w_a2, const GAS float* b_a, GAS bf16_t* KVT, GAS float* DEC, const int item, const int tid) {
    const int lane = tid & 63, w = __builtin_amdgcn_readfirstlane(tid >> 6), fr = lane & 15, g = lane >> 4;
    const int bh = item >> 6, n = item & 63, h = bh & 3; const size_t m0 = (size_t)(bh >> 2) * SEQ + 64 * n;
    float bl[2][8], tot[2];
    gla_decay(lds, GA, w_a2, b_a, h, m0, tid, bl, tot);
    const int kp = tid & 63, s8 = tid >> 6;
    {
        float ks[2][8];
#pragma unroll
        for (int i = 0; i < 8; ++i) {
            const unsigned kk = *(const GAS unsigned*)(Z + (m0 + 8 * s8 + i) * OD_N + 512 + 128 * h + 2 * kp);
            ks[0][i] = bf2f((unsigned short)(kk & 0xffffu)) * __expf(tot[0] - bl[0][i]); ks[1][i] = bf2f((unsigned short)(kk >> 16)) * __expf(tot[1] - bl[1][i]);
        }
#pragma unroll
        for (int c = 0; c < 2; ++c)
            *(LAS u32x4*)(lds + GL_A + (2 * kp + c) * G1_KSSTR + 16 * s8) = pack8((f32x4){ks[c][0], ks[c][1], ks[c][2], ks[c][3]}, (f32x4){ks[c][4], ks[c][5], ks[c][6], ks[c][7]});
        if (s8 == 0) *(GAS f32x2*)(DEC + (size_t)item * 128 + 2 * kp) = (f32x2){__expf(tot[0]), __expf(tot[1])};
    }
    gla_stage_v(lds + G1_V, Z, h, m0, tid);
    __syncthreads();
    const LAS unsigned char* ar = lds + GL_A + (16 * w + fr) * G1_KSSTR + 16 * g;
    const bf16x8 a0 = *(const LAS bf16x8*)ar, a1 = *(const LAS bf16x8*)(ar + 64);
    const int qq = fr >> 2, pp = fr & 3;
    const LAS unsigned char* vb = lds + G1_V + (8 * g + qq) * GL_VSTR + 8 * pp;
    GAS bf16_t* outp = KVT + (size_t)item * 32768 + (size_t)fr * 128 + 16 * w + 4 * g;
#pragma unroll
    for (int vt = 0; vt < 16; ++vt) {
        f32x4 c = (f32x4){0.f, 0.f, 0.f, 0.f};
        c = __builtin_amdgcn_mfma_f32_16x16x32_bf16(a0, tr_pair(vb + 32 * vt, vb + 4 * GL_VSTR + 32 * vt), c, 0, 0, 0);
        c = __builtin_amdgcn_mfma_f32_16x16x32_bf16(a1, tr_pair(vb + 32 * GL_VSTR + 32 * vt, vb + 36 * GL_VSTR + 32 * vt), c, 0, 0, 0);
        u32x2 o; o.x = cvt_pk_bf16(c[0], c[1]); o.y = cvt_pk_bf16(c[2], c[3]);
        *(GAS u32x2*)(outp + (size_t)vt * 16 * 128) = o;
    }
    __syncthreads();
}
__device__ __forceinline__ void gla_scan(GAS bf16_t* KVT, const GAS float* DEC, const int tid, const int G) {
    for (int gid = blockIdx.x * (NWAVES * 64) + tid; gid < 16 * 8192; gid += G * NWAVES * 64) {
        const int bh = gid >> 13, off = (gid & 8191) * 4, k4 = gid & 31;
        GAS bf16_t* p = KVT + (size_t)bh * 64 * 32768 + off; const GAS float* dp = DEC + (size_t)bh * 64 * 128 + 4 * k4;
        f32x4 S = (f32x4){0.f, 0.f, 0.f, 0.f};
        for (int n0 = 0; n0 < 64; n0 += 8) {
            u32x2 kv[8]; f32x4 dc[8];
#pragma unroll
            for (int i = 0; i < 8; ++i) { kv[i] = *(const GAS u32x2*)(p + (size_t)(n0 + i) * 32768); dc[i] = *(const GAS f32x4*)(dp + (n0 + i) * 128); }
#pragma unroll
            for (int i = 0; i < 8; ++i) {
                u32x2 o; o.x = cvt_pk_bf16(S[0], S[1]); o.y = cvt_pk_bf16(S[2], S[3]);
                *(GAS u32x2*)(p + (size_t)(n0 + i) * 32768) = o;
                S[0] = dc[i][0] * S[0] + bf2f((unsigned short)(kv[i].x & 0xffffu)); S[1] = dc[i][1] * S[1] + bf2f((unsigned short)(kv[i].x >> 16));
                S[2] = dc[i][2] * S[2] + bf2f((unsigned short)(kv[i].y & 0xffffu)); S[3] = dc[i][3] * S[3] + bf2f((unsigned short)(kv[i].y >> 16));
            }
        }
    }
}
__device__ __forceinline__ void gla_g3_item(LAS unsigned char* lds, GAS bf16_t* Z, const GAS float* GA, const GAS float* w_a2, const GAS float* b_a, const GAS bf16_t* KVT, const GAS float* head_g, const int item, const int tid) {
    const int lane = tid & 63, w = __builtin_amdgcn_readfirstlane(tid >> 6), fr = lane & 15, g = lane >> 4;
    const int bh = item >> 6, n = item & 63, h = bh & 3; const size_t m0 = (size_t)(bh >> 2) * SEQ + 64 * n;
    float bl[2][8], tot[2];
    gla_decay(lds, GA, w_a2, b_a, h, m0, tid, bl, tot);
    const int kp = tid & 63, s8 = tid >> 6;
#pragma unroll
    for (int i = 0; i < 8; ++i) {
        const int t = 8 * s8 + i;
        const unsigned qv = *(const GAS unsigned*)(Z + (m0 + t) * OD_N + 128 * h + 2 * kp), kv = *(const GAS unsigned*)(Z + (m0 + t) * OD_N + 512 + 128 * h + 2 * kp);
        const float e0 = __expf(bl[0][i]), e1 = __expf(bl[1][i]), f0 = __expf(-bl[0][i]), f1 = __expf(-bl[1][i]);
        *(LAS unsigned*)(lds + GL_A + t * G3_QSTR + 4 * kp) = cvt_pk_bf16(bf2f((unsigned short)(qv & 0xffffu)) * e0, bf2f((unsigned short)(qv >> 16)) * e1);
        *(LAS unsigned*)(lds + G3_KT + t * G3_QSTR + 4 * kp) = cvt_pk_bf16(bf2f((unsigned short)(kv & 0xffffu)) * f0, bf2f((unsigned short)(kv >> 16)) * f1);
    }
    gla_stage_v(lds + G3_V, Z, h, m0, tid);
    __syncthreads();
    u32x4 pb[4][2];
#pragma unroll
    for (int tt = 0; tt < 4; ++tt) {
        bf16x8 qf[4];
#pragma unroll
        for (int ks = 0; ks < 4; ++ks) qf[ks] = *(const LAS bf16x8*)(lds + GL_A + (16 * tt + fr) * G3_QSTR + 64 * ks + 16 * g);
        u32x2 pk[4];
#pragma unroll
        for (int jt = 0; jt < 4; ++jt) {
            if (jt <= tt) {
                f32x4 c = (f32x4){0.f, 0.f, 0.f, 0.f};
#pragma unroll
                for (int ks = 0; ks < 4; ++ks) c = __builtin_amdgcn_mfma_f32_16x16x32_bf16(*(const LAS bf16x8*)(lds + G3_KT + (16 * jt + fr) * G3_QSTR + 64 * ks + 16 * g), qf[ks], c, 0, 0, 0);
                if (jt == tt) {
#pragma unroll
                    for (int e = 0; e < 4; ++e) c[e] = (4 * g + e <= fr) ? c[e] : 0.f;
                }
                pk[jt].x = cvt_pk_bf16(c[0], c[1]); pk[jt].y = cvt_pk_bf16(c[2], c[3]);
            } else { pk[jt].x = 0u; pk[jt].y = 0u; }
        }
        pb[tt][0] = (u32x4){pk[0].x, pk[0].y, pk[1].x, pk[1].y}; pb[tt][1] = (u32x4){pk[2].x, pk[2].y, pk[3].x, pk[3].y};
    }
    const int qq = fr >> 2, pp = fr & 3;
    f32x4 acc[2][4];
    float ssq[4] = {0.f, 0.f, 0.f, 0.f};
#pragma unroll
    for (int vi = 0; vi < 2; ++vi) {
        const int vt = 2 * w + vi;
        bf16x8 sf[4];
        const GAS bf16_t* sp = KVT + (size_t)item * 32768 + (size_t)(16 * vt + fr) * 128 + 8 * g;
#pragma unroll
        for (int ks = 0; ks < 4; ++ks) sf[ks] = *(const GAS bf16x8*)(sp + 32 * ks);
        const LAS unsigned char* vb = lds + G3_V + (4 * g + qq) * GL_VSTR + 32 * vt + 8 * pp;
        const bf16x8 va = tr_pair(vb, vb + 16 * GL_VSTR), vc = tr_pair(vb + 32 * GL_VSTR, vb + 48 * GL_VSTR);
#pragma unroll
        for (int tt = 0; tt < 4; ++tt) {
            f32x4 c = (f32x4){0.f, 0.f, 0.f, 0.f};
#pragma unroll
            for (int ks = 0; ks < 4; ++ks) c = __builtin_amdgcn_mfma_f32_16x16x32_bf16(sf[ks], *(const LAS bf16x8*)(lds + GL_A + (16 * tt + fr) * G3_QSTR + 64 * ks + 16 * g), c, 0, 0, 0);
            c = __builtin_amdgcn_mfma_f32_16x16x32_bf16(va, __builtin_bit_cast(bf16x8, pb[tt][0]), c, 0, 0, 0);
            if (tt >= 2) c = __builtin_amdgcn_mfma_f32_16x16x32_bf16(vc, __builtin_bit_cast(bf16x8, pb[tt][1]), c, 0, 0, 0);
            acc[vi][tt] = c; ssq[tt] += dot4(c);
        }
    }
    LAS float* sl = (LAS float*)(lds + G3_SSQ);
#pragma unroll
    for (int tt = 0; tt < 4; ++tt) { float v = ssq[tt]; v += __shfl_xor(v, 16); v += __shfl_xor(v, 32); if (g == 0) sl[w * 64 + 16 * tt + fr] = v; }
    __syncthreads();
#pragma unroll
    for (int tt = 0; tt < 4; ++tt) {
        float tsum = 0.f;
#pragma unroll
        for (int q = 0; q < 8; ++q) tsum += sl[q * 64 + 16 * tt + fr];
        const float rstd = rsqrtf(tsum * (1.0f / 256.0f) + EPS);
#pragma unroll
        for (int vi = 0; vi < 2; ++vi) {
            const int vc0 = 32 * w + 16 * vi + 4 * g;
            const f32x4 hg = *(const GAS f32x4*)(head_g + vc0);
            GAS bf16_t* row = Z + (m0 + 16 * tt + fr) * OD_N + 256 * h + vc0;
            const u32x2 sr = *(const GAS u32x2*)(row + 2048);
            const f32x4 c = acc[vi][tt];
            u32x2 o; o.x = cvt_pk_bf16(c[0] * rstd * hg[0] * bf2f((unsigned short)(sr.x & 0xffffu)), c[1] * rstd * hg[1] * bf2f((unsigned short)(sr.x >> 16)));
            o.y = cvt_pk_bf16(c[2] * rstd * hg[2] * bf2f((unsigned short)(sr.y & 0xffffu)), c[3] * rstd * hg[3] * bf2f((unsigned short)(sr.y >> 16)));
            *(GAS u32x2*)(row + 1024) = o;
        }
    }
    __syncthreads();
}
__device__ __forceinline__ void ga_group(LAS unsigned char* lds, const GAS bf16_t* XB, const GAS float* RSQ, const GAS bf16_t* WGA, GAS float* GA, const int grp, const int tid) {
    const int lane = tid & 63, w = __builtin_amdgcn_readfirstlane(tid >> 6), fr = lane & 15, g = lane >> 4, tt = w & 3, kh = w >> 2;
    const GAS bf16_t* ap = XB + (size_t)(64 * grp + 16 * tt + fr) * D + 512 * kh + 8 * g; const GAS bf16_t* bp = WGA + (size_t)fr * D + 512 * kh + 8 * g;
    f32x4 c = (f32x4){0.f, 0.f, 0.f, 0.f};
#pragma unroll 4
    for (int ks = 0; ks < 16; ++ks) c = __builtin_amdgcn_mfma_f32_16x16x32_bf16(*(const GAS bf16x8*)(ap + 32 * ks), *(const GAS bf16x8*)(bp + 32 * ks), c, 0, 0, 0);
    LAS float* pl = (LAS float*)lds;
#pragma unroll
    for (int e = 0; e < 4; ++e) pl[(kh * 64 + 16 * tt + 4 * g + e) * 16 + fr] = c[e];
    __syncthreads();
    for (int i = tid; i < 64 * 16; i += NWAVES * 64) {
        const int t = i >> 4; const size_t row = (size_t)64 * grp + t;
        float s = 0.f;
#pragma unroll
        for (int q = 0; q < 4; ++q) s += sum4(*(const GAS f32x4*)(RSQ + row * 16 + 4 * q));
        GA[row * 16 + (i & 15)] = (pl[i] + pl[1024 + i]) * rsqrtf(s * (1.0f / 1024.0f) + EPS);
    }
    __syncthreads();
}

constexpr int RING_BYTES = 131072, LDSCTL_OFF = RING_BYTES, MISC_OFF = LDSCTL_OFF + 320, LDSX_OFF = RING_BYTES + 1024, RSTD_OFF = RING_BYTES + 5120, PAR_OFF = RING_BYTES + 13312, LDS_BYTES = 163840;
constexpr int NPHASE = 1 + 8 * DEPTH;
struct Args { const float* in[21]; float* out; unsigned char* ws; int ph_lo, ph_hi, li, pad; };

#define GIN(i) ((const GAS float*)inp[i])
__global__ void __launch_bounds__(NWAVES * 64, 2) mega(Args args) {
    extern __shared__ __attribute__((aligned(16))) unsigned char lds_raw[];
    LAS unsigned char* lds = (LAS unsigned char*)lds_raw;
    volatile LAS unsigned* MISC = (volatile LAS unsigned*)(lds + MISC_OFF);
    const int G = gridDim.x;
    unsigned* ctl = (unsigned*)(args.ws + WS_CTL);
    for (int u = threadIdx.x; u < (LDS_BYTES - LDSCTL_OFF) / 4; u += NWAVES * 64) ((LAS unsigned*)(lds + LDSCTL_OFF))[u] = 0u;
    __syncthreads();
    XcdBarrier bar = xcd_barrier_post(ctl + CW_BAR + args.li * XCD_BAR_WORDS, MISC + 8);

    typedef const float* cfp_t;
    const __attribute__((address_space(4))) cfp_t* inp0 = (const __attribute__((address_space(4))) cfp_t*)__builtin_amdgcn_kernarg_segment_ptr();

    bool first = true;
    for (int ph = args.ph_lo; ph < args.ph_hi; ++ph) {
        if (ph > 0) { const int L_ = (ph - 1) >> 3, sub_ = (ph - 1) & 7; if (sub_ == 6 || ((L_ & 1) == 0 && sub_ == 3)) continue; }
        if (!first) xcd_barrier(bar);
        first = false;
        const __attribute__((address_space(4))) cfp_t* inp = inp0; asm volatile("" : "+s"(inp));
        unsigned char* ws = args.ws; asm volatile("" : "+s"(ws));
        int tid = threadIdx.x; asm volatile("" : "+v"(tid));
        const int lane = tid & 63, wave = __builtin_amdgcn_readfirstlane(tid >> 6);
        const int gw = blockIdx.x * NWAVES + wave, NGW = G * NWAVES;
        LAS float* scr = (LAS float*)(lds + wave * 16384);
        GAS float* X = (GAS float*)args.out; asm volatile("" : "+s"(X));
        GAS bf16_t* XB = (GAS bf16_t*)(ws + WS_XB); GAS bf16_t* Z = (GAS bf16_t*)(ws + WS_Z);
        GAS float* RSQ = (GAS float*)(ws + WS_RSQ); GAS float* LNP = (GAS float*)(ws + WS_LNP);
        GAS float* HALO = (GAS float*)(ws + WS_HALO); GAS float* FIXP = (GAS float*)(ws + WS_FIXP); GAS float* FIXU = (GAS float*)(ws + WS_FIXU);
        GAS bf16_t* WGU = (GAS bf16_t*)(ws + WS_WFFN); GAS bf16_t* WDN = (GAS bf16_t*)(ws + WS_WFFN + OFF_WDOWN);
        if (ph == 0) {
            constexpr int I_EVIN = 8 * (EV_N / 128), I_SQ = 8 * 8, I_ODIN = 8 * (OD_N / 128);
            constexpr int PER = I_EVIN + I_SQ + I_ODIN + I_SQ;
            for (int it = blockIdx.x; it < 2 * PER; it += G) {
                const int e = it / PER; int r = it % PER;
                if (r < I_EVIN) { conv_block_item(lds, GIN(3) + (size_t)e * D * EV_N, nullptr, EV_N, D, EV_N, GIN(1) + (size_t)(2 * e) * D, (GAS bf16_t*)(ws + WS_WMIX + OFF_EVIN) + (size_t)e * EV_N * D, 1, r, tid); continue; } r -= I_EVIN;
                if (r < I_SQ) { conv_block_item(lds, GIN(10) + (size_t)e * D * D, nullptr, D, D, D, nullptr, (GAS bf16_t*)(ws + WS_WMIX + OFF_EVOUT) + (size_t)e * D * D, 0, r, tid); continue; } r -= I_SQ;
                if (r < I_ODIN) { conv_block_item(lds, GIN(11) + (size_t)e * D * OD_NSRC, nullptr, OD_NSRC, D, OD_N, GIN(1) + (size_t)(2 * e + 1) * D, (GAS bf16_t*)(ws + WS_WMIX + OFF_ODIN) + (size_t)e * OD_N * D, 0, r, tid); continue; } r -= I_ODIN;
                conv_block_item(lds, GIN(15) + (size_t)e * D * D, nullptr, D, D, D, nullptr, (GAS bf16_t*)(ws + WS_WMIX + OFF_ODOUT) + (size_t)e * D * D, 0, r, tid);
            }
            for (int i = blockIdx.x * (NWAVES * 64) + tid; i < 2 * 8 * 128 * 128; i += G * NWAVES * 64) {
                const int tt = (i >> 7) & 127, ss = i & 127;
                ((GAS bf16_t*)(ws + WS_SMALLW))[i] = (bf16_t)((ss <= tt) ? f2bf(GIN(6)[i]) : 0u);
            }
            for (int i = blockIdx.x * (NWAVES * 64) + tid; i < 2 * 16 * 1024; i += G * NWAVES * 64) {
                const int o = i >> 14, j = (i >> 10) & 15, k = i & 1023;
                ((GAS bf16_t*)(ws + WS_SMALLW + 512 * 1024))[i] = (bf16_t)f2bf(GIN(11)[((size_t)o * D + k) * OD_NSRC + 3072 + j] * GIN(1)[(size_t)(2 * o + 1) * D + k]);
            }
            for (int m = gw; m < M; m += NGW) {
                const f32x4* xr = (const f32x4*)(GIN(0) + (size_t)m * D) + lane; f32x4 v[4]; float s = 0.f;
#pragma unroll
                for (int j = 0; j < 4; ++j) { v[j] = xr[64 * j]; s += dot4(v[j]); }
#pragma unroll
                for (int o = 1; o < 64; o <<= 1) s += __shfl_xor(s, o);
                u32x2* o8 = (u32x2*)(XB + (size_t)m * D) + lane;
#pragma unroll
                for (int j = 0; j < 4; ++j) { u32x2 w; w.x = pk2(v[j][0], v[j][1]); w.y = pk2(v[j][2], v[j][3]); o8[64 * j] = w; }
                if (lane < 16) RSQ[(size_t)m * 16 + lane] = (lane == 0) ? s : 0.f;
            }
        } else {
            const int L = (ph - 1) >> 3, sub = (ph - 1) & 7, e = L >> 1; const bool even = (L & 1) == 0;
            if (sub == 0) {
                pg8::StaticOrder S;
                if (even) {
                    pg8::Gemm g{(const bf16_t*)XB, (const bf16_t*)(ws + WS_WMIX + OFF_EVIN) + (size_t)e * EV_N * D, M, EV_N, D, D}; S.init(M, EV_N, G, (int)blockIdx.x);
                    stage_rstd(lds, RSQ, tid, 0);
                    if (tid < 128) ((LAS float*)(lds + PAR_OFF))[tid] = (tid < 64) ? GIN(8)[e * 64 + tid] * 0.125f : GIN(9)[e * 64 + tid - 64];
                    __syncthreads();
                    EpiEvenIn E{Z, (const LAS float*)(lds + RSTD_OFF), LNP, (const LAS float*)(lds + PAR_OFF)};
                    pg8::gemm_phase<EpiEvenIn>(lds, g, S, E, tid);
                } else {
                    pg8::Gemm g{(const bf16_t*)XB, (const bf16_t*)(ws + WS_WMIX + OFF_ODIN) + (size_t)e * OD_N * D, M, OD_N, D, D}; S.init(M, OD_N, G, (int)blockIdx.x);
                    stage_rstd(lds, RSQ, tid, 0);
                    __syncthreads();
                    EpiOddIn E{Z, (const LAS float*)(lds + RSTD_OFF)};
                    pg8::gemm_phase<EpiOddIn>(lds, g, S, E, tid);
                    for (int grp = blockIdx.x; grp < M / 64; grp += G) ga_group(lds, XB, RSQ, (const GAS bf16_t*)(ws + WS_SMALLW + 512 * 1024) + (size_t)e * 16 * D, (GAS float*)(ws + WS_GA), grp, tid);
                }
            } else if (sub == 1) {
                if (even) {
                    GAS bf16_t* P1 = (GAS bf16_t*)(ws + WS_AUX); GAS bf16_t* P2 = (GAS bf16_t*)(ws + WS_AUX + 16 * MiB); GAS float* L1 = (GAS float*)(ws + WS_AUX + 32 * MiB); GAS float* L2 = L1 + (size_t)M * 8;
                    const int cnt = (1024 - (int)blockIdx.x + G - 1) / G;
                    attn_run<false>(lds, Z, 0, blockIdx.x, cnt, G, P1, L1, nullptr, nullptr, nullptr, nullptr, tid);
                    attn_run<false>(lds, Z, 2, blockIdx.x, cnt, G, P2, L2, nullptr, nullptr, nullptr, nullptr, tid);
                    for (int it = blockIdx.x; it < 1024; it += G) gmlp_item(lds, Z, LNP, GIN(4) + e * 512, GIN(5) + e * 512, (const GAS bf16_t*)(ws + WS_SMALLW) + (size_t)e * 8 * 128 * 128, GIN(7) + e * 8 * 128, it, tid);
                } else {
                    for (int it = blockIdx.x; it < 1024; it += G) gla_g1_item(lds, Z, (const GAS float*)(ws + WS_GA), GIN(12) + (size_t)e * 16 * 512, GIN(13) + e * 512, (GAS bf16_t*)(ws + WS_AUX), LNP, it, tid);
                }
            } else if (sub == 2 && even) {
                const GAS bf16_t* P1 = (const GAS bf16_t*)(ws + WS_AUX); const GAS bf16_t* P2 = (const GAS bf16_t*)(ws + WS_AUX + 16 * MiB); const GAS float* L1 = (const GAS float*)(ws + WS_AUX + 32 * MiB); const GAS float* L2 = L1 + (size_t)M * 8;
                attn_run<true>(lds, Z, 4, blockIdx.x, (1024 - (int)blockIdx.x + G - 1) / G, G, nullptr, nullptr, P1, P2, L1, L2, tid);
            } else if (sub == 2) {
                gla_scan((GAS bf16_t*)(ws + WS_AUX), LNP, tid, G);
            } else if (sub == 3) {
                for (int it = blockIdx.x; it < 1024; it += G) gla_g3_item(lds, Z, (const GAS float*)(ws + WS_GA), GIN(12) + (size_t)e * 16 * 512, GIN(13) + e * 512, (const GAS bf16_t*)(ws + WS_AUX), GIN(14) + e * 256, it, tid);
            } else if (sub == 4 || sub == 7) {
                if (sub == 4) {
                    constexpr int I_GU = 8 * (GU_N / 128), I_DN = (FF / 128) * 8;
                    const GAS float* wg = GIN(16) + (size_t)L * D * FF; const GAS float* wu = GIN(17) + (size_t)L * D * FF; const GAS float* wd = GIN(20) + (size_t)L * FF * D;
                    for (int it = blockIdx.x; it < I_GU + I_DN; it += G) {
                        if (it < I_GU) conv_block_item(lds, wg, wu, FF, D, GU_N, GIN(2) + (size_t)L * D, WGU, 2, it, tid);
                        else conv_block_item(lds, wd, nullptr, D, FF, D, nullptr, WDN, 0, it - I_GU, tid);
                    }
                    __syncthreads();
                }
                pg8::StaticOrder S; S.init(M, D, G, (int)blockIdx.x);
                if (sub == 7) {
                    const GAS float* cw = GIN(18) + (size_t)L * 3 * FF; Unit fu;
                    for (int i = 0; S.next(i, fu); ++i) {
                        const int pm = fu.pm; if ((pm & 15) == 0) continue;
                        for (int idx = tid; idx < 2 * FF; idx += NWAVES * 64) {
                            const int j = idx / FF, c = idx % FF;
                            const float h1 = HALO[((size_t)(pm - 1) * 2 + 1) * FF + c], h0 = HALO[((size_t)(pm - 1) * 2 + 0) * FF + c];
                            float pre = FIXP[((size_t)pm * 2 + j) * FF + c];
                            if (j == 0) pre += cw[FF + c] * h1 + cw[c] * h0; else pre += cw[c] * h1;
                            Z[(size_t)(pm * 256 + j) * FF + c] = (bf16_t)f2bf(silu_f(pre) * FIXU[((size_t)pm * 2 + j) * FF + c]);
                        }
                    }
                    asm volatile("s_waitcnt vmcnt(0)" ::: "memory"); __syncthreads();
                }
                pg8::Gemm g;
                if (sub == 7) g = pg8::Gemm{(const bf16_t*)Z, (const bf16_t*)WDN, M, D, FF, FF};
                else if (even) g = pg8::Gemm{(const bf16_t*)Z, (const bf16_t*)(ws + WS_WMIX + OFF_EVOUT) + (size_t)e * D * D, M, D, D, EV_N};
                else g = pg8::Gemm{(const bf16_t*)(Z + 1024), (const bf16_t*)(ws + WS_WMIX + OFF_ODOUT) + (size_t)e * D * D, M, D, D, OD_N};
                const GAS float* xin = (L == 0 && sub == 4) ? GIN(0) : (const GAS float*)X;
                EpiRes E{xin, X, XB, RSQ};
                pg8::gemm_phase<EpiRes>(lds, g, S, E, tid);
            } else if (sub == 5) {
                pg8::StaticOrder S; S.init(M, GU_N, G, (int)blockIdx.x);
                pg8::Gemm g{(const bf16_t*)XB, (const bf16_t*)WGU, M, GU_N, D, D};
                stage_rstd(lds, RSQ, tid, 0);
                {
                    const GAS float* cw = GIN(18) + (size_t)L * 3 * FF; const GAS float* cb = GIN(19) + (size_t)L * FF; Unit pu;
                    for (int i = 0; S.next(i, pu); ++i) { const int arr = tid >> 7, j = tid & 127; ((LAS float*)(lds + PAR_OFF))[i * 512 + tid] = (arr < 3) ? cw[arr * FF + 128 * pu.pn + j] : cb[128 * pu.pn + j]; }
                }
                __syncthreads();
                EpiF1 E{Z, (const LAS float*)(lds + RSTD_OFF), (const LAS float*)(lds + PAR_OFF), HALO, FIXP, FIXU, (LAS float*)(lds + LDSX_OFF)};
                pg8::gemm_phase<EpiF1>(lds, g, S, E, tid);
            }
        }
    }
}

extern "C" void kernel_launch(void* const* d_in, const int* in_sizes, int n_in, void* d_out, int out_size, void* d_ws, size_t ws_size, hipStream_t stream) {
    static int grid = 0;
    if (grid == 0) {
        if (n_in != 21 || out_size != M * D || ws_size < WS_END) { fprintf(stderr, "kernel_launch: unexpected shapes (n_in %d out %d ws %zu)\n", n_in, out_size, ws_size); grid = -1; return; }
        int dev = 0, cus = 0, per_cu = 0;
        hipGetDevice(&dev); hipDeviceGetAttribute(&cus, hipDeviceAttributeMultiprocessorCount, dev);
        hipFuncSetAttribute((const void*)mega, hipFuncAttributeMaxDynamicSharedMemorySize, LDS_BYTES);
        hipOccupancyMaxActiveBlocksPerMultiprocessor(&per_cu, (const void*)mega, NWAVES * 64, LDS_BYTES);
        (void)hipGetLastError();
        if (per_cu < 1) per_cu = 1;
        if (per_cu > 1) per_cu = 1;
        grid = cus * per_cu;
        fprintf(stderr, "kernel_launch: grid %d (cus %d), ws %zu\n", grid, cus, ws_size);
    }
    if (grid < 0) return;
    hipMemsetAsync((char*)d_ws + WS_CTL, 0, CTL_ZERO_BYTES, stream);
    Args a{};
    for (int i = 0; i < 21; ++i) a.in[i] = (const float*)d_in[i];
    a.out = (float*)d_out; a.ws = (unsigned char*)d_ws;
    a.ph_lo = 0; a.ph_hi = NPHASE; a.li = 0;
    void* kargs[] = {&a};
    hipError_t le = hipLaunchCooperativeKernel((const void*)mega, dim3(grid), dim3(NWAVES * 64), kargs, LDS_BYTES, stream);
    if (le != hipSuccess) fprintf(stderr, "cooperative launch failed: %s\n", hipGetErrorString(le));
}
```

```cpp
#include <hip/hip_runtime.h>
#include <cstdio>
#include <cstdint>

#define LAS __attribute__((address_space(3)))
#define GAS __attribute__((address_space(1)))
typedef unsigned short bf16_t;
typedef short bf16x8 __attribute__((ext_vector_type(8)));
typedef float f32x4 __attribute__((ext_vector_type(4)));
typedef float f32x2 __attribute__((ext_vector_type(2)));
typedef unsigned u32x4 __attribute__((ext_vector_type(4)));
typedef unsigned u32x2 __attribute__((ext_vector_type(2)));

constexpr int D = 1024, BATCH = 4, SEQ = 4096, M = BATCH * SEQ, DEPTH = 4;
constexpr int EV_N = 2560, OD_N = 3072, OD_NSRC = 3088, FF = 2816, GU_N = 2 * FF;
constexpr float EPS = 1e-6f;

constexpr size_t MiB = 1u << 20;
constexpr size_t WS_CTL = 0, CTL_ZERO_BYTES = 1 * MiB;
constexpr size_t WS_RSQ = 1 * MiB;
constexpr size_t WS_LNP = 2 * MiB;
constexpr size_t WS_GA = 3 * MiB;
constexpr size_t WS_HALO = 4 * MiB;
constexpr size_t WS_FIXP = 6 * MiB;
constexpr size_t WS_FIXU = 8 * MiB;
constexpr size_t WS_SMALLW = 10 * MiB;
constexpr size_t WS_WMIX = 12 * MiB;
constexpr size_t OFF_EVIN = 0, OFF_EVOUT = 10 * MiB, OFF_ODIN = 14 * MiB, OFF_ODOUT = 26 * MiB;
constexpr size_t WS_WFFN = 42 * MiB;
constexpr size_t OFF_WDOWN = 11 * MiB;
constexpr size_t WS_XB = 60 * MiB;
constexpr size_t WS_Z = 92 * MiB;
constexpr size_t WS_AUX = 188 * MiB;
constexpr size_t WS_END = 252 * MiB;
constexpr int CW_BAR = 4096;

constexpr int NWAVES = 8;
constexpr int RSTD_OFF_ = 131072 + 5120, PAR_OFF_ = 131072 + 13312;
__device__ __forceinline__ unsigned f2bf(float f) { unsigned u = __builtin_bit_cast(unsigned, f); return (u + 0x7fffu + ((u >> 16) & 1u)) >> 16; }
__device__ __forceinline__ unsigned pk2(float lo, float hi) { return f2bf(lo) | (f2bf(hi) << 16); }
__device__ __forceinline__ float bf2f(unsigned short h) { return __builtin_bit_cast(float, (unsigned)h << 16); }
typedef __bf16 bf2_t __attribute__((ext_vector_type(2)));
__device__ __forceinline__ unsigned cvt_pk_bf16(float lo, float hi) { const bf2_t r = __builtin_convertvector((f32x2){lo, hi}, bf2_t); return __builtin_bit_cast(unsigned, r); }
__device__ __forceinline__ float silu_f(float x) { return x * __builtin_amdgcn_rcpf(1.0f + __expf(-x)); }
__device__ __forceinline__ f32x2 gelu_pk(f32x2 v) {
    const f32x2 av = __builtin_elementwise_abs(v), d = av * 0.2316418882f + 1.0f;
    f32x2 t; t.x = __builtin_amdgcn_rcpf(d.x); t.y = __builtin_amdgcn_rcpf(d.y);
    f32x2 q = t * 0.5307027145f + (-0.7265760135f); q = q * t + 0.7107068705f; q = q * t + (-0.142248368f); q = q * t + 0.127414796f; q = q * t;
    const f32x2 s = (v * v) * (-0.72134752044f);
    f32x2 e; e.x = __builtin_amdgcn_exp2f(s.x); e.y = __builtin_amdgcn_exp2f(s.y);
    const f32x2 m = v * (q * e), r = v - m;
    f32x2 o; o.x = v.x < 0.f ? m.x : r.x; o.y = v.y < 0.f ? m.y : r.y; return o;
}
__device__ __forceinline__ f32x4 gelu4(f32x4 v) { f32x2 a = gelu_pk((f32x2){v[0], v[1]}), b = gelu_pk((f32x2){v[2], v[3]}); return (f32x4){a.x, a.y, b.x, b.y}; }
__device__ __forceinline__ float sum4(f32x4 v) { return (v[0] + v[1]) + (v[2] + v[3]); }
__device__ __forceinline__ float dot4(f32x4 v) { return (v[0] * v[0] + v[1] * v[1]) + (v[2] * v[2] + v[3] * v[3]); }
__device__ __forceinline__ u32x4 pack8(f32x4 a, f32x4 b) { u32x4 w; w.x = cvt_pk_bf16(a[0], a[1]); w.y = cvt_pk_bf16(a[2], a[3]); w.z = cvt_pk_bf16(b[0], b[1]); w.w = cvt_pk_bf16(b[2], b[3]); return w; }

namespace pg8 {
constexpr int BM = 256, BK = 64, HALF = 128, HTB = HALF * BK * 2, STAGE_BYTES = 8 * HTB, NXCD = 8, WGM = 8;
__host__ __device__ __forceinline__ int lds_byte(int r, int c) { const int st = (r >> 4) * 2 + (c >> 5), rr = r & 15, cc = c & 31, ob = rr * 64 + cc * 2; return st * 1024 + (ob ^ (((ob >> 9) & 1) << 5)); }
__host__ __device__ __forceinline__ void stage_rc(int b, int& R, int& C) { const int st = b / 1024, sb = b % 1024, swz = sb ^ (((sb >> 9) & 1) << 5); R = (st >> 1) * 16 + swz / 64; C = (st & 1) * 32 + (swz % 64) / 2; }
__host__ __device__ __forceinline__ int perm32(int rho) { const int n = rho >> 4, i = rho & 15; return 8 * (i >> 2) + 4 * n + (i & 3); }
struct Unit { int pm, pn, ui; };
struct Gemm { const bf16_t* A; const bf16_t* Bt; int M, N, K, lda; };
struct StaticOrder {
    int nM, nN, nwg, G, c;
    __device__ void init(int M_, int N_, int G_, int c_) { nM = M_ / BM; nN = N_ / BM; nwg = nM * nN; G = G_; c = c_; }
    __device__ bool next(int i, Unit& u) const {
        const long L = (long)i * G + c; if (L >= nwg) return false;
        int wgid = (int)L; { const int q = nwg / NXCD, r = nwg % NXCD, xcd = wgid % NXCD, off = wgid / NXCD; wgid = (xcd < r ? xcd * (q + 1) : r * (q + 1) + (xcd - r) * q) + off; }
        const int nig = WGM * nN, gid = wgid / nig, fm = gid * WGM, gsz = (nM - fm) < WGM ? (nM - fm) : WGM;
        u.pm = fm + ((wgid % nig) % gsz); u.pn = (wgid % nig) / gsz; u.ui = i; return true;
    }
};
template <class Epi>
__device__ __forceinline__ void gemm_phase(LAS unsigned char* lds, const Gemm g, const StaticOrder& S, const Epi& E, const int tid) {
    const int wid = __builtin_amdgcn_readfirstlane(tid >> 6), lane = tid & 63, wr = wid >> 2, wc = wid & 3, fr = lane & 15, fq = lane >> 4;
    const int K = g.K, nt = K / BK, lda = g.lda;
    unsigned voffA[2], voffB[2];
#pragma unroll
    for (int i = 0; i < 2; ++i) { int R, C; stage_rc(tid * 16 + i * 8192, R, C); const int Rb = (R & ~31) + perm32(R & 31);
        voffA[i] = (unsigned)(R * lda + C) * 2u; voffB[i] = (unsigned)(Rb * K + C) * 2u; }
    const size_t kstep = (size_t)(BK * 2);
    const size_t hstepA = (size_t)HALF * lda * 2, hstepB = (size_t)HALF * K * 2;
    const size_t tstepA = 2 * hstepA, tstepB = 2 * hstepB;
    const unsigned ldsw = (unsigned)wid * 1024u;
    const int aoff = lds_byte(wr * 64 + fr, fq * 8), boff = lds_byte(wc * 32 + fr, fq * 8);
#define PG8_SA(b, h) (((b) * 2 + (h)) * HTB)
#define PG8_SB(b, h) ((4 + (b) * 2 + (h)) * HTB)
#define PG8_STAGE(bufoff, gbase, voff) do { _Pragma("unroll") for (int _i = 0; _i < 2; ++_i) \
        __builtin_amdgcn_global_load_lds((const unsigned*)((const char*)(gbase) + (voff)[_i]), (LAS unsigned*)(lds + (bufoff) + ldsw + _i * 8192), 16, 0, 0); } while (0)
#define PG8_LDA(dst, b, h) do { _Pragma("unroll") for (int m = 0; m < 4; ++m) _Pragma("unroll") for (int k = 0; k < 2; ++k) dst[m][k] = *(const LAS bf16x8*)(lds + PG8_SA(b, h) + aoff + m * 2048 + k * 1024); } while (0)
#define PG8_LDB(dst, b, h) do { _Pragma("unroll") for (int n = 0; n < 2; ++n) _Pragma("unroll") for (int k = 0; k < 2; ++k) dst[n][k] = *(const LAS bf16x8*)(lds + PG8_SB(b, h) + boff + n * 2048 + k * 1024); } while (0)
#define PG8_MMA(ai, bj, At, Bt) do { __builtin_amdgcn_s_setprio(1); _Pragma("unroll") for (int m = 0; m < 4; ++m) _Pragma("unroll") for (int n = 0; n < 2; ++n) _Pragma("unroll") for (int k = 0; k < 2; ++k) \
        acc[ai][bj][m][n] = __builtin_amdgcn_mfma_f32_16x16x32_bf16(Bt[n][k], At[m][k], acc[ai][bj][m][n], 0, 0, 0); __builtin_amdgcn_s_setprio(0); } while (0)
#define PG8_WAIT_V(n) asm volatile("s_waitcnt vmcnt(" #n ")" ::: "memory")
#define PG8_WAIT_L(n) asm volatile("s_waitcnt lgkmcnt(" #n ")" ::: "memory")
#define PG8_BAR __builtin_amdgcn_s_barrier()
#define PG8_SCHED __builtin_amdgcn_sched_barrier(0)
    Unit cur, nxt; int ui = 0;
    if (!S.next(0, cur)) return;
    f32x4 acc[2][2][4][2];
    E.init(acc, cur, wr, wc, fr, fq);
    bf16x8 At[4][2], B0[2][2], B1[2][2];
    const char* cA = (const char*)g.A + (size_t)cur.pm * tstepA; const char* cB = (const char*)g.Bt + (size_t)cur.pn * tstepB;
    PG8_STAGE(PG8_SB(0, 0), cB, voffB); PG8_STAGE(PG8_SB(0, 1), cB + hstepB, voffB); PG8_STAGE(PG8_SA(0, 0), cA, voffA); PG8_STAGE(PG8_SA(0, 1), cA + hstepA, voffA);
    if (wr == 1) PG8_BAR;
    PG8_WAIT_V(2); PG8_BAR;
    PG8_STAGE(PG8_SB(1, 0), cB + kstep, voffB); PG8_STAGE(PG8_SA(1, 0), cA + kstep, voffA); PG8_STAGE(PG8_SB(1, 1), cB + hstepB + kstep, voffB);
    PG8_WAIT_V(6); PG8_BAR;
    for (;;) {
        const bool has_next = S.next(ui + 1, nxt);
        const char* nA = has_next ? (const char*)g.A + (size_t)nxt.pm * tstepA : cA; const char* nB = has_next ? (const char*)g.Bt + (size_t)nxt.pn * tstepB : cB;
        for (int t = 0; t < nt; t += 2) {
            const bool last = (t == nt - 2);
            const char* a1 = cA + (size_t)(t + 1) * kstep;
            const char* a2 = last ? nA : cA + (size_t)(t + 2) * kstep; const char* b2 = last ? nB : cB + (size_t)(t + 2) * kstep;
            const char* a3 = a2 + kstep; const char* b3 = b2 + kstep;
            PG8_LDB(B0, 0, 0); PG8_LDB(B1, 0, 1); PG8_SCHED; PG8_LDA(At, 0, 0); PG8_STAGE(PG8_SA(1, 1), a1 + hstepA, voffA);
            PG8_WAIT_V(8); PG8_WAIT_L(0); PG8_BAR; PG8_MMA(0, 0, At, B0); PG8_MMA(0, 1, At, B1); PG8_BAR; PG8_SCHED;
            PG8_LDA(At, 0, 1); PG8_STAGE(PG8_SB(0, 0), b2, voffB); PG8_STAGE(PG8_SB(0, 1), b2 + hstepB, voffB); PG8_STAGE(PG8_SA(0, 0), a2, voffA);
            PG8_WAIT_V(8); PG8_WAIT_L(0); PG8_BAR; PG8_MMA(1, 0, At, B0); PG8_MMA(1, 1, At, B1); PG8_BAR; PG8_SCHED;
            PG8_LDB(B0, 1, 0); PG8_LDB(B1, 1, 1); PG8_SCHED; PG8_LDA(At, 1, 0); PG8_STAGE(PG8_SA(0, 1), a2 + hstepA, voffA);
            PG8_WAIT_V(8); PG8_WAIT_L(0); PG8_BAR; PG8_MMA(0, 0, At, B0); PG8_MMA(0, 1, At, B1); PG8_BAR; PG8_SCHED;
            PG8_LDA(At, 1, 1); PG8_STAGE(PG8_SB(1, 0), b3, voffB); PG8_STAGE(PG8_SB(1, 1), b3 + hstepB, voffB); PG8_STAGE(PG8_SA(1, 0), a3, voffA);
            PG8_WAIT_V(8); PG8_WAIT_L(0); PG8_BAR; PG8_MMA(1, 0, At, B0); PG8_MMA(1, 1, At, B1); PG8_BAR; PG8_SCHED;
        }
        if (wr == 0) PG8_BAR;
        E(acc, cur, wr, wc, fr, fq);
        if (!has_next) break;
        E.init(acc, nxt, wr, wc, fr, fq);
        cur = nxt; cA = nA; cB = nB; ++ui;
        if (wr == 1) PG8_BAR;
    }
    PG8_WAIT_V(0);
    PG8_BAR;
#undef PG8_SA
#undef PG8_SB
#undef PG8_STAGE
#undef PG8_LDA
#undef PG8_LDB
#undef PG8_MMA
#undef PG8_WAIT_V
#undef PG8_WAIT_L
#undef PG8_BAR
#undef PG8_SCHED
}
}
using pg8::Unit;

__device__ __forceinline__ void row_rstd(const LAS float* rstd, int lrow, float (&rs)[2][4]) {
#pragma unroll
    for (int ai = 0; ai < 2; ++ai)
#pragma unroll
        for (int m = 0; m < 4; ++m) rs[ai][m] = rstd[lrow + ai * 128 + m * 16];
}
__device__ __forceinline__ void stage_rstd(LAS unsigned char* lds, const GAS float* rsq, const int tid, const int extra) {
    LAS float* out = (LAS float*)(lds + RSTD_OFF_);
    const size_t r0 = (size_t)2048 * (blockIdx.x & 7);
    f32x4 p[4][4];
#pragma unroll
    for (int j = 0; j < 4; ++j)
#pragma unroll
        for (int q = 0; q < 4; ++q) p[j][q] = *(const GAS f32x4*)(rsq + (r0 + tid + 512 * j) * 16 + 4 * q);
#pragma unroll
    for (int j = 0; j < 4; ++j) out[tid + 512 * j] = rsqrtf(((sum4(p[j][0]) + sum4(p[j][1])) + (sum4(p[j][2]) + sum4(p[j][3]))) * (1.0f / 1024.0f) + EPS);
    (void)extra;
}

struct EpiEvenIn {
    __device__ __forceinline__ void init(f32x4 (&acc)[2][2][4][2], const Unit&, int, int, int, int) const {
#pragma unroll
        for (int a = 0; a < 2; ++a)
#pragma unroll
            for (int b = 0; b < 2; ++b)
#pragma unroll
                for (int m = 0; m < 4; ++m)
#pragma unroll
                    for (int n = 0; n < 2; ++n) acc[a][b][m][n] = (f32x4){0.f, 0.f, 0.f, 0.f};
    }
    GAS bf16_t* Z; const LAS float* rstd; GAS float* lnp; const LAS float* qkg;
    __device__ __forceinline__ void operator()(const f32x4 (&acc)[2][2][4][2], const Unit& u, int wr, int wc, int fr, int fq) const {
        asm volatile("" : "+v"(fr), "+v"(fq));
        const int rowb = u.pm * 256 + wr * 64 + fr, kind = u.pn >> 1;
        float rs[2][4]; row_rstd(rstd, (u.pm & 7) * 256 + wr * 64 + fr, rs);
        if (kind == 1 || kind == 3) {
            const LAS float* g = qkg + ((kind == 1) ? 0 : 64);
            f32x4 gv[2][2];
#pragma unroll
            for (int bj = 0; bj < 2; ++bj)
#pragma unroll
                for (int n = 0; n < 2; ++n) gv[bj][n] = *(const LAS f32x4*)(g + 32 * bj + 8 * fq + 4 * n);
#pragma unroll
            for (int ai = 0; ai < 2; ++ai)
#pragma unroll
                for (int m = 0; m < 4; ++m) {
                    float ss = 0.f;
#pragma unroll
                    for (int bj = 0; bj < 2; ++bj)
#pragma unroll
                        for (int n = 0; n < 2; ++n) ss += dot4(acc[ai][bj][m][n]);
                    ss += __shfl_xor(ss, 16); ss += __shfl_xor(ss, 32);
                    const float r = rs[ai][m], rh = rsqrtf(ss * r * r * (1.0f / 64.0f) + EPS) * r;
                    GAS bf16_t* rowp = Z + (size_t)(rowb + ai * 128 + m * 16) * EV_N + u.pn * 256 + 64 * wc + 8 * fq;
#pragma unroll
                    for (int bj = 0; bj < 2; ++bj) *(GAS u32x4*)(rowp + 32 * bj) = pack8(acc[ai][bj][m][0] * rh * gv[bj][0], acc[ai][bj][m][1] * rh * gv[bj][1]);
                }
        } else {
#pragma unroll
            for (int ai = 0; ai < 2; ++ai)
#pragma unroll
                for (int m = 0; m < 4; ++m) {
                    const float r = rs[ai][m]; const int row = rowb + ai * 128 + m * 16;
                    GAS bf16_t* rowp = Z + (size_t)row * EV_N + u.pn * 256 + 32 * wc + 8 * fq;
                    float s1 = 0.f, s2 = 0.f;
#pragma unroll
                    for (int bj = 0; bj < 2; ++bj) {
                        f32x4 v0 = acc[ai][bj][m][0] * r, v1 = acc[ai][bj][m][1] * r;
                        if (kind != 4) { v0 = gelu4(v0); v1 = gelu4(v1); }
                        if (kind == 2) { s1 += sum4(v0) + sum4(v1); s2 += dot4(v0) + dot4(v1); }
                        *(GAS u32x4*)(rowp + 128 * bj) = pack8(v0, v1);
                    }
                    if (kind == 2) {
                        s1 += __shfl_xor(s1, 16); s1 += __shfl_xor(s1, 32); s2 += __shfl_xor(s2, 16); s2 += __shfl_xor(s2, 32);
                        if (fq == 0) *(GAS f32x2*)(lnp + ((size_t)row * 8 + (u.pn & 1) * 4 + wc) * 2) = (f32x2){s1, s2};
                    }
                }
        }
    }
};

struct EpiOddIn {
    __device__ __forceinline__ void init(f32x4 (&acc)[2][2][4][2], const Unit&, int, int, int, int) const {
#pragma unroll
        for (int a = 0; a < 2; ++a)
#pragma unroll
            for (int b = 0; b < 2; ++b)
#pragma unroll
                for (int m = 0; m < 4; ++m)
#pragma unroll
                    for (int n = 0; n < 2; ++n) acc[a][b][m][n] = (f32x4){0.f, 0.f, 0.f, 0.f};
    }
    GAS bf16_t* Z; const LAS float* rstd;
    __device__ __forceinline__ void operator()(const f32x4 (&acc)[2][2][4][2], const Unit& u, int wr, int wc, int fr, int fq) const {
        asm volatile("" : "+v"(fr), "+v"(fq));
        const int rowb = u.pm * 256 + wr * 64 + fr;
        float rs[2][4]; row_rstd(rstd, (u.pm & 7) * 256 + wr * 64 + fr, rs);
        const float sc = (u.pn < 2) ? 0.08838834764831845f : 1.0f; const bool act = (u.pn >= 8);
#pragma unroll
        for (int ai = 0; ai < 2; ++ai)
#pragma unroll
            for (int m = 0; m < 4; ++m) {
                const float r = rs[ai][m] * sc;
                GAS bf16_t* rowp = Z + (size_t)(rowb + ai * 128 + m * 16) * OD_N + u.pn * 256 + 32 * wc + 8 * fq;
#pragma unroll
                for (int bj = 0; bj < 2; ++bj) {
                    f32x4 v0 = acc[ai][bj][m][0] * r, v1 = acc[ai][bj][m][1] * r;
                    if (act) {
#pragma unroll
                        for (int e = 0; e < 4; ++e) { v0[e] = silu_f(v0[e]); v1[e] = silu_f(v1[e]); }
                    }
                    *(GAS u32x4*)(rowp + 128 * bj) = pack8(v0, v1);
                }
            }
    }
};

struct EpiRes {
    const GAS float* xin; GAS float* xout; GAS bf16_t* xb; GAS float* rsq;
    __device__ __forceinline__ void init(f32x4 (&acc)[2][2][4][2], const Unit& u, int wr, int wc, int fr, int fq) const {
        const int rowb = u.pm * 256 + wr * 64 + fr;
#pragma unroll
        for (int ai = 0; ai < 2; ++ai)
#pragma unroll
            for (int m = 0; m < 4; ++m) {
                const size_t off = (size_t)(rowb + ai * 128 + m * 16) * D + u.pn * 256 + 32 * wc + 8 * fq;
#pragma unroll
                for (int bj = 0; bj < 2; ++bj) { acc[ai][bj][m][0] = *(const GAS f32x4*)(xin + off + 128 * bj); acc[ai][bj][m][1] = *(const GAS f32x4*)(xin + off + 128 * bj + 4); }
            }
    }
    __device__ __forceinline__ void operator()(const f32x4 (&acc)[2][2][4][2], const Unit& u, int wr, int wc, int fr, int fq) const {
        asm volatile("" : "+v"(fr), "+v"(fq));
        const int rowb = u.pm * 256 + wr * 64 + fr;
#pragma unroll
        for (int ai = 0; ai < 2; ++ai)
#pragma unroll
            for (int m = 0; m < 4; ++m) {
                const int row = rowb + ai * 128 + m * 16; const size_t off = (size_t)row * D + u.pn * 256 + 32 * wc + 8 * fq;
                float ss = 0.f;
#pragma unroll
                for (int bj = 0; bj < 2; ++bj) {
                    const f32x4 o0 = acc[ai][bj][m][0], o1 = acc[ai][bj][m][1];
                    *(GAS f32x4*)(xout + off + 128 * bj) = o0; *(GAS f32x4*)(xout + off + 128 * bj + 4) = o1;
                    *(GAS u32x4*)(xb + off + 128 * bj) = pack8(o0, o1);
                    ss += dot4(o0) + dot4(o1);
                }
                ss += __shfl_xor(ss, 16); ss += __shfl_xor(ss, 32);
                if (fq == 0) rsq[(size_t)row * 16 + u.pn * 4 + wc] = ss;
            }
    }
};

#define DPP_MOV(old, src, ctrl, bc) __builtin_bit_cast(float, __builtin_amdgcn_update_dpp(__builtin_bit_cast(int, (float)(old)), __builtin_bit_cast(int, (float)(src)), (ctrl), 0xf, 0xf, (bc)))

struct EpiF1 {
    __device__ __forceinline__ void init(f32x4 (&acc)[2][2][4][2], const Unit&, int, int, int, int) const {
#pragma unroll
        for (int a = 0; a < 2; ++a)
#pragma unroll
            for (int b = 0; b < 2; ++b)
#pragma unroll
                for (int m = 0; m < 4; ++m)
#pragma unroll
                    for (int n = 0; n < 2; ++n) acc[a][b][m][n] = (f32x4){0.f, 0.f, 0.f, 0.f};
    }
    GAS bf16_t* H; const LAS float* rstd; const LAS float* par; GAS float* halo; GAS float* fixp; GAS float* fixu; LAS float* ldsx;
    __device__ __forceinline__ void operator()(const f32x4 (&acc)[2][2][4][2], const Unit& u, int wr, int wc, int fr, int fq) const {
        asm volatile("" : "+v"(fr), "+v"(fq));
        const int rowb = u.pm * 256 + wr * 64 + fr, ch0 = u.pn * 128 + 32 * wc + 8 * fq, lc = 32 * wc + 8 * fq;
        float rs[2][4]; row_rstd(rstd, (u.pm & 7) * 256 + wr * 64 + fr, rs);
        f32x4 w0[2], w1[2], w2[2], bb[2];
        const LAS float* pp = par + u.ui * 512 + lc;
#pragma unroll
        for (int n = 0; n < 2; ++n) { w0[n] = *(const LAS f32x4*)(pp + 4 * n); w1[n] = *(const LAS f32x4*)(pp + 128 + 4 * n); w2[n] = *(const LAS f32x4*)(pp + 256 + 4 * n); bb[n] = *(const LAS f32x4*)(pp + 384 + 4 * n); }
        if (fr >= 14) {
#pragma unroll
            for (int ai = 0; ai < 2; ++ai)
#pragma unroll
                for (int n = 0; n < 2; ++n) {
                    const f32x4 gvl = acc[ai][0][3][n] * rs[ai][3];
                    *(LAS f32x4*)(ldsx + ((ai * 2 + wr) * 2 + (fr - 14)) * 128 + lc + 4 * n) = gvl;
                    if (ai == 1 && wr == 1) *(GAS f32x4*)(halo + ((size_t)u.pm * 2 + (fr - 14)) * FF + ch0 + 4 * n) = gvl;
                }
        }
        asm volatile("s_waitcnt lgkmcnt(0)" ::: "memory"); __builtin_amdgcn_s_barrier(); asm volatile("" ::: "memory");
        const bool fix = (u.pm & 15) != 0;
#pragma unroll
        for (int ai = 0; ai < 2; ++ai) {
            const int blk = ai * 2 + wr;
            f32x4 pv[2];
#pragma unroll
            for (int n = 0; n < 2; ++n) {
                pv[n] = (f32x4){0.f, 0.f, 0.f, 0.f};
                if (blk > 0 && fr >= 14) pv[n] = *(const LAS f32x4*)(ldsx + ((blk - 1) * 2 + (fr - 14)) * 128 + lc + 4 * n);
            }
#pragma unroll
            for (int m = 0; m < 4; ++m) {
                const float r = rs[ai][m]; const int row = rowb + ai * 128 + m * 16;
                f32x4 hv[2], pre[2], upv[2], cur[2];
#pragma unroll
                for (int n = 0; n < 2; ++n) {
                    cur[n] = acc[ai][0][m][n] * r; upv[n] = acc[ai][1][m][n] * r;
#pragma unroll
                    for (int e = 0; e < 4; ++e) {
                        const float c = cur[n][e], p = pv[n][e];
                        const float t1 = DPP_MOV(0.f, p, 0x10F, true);
                        const float g1 = DPP_MOV(t1, c, 0x111, false);
                        const float t2 = DPP_MOV(0.f, p, 0x10E, true);
                        const float g2 = DPP_MOV(t2, c, 0x112, false);
                        const float pr = bb[n][e] + w2[n][e] * c + w1[n][e] * g1 + w0[n][e] * g2;
                        pre[n][e] = pr; hv[n][e] = silu_f(pr) * upv[n][e];
                    }
                }
                *(GAS u32x4*)(H + (size_t)row * FF + ch0) = pack8(hv[0], hv[1]);
                if (fix && blk == 0 && m == 0 && fr < 2) {
#pragma unroll
                    for (int n = 0; n < 2; ++n) { *(GAS f32x4*)(fixp + ((size_t)u.pm * 2 + fr) * FF + ch0 + 4 * n) = pre[n]; *(GAS f32x4*)(fixu + ((size_t)u.pm * 2 + fr) * FF + ch0 + 4 * n) = upv[n]; }
                }
                pv[0] = cur[0]; pv[1] = cur[1];
            }
        }
    }
};

#define XB_TMO      128
#define XB_XCNT(j)  (256  + 64 * (j))
#define XB_XSUB(j)  (1280 + 64 * (j))
#define XB_XGEN(j)  (2304 + 64 * (j))
#define XB_TOP      3328
#define XB_TOPGEN   3392
#define XCD_BAR_WORDS 3456
#define XB_SPIN_CAP (1u << 18)
__device__ __forceinline__ unsigned xb_ld(unsigned* p)              { return __hip_atomic_load(p, __ATOMIC_RELAXED, __HIP_MEMORY_SCOPE_AGENT); }
__device__ __forceinline__ unsigned xb_add(unsigned* p, unsigned v) { return __hip_atomic_fetch_add(p, v, __ATOMIC_RELAXED, __HIP_MEMORY_SCOPE_AGENT); }
__device__ __forceinline__ unsigned xb_xcc_id() { return (unsigned)__builtin_amdgcn_s_getreg((3 << 11) | 20) & 0xFu; }
#define XB_SPIN(cond, bar) do { unsigned _sp = 0; while (cond) { __builtin_amdgcn_s_sleep(1); \
    if ((++_sp & 255u) == 0u) { if (xb_ld(&(bar)[XB_TMO])) break; if (_sp > XB_SPIN_CAP) { atomicAdd(&(bar)[XB_TMO], 1u); break; } } } } while (0)
struct XcdBarrier { unsigned* bar; unsigned x; volatile LAS unsigned* st; };
__device__ __forceinline__ XcdBarrier xcd_barrier_post(unsigned* bar, volatile LAS unsigned* st) {
    XcdBarrier b; b.bar = bar; b.x = xb_xcc_id(); b.st = st;
    if (threadIdx.x == 0) (void)xb_add(&bar[XB_XCNT(b.x)], 1u);
    return b;
}
__device__ __forceinline__ void xcd_barrier_complete(unsigned* bar, unsigned x, unsigned& nloc, unsigned& nx) {
    const unsigned G = gridDim.x * gridDim.y * gridDim.z;
    unsigned sum, cnt, mine, sp = 0u;
    for (;;) {
        sum = 0u; cnt = 0u; mine = 0u;
#pragma unroll
        for (unsigned j = 0; j < 16; ++j) { const unsigned c = xb_ld(&bar[XB_XCNT(j)]); sum += c; cnt += (c > 0u) ? 1u : 0u; mine = (j == x) ? c : mine; }
        if (sum == G) break;
        __builtin_amdgcn_s_sleep(1);
        if ((++sp & 255u) == 0u) { if (xb_ld(&bar[XB_TMO])) break; if (sp > XB_SPIN_CAP) { atomicAdd(&bar[XB_TMO], 1u); break; } }
    }
    nloc = mine > 0u ? mine : 1u; nx = cnt > 0u ? cnt : 1u;
}
__device__ __forceinline__ void xcd_barrier(const XcdBarrier& b) {
    asm volatile("s_waitcnt vmcnt(0)" ::: "memory");
    __syncthreads();
    if (threadIdx.x == 0) {
        unsigned* bar = b.bar;
        __builtin_amdgcn_s_waitcnt(0);
        unsigned nloc = b.st[0], nx = b.st[1];
        if (nloc == 0u) { xcd_barrier_complete(bar, b.x, nloc, nx); b.st[0] = nloc; b.st[1] = nx; }
        const unsigned old = xb_add(&bar[XB_XSUB(b.x)], 1u);
        const unsigned gen = old / nloc;
        if (old + 1u == (gen + 1u) * nloc) {
            __builtin_amdgcn_fence(__ATOMIC_RELEASE, "agent");
            asm volatile("s_waitcnt vmcnt(0)" ::: "memory");
            const unsigned og = xb_add(&bar[XB_TOP], 1u);
            const unsigned tg = og / nx;
            if (og + 1u == (tg + 1u) * nx) xb_add(&bar[XB_TOPGEN], 1u);
            else XB_SPIN(xb_ld(&bar[XB_TOPGEN]) == tg, bar);
            __builtin_amdgcn_fence(__ATOMIC_ACQUIRE, "agent");
            xb_add(&bar[XB_XGEN(b.x)], 1u);
            asm volatile("s_waitcnt vmcnt(0)" ::: "memory");
        } else {
            XB_SPIN(xb_ld(&bar[XB_XGEN(b.x)]) == gen, bar);
            __builtin_amdgcn_fence(__ATOMIC_ACQUIRE, "agent");
            asm volatile("s_waitcnt vmcnt(0)" ::: "memory");
        }
    }
    __syncthreads();
}

__device__ __forceinline__ int conv_srccol(const int map, const int nd, bool& second) {
    const int nb = nd >> 5, r = nd & 31; second = false;
    if (map == 1) {
        const int pn = nb >> 3, j = nb & 7, bj = j >> 2, wc = j & 3, kind = pn >> 1, zc = 256 * pn + 64 * wc + 32 * bj;
        if (kind == 1) return 1024 + (zc - 512) + r;
        if (kind == 2) return 512 + (nd - 1024);
        if (kind == 3) return zc + r;
        return nd;
    } else if (map == 2) {
        const int pn = nb >> 3, j = nb & 7; second = (j >> 2) != 0;
        return 128 * pn + 32 * (j & 3) + r;
    }
    return nd;
}
constexpr int CV_STR = 65;
__device__ __forceinline__ void conv_block_item(LAS unsigned char* lds, const GAS float* W, const GAS float* W2, const int ldw, const int K, const int Ndst, const GAS float* gk, GAS bf16_t* WT, const int map, const int item, const int tid) {
    const int nblk = Ndst >> 7, kb = item / nblk, nb = item % nblk, k0 = kb << 7, n0 = nb << 7;
    const int l32 = tid & 31, rg = tid >> 5;
    bool second; const int sc = conv_srccol(map, n0 + 4 * l32, second);
    const GAS float* src = (second ? W2 : W) + (size_t)(k0 + 8 * rg) * ldw + sc;
    f32x4 v[8];
#pragma unroll
    for (int i = 0; i < 8; ++i) v[i] = *(const GAS f32x4*)(src + (size_t)i * ldw);
    if (gk) {
        const f32x4 g0 = *(const GAS f32x4*)(gk + k0 + 8 * rg), g1 = *(const GAS f32x4*)(gk + k0 + 8 * rg + 4);
#pragma unroll
        for (int i = 0; i < 4; ++i) { v[i] = v[i] * g0[i]; v[4 + i] = v[4 + i] * g1[i]; }
    }
    LAS unsigned* T = (LAS unsigned*)lds;
#pragma unroll
    for (int i = 0; i < 4; ++i)
#pragma unroll
        for (int e = 0; e < 4; ++e) T[(4 * l32 + e) * CV_STR + 4 * rg + i] = cvt_pk_bf16(v[2 * i][e], v[2 * i + 1][e]);
    __syncthreads();
    const int c = tid & 15;
#pragma unroll
    for (int p = 0; p < 4; ++p) {
        const int n = (tid >> 4) + 32 * p; const LAS unsigned* r = T + n * CV_STR + 4 * c;
        u32x4 o; o.x = r[0]; o.y = r[1]; o.z = r[2]; o.w = r[3];
        *(GAS u32x4*)(WT + (size_t)(n0 + n) * K + k0 + 8 * c) = o;
    }
    __syncthreads();
}

__device__ __forceinline__ void ph_gmlp_simple(LAS unsigned char* lds, bf16_t* Z, const float* LNP, const float* ln_g, const float* ln_b, const float* wsp, const float* bsp, int tid, int G) {
    LAS float* vn = (LAS float*)lds;
    for (int item = blockIdx.x; item < (M / 128) * 8; item += G) {
        const int chunk = item >> 3, g = item & 7, m0 = chunk * 128;
        for (int idx = tid; idx < 128 * 64; idx += NWAVES * 64) {
            const int s = idx >> 6, c = idx & 63; const size_t row = m0 + s;
            float s1 = 0.f, s2 = 0.f;
            for (int k = 0; k < 8; ++k) { s1 += LNP[(row * 8 + k) * 2]; s2 += LNP[(row * 8 + k) * 2 + 1]; }
            const float mean = s1 * (1.f / 512.f), var = s2 * (1.f / 512.f) - mean * mean, rstd = rsqrtf(var + EPS);
            const float gv = bf2f(Z[row * EV_N + 1024 + 64 * g + c]);
            vn[idx] = (gv - mean) * rstd * ln_g[64 * g + c] + ln_b[64 * g + c];
        }
        __syncthreads();
        for (int idx = tid; idx < 128 * 64; idx += NWAVES * 64) {
            const int t = idx >> 6, c = idx & 63; const size_t row = m0 + t;
            float a = bsp[g * 128 + t];
            const float* wr = wsp + ((size_t)g * 128 + t) * 128;
            for (int s2 = 0; s2 <= t; ++s2) a += wr[s2] * vn[s2 * 64 + c];
            const float gu = bf2f(Z[row * EV_N + 64 * g + c]);
            Z[row * EV_N + 64 * g + c] = (bf16_t)f2bf(gu * a);
        }
        __syncthreads();
    }
}
__device__ __forceinline__ void ph_attn_simple(bf16_t* Z, int gw, int NGW, int lane) {
    for (int wv = gw; wv < M * 8; wv += NGW) {
        const int m = wv >> 3, h = wv & 7, t = m & (SEQ - 1), mb = m - t;
        const float q = bf2f(Z[(size_t)m * EV_N + 512 + 64 * h + lane]);
        float ms[3], ls[3], os[3];
#pragma unroll
        for (int r = 0; r < 3; ++r) {
            const int dil = (r == 0) ? 1 : (r == 1) ? 4 : 16;
            float mx = -1e30f, l = 0.f, o = 0.f;
            for (int j = 0; j <= 128; ++j) {
                const int tk = t - j * dil; if (tk < 0) break;
                const size_t kr = (size_t)(mb + tk) * EV_N;
                float sc = q * bf2f(Z[kr + 1536 + 64 * h + lane]);
#pragma unroll
                for (int o2 = 1; o2 < 64; o2 <<= 1) sc += __shfl_xor(sc, o2);
                const float mn = fmaxf(mx, sc), al = __expf(mx - mn), p = __expf(sc - mn);
                l = l * al + p; o = o * al + p * bf2f(Z[kr + 2048 + 64 * h + lane]); mx = mn;
            }
            ms[r] = mx; ls[r] = l; os[r] = o / l;
        }
        const float l0 = ms[0] + __logf(ls[0]), l1 = ms[1] + __logf(ls[1]), l2 = ms[2] + __logf(ls[2]);
        const float mm = fmaxf(l0, fmaxf(l1, l2)), e0 = __expf(l0 - mm), e1 = __expf(l1 - mm), e2 = __expf(l2 - mm), inv = 1.f / (e0 + e1 + e2);
        Z[(size_t)m * EV_N + 512 + 64 * h + lane] = (bf16_t)f2bf((e0 * os[0] + e1 * os[1] + e2 * os[2]) * inv);
    }
}
__device__ __forceinline__ void ph_ga_simple(const float* X, const float* RSQ, const float* gmix, const float* w_in, float* GA, int gw, int NGW, int lane) {
    for (int m = gw; m < M; m += NGW) {
        float acc[16];
#pragma unroll
        for (int j = 0; j < 16; ++j) acc[j] = 0.f;
        for (int i = 0; i < 16; ++i) {
            const int k = i * 64 + lane; const float xv = X[(size_t)m * D + k] * gmix[k];
            const f32x4* wr = (const f32x4*)(w_in + (size_t)k * OD_NSRC + 3072);
#pragma unroll
            for (int j4 = 0; j4 < 4; ++j4) { const f32x4 w = wr[j4]; acc[4 * j4] += xv * w[0]; acc[4 * j4 + 1] += xv * w[1]; acc[4 * j4 + 2] += xv * w[2]; acc[4 * j4 + 3] += xv * w[3]; }
        }
        float s = 0.f;
        for (int j = 0; j < 16; ++j) s += RSQ[(size_t)m * 16 + j];
        const float rstd = rsqrtf(s * (1.f / 1024.f) + EPS);
#pragma unroll
        for (int j = 0; j < 16; ++j) {
            float v = acc[j];
#pragma unroll
            for (int o = 1; o < 64; o <<= 1) v += __shfl_xor(v, o);
            if (lane == j) GA[(size_t)m * 16 + j] = v * rstd;
        }
    }
}
__device__ __forceinline__ void ph_gla_simple(LAS unsigned char* lds, const bf16_t* Z, const float* GA, const float* w_a2, const float* b_a, float* ORAW, int tid, int G) {
    LAS float* sa = (LAS float*)lds; LAS float* sk = sa + 256; LAS float* sq = sk + 256;
    for (int item = blockIdx.x; item < 16; item += G) {
        const int b = item >> 2, h = item & 3, v = tid;
        float S[128];
#pragma unroll
        for (int k = 0; k < 128; ++k) S[k] = 0.f;
        float wa[16]; float ba = 0.f;
#pragma unroll
        for (int j = 0; j < 16; ++j) wa[j] = 0.f;
        if (v < 128) {
#pragma unroll
            for (int j = 0; j < 16; ++j) wa[j] = w_a2[j * 512 + h * 128 + v];
            ba = b_a[h * 128 + v]; }
        for (int t = 0; t < SEQ; ++t) {
            const size_t m = (size_t)b * SEQ + t; const int buf = (t & 1) * 128;
            if (v < 128) {
                float xg = ba;
#pragma unroll
                for (int j = 0; j < 16; ++j) xg += GA[m * 16 + j] * wa[j];
                const float ls = fminf(xg, 0.f) - log1pf(__expf(-fabsf(xg)));
                sa[buf + v] = __expf(ls * (1.f / 16.f));
                sk[buf + v] = bf2f(Z[m * OD_N + 512 + 128 * h + v]);
                sq[buf + v] = bf2f(Z[m * OD_N + 128 * h + v]);
            }
            __syncthreads();
            if (v < 256) {
                const float vv = bf2f(Z[m * OD_N + 1024 + 256 * h + v]);
                float o = 0.f;
#pragma unroll
                for (int k = 0; k < 128; ++k) { S[k] = sa[buf + k] * S[k] + sk[buf + k] * vv; o += sq[buf + k] * S[k]; }
                ORAW[m * 1024 + 256 * h + v] = o;
            }
        }
        __syncthreads();
    }
}
__device__ __forceinline__ void ph_gla_post_simple(bf16_t* Z, const float* ORAW, const float* head_g, int gw, int NGW, int lane) {
    for (int wv = gw; wv < M * 4; wv += NGW) {
        const int m = wv >> 2, h = wv & 3;
        const f32x4 o = *(const f32x4*)(ORAW + (size_t)m * 1024 + 256 * h + 4 * lane);
        float ss = dot4(o);
#pragma unroll
        for (int k = 1; k < 64; k <<= 1) ss += __shfl_xor(ss, k);
        const float rstd = rsqrtf(ss * (1.f / 256.f) + EPS);
        const f32x4 hg = *(const f32x4*)(head_g + 4 * lane);
        bf16_t* sr = Z + (size_t)m * OD_N + 2048 + 256 * h + 4 * lane;
        bf16_t* dst = Z + (size_t)m * OD_N + 1024 + 256 * h + 4 * lane;
        u32x2 w; w.x = pk2(o[0] * rstd * hg[0] * bf2f(sr[0]), o[1] * rstd * hg[1] * bf2f(sr[1])); w.y = pk2(o[2] * rstd * hg[2] * bf2f(sr[2]), o[3] * rstd * hg[3] * bf2f(sr[3]));
        *(u32x2*)dst = w;
    }
}


typedef short s16x4 __attribute__((ext_vector_type(4)));
__device__ __forceinline__ bf16x8 tr_pair(const LAS unsigned char* p0, const LAS unsigned char* p1) {
    const s16x4 lo = __builtin_amdgcn_ds_read_tr16_b64_v4i16((LAS s16x4*)p0), hi = __builtin_amdgcn_ds_read_tr16_b64_v4i16((LAS s16x4*)p1);
    return __builtin_shufflevector(lo, hi, 0, 1, 2, 3, 4, 5, 6, 7);
}
constexpr int AT_KSTR = 144, AT_VSTR = 160, AT_VOFF = 256 * AT_KSTR;
struct AttnPre { u32x4 k[4], v[4]; bf16x8 q0, q1; };
__device__ __forceinline__ void attn_load(const GAS bf16_t* Z, const int dlog, const int idx, const int tid, AttnPre& P) {
    const int lane = tid & 63, w = tid >> 6, fr = lane & 15, g = lane >> 4;
    const int nbl = 5 - dlog, bh = idx >> 5, b = bh >> 3, h = bh & 7, rn = idx & 31, r = rn >> nbl, n = rn & ((1 << nbl) - 1);
    const size_t mb = (size_t)b * SEQ;
#pragma unroll
    for (int pass = 0; pass < 4; ++pass) {
        const int row = pass * 64 + (tid >> 3), ch = tid & 7, tok = (((128 * (n - 1) + row)) << dlog) + r;
        P.k[pass] = (u32x4){0u, 0u, 0u, 0u}; P.v[pass] = (u32x4){0u, 0u, 0u, 0u};
        if (tok >= 0) { const GAS bf16_t* src = Z + (mb + tok) * EV_N + 64 * h + 8 * ch; P.k[pass] = *(const GAS u32x4*)(src + 1536); P.v[pass] = *(const GAS u32x4*)(src + 2048); }
    }
    const int tq = ((128 * n + 16 * w + fr) << dlog) + r;
    const GAS bf16_t* qp = Z + (mb + tq) * EV_N + 512 + 64 * h;
    P.q0 = *(const GAS bf16x8*)(qp + 8 * g); P.q1 = *(const GAS bf16x8*)(qp + 32 + 8 * g);
}
template <bool FINAL>
__device__ __forceinline__ void attn_run(LAS unsigned char* lds, GAS bf16_t* Z, const int dlog, const int idx0, const int count, const int stride, GAS bf16_t* Pout, GAS float* Lout,
                                         const GAS bf16_t* P1, const GAS bf16_t* P2, const GAS float* L1, const GAS float* L2, const int tid) {
    constexpr bool final = FINAL;
    const int lane = tid & 63, w = __builtin_amdgcn_readfirstlane(tid >> 6), fr = lane & 15, g = lane >> 4;
    AttnPre P;
    if (count > 0) attn_load(Z, dlog, idx0, tid, P);
    for (int it_ = 0; it_ < count; ++it_) {
    const int idx = idx0 + it_ * stride;
    const int nbl = 5 - dlog, bh = idx >> 5, b = bh >> 3, h = bh & 7, rn = idx & 31, r = rn >> nbl, n = rn & ((1 << nbl) - 1);
    const size_t mb = (size_t)b * SEQ;
#pragma unroll
    for (int pass = 0; pass < 4; ++pass) {
        const int row = pass * 64 + (tid >> 3), ch = tid & 7;
        *(LAS u32x4*)(lds + row * AT_KSTR + 16 * ch) = P.k[pass];
        *(LAS u32x4*)(lds + AT_VOFF + row * AT_VSTR + 16 * ch) = P.v[pass];
    }
    const bf16x8 q0 = P.q0, q1 = P.q1;
    const int tq = ((128 * n + 16 * w + fr) << dlog) + r;
    __syncthreads();
    if (it_ + 1 < count) attn_load(Z, dlog, idx + stride, tid, P);
    f32x4 st[9];
#pragma unroll
    for (int kt = 0; kt < 9; ++kt) {
        const LAS unsigned char* kr = lds + (16 * w + 16 * kt + fr) * AT_KSTR + 16 * g;
        const bf16x8 a0 = *(const LAS bf16x8*)kr, a1 = *(const LAS bf16x8*)(kr + 64);
        f32x4 c = (f32x4){0.f, 0.f, 0.f, 0.f};
        c = __builtin_amdgcn_mfma_f32_16x16x32_bf16(a0, q0, c, 0, 0, 0);
        c = __builtin_amdgcn_mfma_f32_16x16x32_bf16(a1, q1, c, 0, 0, 0);
        st[kt] = c;
    }
    float mx = -1e30f;
#pragma unroll
    for (int kt = 0; kt < 9; ++kt) {
        const bool tv = (n > 0) || (kt >= 8 - w);
#pragma unroll
        for (int e = 0; e < 4; ++e) {
            const int jj = 4 * g + e;
            bool ok = tv; if (kt == 0) ok = ok && (jj >= fr); if (kt == 8) ok = ok && (jj <= fr);
            const float sv = ok ? st[kt][e] : -1e30f; st[kt][e] = sv; mx = fmaxf(mx, sv);
        }
    }
    mx = fmaxf(mx, __shfl_xor(mx, 16)); mx = fmaxf(mx, __shfl_xor(mx, 32));
    float l = 0.f;
#pragma unroll
    for (int kt = 0; kt < 9; ++kt)
#pragma unroll
        for (int e = 0; e < 4; ++e) { const float p = __expf(st[kt][e] - mx); st[kt][e] = p; l += p; }
    l += __shfl_xor(l, 16); l += __shfl_xor(l, 32);
    f32x4 ot[4];
#pragma unroll
    for (int dt = 0; dt < 4; ++dt) ot[dt] = (f32x4){0.f, 0.f, 0.f, 0.f};
    const int qq = fr >> 2, pp = fr & 3;
#pragma unroll
    for (int ks2 = 0; ks2 < 5; ++ks2) {
        const int T0 = 2 * ks2, T1 = (ks2 < 4) ? 2 * ks2 + 1 : 2 * ks2;
        u32x4 pb; pb.x = cvt_pk_bf16(st[T0][0], st[T0][1]); pb.y = cvt_pk_bf16(st[T0][2], st[T0][3]);
        if (ks2 < 4) { pb.z = cvt_pk_bf16(st[T1][0], st[T1][1]); pb.w = cvt_pk_bf16(st[T1][2], st[T1][3]); } else { pb.z = 0u; pb.w = 0u; }
        const bf16x8 bfrag = __builtin_bit_cast(bf16x8, pb);
        const LAS unsigned char* v0 = lds + AT_VOFF + (16 * w + 16 * T0 + 4 * g + qq) * AT_VSTR + 8 * pp;
        const LAS unsigned char* v1 = lds + AT_VOFF + (16 * w + 16 * T1 + 4 * g + qq) * AT_VSTR + 8 * pp;
#pragma unroll
        for (int dt = 0; dt < 4; ++dt) ot[dt] = __builtin_amdgcn_mfma_f32_16x16x32_bf16(tr_pair(v0 + 32 * dt, v1 + 32 * dt), bfrag, ot[dt], 0, 0, 0);
    }
    const float inv = 1.0f / l, lse = mx + __logf(l);
    if (!final) {
        GAS bf16_t* op = Pout + (mb + tq) * 512 + 64 * h + 4 * g;
#pragma unroll
        for (int dt = 0; dt < 4; ++dt) { u32x2 o; o.x = cvt_pk_bf16(ot[dt][0] * inv, ot[dt][1] * inv); o.y = cvt_pk_bf16(ot[dt][2] * inv, ot[dt][3] * inv); *(GAS u32x2*)(op + 16 * dt) = o; }
        if (g == 0) Lout[(mb + tq) * 8 + h] = lse;
    } else {
        const float l1 = L1[(mb + tq) * 8 + h], l2 = L2[(mb + tq) * 8 + h];
        const float mm = fmaxf(lse, fmaxf(l1, l2)), e0 = __expf(lse - mm), e1 = __expf(l1 - mm), e2 = __expf(l2 - mm), rs = 1.0f / (e0 + e1 + e2);
        const float w0 = e0 * rs * inv, w1 = e1 * rs, w2 = e2 * rs;
        const GAS bf16_t* p1 = P1 + (mb + tq) * 512 + 64 * h + 4 * g; const GAS bf16_t* p2 = P2 + (mb + tq) * 512 + 64 * h + 4 * g;
        GAS bf16_t* op = Z + (mb + tq) * EV_N + 512 + 64 * h + 4 * g;
#pragma unroll
        for (int dt = 0; dt < 4; ++dt) {
            const u32x2 a = *(const GAS u32x2*)(p1 + 16 * dt), c = *(const GAS u32x2*)(p2 + 16 * dt);
            const float r0 = w0 * ot[dt][0] + w1 * bf2f((unsigned short)(a.x & 0xffffu)) + w2 * bf2f((unsigned short)(c.x & 0xffffu));
            const float r1 = w0 * ot[dt][1] + w1 * bf2f((unsigned short)(a.x >> 16)) + w2 * bf2f((unsigned short)(c.x >> 16));
            const float r2 = w0 * ot[dt][2] + w1 * bf2f((unsigned short)(a.y & 0xffffu)) + w2 * bf2f((unsigned short)(c.y & 0xffffu));
            const float r3 = w0 * ot[dt][3] + w1 * bf2f((unsigned short)(a.y >> 16)) + w2 * bf2f((unsigned short)(c.y >> 16));
            u32x2 o; o.x = cvt_pk_bf16(r0, r1); o.y = cvt_pk_bf16(r2, r3); *(GAS u32x2*)(op + 16 * dt) = o;
        }
    }
    __syncthreads();
    }
}
constexpr int GM_STR = 160;
__device__ __forceinline__ void gmlp_item(LAS unsigned char* lds, GAS bf16_t* Z, const GAS float* LNP, const GAS float* ln_g, const GAS float* ln_b, const GAS bf16_t* Wbf, const GAS float* bs, const int item, const int tid) {
    const int lane = tid & 63, w = __builtin_amdgcn_readfirstlane(tid >> 6), fr = lane & 15, g4 = lane >> 4;
    const int chunk = item >> 3, g = item & 7, m0 = chunk * 128;
    {
        const int s = tid >> 2, c0 = (tid & 3) * 16; const size_t row = m0 + s;
        float s1 = 0.f, s2 = 0.f;
#pragma unroll
        for (int k = 0; k < 4; ++k) { const f32x4 p = *(const GAS f32x4*)(LNP + row * 16 + 4 * k); s1 += p[0] + p[2]; s2 += p[1] + p[3]; }
        const float mean = s1 * (1.f / 512.f), var = s2 * (1.f / 512.f) - mean * mean, rstd = rsqrtf(var + EPS);
        const GAS bf16_t* gp = Z + row * EV_N + 1024 + 64 * g + c0;
#pragma unroll
        for (int hh = 0; hh < 2; ++hh) {
            const u32x4 raw = *(const GAS u32x4*)(gp + 8 * hh);
            const f32x4 la = *(const GAS f32x4*)(ln_g + 64 * g + c0 + 8 * hh), lb = *(const GAS f32x4*)(ln_g + 64 * g + c0 + 8 * hh + 4);
            const f32x4 ba = *(const GAS f32x4*)(ln_b + 64 * g + c0 + 8 * hh), bb = *(const GAS f32x4*)(ln_b + 64 * g + c0 + 8 * hh + 4);
            f32x4 x0, x1;
            x0[0] = bf2f((unsigned short)(raw.x & 0xffffu)); x0[1] = bf2f((unsigned short)(raw.x >> 16)); x0[2] = bf2f((unsigned short)(raw.y & 0xffffu)); x0[3] = bf2f((unsigned short)(raw.y >> 16));
            x1[0] = bf2f((unsigned short)(raw.z & 0xffffu)); x1[1] = bf2f((unsigned short)(raw.z >> 16)); x1[2] = bf2f((unsigned short)(raw.w & 0xffffu)); x1[3] = bf2f((unsigned short)(raw.w >> 16));
            x0 = (x0 - mean) * rstd * la + ba; x1 = (x1 - mean) * rstd * lb + bb;
            *(LAS u32x4*)(lds + s * GM_STR + (c0 + 8 * hh) * 2) = pack8(x0, x1);
        }
    }
    __syncthreads();
    f32x4 acc[4];
#pragma unroll
    for (int ct = 0; ct < 4; ++ct) acc[ct] = (f32x4){0.f, 0.f, 0.f, 0.f};
    const int t = 16 * w + fr, qq = fr >> 2, pp = fr & 3;
    const GAS bf16_t* wrow = Wbf + ((size_t)g * 128 + t) * 128 + 8 * g4;
#pragma unroll
    for (int ks = 0; ks < 4; ++ks) {
        if (32 * ks <= 16 * w + 15) {
            const bf16x8 bfr = *(const GAS bf16x8*)(wrow + 32 * ks);
            const LAS unsigned char* a0 = lds + (32 * ks + 8 * g4 + qq) * GM_STR + 8 * pp;
#pragma unroll
            for (int ct = 0; ct < 4; ++ct) acc[ct] = __builtin_amdgcn_mfma_f32_16x16x32_bf16(tr_pair(a0 + 32 * ct, a0 + 4 * GM_STR + 32 * ct), bfr, acc[ct], 0, 0, 0);
        }
    }
    const float bias = bs[g * 128 + t];
    GAS bf16_t* up = Z + (size_t)(m0 + t) * EV_N + 64 * g + 4 * g4;
#pragma unroll
    for (int ct = 0; ct < 4; ++ct) {
        const u32x2 a = *(const GAS u32x2*)(up + 16 * ct);
        u32x2 o; o.x = cvt_pk_bf16(bf2f((unsigned short)(a.x & 0xffffu)) * (acc[ct][0] + bias), bf2f((unsigned short)(a.x >> 16)) * (acc[ct][1] + bias));
        o.y = cvt_pk_bf16(bf2f((unsigned short)(a.y & 0xffffu)) * (acc[ct][2] + bias), bf2f((unsigned short)(a.y >> 16)) * (acc[ct][3] + bias));
        *(GAS u32x2*)(up + 16 * ct) = o;
    }
    __syncthreads();
}


constexpr int GL_GAL = 0, GL_SEG = 4096, GL_A = 8192;
constexpr int G1_KSSTR = 144, G1_V = GL_A + 128 * G1_KSSTR, GL_VSTR = 544;
constexpr int G3_QSTR = 272, G3_KT = GL_A + 64 * G3_QSTR, G3_V = G3_KT + 64 * G3_QSTR, G3_SSQ = G3_V + 64 * GL_VSTR;
__device__ __forceinline__ void gla_decay(LAS unsigned char* lds, const GAS float* GA, const GAS float* w_a2, const GAS float* b_a, const int h, const size_t m0, const int tid, float (&bl)[2][8], float (&tot)[2]) {
    LAS float* gal = (LAS float*)(lds + GL_GAL); LAS float* seg = (LAS float*)(lds + GL_SEG);
    const int kp = tid & 63, s8 = tid >> 6;
    if (tid < 256) *(LAS f32x4*)(gal + 4 * tid) = *(const GAS f32x4*)(GA + m0 * 16 + 4 * tid);
    float wa[2][16], ba[2];
#pragma unroll
    for (int c = 0; c < 2; ++c) {
#pragma unroll
        for (int j = 0; j < 16; ++j) wa[c][j] = w_a2[j * 512 + 128 * h + 2 * kp + c];
        ba[c] = b_a[128 * h + 2 * kp + c]; }
    __syncthreads();
    float run[2] = {0.f, 0.f};
#pragma unroll
    for (int i = 0; i < 8; ++i) {
        const LAS f32x4* gr = (const LAS f32x4*)(gal + (8 * s8 + i) * 16);
        const f32x4 g0 = gr[0], g1 = gr[1], g2 = gr[2], g3 = gr[3];
#pragma unroll
        for (int c = 0; c < 2; ++c) {
            float x = ba[c];
#pragma unroll
            for (int j = 0; j < 4; ++j) x += g0[j] * wa[c][j] + g1[j] * wa[c][4 + j] + g2[j] * wa[c][8 + j] + g3[j] * wa[c][12 + j];
            const float ls = fminf(x, 0.f) - __logf(1.0f + __expf(-fabsf(x)));
            run[c] += ls * (1.0f / 16.0f); bl[c][i] = run[c];
        }
    }
    *(LAS f32x2*)(seg + s8 * 128 + 2 * kp) = (f32x2){run[0], run[1]};
    __syncthreads();
    float pre[2] = {0.f, 0.f}; tot[0] = 0.f; tot[1] = 0.f;
#pragma unroll
    for (int q = 0; q < 8; ++q) { const f32x2 sv = *(const LAS f32x2*)(seg + q * 128 + 2 * kp); if (q < s8) { pre[0] += sv.x; pre[1] += sv.y; } tot[0] += sv.x; tot[1] += sv.y; }
#pragma unroll
    for (int i = 0; i < 8; ++i) { bl[0][i] += pre[0]; bl[1][i] += pre[1]; }
}
__device__ __forceinline__ void gla_stage_v(LAS unsigned char* vl, const GAS bf16_t* Z, const int h, const size_t m0, const int tid) {
#pragma unroll
    for (int p = 0; p < 4; ++p) { const int idx = p * 512 + tid, t = idx >> 5, ch = idx & 31;
        *(LAS u32x4*)(vl + t * GL_VSTR + 16 * ch) = *(const GAS u32x4*)(Z + (m0 + t) * OD_N + 1024 + 256 * h + 8 * ch); }
}
constexpr int G1_DEC = G1_V + 64 * GL_VSTR;
__device__ __forceinline__ void gla_g1_group(LAS unsigned char* lds, const GAS bf16_t* Z, const GAS float* GA, const GAS float* w_a2, const GAS float* b_a, GAS bf16_t* KVT, GAS float* DCC, GAS float* DG, GAS bf16_t* QK, const int item, const int tid) {
    const int lane = tid & 63, w = __builtin_amdgcn_readfirstlane(tid >> 6), fr = lane & 15, g = lane >> 4;
    const int bh = item >> 4, grp = item & 15, h = bh & 3; const size_t mbase = (size_t)(bh >> 2) * SEQ + 256 * grp;
    const int kp = tid & 63, s8 = tid >> 6;
    LAS float* gal = (LAS float*)(lds + GL_GAL); LAS float* seg = (LAS float*)(lds + GL_SEG); LAS float* decs = (LAS float*)(lds + G1_DEC);
    float wa[2][16], ba[2];
#pragma unroll
    for (int c = 0; c < 2; ++c) {
#pragma unroll
        for (int j = 0; j < 16; ++j) wa[c][j] = w_a2[j * 512 + 128 * h + 2 * kp + c];
        ba[c] = b_a[128 * h + 2 * kp + c]; }
    f32x4 acc[16];
#pragma unroll
    for (int vt = 0; vt < 16; ++vt) acc[vt] = (f32x4){0.f, 0.f, 0.f, 0.f};
    float cum[2] = {0.f, 0.f};
    const int qq = fr >> 2, pp = fr & 3;
    f32x4 pga = (f32x4){0.f, 0.f, 0.f, 0.f};
    if (tid < 256) pga = *(const GAS f32x4*)(GA + mbase * 16 + 4 * tid);
    for (int cc = 0; cc < 4; ++cc) {
        const size_t m0 = mbase + 64 * cc; const int chunk = bh * 64 + 4 * grp + cc;
        if (tid < 256) *(LAS f32x4*)(gal + 4 * tid) = pga;
        unsigned qraw[8], kraw[8];
#pragma unroll
        for (int i = 0; i < 8; ++i) { const GAS bf16_t* zr = Z + (m0 + 8 * s8 + i) * OD_N + 128 * h + 2 * kp; qraw[i] = *(const GAS unsigned*)zr; kraw[i] = *(const GAS unsigned*)(zr + 512); }
        __syncthreads();
        if (cc < 3 && tid < 256) pga = *(const GAS f32x4*)(GA + (m0 + 64) * 16 + 4 * tid);
        float bl[2][8], run[2] = {0.f, 0.f};
#pragma unroll
        for (int i = 0; i < 8; ++i) {
            const LAS f32x4* gr = (const LAS f32x4*)(gal + (8 * s8 + i) * 16);
            const f32x4 g0 = gr[0], g1 = gr[1], g2 = gr[2], g3 = gr[3];
#pragma unroll
            for (int c = 0; c < 2; ++c) {
                float x = ba[c];
#pragma unroll
                for (int j = 0; j < 4; ++j) x += g0[j] * wa[c][j] + g1[j] * wa[c][4 + j] + g2[j] * wa[c][8 + j] + g3[j] * wa[c][12 + j];
                const float ls = fminf(x, 0.f) - __logf(1.0f + __expf(-fabsf(x)));
                run[c] += ls * (1.0f / 16.0f); bl[c][i] = run[c];
            }
        }
        *(LAS f32x2*)(seg + s8 * 128 + 2 * kp) = (f32x2){run[0], run[1]};
        __syncthreads();
        float pre[2] = {0.f, 0.f}, tot[2] = {0.f, 0.f};
#pragma unroll
        for (int q = 0; q < 8; ++q) { const f32x2 sv = *(const LAS f32x2*)(seg + q * 128 + 2 * kp); if (q < s8) { pre[0] += sv.x; pre[1] += sv.y; } tot[0] += sv.x; tot[1] += sv.y; }
        float ks[2][8];
#pragma unroll
        for (int i = 0; i < 8; ++i) {
            const float b0 = bl[0][i] + pre[0], b1 = bl[1][i] + pre[1];
            const float k0 = bf2f((unsigned short)(kraw[i] & 0xffffu)), k1 = bf2f((unsigned short)(kraw[i] >> 16));
            ks[0][i] = k0 * __expf(tot[0] - b0); ks[1][i] = k1 * __expf(tot[1] - b1);
            GAS bf16_t* qr = QK + (m0 + 8 * s8 + i) * 1024 + 128 * h + 2 * kp;
            *(GAS unsigned*)qr = cvt_pk_bf16(bf2f((unsigned short)(qraw[i] & 0xffffu)) * __expf(b0), bf2f((unsigned short)(qraw[i] >> 16)) * __expf(b1));
            *(GAS unsigned*)(qr + 512) = cvt_pk_bf16(k0 * __expf(-b0), k1 * __expf(-b1));
        }
#pragma unroll
        for (int c = 0; c < 2; ++c)
            *(LAS u32x4*)(lds + GL_A + (2 * kp + c) * G1_KSSTR + 16 * s8) = pack8((f32x4){ks[c][0], ks[c][1], ks[c][2], ks[c][3]}, (f32x4){ks[c][4], ks[c][5], ks[c][6], ks[c][7]});
        gla_stage_v(lds + G1_V, Z, h, m0, tid);
        if (s8 == 0) {
            *(LAS f32x2*)(decs + 2 * kp) = (f32x2){__expf(tot[0]), __expf(tot[1])};
            *(GAS f32x2*)(DCC + (size_t)chunk * 128 + 2 * kp) = (f32x2){__expf(cum[0]), __expf(cum[1])};
        }
        cum[0] += tot[0]; cum[1] += tot[1];
        __syncthreads();
        const LAS unsigned char* ar = lds + GL_A + (16 * w + fr) * G1_KSSTR + 16 * g;
        const bf16x8 a0 = *(const LAS bf16x8*)ar, a1 = *(const LAS bf16x8*)(ar + 64);
        const f32x4 dcv = *(const LAS f32x4*)(decs + 16 * w + 4 * g);
        const LAS unsigned char* vb = lds + G1_V + (8 * g + qq) * GL_VSTR + 8 * pp;
        GAS bf16_t* outp = KVT + (size_t)chunk * 32768 + (size_t)fr * 128 + 16 * w + 4 * g;
#pragma unroll
        for (int vt = 0; vt < 16; ++vt) {
            f32x4 c = acc[vt];
            if (cc > 0) { u32x2 o; o.x = cvt_pk_bf16(c[0], c[1]); o.y = cvt_pk_bf16(c[2], c[3]); *(GAS u32x2*)(outp + (size_t)vt * 16 * 128) = o; }
            c = c * dcv;
            c = __builtin_amdgcn_mfma_f32_16x16x32_bf16(a0, tr_pair(vb + 32 * vt, vb + 4 * GL_VSTR + 32 * vt), c, 0, 0, 0);
            c = __builtin_amdgcn_mfma_f32_16x16x32_bf16(a1, tr_pair(vb + 32 * GL_VSTR + 32 * vt, vb + 36 * GL_VSTR + 32 * vt), c, 0, 0, 0);
            acc[vt] = c;
        }
        __syncthreads();
    }
    {
        GAS bf16_t* outp = KVT + (size_t)(bh * 64 + 4 * grp) * 32768 + (size_t)fr * 128 + 16 * w + 4 * g;
#pragma unroll
        for (int vt = 0; vt < 16; ++vt) { u32x2 o; o.x = cvt_pk_bf16(acc[vt][0], acc[vt][1]); o.y = cvt_pk_bf16(acc[vt][2], acc[vt][3]); *(GAS u32x2*)(outp + (size_t)vt * 16 * 128) = o; }
        if (s8 == 0) *(GAS f32x2*)(DG + (size_t)item * 128 + 2 * kp) = (f32x2){__expf(cum[0]), __expf(cum[1])};
    }
}
__device__ __forceinline__ void gla_scan(GAS bf16_t* KVT, const GAS float* DG, const int tid, const int G) {
    for (int gid = blockIdx.x * (NWAVES * 64) + tid; gid < 16 * 8192; gid += G * NWAVES * 64) {
        const int bh = gid >> 13, off = (gid & 8191) * 4, k4 = gid & 31;
        GAS bf16_t* p = KVT + (size_t)bh * 64 * 32768 + off; const GAS float* dp = DG + (size_t)bh * 16 * 128 + 4 * k4;
        f32x4 S = (f32x4){0.f, 0.f, 0.f, 0.f};
        u32x2 kv[16]; f32x4 dc[16];
#pragma unroll
        for (int i = 0; i < 16; ++i) { kv[i] = *(const GAS u32x2*)(p + (size_t)(4 * i) * 32768); dc[i] = *(const GAS f32x4*)(dp + i * 128); }
#pragma unroll
        for (int i = 0; i < 16; ++i) {
            u32x2 o; o.x = cvt_pk_bf16(S[0], S[1]); o.y = cvt_pk_bf16(S[2], S[3]);
            *(GAS u32x2*)(p + (size_t)(4 * i) * 32768) = o;
            S[0] = dc[i][0] * S[0] + bf2f((unsigned short)(kv[i].x & 0xffffu)); S[1] = dc[i][1] * S[1] + bf2f((unsigned short)(kv[i].x >> 16));
            S[2] = dc[i][2] * S[2] + bf2f((unsigned short)(kv[i].y & 0xffffu)); S[3] = dc[i][3] * S[3] + bf2f((unsigned short)(kv[i].y >> 16));
        }
    }
}
__device__ __forceinline__ void gla_g3_group(LAS unsigned char* lds, GAS bf16_t* Z, const GAS bf16_t* QK, const GAS bf16_t* KVT, const GAS float* DCC, const GAS float* head_g, const int gitem, const int tid) {
    const int lane = tid & 63, w = __builtin_amdgcn_readfirstlane(tid >> 6), fr = lane & 15, g = lane >> 4;
    const int bh = gitem >> 4, grp = gitem & 15, h = bh & 3; const size_t mbase = (size_t)(bh >> 2) * SEQ + 256 * grp;
    const int qq = fr >> 2, pp = fr & 3;
    u32x4 pq[2], pk_[2], pv[4];
#define G3_LOAD(m0_) do { _Pragma("unroll") for (int p = 0; p < 2; ++p) { const int idx = p * 512 + tid, t = idx >> 4, ch = idx & 15; const GAS bf16_t* src = QK + ((m0_) + t) * 1024 + 128 * h + 8 * ch; pq[p] = *(const GAS u32x4*)src; pk_[p] = *(const GAS u32x4*)(src + 512); } \
        _Pragma("unroll") for (int p = 0; p < 4; ++p) { const int idx = p * 512 + tid, t = idx >> 5, ch = idx & 31; pv[p] = *(const GAS u32x4*)(Z + ((m0_) + t) * OD_N + 1024 + 256 * h + 8 * ch); } } while (0)
    G3_LOAD(mbase);
    for (int cc = 0; cc < 4; ++cc) {
    const size_t m0 = mbase + 64 * cc; const int item = bh * 64 + 4 * grp + cc;
#pragma unroll
    for (int p = 0; p < 2; ++p) { const int idx = p * 512 + tid, t = idx >> 4, ch = idx & 15;
        *(LAS u32x4*)(lds + GL_A + t * G3_QSTR + 16 * ch) = pq[p]; *(LAS u32x4*)(lds + G3_KT + t * G3_QSTR + 16 * ch) = pk_[p]; }
#pragma unroll
    for (int p = 0; p < 4; ++p) { const int idx = p * 512 + tid, t = idx >> 5, ch = idx & 31; *(LAS u32x4*)(lds + G3_V + t * GL_VSTR + 16 * ch) = pv[p]; }
    __syncthreads();
    if (cc < 3) G3_LOAD(m0 + 64);
    __builtin_amdgcn_sched_barrier(0);
    u32x4 pb[4][2];
#pragma unroll
    for (int tt = 0; tt < 4; ++tt) {
        bf16x8 qf[4];
#pragma unroll
        for (int ks = 0; ks < 4; ++ks) qf[ks] = *(const LAS bf16x8*)(lds + GL_A + (16 * tt + fr) * G3_QSTR + 64 * ks + 16 * g);
        u32x2 pk[4];
#pragma unroll
        for (int jt = 0; jt < 4; ++jt) {
            if (jt <= tt) {
                f32x4 c = (f32x4){0.f, 0.f, 0.f, 0.f};
#pragma unroll
                for (int ks = 0; ks < 4; ++ks) c = __builtin_amdgcn_mfma_f32_16x16x32_bf16(*(const LAS bf16x8*)(lds + G3_KT + (16 * jt + fr) * G3_QSTR + 64 * ks + 16 * g), qf[ks], c, 0, 0, 0);
                if (jt == tt) {
#pragma unroll
                    for (int e = 0; e < 4; ++e) c[e] = (4 * g + e <= fr) ? c[e] : 0.f;
                }
                pk[jt].x = cvt_pk_bf16(c[0], c[1]); pk[jt].y = cvt_pk_bf16(c[2], c[3]);
            } else { pk[jt].x = 0u; pk[jt].y = 0u; }
        }
        pb[tt][0] = (u32x4){pk[0].x, pk[0].y, pk[1].x, pk[1].y}; pb[tt][1] = (u32x4){pk[2].x, pk[2].y, pk[3].x, pk[3].y};
    }
    __builtin_amdgcn_sched_barrier(0);
    f32x4 acc[2][4];
    float ssq[4] = {0.f, 0.f, 0.f, 0.f};
#pragma unroll
    for (int vi = 0; vi < 2; ++vi) {
        const int vt = 2 * w + vi;
        __builtin_amdgcn_sched_barrier(0);
        bf16x8 sf[4];
        {
            const GAS bf16_t* sp = KVT + (size_t)item * 32768 + (size_t)(16 * vt + fr) * 128 + 8 * g;
            const GAS bf16_t* gp = KVT + (size_t)(bh * 64 + 4 * grp) * 32768 + (size_t)(16 * vt + fr) * 128 + 8 * g;
#pragma unroll
            for (int ks = 0; ks < 4; ++ks) {
                const u32x4 sg = *(const GAS u32x4*)(gp + 32 * ks);
                if (cc == 0) sf[ks] = __builtin_bit_cast(bf16x8, sg);
                else {
                    const u32x4 sl_ = *(const GAS u32x4*)(sp + 32 * ks);
                    const f32x4 d0 = *(const GAS f32x4*)(DCC + (size_t)item * 128 + 32 * ks + 8 * g), d1 = *(const GAS f32x4*)(DCC + (size_t)item * 128 + 32 * ks + 8 * g + 4);
                    u32x4 r;
                    r.x = cvt_pk_bf16(bf2f((unsigned short)(sl_.x & 0xffffu)) + d0[0] * bf2f((unsigned short)(sg.x & 0xffffu)), bf2f((unsigned short)(sl_.x >> 16)) + d0[1] * bf2f((unsigned short)(sg.x >> 16)));
                    r.y = cvt_pk_bf16(bf2f((unsigned short)(sl_.y & 0xffffu)) + d0[2] * bf2f((unsigned short)(sg.y & 0xffffu)), bf2f((unsigned short)(sl_.y >> 16)) + d0[3] * bf2f((unsigned short)(sg.y >> 16)));
                    r.z = cvt_pk_bf16(bf2f((unsigned short)(sl_.z & 0xffffu)) + d1[0] * bf2f((unsigned short)(sg.z & 0xffffu)), bf2f((unsigned short)(sl_.z >> 16)) + d1[1] * bf2f((unsigned short)(sg.z >> 16)));
                    r.w = cvt_pk_bf16(bf2f((unsigned short)(sl_.w & 0xffffu)) + d1[2] * bf2f((unsigned short)(sg.w & 0xffffu)), bf2f((unsigned short)(sl_.w >> 16)) + d1[3] * bf2f((unsigned short)(sg.w >> 16)));
                    sf[ks] = __builtin_bit_cast(bf16x8, r);
                }
            }
        }
        const LAS unsigned char* vb = lds + G3_V + (4 * g + qq) * GL_VSTR + 32 * vt + 8 * pp;
        const bf16x8 va = tr_pair(vb, vb + 16 * GL_VSTR), vc = tr_pair(vb + 32 * GL_VSTR, vb + 48 * GL_VSTR);
#pragma unroll
        for (int tt = 0; tt < 4; ++tt) {
            f32x4 c = (f32x4){0.f, 0.f, 0.f, 0.f};
#pragma unroll
            for (int ks = 0; ks < 4; ++ks) c = __builtin_amdgcn_mfma_f32_16x16x32_bf16(sf[ks], *(const LAS bf16x8*)(lds + GL_A + (16 * tt + fr) * G3_QSTR + 64 * ks + 16 * g), c, 0, 0, 0);
            c = __builtin_amdgcn_mfma_f32_16x16x32_bf16(va, __builtin_bit_cast(bf16x8, pb[tt][0]), c, 0, 0, 0);
            if (tt >= 2) c = __builtin_amdgcn_mfma_f32_16x16x32_bf16(vc, __builtin_bit_cast(bf16x8, pb[tt][1]), c, 0, 0, 0);
            acc[vi][tt] = c; ssq[tt] += dot4(c);
        }
    }
    LAS float* sl = (LAS float*)(lds + G3_SSQ);
#pragma unroll
    for (int tt = 0; tt < 4; ++tt) { float v = ssq[tt]; v += __shfl_xor(v, 16); v += __shfl_xor(v, 32); if (g == 0) sl[w * 64 + 16 * tt + fr] = v; }
    __syncthreads();
#pragma unroll
    for (int tt = 0; tt < 4; ++tt) {
        float tsum = 0.f;
#pragma unroll
        for (int q = 0; q < 8; ++q) tsum += sl[q * 64 + 16 * tt + fr];
        const float rstd = rsqrtf(tsum * (1.0f / 256.0f) + EPS);
#pragma unroll
        for (int vi = 0; vi < 2; ++vi) {
            const int vc0 = 32 * w + 16 * vi + 4 * g;
            const f32x4 hg = *(const GAS f32x4*)(head_g + vc0);
            GAS bf16_t* row = Z + (m0 + 16 * tt + fr) * OD_N + 256 * h + vc0;
            const u32x2 sr = *(const GAS u32x2*)(row + 2048);
            const f32x4 c = acc[vi][tt];
            u32x2 o; o.x = cvt_pk_bf16(c[0] * rstd * hg[0] * bf2f((unsigned short)(sr.x & 0xffffu)), c[1] * rstd * hg[1] * bf2f((unsigned short)(sr.x >> 16)));
            o.y = cvt_pk_bf16(c[2] * rstd * hg[2] * bf2f((unsigned short)(sr.y & 0xffffu)), c[3] * rstd * hg[3] * bf2f((unsigned short)(sr.y >> 16)));
            *(GAS u32x2*)(row + 1024) = o;
        }
    }
    __syncthreads();
    }
#undef G3_LOAD
}
__device__ __forceinline__ void ga_group(LAS unsigned char* lds, const GAS bf16_t* XB, const GAS float* RSQ, const GAS bf16_t* WGA, GAS float* GA, const int grp, const int tid) {
    const int lane = tid & 63, w = __builtin_amdgcn_readfirstlane(tid >> 6), fr = lane & 15, g = lane >> 4, tt = w & 3, kh = w >> 2;
    const GAS bf16_t* ap = XB + (size_t)(64 * grp + 16 * tt + fr) * D + 512 * kh + 8 * g; const GAS bf16_t* bp = WGA + (size_t)fr * D + 512 * kh + 8 * g;
    f32x4 c = (f32x4){0.f, 0.f, 0.f, 0.f};
#pragma unroll 4
    for (int ks = 0; ks < 16; ++ks) c = __builtin_amdgcn_mfma_f32_16x16x32_bf16(*(const GAS bf16x8*)(ap + 32 * ks), *(const GAS bf16x8*)(bp + 32 * ks), c, 0, 0, 0);
    LAS float* pl = (LAS float*)lds;
#pragma unroll
    for (int e = 0; e < 4; ++e) pl[(kh * 64 + 16 * tt + 4 * g + e) * 16 + fr] = c[e];
    __syncthreads();
    for (int i = tid; i < 64 * 16; i += NWAVES * 64) {
        const int t = i >> 4; const size_t row = (size_t)64 * grp + t;
        float s = 0.f;
#pragma unroll
        for (int q = 0; q < 4; ++q) s += sum4(*(const GAS f32x4*)(RSQ + row * 16 + 4 * q));
        GA[row * 16 + (i & 15)] = (pl[i] + pl[1024 + i]) * rsqrtf(s * (1.0f / 1024.0f) + EPS);
    }
    __syncthreads();
}

constexpr int RING_BYTES = 131072, LDSCTL_OFF = RING_BYTES, MISC_OFF = LDSCTL_OFF + 320, LDSX_OFF = RING_BYTES + 1024, RSTD_OFF = RING_BYTES + 5120, PAR_OFF = RING_BYTES + 13312, LDS_BYTES = 163840;
constexpr int NPHASE = 1 + 8 * DEPTH;
struct Args { const float* in[21]; float* out; unsigned char* ws; int ph_lo, ph_hi, li, pad; };

#define GIN(i) ((const GAS float*)inp[i])
__global__ void __launch_bounds__(NWAVES * 64, 2) mega(Args args) {
    extern __shared__ __attribute__((aligned(16))) unsigned char lds_raw[];
    LAS unsigned char* lds = (LAS unsigned char*)lds_raw;
    volatile LAS unsigned* MISC = (volatile LAS unsigned*)(lds + MISC_OFF);
    const int Gk = gridDim.x;
    unsigned* ctl = (unsigned*)(args.ws + WS_CTL);
    for (int u = threadIdx.x; u < (LDS_BYTES - LDSCTL_OFF) / 4; u += NWAVES * 64) ((LAS unsigned*)(lds + LDSCTL_OFF))[u] = 0u;
    __syncthreads();
    XcdBarrier bar = xcd_barrier_post(ctl + CW_BAR + args.li * XCD_BAR_WORDS, MISC + 8);

    typedef const float* cfp_t;
    const __attribute__((address_space(4))) cfp_t* inp0 = (const __attribute__((address_space(4))) cfp_t*)__builtin_amdgcn_kernarg_segment_ptr();

    bool first = true;
    for (int ph = args.ph_lo; ph < args.ph_hi; ++ph) {
        if (ph > 0) { const int L_ = (ph - 1) >> 3, sub_ = (ph - 1) & 7; if (sub_ == 6 || ((L_ & 1) == 0 && sub_ == 3)) continue; }
        if (!first) xcd_barrier(bar);
        first = false;
        const __attribute__((address_space(4))) cfp_t* inp = inp0; asm volatile("" : "+s"(inp));
        unsigned char* ws = args.ws; asm volatile("" : "+s"(ws));
        int G = Gk; asm volatile("" : "+s"(G));
        int bid = blockIdx.x; asm volatile("" : "+s"(bid));
        int tid = threadIdx.x; asm volatile("" : "+v"(tid));
        const int lane = tid & 63, wave = __builtin_amdgcn_readfirstlane(tid >> 6);
        const int gw = bid * NWAVES + wave, NGW = G * NWAVES;
        LAS float* scr = (LAS float*)(lds + wave * 16384);
        GAS float* X = (GAS float*)args.out; asm volatile("" : "+s"(X));
        GAS bf16_t* XB = (GAS bf16_t*)(ws + WS_XB); GAS bf16_t* Z = (GAS bf16_t*)(ws + WS_Z);
        GAS float* RSQ = (GAS float*)(ws + WS_RSQ); GAS float* LNP = (GAS float*)(ws + WS_LNP);
        GAS float* HALO = (GAS float*)(ws + WS_HALO); GAS float* FIXP = (GAS float*)(ws + WS_FIXP); GAS float* FIXU = (GAS float*)(ws + WS_FIXU);
        GAS bf16_t* WGU = (GAS bf16_t*)(ws + WS_WFFN); GAS bf16_t* WDN = (GAS bf16_t*)(ws + WS_WFFN + OFF_WDOWN);
        if (ph == 0) {
            constexpr int I_EVIN = 8 * (EV_N / 128), I_SQ = 8 * 8, I_ODIN = 8 * (OD_N / 128);
            constexpr int PER = I_EVIN + I_SQ + I_ODIN + I_SQ;
            for (int it = bid; it < 2 * PER; it += G) {
                const int e = it / PER; int r = it % PER;
                if (r < I_EVIN) { conv_block_item(lds, GIN(3) + (size_t)e * D * EV_N, nullptr, EV_N, D, EV_N, GIN(1) + (size_t)(2 * e) * D, (GAS bf16_t*)(ws + WS_WMIX + OFF_EVIN) + (size_t)e * EV_N * D, 1, r, tid); continue; } r -= I_EVIN;
                if (r < I_SQ) { conv_block_item(lds, GIN(10) + (size_t)e * D * D, nullptr, D, D, D, nullptr, (GAS bf16_t*)(ws + WS_WMIX + OFF_EVOUT) + (size_t)e * D * D, 0, r, tid); continue; } r -= I_SQ;
                if (r < I_ODIN) { conv_block_item(lds, GIN(11) + (size_t)e * D * OD_NSRC, nullptr, OD_NSRC, D, OD_N, GIN(1) + (size_t)(2 * e + 1) * D, (GAS bf16_t*)(ws + WS_WMIX + OFF_ODIN) + (size_t)e * OD_N * D, 0, r, tid); continue; } r -= I_ODIN;
                conv_block_item(lds, GIN(15) + (size_t)e * D * D, nullptr, D, D, D, nullptr, (GAS bf16_t*)(ws + WS_WMIX + OFF_ODOUT) + (size_t)e * D * D, 0, r, tid);
            }
            for (int i = bid * (NWAVES * 64) + tid; i < 2 * 8 * 128 * 128; i += G * NWAVES * 64) {
                const int tt = (i >> 7) & 127, ss = i & 127;
                ((GAS bf16_t*)(ws + WS_SMALLW))[i] = (bf16_t)((ss <= tt) ? f2bf(GIN(6)[i]) : 0u);
            }
            for (int i = bid * (NWAVES * 64) + tid; i < 2 * 16 * 1024; i += G * NWAVES * 64) {
                const int o = i >> 14, j = (i >> 10) & 15, k = i & 1023;
                ((GAS bf16_t*)(ws + WS_SMALLW + 512 * 1024))[i] = (bf16_t)f2bf(GIN(11)[((size_t)o * D + k) * OD_NSRC + 3072 + j] * GIN(1)[(size_t)(2 * o + 1) * D + k]);
            }
            for (int m = gw; m < M; m += NGW) {
                const f32x4* xr = (const f32x4*)(GIN(0) + (size_t)m * D) + lane; f32x4 v[4]; float s = 0.f;
#pragma unroll
                for (int j = 0; j < 4; ++j) { v[j] = xr[64 * j]; s += dot4(v[j]); }
#pragma unroll
                for (int o = 1; o < 64; o <<= 1) s += __shfl_xor(s, o);
                u32x2* o8 = (u32x2*)(XB + (size_t)m * D) + lane;
#pragma unroll
                for (int j = 0; j < 4; ++j) { u32x2 w; w.x = pk2(v[j][0], v[j][1]); w.y = pk2(v[j][2], v[j][3]); o8[64 * j] = w; }
                if (lane < 16) RSQ[(size_t)m * 16 + lane] = (lane == 0) ? s : 0.f;
            }
        } else {
            const int L = (ph - 1) >> 3, sub = (ph - 1) & 7, e = L >> 1; const bool even = (L & 1) == 0;
            if (sub == 0) {
                pg8::StaticOrder S;
                if (even) {
                    pg8::Gemm g{(const bf16_t*)XB, (const bf16_t*)(ws + WS_WMIX + OFF_EVIN) + (size_t)e * EV_N * D, M, EV_N, D, D}; S.init(M, EV_N, G, bid);
                    stage_rstd(lds, RSQ, tid, 0);
                    if (tid < 128) ((LAS float*)(lds + PAR_OFF))[tid] = (tid < 64) ? GIN(8)[e * 64 + tid] * 0.125f : GIN(9)[e * 64 + tid - 64];
                    __syncthreads();
                    EpiEvenIn E{Z, (const LAS float*)(lds + RSTD_OFF), LNP, (const LAS float*)(lds + PAR_OFF)};
                    pg8::gemm_phase<EpiEvenIn>(lds, g, S, E, tid);
                    {
                        Unit tu; int nun = 0; while (S.next(nun, tu)) ++nun;
                        int nshort = 0, myrank = -1;
                        const int umax = (640 + G - 1) / G, full = 640 - (umax - 1) * G;
                        if (umax * G != 640) { nshort = G - full; myrank = (nun < umax) ? (bid - full) : -1; }
                        if (nshort == 0) { nshort = G; myrank = bid; }
                        if (myrank >= 0) {
                            constexpr int I_GU = 8 * (GU_N / 128), I_DN = (FF / 128) * 8;
                            const GAS float* wg = GIN(16) + (size_t)L * D * FF; const GAS float* wu = GIN(17) + (size_t)L * D * FF; const GAS float* wd = GIN(20) + (size_t)L * FF * D;
                            for (int it = myrank; it < I_GU + I_DN; it += nshort) {
                                if (it < I_GU) conv_block_item(lds, wg, wu, FF, D, GU_N, GIN(2) + (size_t)L * D, WGU, 2, it, tid);
                                else conv_block_item(lds, wd, nullptr, D, FF, D, nullptr, WDN, 0, it - I_GU, tid);
                            }
                        }
                    }
                } else {
                    pg8::Gemm g{(const bf16_t*)XB, (const bf16_t*)(ws + WS_WMIX + OFF_ODIN) + (size_t)e * OD_N * D, M, OD_N, D, D}; S.init(M, OD_N, G, bid);
                    stage_rstd(lds, RSQ, tid, 0);
                    __syncthreads();
                    EpiOddIn E{Z, (const LAS float*)(lds + RSTD_OFF)};
                    pg8::gemm_phase<EpiOddIn>(lds, g, S, E, tid);
                    for (int grp = bid; grp < M / 64; grp += G) ga_group(lds, XB, RSQ, (const GAS bf16_t*)(ws + WS_SMALLW + 512 * 1024) + (size_t)e * 16 * D, (GAS float*)(ws + WS_GA), grp, tid);
                }
            } else if (sub == 1) {
                if (even) {
                    GAS bf16_t* P1 = (GAS bf16_t*)(ws + WS_AUX); GAS bf16_t* P2 = (GAS bf16_t*)(ws + WS_AUX + 16 * MiB); GAS float* L1 = (GAS float*)(ws + WS_AUX + 32 * MiB); GAS float* L2 = L1 + (size_t)M * 8;
                    const int cnt = (1024 - bid + G - 1) / G;
                    attn_run<false>(lds, Z, 0, bid, cnt, G, P1, L1, nullptr, nullptr, nullptr, nullptr, tid);
                    attn_run<false>(lds, Z, 2, bid, cnt, G, P2, L2, nullptr, nullptr, nullptr, nullptr, tid);
                    for (int it = bid; it < 1024; it += G) gmlp_item(lds, Z, LNP, GIN(4) + e * 512, GIN(5) + e * 512, (const GAS bf16_t*)(ws + WS_SMALLW) + (size_t)e * 8 * 128 * 128, GIN(7) + e * 8 * 128, it, tid);
                } else {
                    for (int it = bid; it < 256; it += G) gla_g1_group(lds, Z, (const GAS float*)(ws + WS_GA), GIN(12) + (size_t)e * 16 * 512, GIN(13) + e * 512, (GAS bf16_t*)(ws + WS_AUX), LNP, LNP + 131072, XB, it, tid);
                }
            } else if (sub == 2 && even) {
                const GAS bf16_t* P1 = (const GAS bf16_t*)(ws + WS_AUX); const GAS bf16_t* P2 = (const GAS bf16_t*)(ws + WS_AUX + 16 * MiB); const GAS float* L1 = (const GAS float*)(ws + WS_AUX + 32 * MiB); const GAS float* L2 = L1 + (size_t)M * 8;
                attn_run<true>(lds, Z, 4, bid, (1024 - bid + G - 1) / G, G, nullptr, nullptr, P1, P2, L1, L2, tid);
            } else if (sub == 2) {
                gla_scan((GAS bf16_t*)(ws + WS_AUX), LNP + 131072, tid, G);
            } else if (sub == 3) {
                for (int it = bid; it < 256; it += G) gla_g3_group(lds, Z, XB, (const GAS bf16_t*)(ws + WS_AUX), LNP, GIN(14) + e * 256, it, tid);
            } else if (sub == 4 || sub == 7) {
                if (sub == 4 && !even) {
                    constexpr int I_GU = 8 * (GU_N / 128), I_DN = (FF / 128) * 8;
                    const GAS float* wg = GIN(16) + (size_t)L * D * FF; const GAS float* wu = GIN(17) + (size_t)L * D * FF; const GAS float* wd = GIN(20) + (size_t)L * FF * D;
                    for (int it = bid; it < I_GU + I_DN; it += G) {
                        if (it < I_GU) conv_block_item(lds, wg, wu, FF, D, GU_N, GIN(2) + (size_t)L * D, WGU, 2, it, tid);
                        else conv_block_item(lds, wd, nullptr, D, FF, D, nullptr, WDN, 0, it - I_GU, tid);
                    }
                    __syncthreads();
                }
                pg8::StaticOrder S; S.init(M, D, G, bid);
                if (sub == 7) {
                    const GAS float* cw = GIN(18) + (size_t)L * 3 * FF; Unit fu;
                    for (int i = 0; S.next(i, fu); ++i) {
                        const int pm = fu.pm; if ((pm & 15) == 0) continue;
                        for (int idx = tid; idx < 2 * FF; idx += NWAVES * 64) {
                            const int j = idx / FF, c = idx % FF;
                            const float h1 = HALO[((size_t)(pm - 1) * 2 + 1) * FF + c], h0 = HALO[((size_t)(pm - 1) * 2 + 0) * FF + c];
                            float pre = FIXP[((size_t)pm * 2 + j) * FF + c];
                            if (j == 0) pre += cw[FF + c] * h1 + cw[c] * h0; else pre += cw[c] * h1;
                            Z[(size_t)(pm * 256 + j) * FF + c] = (bf16_t)f2bf(silu_f(pre) * FIXU[((size_t)pm * 2 + j) * FF + c]);
                        }
                    }
                    asm volatile("s_waitcnt vmcnt(0)" ::: "memory"); __syncthreads();
                }
                pg8::Gemm g;
                if (sub == 7) g = pg8::Gemm{(const bf16_t*)Z, (const bf16_t*)WDN, M, D, FF, FF};
                else if (even) g = pg8::Gemm{(const bf16_t*)Z, (const bf16_t*)(ws + WS_WMIX + OFF_EVOUT) + (size_t)e * D * D, M, D, D, EV_N};
                else g = pg8::Gemm{(const bf16_t*)(Z + 1024), (const bf16_t*)(ws + WS_WMIX + OFF_ODOUT) + (size_t)e * D * D, M, D, D, OD_N};
                const GAS float* xin = (L == 0 && sub == 4) ? GIN(0) : (const GAS float*)X;
                EpiRes E{xin, X, XB, RSQ};
                pg8::gemm_phase<EpiRes>(lds, g, S, E, tid);
            } else if (sub == 5) {
                pg8::StaticOrder S; S.init(M, GU_N, G, bid);
                pg8::Gemm g{(const bf16_t*)XB, (const bf16_t*)WGU, M, GU_N, D, D};
                stage_rstd(lds, RSQ, tid, 0);
                {
                    const GAS float* cw = GIN(18) + (size_t)L * 3 * FF; const GAS float* cb = GIN(19) + (size_t)L * FF; Unit pu;
                    for (int i = 0; S.next(i, pu); ++i) { const int arr = tid >> 7, j = tid & 127; ((LAS float*)(lds + PAR_OFF))[i * 512 + tid] = (arr < 3) ? cw[arr * FF + 128 * pu.pn + j] : cb[128 * pu.pn + j]; }
                }
                __syncthreads();
                EpiF1 E{Z, (const LAS float*)(lds + RSTD_OFF), (const LAS float*)(lds + PAR_OFF), HALO, FIXP, FIXU, (LAS float*)(lds + LDSX_OFF)};
                pg8::gemm_phase<EpiF1>(lds, g, S, E, tid);
            }
        }
    }
}

extern "C" void kernel_launch(void* const* d_in, const int* in_sizes, int n_in, void* d_out, int out_size, void* d_ws, size_t ws_size, hipStream_t stream) {
    static int grid = 0;
    if (grid == 0) {
        if (n_in != 21 || out_size != M * D || ws_size < WS_END) { fprintf(stderr, "kernel_launch: unexpected shapes (n_in %d out %d ws %zu)\n", n_in, out_size, ws_size); grid = -1; return; }
        int dev = 0, cus = 0, per_cu = 0;
        hipGetDevice(&dev); hipDeviceGetAttribute(&cus, hipDeviceAttributeMultiprocessorCount, dev);
        hipFuncSetAttribute((const void*)mega, hipFuncAttributeMaxDynamicSharedMemorySize, LDS_BYTES);
        hipOccupancyMaxActiveBlocksPerMultiprocessor(&per_cu, (const void*)mega, NWAVES * 64, LDS_BYTES);
        (void)hipGetLastError();
        if (per_cu < 1) per_cu = 1;
        if (per_cu > 1) per_cu = 1;
        grid = cus * per_cu;
        fprintf(stderr, "kernel_launch: grid %d (cus %d), ws %zu\n", grid, cus, ws_size);
    }
    if (grid < 0) return;
    hipMemsetAsync((char*)d_ws + WS_CTL, 0, CTL_ZERO_BYTES, stream);
    Args a{};
    for (int i = 0; i < 21; ++i) a.in[i] = (const float*)d_in[i];
    a.out = (float*)d_out; a.ws = (unsigned char*)d_ws;
    a.ph_lo = 0; a.ph_hi = NPHASE; a.li = 0;
    void* kargs[] = {&a};
    hipError_t le = hipLaunchCooperativeKernel((const void*)mega, dim3(grid), dim3(NWAVES * 64), kargs, LDS_BYTES, stream);
    if (le != hipSuccess) fprintf(stderr, "cooperative launch failed: %s\n", hipGetErrorString(le));
}
```

```cpp
#include <hip/hip_runtime.h>
#include <cstdio>
#include <cstdint>

#define LAS __attribute__((address_space(3)))
#define GAS __attribute__((address_space(1)))
typedef unsigned short bf16_t;
typedef short bf16x8 __attribute__((ext_vector_type(8)));
typedef float f32x4 __attribute__((ext_vector_type(4)));
typedef float f32x2 __attribute__((ext_vector_type(2)));
typedef unsigned u32x4 __attribute__((ext_vector_type(4)));
typedef unsigned u32x2 __attribute__((ext_vector_type(2)));

constexpr int D = 1024, BATCH = 4, SEQ = 4096, M = BATCH * SEQ, DEPTH = 4;
constexpr int EV_N = 2560, OD_N = 3072, OD_NSRC = 3088, FF = 2816, GU_N = 2 * FF;
constexpr int ZLD = 3072;
constexpr float EPS = 1e-6f;

constexpr size_t MiB = 1u << 20;
constexpr size_t WS_CTL = 0, CTL_ZERO_BYTES = 1 * MiB;
constexpr size_t WS_RSQ = 1 * MiB;
constexpr size_t WS_LNP = 2 * MiB;
constexpr size_t WS_GA = 3 * MiB;
constexpr size_t WS_HALO = 4 * MiB;
constexpr size_t WS_FIXP = 6 * MiB;
constexpr size_t WS_FIXU = 8 * MiB;
constexpr size_t WS_SMALLW = 10 * MiB;
constexpr size_t WS_WMIX = 12 * MiB;
constexpr size_t OFF_EVIN = 0, OFF_EVOUT = 10 * MiB, OFF_ODIN = 14 * MiB, OFF_ODOUT = 26 * MiB;
constexpr size_t WS_WFFN = 42 * MiB;
constexpr size_t OFF_WDOWN = 11 * MiB;
constexpr size_t WS_XB = 60 * MiB;
constexpr size_t WS_Z = 92 * MiB;
constexpr size_t WS_AUX = 188 * MiB;
constexpr size_t WS_END = 252 * MiB;
constexpr int CW_BAR = 4096, CW_CENSUS = 2048, CW_HCNT = 16384, CW_DONE = 40960;

constexpr int NWAVES = 8;
#define probe_lds ((LAS unsigned char*)(163840 - 512 + 64))
constexpr int RSTD_OFF_ = 131072 + 5120, PAR_OFF_ = 131072 + 13312;
#ifndef PROBE_ID
#define PROBE_ID -1
#endif
#ifndef PROBE_K
#define PROBE_K 8
#endif
#define PROBE_T0(id) do { if ((id) == PROBE_ID && blockIdx.x == 0 && threadIdx.x == 0) { *(volatile LAS unsigned long long*)(probe_lds + 8) = __builtin_amdgcn_s_memrealtime(); } } while (0)
#define PROBE_T1(id) do { if ((id) == PROBE_ID && blockIdx.x == 0 && threadIdx.x == 0) { *(volatile LAS unsigned long long*)(probe_lds) += __builtin_amdgcn_s_memrealtime() - *(volatile LAS unsigned long long*)(probe_lds + 8); } } while (0)
__device__ __forceinline__ unsigned f2bf(float f) { unsigned u = __builtin_bit_cast(unsigned, f); return (u + 0x7fffu + ((u >> 16) & 1u)) >> 16; }
__device__ __forceinline__ unsigned pk2(float lo, float hi) { return f2bf(lo) | (f2bf(hi) << 16); }
__device__ __forceinline__ float bf2f(unsigned short h) { return __builtin_bit_cast(float, (unsigned)h << 16); }
typedef __bf16 bf2_t __attribute__((ext_vector_type(2)));
__device__ __forceinline__ unsigned cvt_pk_bf16(float lo, float hi) { const bf2_t r = __builtin_convertvector((f32x2){lo, hi}, bf2_t); return __builtin_bit_cast(unsigned, r); }
__device__ __forceinline__ float silu_f(float x) { return x * __builtin_amdgcn_rcpf(1.0f + __expf(-x)); }
__device__ __forceinline__ f32x2 gelu_pk(f32x2 v) {
    const f32x2 z0 = v * 0.70710678118f;
    f32x2 z; z.x = __builtin_amdgcn_fmed3f(z0.x, -3.0f, 3.0f); z.y = __builtin_amdgcn_fmed3f(z0.y, -3.0f, 3.0f);
    const f32x2 sv = (z * z) * 0.22222222222f + (-1.0f);
    f32x2 p = sv * 0.0065809390507638454f + (-0.01773315854370594f);
    p = p * sv + 0.024549897760152817f; p = p * sv + (-0.039930570870637894f); p = p * sv + 0.0718911811709404f; p = p * sv + (-0.11105967313051224f);
    p = p * sv + 0.15764106810092926f; p = p * sv + (-0.22873686254024506f); p = p * sv + 0.4701276421546936f;
    const f32x2 e = p * z, hx = v * 0.5f;
    return e * hx + hx;
}
__device__ __forceinline__ f32x4 gelu4(f32x4 v) { f32x2 a = gelu_pk((f32x2){v[0], v[1]}), b = gelu_pk((f32x2){v[2], v[3]}); return (f32x4){a.x, a.y, b.x, b.y}; }
__device__ __forceinline__ float sum4(f32x4 v) { return (v[0] + v[1]) + (v[2] + v[3]); }
__device__ __forceinline__ float dot4(f32x4 v) { return (v[0] * v[0] + v[1] * v[1]) + (v[2] * v[2] + v[3] * v[3]); }
__device__ __forceinline__ u32x4 pack8(f32x4 a, f32x4 b) { u32x4 w; w.x = cvt_pk_bf16(a[0], a[1]); w.y = cvt_pk_bf16(a[2], a[3]); w.z = cvt_pk_bf16(b[0], b[1]); w.w = cvt_pk_bf16(b[2], b[3]); return w; }

namespace pg8 {
constexpr int BM = 256, BK = 64, HALF = 128, HTB = HALF * BK * 2, STAGE_BYTES = 8 * HTB, NXCD = 8, WGM = 8;
__host__ __device__ __forceinline__ int lds_byte(int r, int c) { const int st = (r >> 4) * 2 + (c >> 5), rr = r & 15, cc = c & 31, ob = rr * 64 + cc * 2; return st * 1024 + (ob ^ (((ob >> 9) & 1) << 5)); }
__host__ __device__ __forceinline__ void stage_rc(int b, int& R, int& C) { const int st = b / 1024, sb = b % 1024, swz = sb ^ (((sb >> 9) & 1) << 5); R = (st >> 1) * 16 + swz / 64; C = (st & 1) * 32 + (swz % 64) / 2; }
__host__ __device__ __forceinline__ int perm32(int rho) { const int n = rho >> 4, i = rho & 15; return 8 * (i >> 2) + 4 * n + (i & 3); }
struct Unit { int pm, pn, ui; };
struct Gemm { const bf16_t* A; const bf16_t* Bt; int M, N, K, lda; };
struct StaticOrder {
    int nM, nN, nwg, G, c;
    __device__ void init(int M_, int N_, int G_, int c_) { nM = M_ / BM; nN = N_ / BM; nwg = nM * nN; G = G_; c = c_; }
    __device__ bool next(int i, Unit& u) const {
        const long L = (long)i * G + c; if (L >= nwg) return false;
        int wgid = (int)L; { const int q = nwg / NXCD, r = nwg % NXCD, xcd = wgid % NXCD, off = wgid / NXCD; wgid = (xcd < r ? xcd * (q + 1) : r * (q + 1) + (xcd - r) * q) + off; }
        const int nig = WGM * nN, gid = wgid / nig, fm = gid * WGM, gsz = (nM - fm) < WGM ? (nM - fm) : WGM;
        u.pm = fm + ((wgid % nig) % gsz); u.pn = (wgid % nig) / gsz; u.ui = i; return true;
    }
};
template <class Epi>
__device__ __forceinline__ void gemm_phase(LAS unsigned char* lds, const Gemm g, const StaticOrder& S, const Epi& E, const int tid) {
    const int wid = __builtin_amdgcn_readfirstlane(tid >> 6), lane = tid & 63, wr = wid >> 2, wc = wid & 3, fr = lane & 15, fq = lane >> 4;
    const int K = g.K, nt = K / BK, lda = g.lda;
    unsigned voffA[2], voffB[2];
#pragma unroll
    for (int i = 0; i < 2; ++i) { int R, C; stage_rc(tid * 16 + i * 8192, R, C); const int Rb = (R & ~31) + perm32(R & 31);
        voffA[i] = (unsigned)(R * lda + C) * 2u; voffB[i] = (unsigned)(Rb * K + C) * 2u; }
    const size_t kstep = (size_t)(BK * 2);
    const size_t hstepA = (size_t)HALF * lda * 2, hstepB = (size_t)HALF * K * 2;
    const size_t tstepA = 2 * hstepA, tstepB = 2 * hstepB;
    const unsigned ldsw = (unsigned)wid * 1024u;
    const int aoff = lds_byte(wr * 64 + fr, fq * 8), boff = lds_byte(wc * 32 + fr, fq * 8);
#define PG8_SA(b, h) (((b) * 2 + (h)) * HTB)
#define PG8_SB(b, h) ((4 + (b) * 2 + (h)) * HTB)
#define PG8_STAGE(bufoff, gbase, voff) do { _Pragma("unroll") for (int _i = 0; _i < 2; ++_i) \
        __builtin_amdgcn_global_load_lds((const unsigned*)((const char*)(gbase) + (voff)[_i]), (LAS unsigned*)(lds + (bufoff) + ldsw + _i * 8192), 16, 0, 0); } while (0)
#define PG8_LDA(dst, b, h) do { _Pragma("unroll") for (int m = 0; m < 4; ++m) _Pragma("unroll") for (int k = 0; k < 2; ++k) dst[m][k] = *(const LAS bf16x8*)(lds + PG8_SA(b, h) + aoff + m * 2048 + k * 1024); } while (0)
#define PG8_LDB(dst, b, h) do { _Pragma("unroll") for (int n = 0; n < 2; ++n) _Pragma("unroll") for (int k = 0; k < 2; ++k) dst[n][k] = *(const LAS bf16x8*)(lds + PG8_SB(b, h) + boff + n * 2048 + k * 1024); } while (0)
#define PG8_MMA(ai, bj, At, Bt) do { __builtin_amdgcn_s_setprio(1); _Pragma("unroll") for (int m = 0; m < 4; ++m) _Pragma("unroll") for (int n = 0; n < 2; ++n) _Pragma("unroll") for (int k = 0; k < 2; ++k) \
        acc[ai][bj][m][n] = __builtin_amdgcn_mfma_f32_16x16x32_bf16(Bt[n][k], At[m][k], acc[ai][bj][m][n], 0, 0, 0); __builtin_amdgcn_s_setprio(0); } while (0)
#define PG8_WAIT_V(n) asm volatile("s_waitcnt vmcnt(" #n ")" ::: "memory")
#define PG8_WAIT_L(n) asm volatile("s_waitcnt lgkmcnt(" #n ")" ::: "memory")
#define PG8_BAR __builtin_amdgcn_s_barrier()
#define PG8_SCHED __builtin_amdgcn_sched_barrier(0)
    Unit cur, nxt; int ui = 0;
    if (!S.next(0, cur)) return;
    f32x4 acc[2][2][4][2];
    E.init(acc, cur, wr, wc, fr, fq);
    bf16x8 At[4][2], B0[2][2], B1[2][2];
    const char* cA = (const char*)g.A + (size_t)cur.pm * tstepA; const char* cB = (const char*)g.Bt + (size_t)cur.pn * tstepB;
    PG8_STAGE(PG8_SB(0, 0), cB, voffB); PG8_STAGE(PG8_SB(0, 1), cB + hstepB, voffB); PG8_STAGE(PG8_SA(0, 0), cA, voffA); PG8_STAGE(PG8_SA(0, 1), cA + hstepA, voffA);
    if (wr == 1) PG8_BAR;
    PG8_WAIT_V(2); PG8_BAR;
    PG8_STAGE(PG8_SB(1, 0), cB + kstep, voffB); PG8_STAGE(PG8_SA(1, 0), cA + kstep, voffA); PG8_STAGE(PG8_SB(1, 1), cB + hstepB + kstep, voffB);
    PG8_WAIT_V(6); PG8_BAR;
    for (;;) {
        const bool has_next = S.next(ui + 1, nxt);
        const char* nA = has_next ? (const char*)g.A + (size_t)nxt.pm * tstepA : cA; const char* nB = has_next ? (const char*)g.Bt + (size_t)nxt.pn * tstepB : cB;
        for (int t = 0; t < nt; t += 2) {
            const bool last = (t == nt - 2);
            const char* a1 = cA + (size_t)(t + 1) * kstep;
            const char* a2 = last ? nA : cA + (size_t)(t + 2) * kstep; const char* b2 = last ? nB : cB + (size_t)(t + 2) * kstep;
            const char* a3 = a2 + kstep; const char* b3 = b2 + kstep;
            PG8_LDB(B0, 0, 0); PG8_LDB(B1, 0, 1); PG8_SCHED; PG8_LDA(At, 0, 0); PG8_STAGE(PG8_SA(1, 1), a1 + hstepA, voffA);
            PG8_WAIT_V(8); PG8_WAIT_L(0); PG8_BAR; PG8_MMA(0, 0, At, B0); PG8_MMA(0, 1, At, B1); PG8_BAR; PG8_SCHED;
            PG8_LDA(At, 0, 1); PG8_STAGE(PG8_SB(0, 0), b2, voffB); PG8_STAGE(PG8_SB(0, 1), b2 + hstepB, voffB); PG8_STAGE(PG8_SA(0, 0), a2, voffA);
            PG8_WAIT_V(8); PG8_WAIT_L(0); PG8_BAR; PG8_MMA(1, 0, At, B0); PG8_MMA(1, 1, At, B1); PG8_BAR; PG8_SCHED;
            PG8_LDB(B0, 1, 0); PG8_LDB(B1, 1, 1); PG8_SCHED; PG8_LDA(At, 1, 0); PG8_STAGE(PG8_SA(0, 1), a2 + hstepA, voffA);
            PG8_WAIT_V(8); PG8_WAIT_L(0); PG8_BAR; PG8_MMA(0, 0, At, B0); PG8_MMA(0, 1, At, B1); PG8_BAR; PG8_SCHED;
            PG8_LDA(At, 1, 1); PG8_STAGE(PG8_SB(1, 0), b3, voffB); PG8_STAGE(PG8_SB(1, 1), b3 + hstepB, voffB); PG8_STAGE(PG8_SA(1, 0), a3, voffA);
            PG8_WAIT_V(8); PG8_WAIT_L(0); PG8_BAR; PG8_MMA(1, 0, At, B0); PG8_MMA(1, 1, At, B1); PG8_BAR; PG8_SCHED;
        }
        if (wr == 0) PG8_BAR;
        E(acc, cur, wr, wc, fr, fq);
        if (!has_next) break;
        E.init(acc, nxt, wr, wc, fr, fq);
        cur = nxt; cA = nA; cB = nB; ++ui;
        if (wr == 1) PG8_BAR;
    }
    PG8_WAIT_V(0);
    PG8_BAR;
#undef PG8_SA
#undef PG8_SB
#undef PG8_STAGE
#undef PG8_LDA
#undef PG8_LDB
#undef PG8_MMA
#undef PG8_WAIT_V
#undef PG8_WAIT_L
#undef PG8_BAR
#undef PG8_SCHED
}
}
using pg8::Unit;

__device__ __forceinline__ void row_rstd(const LAS float* rstd, int lrow, float (&rs)[2][4]) {
#pragma unroll
    for (int ai = 0; ai < 2; ++ai)
#pragma unroll
        for (int m = 0; m < 4; ++m) rs[ai][m] = rstd[lrow + ai * 128 + m * 16];
}
__device__ __forceinline__ void stage_rstd(LAS unsigned char* lds, const GAS float* rsq, const int tid, const int vbx) {
    LAS float* out = (LAS float*)(lds + RSTD_OFF_);
    const size_t r0 = (size_t)2048 * (vbx & 7);
    f32x4 p[4][4];
#pragma unroll
    for (int j = 0; j < 4; ++j)
#pragma unroll
        for (int q = 0; q < 4; ++q) p[j][q] = *(const GAS f32x4*)(rsq + (r0 + tid + 512 * j) * 16 + 4 * q);
#pragma unroll
    for (int j = 0; j < 4; ++j) out[tid + 512 * j] = rsqrtf(((sum4(p[j][0]) + sum4(p[j][1])) + (sum4(p[j][2]) + sum4(p[j][3]))) * (1.0f / 1024.0f) + EPS);
}

struct EpiEvenIn {
    __device__ __forceinline__ void init(f32x4 (&acc)[2][2][4][2], const Unit&, int, int, int, int) const {
#pragma unroll
        for (int a = 0; a < 2; ++a)
#pragma unroll
            for (int b = 0; b < 2; ++b)
#pragma unroll
                for (int m = 0; m < 4; ++m)
#pragma unroll
                    for (int n = 0; n < 2; ++n) acc[a][b][m][n] = (f32x4){0.f, 0.f, 0.f, 0.f};
    }
    GAS bf16_t* Z; const LAS float* rstd; GAS float* lnp; const LAS float* qkg;
    __device__ __forceinline__ void operator()(const f32x4 (&acc)[2][2][4][2], const Unit& u, int wr, int wc, int fr, int fq) const {
        asm volatile("" : "+v"(fr), "+v"(fq));
        const int rowb = u.pm * 256 + wr * 64 + fr, kind = u.pn >> 1;
        float rs[2][4]; row_rstd(rstd, (u.pm & 7) * 256 + wr * 64 + fr, rs);
        if (kind == 1 || kind == 3) {
            const LAS float* g = qkg + ((kind == 1) ? 0 : 64);
            f32x4 gv[2][2];
#pragma unroll
            for (int bj = 0; bj < 2; ++bj)
#pragma unroll
                for (int n = 0; n < 2; ++n) gv[bj][n] = *(const LAS f32x4*)(g + 32 * bj + 8 * fq + 4 * n);
#pragma unroll
            for (int ai = 0; ai < 2; ++ai)
#pragma unroll
                for (int m = 0; m < 4; ++m) {
                    float ss = 0.f;
#pragma unroll
                    for (int bj = 0; bj < 2; ++bj)
#pragma unroll
                        for (int n = 0; n < 2; ++n) ss += dot4(acc[ai][bj][m][n]);
                    ss += __shfl_xor(ss, 16); ss += __shfl_xor(ss, 32);
                    const float r = rs[ai][m], rh = rsqrtf(ss * r * r * (1.0f / 64.0f) + EPS) * r;
                    GAS bf16_t* rowp = Z + (size_t)(rowb + ai * 128 + m * 16) * ZLD + u.pn * 256 + 64 * wc + 8 * fq;
#pragma unroll
                    for (int bj = 0; bj < 2; ++bj) *(GAS u32x4*)(rowp + 32 * bj) = pack8(acc[ai][bj][m][0] * rh * gv[bj][0], acc[ai][bj][m][1] * rh * gv[bj][1]);
                }
        } else {
#pragma unroll
            for (int ai = 0; ai < 2; ++ai)
#pragma unroll
                for (int m = 0; m < 4; ++m) {
                    const float r = rs[ai][m]; const int row = rowb + ai * 128 + m * 16;
                    GAS bf16_t* rowp = Z + (size_t)row * ZLD + u.pn * 256 + 32 * wc + 8 * fq;
                    float s1 = 0.f, s2 = 0.f;
#pragma unroll
                    for (int bj = 0; bj < 2; ++bj) {
                        f32x4 v0 = acc[ai][bj][m][0] * r, v1 = acc[ai][bj][m][1] * r;
                        if (kind != 4) { v0 = gelu4(v0); v1 = gelu4(v1); }
                        if (kind == 2) { s1 += sum4(v0) + sum4(v1); s2 += dot4(v0) + dot4(v1); }
                        *(GAS u32x4*)(rowp + 128 * bj) = pack8(v0, v1);
                    }
                    if (kind == 2) {
                        s1 += __shfl_xor(s1, 16); s1 += __shfl_xor(s1, 32); s2 += __shfl_xor(s2, 16); s2 += __shfl_xor(s2, 32);
                        if (fq == 0) *(GAS f32x2*)(lnp + ((size_t)row * 8 + (u.pn & 1) * 4 + wc) * 2) = (f32x2){s1, s2};
                    }
                }
        }
    }
};

struct EpiOddIn {
    __device__ __forceinline__ void init(f32x4 (&acc)[2][2][4][2], const Unit&, int, int, int, int) const {
#pragma unroll
        for (int a = 0; a < 2; ++a)
#pragma unroll
            for (int b = 0; b < 2; ++b)
#pragma unroll
                for (int m = 0; m < 4; ++m)
#pragma unroll
                    for (int n = 0; n < 2; ++n) acc[a][b][m][n] = (f32x4){0.f, 0.f, 0.f, 0.f};
    }
    GAS bf16_t* Z; const LAS float* rstd;
    __device__ __forceinline__ void operator()(const f32x4 (&acc)[2][2][4][2], const Unit& u, int wr, int wc, int fr, int fq) const {
        asm volatile("" : "+v"(fr), "+v"(fq));
        const int rowb = u.pm * 256 + wr * 64 + fr;
        float rs[2][4]; row_rstd(rstd, (u.pm & 7) * 256 + wr * 64 + fr, rs);
        const float sc = (u.pn < 2) ? 0.08838834764831845f : 1.0f; const bool act = (u.pn >= 8);
#pragma unroll
        for (int ai = 0; ai < 2; ++ai)
#pragma unroll
            for (int m = 0; m < 4; ++m) {
                const float r = rs[ai][m] * sc;
                GAS bf16_t* rowp = Z + (size_t)(rowb + ai * 128 + m * 16) * OD_N + u.pn * 256 + 32 * wc + 8 * fq;
#pragma unroll
                for (int bj = 0; bj < 2; ++bj) {
                    f32x4 v0 = acc[ai][bj][m][0] * r, v1 = acc[ai][bj][m][1] * r;
                    if (act) {
#pragma unroll
                        for (int e = 0; e < 4; ++e) { v0[e] = silu_f(v0[e]); v1[e] = silu_f(v1[e]); }
                    }
                    *(GAS u32x4*)(rowp + 128 * bj) = pack8(v0, v1);
                }
            }
    }
};

struct EpiRes {
    const GAS float* xin_f32; const GAS bf16_t* xin_bf; GAS float* xout_f32; GAS bf16_t* xb; GAS float* rsq;
    __device__ __forceinline__ void init(f32x4 (&acc)[2][2][4][2], const Unit& u, int wr, int wc, int fr, int fq) const {
        const int rowb = u.pm * 256 + wr * 64 + fr;
#pragma unroll
        for (int ai = 0; ai < 2; ++ai)
#pragma unroll
            for (int m = 0; m < 4; ++m) {
                const size_t off = (size_t)(rowb + ai * 128 + m * 16) * D + u.pn * 256 + 32 * wc + 8 * fq;
#pragma unroll
                for (int bj = 0; bj < 2; ++bj) {
                    if (xin_f32) { acc[ai][bj][m][0] = *(const GAS f32x4*)(xin_f32 + off + 128 * bj); acc[ai][bj][m][1] = *(const GAS f32x4*)(xin_f32 + off + 128 * bj + 4); }
                    else { const u32x4 r = *(const GAS u32x4*)(xin_bf + off + 128 * bj);
                        acc[ai][bj][m][0] = (f32x4){__builtin_bit_cast(float, r.x << 16), __builtin_bit_cast(float, r.x & 0xffff0000u), __builtin_bit_cast(float, r.y << 16), __builtin_bit_cast(float, r.y & 0xffff0000u)};
                        acc[ai][bj][m][1] = (f32x4){__builtin_bit_cast(float, r.z << 16), __builtin_bit_cast(float, r.z & 0xffff0000u), __builtin_bit_cast(float, r.w << 16), __builtin_bit_cast(float, r.w & 0xffff0000u)}; }
                }
            }
    }
    __device__ __forceinline__ void operator()(const f32x4 (&acc)[2][2][4][2], const Unit& u, int wr, int wc, int fr, int fq) const {
        asm volatile("" : "+v"(fr), "+v"(fq));
        const int rowb = u.pm * 256 + wr * 64 + fr;
#pragma unroll
        for (int ai = 0; ai < 2; ++ai)
#pragma unroll
            for (int m = 0; m < 4; ++m) {
                const int row = rowb + ai * 128 + m * 16; const size_t off = (size_t)row * D + u.pn * 256 + 32 * wc + 8 * fq;
                float ss = 0.f;
#pragma unroll
                for (int bj = 0; bj < 2; ++bj) {
                    const f32x4 o0 = acc[ai][bj][m][0], o1 = acc[ai][bj][m][1];
                    if (xout_f32) { *(GAS f32x4*)(xout_f32 + off + 128 * bj) = o0; *(GAS f32x4*)(xout_f32 + off + 128 * bj + 4) = o1; }
                    else *(GAS u32x4*)(xb + off + 128 * bj) = pack8(o0, o1);
                    ss += dot4(o0) + dot4(o1);
                }
                ss += __shfl_xor(ss, 16); ss += __shfl_xor(ss, 32);
                if (fq == 0) rsq[(size_t)row * 16 + u.pn * 4 + wc] = ss;
            }
    }
};

#define DPP_MOV(old, src, ctrl, bc) __builtin_bit_cast(float, __builtin_amdgcn_update_dpp(__builtin_bit_cast(int, (float)(old)), __builtin_bit_cast(int, (float)(src)), (ctrl), 0xf, 0xf, (bc)))

struct EpiF1 {
    __device__ __forceinline__ void init(f32x4 (&acc)[2][2][4][2], const Unit&, int, int, int, int) const {
#pragma unroll
        for (int a = 0; a < 2; ++a)
#pragma unroll
            for (int b = 0; b < 2; ++b)
#pragma unroll
                for (int m = 0; m < 4; ++m)
#pragma unroll
                    for (int n = 0; n < 2; ++n) acc[a][b][m][n] = (f32x4){0.f, 0.f, 0.f, 0.f};
    }
    GAS bf16_t* H; const LAS float* rstd; const LAS float* par; GAS float* halo; GAS float* fixp; GAS float* fixu; LAS float* ldsx; unsigned* hcnt;
    __device__ __forceinline__ void operator()(const f32x4 (&acc)[2][2][4][2], const Unit& u, int wr, int wc, int fr, int fq) const {
        asm volatile("" : "+v"(fr), "+v"(fq));
        const int rowb = u.pm * 256 + wr * 64 + fr, ch0 = u.pn * 128 + 32 * wc + 8 * fq, lc = 32 * wc + 8 * fq;
        float rs[2][4]; row_rstd(rstd, (u.pm & 7) * 256 + wr * 64 + fr, rs);
        f32x4 w0[2], w1[2], w2[2], bb[2];
        const LAS float* pp = par + u.ui * 512 + lc;
#pragma unroll
        for (int n = 0; n < 2; ++n) { w0[n] = *(const LAS f32x4*)(pp + 4 * n); w1[n] = *(const LAS f32x4*)(pp + 128 + 4 * n); w2[n] = *(const LAS f32x4*)(pp + 256 + 4 * n); bb[n] = *(const LAS f32x4*)(pp + 384 + 4 * n); }
        const bool xpub = (u.pm & 15) == 7;
        if (fr >= 14) {
#pragma unroll
            for (int ai = 0; ai < 2; ++ai)
#pragma unroll
                for (int n = 0; n < 2; ++n) {
                    const f32x4 gvl = acc[ai][0][3][n] * rs[ai][3];
                    *(LAS f32x4*)(ldsx + ((ai * 2 + wr) * 2 + (fr - 14)) * 128 + lc + 4 * n) = gvl;
                    if (ai == 1 && wr == 1) {
                        GAS float* hp = halo + ((size_t)u.pm * 2 + (fr - 14)) * FF + ch0 + 4 * n;
                        if (xpub) asm volatile("global_store_dwordx4 %0, %1, off sc1" :: "v"(hp), "v"(gvl) : "memory");
                        else *(GAS f32x4*)hp = gvl;
                    }
                }
        }
        if (xpub) asm volatile("s_waitcnt vmcnt(0)" ::: "memory");
        asm volatile("s_waitcnt lgkmcnt(0)" ::: "memory"); __builtin_amdgcn_s_barrier(); asm volatile("" ::: "memory");
        if (xpub && wr == 0 && wc == 0 && fr == 0 && fq == 0) __hip_atomic_fetch_add(hcnt + 64 * u.pm, 1u, __ATOMIC_RELAXED, __HIP_MEMORY_SCOPE_AGENT);
        const bool fix = (u.pm & 15) != 0;
#pragma unroll
        for (int ai = 0; ai < 2; ++ai) {
            const int blk = ai * 2 + wr;
            f32x4 pv[2];
#pragma unroll
            for (int n = 0; n < 2; ++n) {
                pv[n] = (f32x4){0.f, 0.f, 0.f, 0.f};
                if (blk > 0 && fr >= 14) pv[n] = *(const LAS f32x4*)(ldsx + ((blk - 1) * 2 + (fr - 14)) * 128 + lc + 4 * n);
            }
#pragma unroll
            for (int m = 0; m < 4; ++m) {
                const float r = rs[ai][m]; const int row = rowb + ai * 128 + m * 16;
                f32x4 hv[2], pre[2], upv[2], cur[2];
#pragma unroll
                for (int n = 0; n < 2; ++n) {
                    cur[n] = acc[ai][0][m][n] * r; upv[n] = acc[ai][1][m][n] * r;
#pragma unroll
                    for (int e = 0; e < 4; ++e) {
                        const float c = cur[n][e], p = pv[n][e];
                        const float t1 = DPP_MOV(0.f, p, 0x10F, true);
                        const float g1 = DPP_MOV(t1, c, 0x111, false);
                        const float t2 = DPP_MOV(0.f, p, 0x10E, true);
                        const float g2 = DPP_MOV(t2, c, 0x112, false);
                        const float pr = bb[n][e] + w2[n][e] * c + w1[n][e] * g1 + w0[n][e] * g2;
                        pre[n][e] = pr; hv[n][e] = silu_f(pr) * upv[n][e];
                    }
                }
                *(GAS u32x4*)(H + (size_t)row * ZLD + ch0) = pack8(hv[0], hv[1]);
                if (fix && blk == 0 && m == 0 && fr < 2) {
#pragma unroll
                    for (int n = 0; n < 2; ++n) { *(GAS f32x4*)(fixp + ((size_t)u.pm * 2 + fr) * FF + ch0 + 4 * n) = pre[n]; *(GAS f32x4*)(fixu + ((size_t)u.pm * 2 + fr) * FF + ch0 + 4 * n) = upv[n]; }
                }
                pv[0] = cur[0]; pv[1] = cur[1];
            }
        }
    }
};

#define XB_TMO      128
#define XB_XCNT(j)  (256  + 64 * (j))
#define XB_XSUB(j)  (1280 + 64 * (j))
#define XB_XGEN(j)  (2304 + 64 * (j))
#define XB_TOP      3328
#define XB_TOPGEN   3392
#define XCD_BAR_WORDS 3456
#define XB_SPIN_CAP (1u << 18)
__device__ __forceinline__ unsigned xb_ld(unsigned* p)              { return __hip_atomic_load(p, __ATOMIC_RELAXED, __HIP_MEMORY_SCOPE_AGENT); }
__device__ __forceinline__ unsigned xb_add(unsigned* p, unsigned v) { return __hip_atomic_fetch_add(p, v, __ATOMIC_RELAXED, __HIP_MEMORY_SCOPE_AGENT); }
__device__ __forceinline__ unsigned xb_xcc_id() { return (unsigned)__builtin_amdgcn_s_getreg((3 << 11) | 20) & 0xFu; }
#define XB_SPIN(cond, bar) do { unsigned _sp = 0; while (cond) { __builtin_amdgcn_s_sleep(1); \
    if ((++_sp & 255u) == 0u) { if (xb_ld(&(bar)[XB_TMO])) break; if (_sp > XB_SPIN_CAP) { atomicAdd(&(bar)[XB_TMO], 1u); break; } } } } while (0)
struct XcdBarrier { unsigned* bar; unsigned x; volatile LAS unsigned* st; };
__device__ __forceinline__ XcdBarrier xcd_barrier_post(unsigned* bar, volatile LAS unsigned* st) {
    XcdBarrier b; b.bar = bar; b.x = xb_xcc_id(); b.st = st;
    if (threadIdx.x == 0) (void)xb_add(&bar[XB_XCNT(b.x)], 1u);
    return b;
}
__device__ __forceinline__ void xcd_barrier_complete(unsigned* bar, unsigned x, unsigned& nloc, unsigned& nx) {
    const unsigned G = gridDim.x * gridDim.y * gridDim.z;
    unsigned sum, cnt, mine, sp = 0u;
    for (;;) {
        sum = 0u; cnt = 0u; mine = 0u;
#pragma unroll
        for (unsigned j = 0; j < 16; ++j) { const unsigned c = xb_ld(&bar[XB_XCNT(j)]); sum += c; cnt += (c > 0u) ? 1u : 0u; mine = (j == x) ? c : mine; }
        if (sum == G) break;
        __builtin_amdgcn_s_sleep(1);
        if ((++sp & 255u) == 0u) { if (xb_ld(&bar[XB_TMO])) break; if (sp > XB_SPIN_CAP) { atomicAdd(&bar[XB_TMO], 1u); break; } }
    }
    nloc = mine > 0u ? mine : 1u; nx = cnt > 0u ? cnt : 1u;
}
__device__ __forceinline__ void xcd_barrier(const XcdBarrier& b) {
    asm volatile("s_waitcnt vmcnt(0)" ::: "memory");
    __syncthreads();
    if (threadIdx.x == 0) {
        unsigned* bar = b.bar;
        __builtin_amdgcn_s_waitcnt(0);
        unsigned nloc = b.st[0], nx = b.st[1];
        if (nloc == 0u) { xcd_barrier_complete(bar, b.x, nloc, nx); b.st[0] = nloc; b.st[1] = nx; }
        const unsigned old = xb_add(&bar[XB_XSUB(b.x)], 1u);
        const unsigned gen = old / nloc;
        if (old + 1u == (gen + 1u) * nloc) {
            __builtin_amdgcn_fence(__ATOMIC_RELEASE, "agent");
            asm volatile("s_waitcnt vmcnt(0)" ::: "memory");
            const unsigned og = xb_add(&bar[XB_TOP], 1u);
            const unsigned tg = og / nx;
            if (og + 1u == (tg + 1u) * nx) xb_add(&bar[XB_TOPGEN], 1u);
            else XB_SPIN(xb_ld(&bar[XB_TOPGEN]) == tg, bar);
            xb_add(&bar[XB_XGEN(b.x)], 1u);
            __builtin_amdgcn_fence(__ATOMIC_ACQUIRE, "agent");
            asm volatile("s_waitcnt vmcnt(0)" ::: "memory");
        } else {
            XB_SPIN(xb_ld(&bar[XB_XGEN(b.x)]) == gen, bar);
            __builtin_amdgcn_fence(__ATOMIC_ACQUIRE, "agent");
            asm volatile("s_waitcnt vmcnt(0)" ::: "memory");
        }
    }
    __syncthreads();
}

__device__ __forceinline__ void done_arrive(unsigned* c) { asm volatile("s_waitcnt vmcnt(0)" ::: "memory"); __syncthreads(); if (threadIdx.x == 0) (void)xb_add(c, 1u); }
__device__ __forceinline__ void done_wait(unsigned* c, const unsigned target) {
    if (threadIdx.x == 0) { unsigned sp = 0; while (xb_ld(c) < target && ++sp < XB_SPIN_CAP) __builtin_amdgcn_s_sleep(1); }
    __syncthreads();
}
__device__ __forceinline__ void xcd_local_barrier(const XcdBarrier& b) {
    asm volatile("s_waitcnt vmcnt(0)" ::: "memory");
    __syncthreads();
    if (threadIdx.x == 0) {
        unsigned* bar = b.bar;
        asm volatile("buffer_inv sc1" ::: "memory");
        const unsigned nloc = b.st[0];
        const unsigned old = xb_add(&bar[XB_XSUB(b.x)], 1u);
        const unsigned gen = old / nloc;
        if (old + 1u == (gen + 1u) * nloc) xb_add(&bar[XB_XGEN(b.x)], 1u);
        else XB_SPIN(xb_ld(&bar[XB_XGEN(b.x)]) == gen, bar);
        asm volatile("s_waitcnt vmcnt(0)" ::: "memory");
    }
    __syncthreads();
}

__device__ __forceinline__ int conv_srccol(const int map, const int nd, bool& second) {
    const int nb = nd >> 5, r = nd & 31; second = false;
    if (map == 1) {
        const int pn = nb >> 3, j = nb & 7, bj = j >> 2, wc = j & 3, kind = pn >> 1, zc = 256 * pn + 64 * wc + 32 * bj;
        if (kind == 1) return 1024 + (zc - 512) + r;
        if (kind == 2) return 512 + (nd - 1024);
        if (kind == 3) return zc + r;
        return nd;
    } else if (map == 2) {
        const int pn = nb >> 3, j = nb & 7; second = (j >> 2) != 0;
        return 128 * pn + 32 * (j & 3) + r;
    }
    return nd;
}
constexpr int CV_STR = 65;
__device__ __forceinline__ void conv_block_item(LAS unsigned char* lds, const GAS float* W, const GAS float* W2, const int ldw, const int K, const int Ndst, const GAS float* gk, GAS bf16_t* WT, const int map, const int item, const int tid) {
    const int nblk = Ndst >> 7, kb = item / nblk, nb = item % nblk, k0 = kb << 7, n0 = nb << 7;
    const int l32 = tid & 31, rg = tid >> 5;
    bool second; const int sc = conv_srccol(map, n0 + 4 * l32, second);
    const GAS float* src = (second ? W2 : W) + (size_t)(k0 + 8 * rg) * ldw + sc;
    f32x4 v[8];
#pragma unroll
    for (int i = 0; i < 8; ++i) v[i] = *(const GAS f32x4*)(src + (size_t)i * ldw);
    if (gk) {
        const f32x4 g0 = *(const GAS f32x4*)(gk + k0 + 8 * rg), g1 = *(const GAS f32x4*)(gk + k0 + 8 * rg + 4);
#pragma unroll
        for (int i = 0; i < 4; ++i) { v[i] = v[i] * g0[i]; v[4 + i] = v[4 + i] * g1[i]; }
    }
    LAS unsigned* T = (LAS unsigned*)lds;
#pragma unroll
    for (int i = 0; i < 4; ++i)
#pragma unroll
        for (int e = 0; e < 4; ++e) T[(4 * l32 + e) * CV_STR + 4 * rg + i] = cvt_pk_bf16(v[2 * i][e], v[2 * i + 1][e]);
    __syncthreads();
    const int c = tid & 15;
#pragma unroll
    for (int p = 0; p < 4; ++p) {
        const int n = (tid >> 4) + 32 * p; const LAS unsigned* r = T + n * CV_STR + 4 * c;
        u32x4 o; o.x = r[0]; o.y = r[1]; o.z = r[2]; o.w = r[3];
        *(GAS u32x4*)(WT + (size_t)(n0 + n) * K + k0 + 8 * c) = o;
    }
    __syncthreads();
}

__device__ __forceinline__ void ph_gmlp_simple(LAS unsigned char* lds, bf16_t* Z, const float* LNP, const float* ln_g, const float* ln_b, const float* wsp, const float* bsp, int tid, int G) {
    LAS float* vn = (LAS float*)lds;
    for (int item = blockIdx.x; item < (M / 128) * 8; item += G) {
        const int chunk = item >> 3, g = item & 7, m0 = chunk * 128;
        for (int idx = tid; idx < 128 * 64; idx += NWAVES * 64) {
            const int s = idx >> 6, c = idx & 63; const size_t row = m0 + s;
            float s1 = 0.f, s2 = 0.f;
            for (int k = 0; k < 8; ++k) { s1 += LNP[(row * 8 + k) * 2]; s2 += LNP[(row * 8 + k) * 2 + 1]; }
            const float mean = s1 * (1.f / 512.f), var = s2 * (1.f / 512.f) - mean * mean, rstd = rsqrtf(var + EPS);
            const float gv = bf2f(Z[row * ZLD + 1024 + 64 * g + c]);
            vn[idx] = (gv - mean) * rstd * ln_g[64 * g + c] + ln_b[64 * g + c];
        }
        __syncthreads();
        for (int idx = tid; idx < 128 * 64; idx += NWAVES * 64) {
            const int t = idx >> 6, c = idx & 63; const size_t row = m0 + t;
            float a = bsp[g * 128 + t];
            const float* wr = wsp + ((size_t)g * 128 + t) * 128;
            for (int s2 = 0; s2 <= t; ++s2) a += wr[s2] * vn[s2 * 64 + c];
            const float gu = bf2f(Z[row * ZLD + 64 * g + c]);
            Z[row * ZLD + 64 * g + c] = (bf16_t)f2bf(gu * a);
        }
        __syncthreads();
    }
}
__device__ __forceinline__ void ph_attn_simple(bf16_t* Z, int gw, int NGW, int lane) {
    for (int wv = gw; wv < M * 8; wv += NGW) {
        const int m = wv >> 3, h = wv & 7, t = m & (SEQ - 1), mb = m - t;
        const float q = bf2f(Z[(size_t)m * ZLD + 512 + 64 * h + lane]);
        float ms[3], ls[3], os[3];
#pragma unroll
        for (int r = 0; r < 3; ++r) {
            const int dil = (r == 0) ? 1 : (r == 1) ? 4 : 16;
            float mx = -1e30f, l = 0.f, o = 0.f;
            for (int j = 0; j <= 128; ++j) {
                const int tk = t - j * dil; if (tk < 0) break;
                const size_t kr = (size_t)(mb + tk) * ZLD;
                float sc = q * bf2f(Z[kr + 1536 + 64 * h + lane]);
#pragma unroll
                for (int o2 = 1; o2 < 64; o2 <<= 1) sc += __shfl_xor(sc, o2);
                const float mn = fmaxf(mx, sc), al = __expf(mx - mn), p = __expf(sc - mn);
                l = l * al + p; o = o * al + p * bf2f(Z[kr + 2048 + 64 * h + lane]); mx = mn;
            }
            ms[r] = mx; ls[r] = l; os[r] = o / l;
        }
        const float l0 = ms[0] + __logf(ls[0]), l1 = ms[1] + __logf(ls[1]), l2 = ms[2] + __logf(ls[2]);
        const float mm = fmaxf(l0, fmaxf(l1, l2)), e0 = __expf(l0 - mm), e1 = __expf(l1 - mm), e2 = __expf(l2 - mm), inv = 1.f / (e0 + e1 + e2);
        Z[(size_t)m * ZLD + 512 + 64 * h + lane] = (bf16_t)f2bf((e0 * os[0] + e1 * os[1] + e2 * os[2]) * inv);
    }
}
__device__ __forceinline__ void ph_ga_simple(const float* X, const float* RSQ, const float* gmix, const float* w_in, float* GA, int gw, int NGW, int lane) {
    for (int m = gw; m < M; m += NGW) {
        float acc[16];
#pragma unroll
        for (int j = 0; j < 16; ++j) acc[j] = 0.f;
        for (int i = 0; i < 16; ++i) {
            const int k = i * 64 + lane; const float xv = X[(size_t)m * D + k] * gmix[k];
            const f32x4* wr = (const f32x4*)(w_in + (size_t)k * OD_NSRC + 3072);
#pragma unroll
            for (int j4 = 0; j4 < 4; ++j4) { const f32x4 w = wr[j4]; acc[4 * j4] += xv * w[0]; acc[4 * j4 + 1] += xv * w[1]; acc[4 * j4 + 2] += xv * w[2]; acc[4 * j4 + 3] += xv * w[3]; }
        }
        float s = 0.f;
        for (int j = 0; j < 16; ++j) s += RSQ[(size_t)m * 16 + j];
        const float rstd = rsqrtf(s * (1.f / 1024.f) + EPS);
#pragma unroll
        for (int j = 0; j < 16; ++j) {
            float v = acc[j];
#pragma unroll
            for (int o = 1; o < 64; o <<= 1) v += __shfl_xor(v, o);
            if (lane == j) GA[(size_t)m * 16 + j] = v * rstd;
        }
    }
}
__device__ __forceinline__ void ph_gla_simple(LAS unsigned char* lds, const bf16_t* Z, const float* GA, const float* w_a2, const float* b_a, float* ORAW, int tid, int G) {
    LAS float* sa = (LAS float*)lds; LAS float* sk = sa + 256; LAS float* sq = sk + 256;
    for (int item = blockIdx.x; item < 16; item += G) {
        const int b = item >> 2, h = item & 3, v = tid;
        float S[128];
#pragma unroll
        for (int k = 0; k < 128; ++k) S[k] = 0.f;
        float wa[16]; float ba = 0.f;
#pragma unroll
        for (int j = 0; j < 16; ++j) wa[j] = 0.f;
        if (v < 128) {
#pragma unroll
            for (int j = 0; j < 16; ++j) wa[j] = w_a2[j * 512 + h * 128 + v];
            ba = b_a[h * 128 + v]; }
        for (int t = 0; t < SEQ; ++t) {
            const size_t m = (size_t)b * SEQ + t; const int buf = (t & 1) * 128;
            if (v < 128) {
                float xg = ba;
#pragma unroll
                for (int j = 0; j < 16; ++j) xg += GA[m * 16 + j] * wa[j];
                const float ls = fminf(xg, 0.f) - log1pf(__expf(-fabsf(xg)));
                sa[buf + v] = __expf(ls * (1.f / 16.f));
                sk[buf + v] = bf2f(Z[m * OD_N + 512 + 128 * h + v]);
                sq[buf + v] = bf2f(Z[m * OD_N + 128 * h + v]);
            }
            __syncthreads();
            if (v < 256) {
                const float vv = bf2f(Z[m * OD_N + 1024 + 256 * h + v]);
                float o = 0.f;
#pragma unroll
                for (int k = 0; k < 128; ++k) { S[k] = sa[buf + k] * S[k] + sk[buf + k] * vv; o += sq[buf + k] * S[k]; }
                ORAW[m * 1024 + 256 * h + v] = o;
            }
        }
        __syncthreads();
    }
}
__device__ __forceinline__ void ph_gla_post_simple(bf16_t* Z, const float* ORAW, const float* head_g, int gw, int NGW, int lane) {
    for (int wv = gw; wv < M * 4; wv += NGW) {
        const int m = wv >> 2, h = wv & 3;
        const f32x4 o = *(const f32x4*)(ORAW + (size_t)m * 1024 + 256 * h + 4 * lane);
        float ss = dot4(o);
#pragma unroll
        for (int k = 1; k < 64; k <<= 1) ss += __shfl_xor(ss, k);
        const float rstd = rsqrtf(ss * (1.f / 256.f) + EPS);
        const f32x4 hg = *(const f32x4*)(head_g + 4 * lane);
        bf16_t* sr = Z + (size_t)m * OD_N + 2048 + 256 * h + 4 * lane;
        bf16_t* dst = Z + (size_t)m * OD_N + 1024 + 256 * h + 4 * lane;
        u32x2 w; w.x = pk2(o[0] * rstd * hg[0] * bf2f(sr[0]), o[1] * rstd * hg[1] * bf2f(sr[1])); w.y = pk2(o[2] * rstd * hg[2] * bf2f(sr[2]), o[3] * rstd * hg[3] * bf2f(sr[3]));
        *(u32x2*)dst = w;
    }
}


typedef short s16x4 __attribute__((ext_vector_type(4)));
__device__ __forceinline__ bf16x8 tr_pair(const LAS unsigned char* p0, const LAS unsigned char* p1) {
    const s16x4 lo = __builtin_amdgcn_ds_read_tr16_b64_v4i16((LAS s16x4*)p0), hi = __builtin_amdgcn_ds_read_tr16_b64_v4i16((LAS s16x4*)p1);
    return __builtin_shufflevector(lo, hi, 0, 1, 2, 3, 4, 5, 6, 7);
}
constexpr int AT_KSTR = 144, AT_VSTR = 160, AT_VOFF = 256 * AT_KSTR;
struct AttnPre { u32x4 k[4], v[4]; bf16x8 q0, q1; };
__device__ __forceinline__ void attn_load(const GAS bf16_t* Z, const int dlog, const int idx, const int tid, AttnPre& P) {
    const int lane = tid & 63, w = tid >> 6, fr = lane & 15, g = lane >> 4;
    const int nbl = 5 - dlog, bh = idx >> 5, b = bh >> 3, h = bh & 7, rn = idx & 31, r = rn >> nbl, n = rn & ((1 << nbl) - 1);
    const size_t mb = (size_t)b * SEQ;
#pragma unroll
    for (int pass = 0; pass < 4; ++pass) {
        const int row = pass * 64 + (tid >> 3), ch = tid & 7, tok = (((128 * (n - 1) + row)) << dlog) + r;
        P.k[pass] = (u32x4){0u, 0u, 0u, 0u}; P.v[pass] = (u32x4){0u, 0u, 0u, 0u};
        if (tok >= 0) { const GAS bf16_t* src = Z + (mb + tok) * ZLD + 64 * h + 8 * ch; P.k[pass] = *(const GAS u32x4*)(src + 1536); P.v[pass] = *(const GAS u32x4*)(src + 2048); }
    }
    const int tq = ((128 * n + 16 * w + fr) << dlog) + r;
    const GAS bf16_t* qp = Z + (mb + tq) * ZLD + 512 + 64 * h;
    P.q0 = *(const GAS bf16x8*)(qp + 8 * g); P.q1 = *(const GAS bf16x8*)(qp + 32 + 8 * g);
}
__device__ __forceinline__ int attn_item_idx(const int dlog, const int xmap, const int j, const int idx0, const int stride, const int it) {
    if (xmap < 0) return idx0 + it * stride;
    const int q = j + 32 * it, h = q >> 4, b = xmap >> 1, hf = xmap & 1;
    int rn;
    if (dlog == 0) rn = 16 * hf + (q & 15);
    else if (dlog == 2) rn = ((q >> 2) & 3) * 8 + 4 * hf + (q & 3);
    else rn = (q & 15) * 2 + hf;
    return (b * 8 + h) * 32 + rn;
}
template <bool FINAL>
__device__ __forceinline__ void attn_run(LAS unsigned char* lds, GAS bf16_t* Z, const int dlog, const int idx0, const int count, const int stride, const int xmap, const int jmap, GAS bf16_t* Pout, GAS float* Lout,
                                         const GAS bf16_t* P1, const GAS bf16_t* P2, const GAS float* L1, const GAS float* L2, const int tid) {
    constexpr bool final = FINAL;
    const int lane = tid & 63, w = __builtin_amdgcn_readfirstlane(tid >> 6), fr = lane & 15, g = lane >> 4;
    AttnPre P;
    constexpr int AT_IMG = 256 * AT_KSTR + 256 * AT_VSTR;
    bf16x8 q0 = (bf16x8){0, 0, 0, 0, 0, 0, 0, 0}, q1 = q0;
    if (count > 0) {
        attn_load(Z, dlog, attn_item_idx(dlog, xmap, jmap, idx0, stride, 0), tid, P);
#pragma unroll
        for (int pass = 0; pass < 4; ++pass) {
            const int row = pass * 64 + (tid >> 3), ch = tid & 7;
            *(LAS u32x4*)(lds + row * AT_KSTR + 16 * ch) = P.k[pass];
            *(LAS u32x4*)(lds + AT_VOFF + row * AT_VSTR + 16 * ch) = P.v[pass];
        }
        q0 = P.q0; q1 = P.q1;
        __syncthreads();
    }
    for (int it_ = 0; it_ < count; ++it_) {
    const int idx = attn_item_idx(dlog, xmap, jmap, idx0, stride, it_);
    const int nbl = 5 - dlog, bh = idx >> 5, b = bh >> 3, h = bh & 7, rn = idx & 31, r = rn >> nbl, n = rn & ((1 << nbl) - 1);
    const size_t mb = (size_t)b * SEQ;
    const LAS unsigned char* img = lds + (it_ & 1) * AT_IMG;
    const int tq = ((128 * n + 16 * w + fr) << dlog) + r;
    if (it_ + 1 < count) attn_load(Z, dlog, attn_item_idx(dlog, xmap, jmap, idx0, stride, it_ + 1), tid, P);
    u32x2 mp1[4], mp2[4]; float ml1 = 0.f, ml2 = 0.f;
    if (final) {
        const GAS bf16_t* p1 = P1 + (mb + tq) * 512 + 64 * h + 4 * g; const GAS bf16_t* p2 = P2 + (mb + tq) * 512 + 64 * h + 4 * g;
#pragma unroll
        for (int dt = 0; dt < 4; ++dt) { mp1[dt] = *(const GAS u32x2*)(p1 + 16 * dt); mp2[dt] = *(const GAS u32x2*)(p2 + 16 * dt); }
        ml1 = L1[(mb + tq) * 8 + h]; ml2 = L2[(mb + tq) * 8 + h];
    }
    f32x4 st[9];
#pragma unroll
    for (int kt = 0; kt < 9; ++kt) {
        const LAS unsigned char* kr = img + (16 * w + 16 * kt + fr) * AT_KSTR + 16 * g;
        const bf16x8 a0 = *(const LAS bf16x8*)kr, a1 = *(const LAS bf16x8*)(kr + 64);
        f32x4 c = (f32x4){0.f, 0.f, 0.f, 0.f};
        c = __builtin_amdgcn_mfma_f32_16x16x32_bf16(a0, q0, c, 0, 0, 0);
        c = __builtin_amdgcn_mfma_f32_16x16x32_bf16(a1, q1, c, 0, 0, 0);
        st[kt] = c;
    }
    float mx = -1e30f;
#pragma unroll
    for (int kt = 0; kt < 9; ++kt) {
        const bool tv = (n > 0) || (kt >= 8 - w);
#pragma unroll
        for (int e = 0; e < 4; ++e) {
            const int jj = 4 * g + e;
            bool ok = tv; if (kt == 0) ok = ok && (jj >= fr); if (kt == 8) ok = ok && (jj <= fr);
            const float sv = ok ? st[kt][e] : -1e30f; st[kt][e] = sv; mx = fmaxf(mx, sv);
        }
    }
    mx = fmaxf(mx, __shfl_xor(mx, 16)); mx = fmaxf(mx, __shfl_xor(mx, 32));
    f32x4 lacc = (f32x4){0.f, 0.f, 0.f, 0.f};
#pragma unroll
    for (int kt = 0; kt < 9; ++kt) {
        const f32x4 d = st[kt] - mx; f32x4 p;
#pragma unroll
        for (int e = 0; e < 4; ++e) p[e] = __builtin_amdgcn_exp2f(d[e]);
        st[kt] = p; lacc += p;
    }
    float l = (lacc[0] + lacc[1]) + (lacc[2] + lacc[3]);
    l += __shfl_xor(l, 16); l += __shfl_xor(l, 32);
    f32x4 ot[4];
#pragma unroll
    for (int dt = 0; dt < 4; ++dt) ot[dt] = (f32x4){0.f, 0.f, 0.f, 0.f};
    const int qq = fr >> 2, pp = fr & 3;
#pragma unroll
    for (int ks2 = 0; ks2 < 5; ++ks2) {
        const int T0 = 2 * ks2, T1 = (ks2 < 4) ? 2 * ks2 + 1 : 2 * ks2;
        u32x4 pb; pb.x = cvt_pk_bf16(st[T0][0], st[T0][1]); pb.y = cvt_pk_bf16(st[T0][2], st[T0][3]);
        if (ks2 < 4) { pb.z = cvt_pk_bf16(st[T1][0], st[T1][1]); pb.w = cvt_pk_bf16(st[T1][2], st[T1][3]); } else { pb.z = 0u; pb.w = 0u; }
        const bf16x8 bfrag = __builtin_bit_cast(bf16x8, pb);
        const LAS unsigned char* v0 = img + AT_VOFF + (16 * w + 16 * T0 + 4 * g + qq) * AT_VSTR + 8 * pp;
        const LAS unsigned char* v1 = img + AT_VOFF + (16 * w + 16 * T1 + 4 * g + qq) * AT_VSTR + 8 * pp;
#pragma unroll
        for (int dt = 0; dt < 4; ++dt) ot[dt] = __builtin_amdgcn_mfma_f32_16x16x32_bf16(tr_pair(v0 + 32 * dt, v1 + 32 * dt), bfrag, ot[dt], 0, 0, 0);
    }
    const float inv = 1.0f / l, lse = mx + __builtin_amdgcn_logf(l);
    if (!final) {
        GAS bf16_t* op = Pout + (mb + tq) * 512 + 64 * h + 4 * g;
#pragma unroll
        for (int dt = 0; dt < 4; ++dt) { u32x2 o; o.x = cvt_pk_bf16(ot[dt][0] * inv, ot[dt][1] * inv); o.y = cvt_pk_bf16(ot[dt][2] * inv, ot[dt][3] * inv); *(GAS u32x2*)(op + 16 * dt) = o; }
        if (g == 0) Lout[(mb + tq) * 8 + h] = lse;
    } else {
        const float l1 = ml1, l2 = ml2;
        const float mm = fmaxf(lse, fmaxf(l1, l2)), e0 = __builtin_amdgcn_exp2f(lse - mm), e1 = __builtin_amdgcn_exp2f(l1 - mm), e2 = __builtin_amdgcn_exp2f(l2 - mm), rs = 1.0f / (e0 + e1 + e2);
        const float w0 = e0 * rs * inv, w1 = e1 * rs, w2 = e2 * rs;
        GAS bf16_t* op = Z + (mb + tq) * ZLD + 512 + 64 * h + 4 * g;
#pragma unroll
        for (int dt = 0; dt < 4; ++dt) {
            const u32x2 a = mp1[dt], c = mp2[dt];
            const float r0 = w0 * ot[dt][0] + w1 * bf2f((unsigned short)(a.x & 0xffffu)) + w2 * bf2f((unsigned short)(c.x & 0xffffu));
            const float r1 = w0 * ot[dt][1] + w1 * bf2f((unsigned short)(a.x >> 16)) + w2 * bf2f((unsigned short)(c.x >> 16));
            const float r2 = w0 * ot[dt][2] + w1 * bf2f((unsigned short)(a.y & 0xffffu)) + w2 * bf2f((unsigned short)(c.y & 0xffffu));
            const float r3 = w0 * ot[dt][3] + w1 * bf2f((unsigned short)(a.y >> 16)) + w2 * bf2f((unsigned short)(c.y >> 16));
            u32x2 o; o.x = cvt_pk_bf16(r0, r1); o.y = cvt_pk_bf16(r2, r3); *(GAS u32x2*)(op + 16 * dt) = o;
        }
    }
    if (it_ + 1 < count) {
        LAS unsigned char* nimg = lds + ((it_ + 1) & 1) * AT_IMG;
#pragma unroll
        for (int pass = 0; pass < 4; ++pass) {
            const int row = pass * 64 + (tid >> 3), ch = tid & 7;
            *(LAS u32x4*)(nimg + row * AT_KSTR + 16 * ch) = P.k[pass];
            *(LAS u32x4*)(nimg + AT_VOFF + row * AT_VSTR + 16 * ch) = P.v[pass];
        }
        q0 = P.q0; q1 = P.q1;
    }
    __syncthreads();
    }
}
constexpr int GM_STR = 160;
constexpr int GM_TILE = 128 * GM_STR, GM_LNP = 2 * GM_TILE;
struct GmPre { bf16x8 wfr[4]; u32x2 guv[4]; f32x4 lnp[4]; u32x4 raw[2]; float bias; };
__device__ __forceinline__ void gmlp_load(const GAS bf16_t* Z, const GAS float* LNP, const GAS bf16_t* Wbf, const GAS float* bs, const int item, const int tid, GmPre& P) {
    const int lane = tid & 63, w = __builtin_amdgcn_readfirstlane(tid >> 6), fr = lane & 15, g4 = lane >> 4;
    const int chunk = item >> 3, g = item & 7, m0 = chunk * 128, t = 16 * w + fr;
    const GAS bf16_t* wrow = Wbf + ((size_t)g * 128 + t) * 128 + 8 * g4;
    const GAS bf16_t* up = Z + (size_t)(m0 + t) * ZLD + 64 * g + 4 * g4;
#pragma unroll
    for (int ks = 0; ks < 4; ++ks) P.wfr[ks] = *(const GAS bf16x8*)(wrow + 32 * ks);
#pragma unroll
    for (int ct = 0; ct < 4; ++ct) P.guv[ct] = *(const GAS u32x2*)(up + 16 * ct);
    P.bias = bs[g * 128 + t];
    const int s = tid >> 2, c0 = (tid & 3) * 16; const size_t row = m0 + s;
#pragma unroll
    for (int k = 0; k < 4; ++k) P.lnp[k] = *(const GAS f32x4*)(LNP + row * 16 + 4 * k);
    const GAS bf16_t* gp = Z + row * ZLD + 1024 + 64 * g + c0;
#pragma unroll
    for (int hh = 0; hh < 2; ++hh) P.raw[hh] = *(const GAS u32x4*)(gp + 8 * hh);
}
template <class ItemFn>
__device__ __forceinline__ void gmlp_run(LAS unsigned char* lds, GAS bf16_t* Z, const GAS float* LNP, const GAS float* ln_g, const GAS float* ln_b, const GAS bf16_t* Wbf, const GAS float* bs, const int count, const ItemFn itemf, const int tid) {
    const int lane = tid & 63, w = __builtin_amdgcn_readfirstlane(tid >> 6), fr = lane & 15, g4 = lane >> 4;
    const int t = 16 * w + fr, qq = fr >> 2, pp = fr & 3;
    if (count <= 0) return;
    GmPre P;
    gmlp_load(Z, LNP, Wbf, bs, itemf(0), tid, P);
    ((LAS float*)(lds + GM_LNP))[tid] = ln_g[tid]; ((LAS float*)(lds + GM_LNP))[512 + tid] = ln_b[tid];
    __syncthreads();
    for (int i = 0; i < count; ++i) {
        const int item = itemf(i), chunk = item >> 3, g = item & 7, m0 = chunk * 128;
        LAS unsigned char* tile = lds + (i & 1) * GM_TILE;
        {
            const int s = tid >> 2, c0 = (tid & 3) * 16;
            float s1 = 0.f, s2 = 0.f;
#pragma unroll
            for (int k = 0; k < 4; ++k) { const f32x4 p = P.lnp[k]; s1 += p[0] + p[2]; s2 += p[1] + p[3]; }
            const float mean = s1 * (1.f / 512.f), var = s2 * (1.f / 512.f) - mean * mean, rstd = rsqrtf(var + EPS);
#pragma unroll
            for (int hh = 0; hh < 2; ++hh) {
                const u32x4 raw = P.raw[hh];
                const LAS float* lg = (const LAS float*)(lds + GM_LNP) + 64 * g + c0 + 8 * hh;
                const f32x4 la = *(const LAS f32x4*)lg, lb = *(const LAS f32x4*)(lg + 4), ba = *(const LAS f32x4*)(lg + 512), bb = *(const LAS f32x4*)(lg + 516);
                f32x4 x0, x1;
                x0[0] = bf2f((unsigned short)(raw.x & 0xffffu)); x0[1] = bf2f((unsigned short)(raw.x >> 16)); x0[2] = bf2f((unsigned short)(raw.y & 0xffffu)); x0[3] = bf2f((unsigned short)(raw.y >> 16));
                x1[0] = bf2f((unsigned short)(raw.z & 0xffffu)); x1[1] = bf2f((unsigned short)(raw.z >> 16)); x1[2] = bf2f((unsigned short)(raw.w & 0xffffu)); x1[3] = bf2f((unsigned short)(raw.w >> 16));
                x0 = (x0 - mean) * rstd * la + ba; x1 = (x1 - mean) * rstd * lb + bb;
                *(LAS u32x4*)(tile + s * GM_STR + (c0 + 8 * hh) * 2) = pack8(x0, x1);
            }
        }
        bf16x8 wfr[4]; u32x2 guv[4];
#pragma unroll
        for (int ks = 0; ks < 4; ++ks) wfr[ks] = P.wfr[ks];
#pragma unroll
        for (int ct = 0; ct < 4; ++ct) guv[ct] = P.guv[ct];
        const float bias = P.bias;
        if (i + 1 < count) gmlp_load(Z, LNP, Wbf, bs, itemf(i + 1), tid, P);
        __syncthreads();
        f32x4 acc[4];
#pragma unroll
        for (int ct = 0; ct < 4; ++ct) acc[ct] = (f32x4){0.f, 0.f, 0.f, 0.f};
#pragma unroll
        for (int ks = 0; ks < 4; ++ks) {
            if (32 * ks <= 16 * w + 15) {
                const bf16x8 bfr = wfr[ks];
                const LAS unsigned char* a0 = tile + (32 * ks + 8 * g4 + qq) * GM_STR + 8 * pp;
#pragma unroll
                for (int ct = 0; ct < 4; ++ct) acc[ct] = __builtin_amdgcn_mfma_f32_16x16x32_bf16(tr_pair(a0 + 32 * ct, a0 + 4 * GM_STR + 32 * ct), bfr, acc[ct], 0, 0, 0);
            }
        }
        GAS bf16_t* up = Z + (size_t)(m0 + t) * ZLD + 64 * g + 4 * g4;
#pragma unroll
        for (int ct = 0; ct < 4; ++ct) {
            const u32x2 a = guv[ct];
            u32x2 o; o.x = cvt_pk_bf16(bf2f((unsigned short)(a.x & 0xffffu)) * (acc[ct][0] + bias), bf2f((unsigned short)(a.x >> 16)) * (acc[ct][1] + bias));
            o.y = cvt_pk_bf16(bf2f((unsigned short)(a.y & 0xffffu)) * (acc[ct][2] + bias), bf2f((unsigned short)(a.y >> 16)) * (acc[ct][3] + bias));
            *(GAS u32x2*)(up + 16 * ct) = o;
        }
    }
    __syncthreads();
}


constexpr int GL_GAL = 0, GL_SEG = 4096, GL_A = 8192;
constexpr int G1_KSSTR = 144, G1_V = GL_A + 128 * G1_KSSTR, GL_VSTR = 544;
constexpr int G3_QSTR = 272, G3_KT = GL_A + 64 * G3_QSTR, G3_V = G3_KT + 64 * G3_QSTR, G3_SSQ = G3_V + 64 * GL_VSTR;
__device__ __forceinline__ void gla_decay(LAS unsigned char* lds, const GAS float* GA, const GAS float* w_a2, const GAS float* b_a, const int h, const size_t m0, const int tid, float (&bl)[2][8], float (&tot)[2]) {
    LAS float* gal = (LAS float*)(lds + GL_GAL); LAS float* seg = (LAS float*)(lds + GL_SEG);
    const int kp = tid & 63, s8 = tid >> 6;
    if (tid < 256) *(LAS f32x4*)(gal + 4 * tid) = *(const GAS f32x4*)(GA + m0 * 16 + 4 * tid);
    float wa[2][16], ba[2];
#pragma unroll
    for (int c = 0; c < 2; ++c) {
#pragma unroll
        for (int j = 0; j < 16; ++j) wa[c][j] = w_a2[j * 512 + 128 * h + 2 * kp + c];
        ba[c] = b_a[128 * h + 2 * kp + c]; }
    __syncthreads();
    float run[2] = {0.f, 0.f};
#pragma unroll
    for (int i = 0; i < 8; ++i) {
        const LAS f32x4* gr = (const LAS f32x4*)(gal + (8 * s8 + i) * 16);
        const f32x4 g0 = gr[0], g1 = gr[1], g2 = gr[2], g3 = gr[3];
#pragma unroll
        for (int c = 0; c < 2; ++c) {
            float x = ba[c];
#pragma unroll
            for (int j = 0; j < 4; ++j) x += g0[j] * wa[c][j] + g1[j] * wa[c][4 + j] + g2[j] * wa[c][8 + j] + g3[j] * wa[c][12 + j];
            const float ls = fminf(x, 0.f) - __logf(1.0f + __expf(-fabsf(x)));
            run[c] += ls * (1.0f / 16.0f); bl[c][i] = run[c];
        }
    }
    *(LAS f32x2*)(seg + s8 * 128 + 2 * kp) = (f32x2){run[0], run[1]};
    __syncthreads();
    float pre[2] = {0.f, 0.f}; tot[0] = 0.f; tot[1] = 0.f;
#pragma unroll
    for (int q = 0; q < 8; ++q) { const f32x2 sv = *(const LAS f32x2*)(seg + q * 128 + 2 * kp); if (q < s8) { pre[0] += sv.x; pre[1] += sv.y; } tot[0] += sv.x; tot[1] += sv.y; }
#pragma unroll
    for (int i = 0; i < 8; ++i) { bl[0][i] += pre[0]; bl[1][i] += pre[1]; }
}
__device__ __forceinline__ void gla_stage_v(LAS unsigned char* vl, const GAS bf16_t* Z, const int h, const size_t m0, const int tid) {
#pragma unroll
    for (int p = 0; p < 4; ++p) { const int idx = p * 512 + tid, t = idx >> 5, ch = idx & 31;
        *(LAS u32x4*)(vl + t * GL_VSTR + 16 * ch) = *(const GAS u32x4*)(Z + (m0 + t) * OD_N + 1024 + 256 * h + 8 * ch); }
}
constexpr int G1_DEC = G1_V + 64 * GL_VSTR;
__device__ __forceinline__ void gla_g1_group(LAS unsigned char* lds, const GAS bf16_t* Z, const GAS float* GA, const GAS float* w_a2, const GAS float* b_a, GAS bf16_t* KVT, GAS float* DCC, GAS float* DG, GAS bf16_t* QK, const int item, const int tid) {
    const int lane = tid & 63, w = __builtin_amdgcn_readfirstlane(tid >> 6), fr = lane & 15, g = lane >> 4;
    const int bh = item >> 4, grp = item & 15, h = bh & 3; const size_t mbase = (size_t)(bh >> 2) * SEQ + 256 * grp;
    const int kp = tid & 63, s8 = tid >> 6;
    LAS float* gal = (LAS float*)(lds + GL_GAL); LAS float* seg = (LAS float*)(lds + GL_SEG); LAS float* decs = (LAS float*)(lds + G1_DEC);
    float wa[2][16], ba[2];
#pragma unroll
    for (int c = 0; c < 2; ++c) {
#pragma unroll
        for (int j = 0; j < 16; ++j) wa[c][j] = w_a2[j * 512 + 128 * h + 2 * kp + c];
        ba[c] = b_a[128 * h + 2 * kp + c]; }
    f32x4 acc[16];
#pragma unroll
    for (int vt = 0; vt < 16; ++vt) acc[vt] = (f32x4){0.f, 0.f, 0.f, 0.f};
    float cum[2] = {0.f, 0.f};
    const int qq = fr >> 2, pp = fr & 3;
    f32x4 pga = (f32x4){0.f, 0.f, 0.f, 0.f};
    if (tid < 256) pga = *(const GAS f32x4*)(GA + mbase * 16 + 4 * tid);
    for (int cc = 0; cc < 4; ++cc) {
        const size_t m0 = mbase + 64 * cc; const int chunk = bh * 64 + 4 * grp + cc;
        if (tid < 256) *(LAS f32x4*)(gal + 4 * tid) = pga;
        unsigned qraw[8], kraw[8];
#pragma unroll
        for (int i = 0; i < 8; ++i) { const GAS bf16_t* zr = Z + (m0 + 8 * s8 + i) * OD_N + 128 * h + 2 * kp; qraw[i] = *(const GAS unsigned*)zr; kraw[i] = *(const GAS unsigned*)(zr + 512); }
        __syncthreads();
        if (cc < 3 && tid < 256) pga = *(const GAS f32x4*)(GA + (m0 + 64) * 16 + 4 * tid);
        float bl[2][8], run[2] = {0.f, 0.f};
#pragma unroll
        for (int i = 0; i < 8; ++i) {
            const LAS f32x4* gr = (const LAS f32x4*)(gal + (8 * s8 + i) * 16);
            const f32x4 g0 = gr[0], g1 = gr[1], g2 = gr[2], g3 = gr[3];
#pragma unroll
            for (int c = 0; c < 2; ++c) {
                float x = ba[c];
#pragma unroll
                for (int j = 0; j < 4; ++j) x += g0[j] * wa[c][j] + g1[j] * wa[c][4 + j] + g2[j] * wa[c][8 + j] + g3[j] * wa[c][12 + j];
                const float ls = fminf(x, 0.f) - __logf(1.0f + __expf(-fabsf(x)));
                run[c] += ls * (1.0f / 16.0f); bl[c][i] = run[c];
            }
        }
        *(LAS f32x2*)(seg + s8 * 128 + 2 * kp) = (f32x2){run[0], run[1]};
        __syncthreads();
        u32x4 pv[4];
#pragma unroll
        for (int p = 0; p < 4; ++p) { const int idx = p * 512 + tid, t = idx >> 5, ch = idx & 31; pv[p] = *(const GAS u32x4*)(Z + (m0 + t) * OD_N + 1024 + 256 * h + 8 * ch); }
        float pre[2] = {0.f, 0.f}, tot[2] = {0.f, 0.f};
#pragma unroll
        for (int q = 0; q < 8; ++q) { const f32x2 sv = *(const LAS f32x2*)(seg + q * 128 + 2 * kp); if (q < s8) { pre[0] += sv.x; pre[1] += sv.y; } tot[0] += sv.x; tot[1] += sv.y; }
        float ks[2][8]; const float et0 = __expf(tot[0]), et1 = __expf(tot[1]);
#pragma unroll
        for (int i = 0; i < 8; ++i) {
            const float b0 = bl[0][i] + pre[0], b1 = bl[1][i] + pre[1];
            const float k0 = bf2f((unsigned short)(kraw[i] & 0xffffu)), k1 = bf2f((unsigned short)(kraw[i] >> 16));
            const float kt0 = k0 * __expf(-b0), kt1 = k1 * __expf(-b1);
            ks[0][i] = kt0 * et0; ks[1][i] = kt1 * et1;
            GAS bf16_t* qr = QK + (m0 + 8 * s8 + i) * 1024 + 128 * h + 2 * kp;
            *(GAS unsigned*)qr = cvt_pk_bf16(bf2f((unsigned short)(qraw[i] & 0xffffu)) * __expf(b0), bf2f((unsigned short)(qraw[i] >> 16)) * __expf(b1));
            *(GAS unsigned*)(qr + 512) = cvt_pk_bf16(kt0, kt1);
        }
#pragma unroll
        for (int c = 0; c < 2; ++c)
            *(LAS u32x4*)(lds + GL_A + (2 * kp + c) * G1_KSSTR + 16 * s8) = pack8((f32x4){ks[c][0], ks[c][1], ks[c][2], ks[c][3]}, (f32x4){ks[c][4], ks[c][5], ks[c][6], ks[c][7]});
#pragma unroll
        for (int p = 0; p < 4; ++p) { const int idx = p * 512 + tid, t = idx >> 5, ch = idx & 31; *(LAS u32x4*)(lds + G1_V + t * GL_VSTR + 16 * ch) = pv[p]; }
        if (s8 == 0) {
            *(LAS f32x2*)(decs + 2 * kp) = (f32x2){et0, et1};
            *(GAS f32x2*)(DCC + (size_t)chunk * 128 + 2 * kp) = (f32x2){et0, et1};
        }
        cum[0] += tot[0]; cum[1] += tot[1];
        __syncthreads();
        const LAS unsigned char* ar = lds + GL_A + (16 * w + fr) * G1_KSSTR + 16 * g;
        const bf16x8 a0 = *(const LAS bf16x8*)ar, a1 = *(const LAS bf16x8*)(ar + 64);
        const f32x4 dcv = *(const LAS f32x4*)(decs + 16 * w + 4 * g);
        const LAS unsigned char* vb = lds + G1_V + (8 * g + qq) * GL_VSTR + 8 * pp;
#pragma unroll
        for (int vt = 0; vt < 16; ++vt) {
            f32x4 c = acc[vt];
            c = c * dcv;
            c = __builtin_amdgcn_mfma_f32_16x16x32_bf16(a0, tr_pair(vb + 32 * vt, vb + 4 * GL_VSTR + 32 * vt), c, 0, 0, 0);
            c = __builtin_amdgcn_mfma_f32_16x16x32_bf16(a1, tr_pair(vb + 32 * GL_VSTR + 32 * vt, vb + 36 * GL_VSTR + 32 * vt), c, 0, 0, 0);
            acc[vt] = c;
        }
        __syncthreads();
    }
    {
        GAS bf16_t* outp = KVT + (size_t)(bh * 64 + 4 * grp) * 32768 + (size_t)w * 4096 + fr * 16 + 4 * g;
#pragma unroll
        for (int vt = 0; vt < 16; ++vt) { u32x2 o; o.x = cvt_pk_bf16(acc[vt][0], acc[vt][1]); o.y = cvt_pk_bf16(acc[vt][2], acc[vt][3]); *(GAS u32x2*)(outp + vt * 256) = o; }
        if (s8 == 0) *(GAS f32x2*)(DG + (size_t)item * 128 + 2 * kp) = (f32x2){__expf(cum[0]), __expf(cum[1])};
    }
}
__device__ __forceinline__ void gla_scan(GAS bf16_t* KVT, const GAS float* DG, const int tid, const int G) {
    for (int gid = blockIdx.x * (NWAVES * 64) + tid; gid < 16 * 8192; gid += G * NWAVES * 64) {
        const int bh = gid >> 13, off = (gid & 8191) * 4, kq = 16 * (off >> 12) + (off & 15);
        GAS bf16_t* p = KVT + (size_t)bh * 64 * 32768 + off; const GAS float* dp = DG + (size_t)bh * 16 * 128 + kq;
        float z_ = 0.f; asm volatile("" : "+v"(z_));
        f32x4 S = (f32x4){z_, z_, z_, z_};
        u32x2 kv[16]; f32x4 dc[16];
#pragma unroll
        for (int i = 0; i < 16; ++i) { kv[i] = *(const GAS u32x2*)(p + (size_t)(4 * i) * 32768); dc[i] = *(const GAS f32x4*)(dp + i * 128); }
#pragma unroll
        for (int i = 0; i < 16; ++i) {
            u32x2 o; o.x = cvt_pk_bf16(S[0], S[1]); o.y = cvt_pk_bf16(S[2], S[3]);
            *(GAS u32x2*)(p + (size_t)(4 * i) * 32768) = o;
            S[0] = dc[i][0] * S[0] + bf2f((unsigned short)(kv[i].x & 0xffffu)); S[1] = dc[i][1] * S[1] + bf2f((unsigned short)(kv[i].x >> 16));
            S[2] = dc[i][2] * S[2] + bf2f((unsigned short)(kv[i].y & 0xffffu)); S[3] = dc[i][3] * S[3] + bf2f((unsigned short)(kv[i].y >> 16));
        }
    }
}
__device__ __forceinline__ void gla_g3_group(LAS unsigned char* lds, GAS bf16_t* Z, const GAS bf16_t* QK, const GAS bf16_t* KVT, const GAS float* DCC, const GAS float* head_g, const int gitem, const int tid) {
    const int lane = tid & 63, w = __builtin_amdgcn_readfirstlane(tid >> 6); int fr = lane & 15, g = lane >> 4;
    const int bh = gitem >> 4, grp = gitem & 15, h = bh & 3; const size_t mbase = (size_t)(bh >> 2) * SEQ + 256 * grp;
    constexpr int G3_DCC = G3_SSQ + 2048;
    constexpr int G3_ST = 81920;
    const f32x4 hg0 = *(const GAS f32x4*)(head_g + 32 * w + 4 * g), hg1 = *(const GAS f32x4*)(head_g + 32 * w + 16 + 4 * g);
    u32x4 pq[2], pk_[2], pv[4];
#define G3_LOAD(m0_) do { int tl_ = tid; asm volatile("" : "+v"(tl_)); _Pragma("unroll") for (int p = 0; p < 2; ++p) { const int idx = p * 512 + tl_, t = idx >> 4, ch = idx & 15; const GAS bf16_t* src = QK + ((m0_) + t) * 1024 + 128 * h + 8 * ch; pq[p] = *(const GAS u32x4*)src; pk_[p] = *(const GAS u32x4*)(src + 512); } \
        _Pragma("unroll") for (int p = 0; p < 4; ++p) { const int idx = p * 512 + tl_, t = idx >> 5, ch = idx & 31; pv[p] = *(const GAS u32x4*)(Z + ((m0_) + t) * OD_N + 1024 + 256 * h + 8 * ch); } } while (0)
    G3_LOAD(mbase);
    {
        const GAS u32x4* gp = (const GAS u32x4*)(KVT + (size_t)(bh * 64 + 4 * grp) * 32768) + tid; u32x4 sg[8];
#pragma unroll
        for (int i = 0; i < 8; ++i) sg[i] = gp[512 * i];
#pragma unroll
        for (int i = 0; i < 8; ++i) *(LAS u32x4*)(lds + G3_ST + 16 * (tid + 512 * i)) = sg[i];
    }
    for (int cc = 0; cc < 4; ++cc) {
    const size_t m0 = mbase + 64 * cc; const int item = bh * 64 + 4 * grp + cc;
    asm volatile("" : "+v"(fr), "+v"(g));
    const int qq = fr >> 2, pp = fr & 3;
    const int so0 = 2 * ((g >> 1) * 4096 + (32 * w + fr) * 16 + 8 * (g & 1));
    PROBE_T0(50);
#pragma unroll
    for (int p = 0; p < 2; ++p) { const int idx = p * 512 + tid, t = idx >> 4, ch = idx & 15;
        *(LAS u32x4*)(lds + GL_A + t * G3_QSTR + 16 * ch) = pq[p]; *(LAS u32x4*)(lds + G3_KT + t * G3_QSTR + 16 * ch) = pk_[p]; }
#pragma unroll
    for (int p = 0; p < 4; ++p) { const int idx = p * 512 + tid, t = idx >> 5, ch = idx & 31; *(LAS u32x4*)(lds + G3_V + t * GL_VSTR + 16 * ch) = pv[p]; }
    if (tid < 32) *(LAS f32x4*)(lds + G3_DCC + 16 * tid) = *(const GAS f32x4*)(DCC + (size_t)item * 128 + 4 * tid);
    __syncthreads();
    PROBE_T1(50); PROBE_T0(51);
    u32x2 srv[4][2];
#pragma unroll
    for (int tt = 0; tt < 4; ++tt)
#pragma unroll
        for (int vi = 0; vi < 2; ++vi) srv[tt][vi] = *(const GAS u32x2*)(Z + (m0 + 16 * tt + fr) * OD_N + 2048 + 256 * h + 32 * w + 16 * vi + 4 * g);
    __builtin_amdgcn_sched_barrier(0);
    u32x4 pb[4][2];
#pragma unroll
    for (int tt = 0; tt < 4; ++tt) {
        bf16x8 qf[4];
#pragma unroll
        for (int ks = 0; ks < 4; ++ks) qf[ks] = *(const LAS bf16x8*)(lds + GL_A + (16 * tt + fr) * G3_QSTR + 64 * ks + 16 * g);
        u32x2 pk[4];
#pragma unroll
        for (int jt = 0; jt < 4; ++jt) {
            if (jt <= tt) {
                f32x4 c = (f32x4){0.f, 0.f, 0.f, 0.f};
#pragma unroll
                for (int ks = 0; ks < 4; ++ks) c = __builtin_amdgcn_mfma_f32_16x16x32_bf16(*(const LAS bf16x8*)(lds + G3_KT + (16 * jt + fr) * G3_QSTR + 64 * ks + 16 * g), qf[ks], c, 0, 0, 0);
                if (jt == tt) {
#pragma unroll
                    for (int e = 0; e < 4; ++e) c[e] = (4 * g + e <= fr) ? c[e] : 0.f;
                }
                pk[jt].x = cvt_pk_bf16(c[0], c[1]); pk[jt].y = cvt_pk_bf16(c[2], c[3]);
            } else { pk[jt].x = 0u; pk[jt].y = 0u; }
        }
        pb[tt][0] = (u32x4){pk[0].x, pk[0].y, pk[1].x, pk[1].y}; pb[tt][1] = (u32x4){pk[2].x, pk[2].y, pk[3].x, pk[3].y};
    }
    PROBE_T1(51); PROBE_T0(52);
    __builtin_amdgcn_sched_barrier(0);
    f32x4 acc[2][4];
    float ssq[4] = {0.f, 0.f, 0.f, 0.f};
#pragma unroll
    for (int vi = 0; vi < 2; ++vi) {
        const int vt = 2 * w + vi;
        bf16x8 sf[4];
#pragma unroll
        for (int ks = 0; ks < 4; ++ks) sf[ks] = *(const LAS bf16x8*)(lds + G3_ST + so0 + 512 * vi + 16384 * ks);
        const LAS unsigned char* vb = lds + G3_V + (4 * g + qq) * GL_VSTR + 32 * vt + 8 * pp;
        const bf16x8 va = tr_pair(vb, vb + 16 * GL_VSTR), vc = tr_pair(vb + 32 * GL_VSTR, vb + 48 * GL_VSTR);
#pragma unroll
        for (int tt = 0; tt < 4; ++tt) {
            f32x4 c = (f32x4){0.f, 0.f, 0.f, 0.f};
#pragma unroll
            for (int ks = 0; ks < 4; ++ks) c = __builtin_amdgcn_mfma_f32_16x16x32_bf16(sf[ks], *(const LAS bf16x8*)(lds + GL_A + (16 * tt + fr) * G3_QSTR + 64 * ks + 16 * g), c, 0, 0, 0);
            c = __builtin_amdgcn_mfma_f32_16x16x32_bf16(va, __builtin_bit_cast(bf16x8, pb[tt][0]), c, 0, 0, 0);
            if (tt >= 2) c = __builtin_amdgcn_mfma_f32_16x16x32_bf16(vc, __builtin_bit_cast(bf16x8, pb[tt][1]), c, 0, 0, 0);
            acc[vi][tt] = c; ssq[tt] += dot4(c);
        }
    }
    PROBE_T1(52); PROBE_T0(53);
    LAS float* sl = (LAS float*)(lds + G3_SSQ);
#pragma unroll
    for (int tt = 0; tt < 4; ++tt) { float v = ssq[tt]; v += __shfl_xor(v, 16); v += __shfl_xor(v, 32); if (g == 0) sl[w * 64 + 16 * tt + fr] = v; }
    __syncthreads();
    if (cc < 3) G3_LOAD(m0 + 64);
#pragma unroll
    for (int tt = 0; tt < 4; ++tt) {
        float tsum = 0.f;
#pragma unroll
        for (int q = 0; q < 8; ++q) tsum += sl[q * 64 + 16 * tt + fr];
        const float rstd = rsqrtf(tsum * (1.0f / 256.0f) + EPS);
#pragma unroll
        for (int vi = 0; vi < 2; ++vi) {
            const f32x4 hg = (vi == 0) ? hg0 : hg1;
            GAS bf16_t* row = Z + (m0 + 16 * tt + fr) * OD_N + 256 * h + 32 * w + 16 * vi + 4 * g;
            const u32x2 sr = srv[tt][vi];
            const f32x4 c = acc[vi][tt];
            u32x2 o; o.x = cvt_pk_bf16(c[0] * rstd * hg[0] * bf2f((unsigned short)(sr.x & 0xffffu)), c[1] * rstd * hg[1] * bf2f((unsigned short)(sr.x >> 16)));
            o.y = cvt_pk_bf16(c[2] * rstd * hg[2] * bf2f((unsigned short)(sr.y & 0xffffu)), c[3] * rstd * hg[3] * bf2f((unsigned short)(sr.y >> 16)));
            *(GAS u32x2*)(row + 1024) = o;
        }
    }
    if (cc < 3) {
        __builtin_amdgcn_sched_barrier(0);
        const LAS unsigned char* ka = lds + G3_KT + (8 * g + qq) * G3_QSTR + 32 * w + 8 * pp;
        const bf16x8 a0 = tr_pair(ka, ka + 4 * G3_QSTR), a1 = tr_pair(ka + 32 * G3_QSTR, ka + 36 * G3_QSTR);
        const f32x4 dcv = *(const LAS f32x4*)(lds + G3_DCC + 4 * (16 * w + 4 * g));
        const LAS unsigned char* vb = lds + G3_V + (8 * g + qq) * GL_VSTR + 8 * pp;
        LAS unsigned char* stp = lds + G3_ST + 2 * (w * 4096 + fr * 16 + 4 * g);
#pragma unroll
        for (int vt = 0; vt < 16; ++vt) {
            const u32x2 ov = *(const LAS u32x2*)(stp + 512 * vt);
            f32x4 c = (f32x4){bf2f((unsigned short)(ov.x & 0xffffu)), bf2f((unsigned short)(ov.x >> 16)), bf2f((unsigned short)(ov.y & 0xffffu)), bf2f((unsigned short)(ov.y >> 16))};
            c = __builtin_amdgcn_mfma_f32_16x16x32_bf16(a0, tr_pair(vb + 32 * vt, vb + 4 * GL_VSTR + 32 * vt), c, 0, 0, 0);
            c = __builtin_amdgcn_mfma_f32_16x16x32_bf16(a1, tr_pair(vb + 32 * GL_VSTR + 32 * vt, vb + 36 * GL_VSTR + 32 * vt), c, 0, 0, 0);
            c = c * dcv;
            u32x2 o; o.x = cvt_pk_bf16(c[0], c[1]); o.y = cvt_pk_bf16(c[2], c[3]);
            *(LAS u32x2*)(stp + 512 * vt) = o;
        }
    }
    __syncthreads();
    PROBE_T1(53);
    }
#undef G3_LOAD
}
__device__ __forceinline__ void ga_group(LAS unsigned char* lds, const GAS bf16_t* XB, const GAS float* RSQ, const GAS bf16_t* WGA, GAS float* GA, const int grp, const int tid) {
    const int lane = tid & 63, w = __builtin_amdgcn_readfirstlane(tid >> 6), fr = lane & 15, g = lane >> 4, tt = w & 3, kh = w >> 2;
    const GAS bf16_t* ap = XB + (size_t)(64 * grp + 16 * tt + fr) * D + 512 * kh + 8 * g; const GAS bf16_t* bp = WGA + (size_t)fr * D + 512 * kh + 8 * g;
    f32x4 c = (f32x4){0.f, 0.f, 0.f, 0.f};
#pragma unroll 4
    for (int ks = 0; ks < 16; ++ks) c = __builtin_amdgcn_mfma_f32_16x16x32_bf16(*(const GAS bf16x8*)(ap + 32 * ks), *(const GAS bf16x8*)(bp + 32 * ks), c, 0, 0, 0);
    LAS float* pl = (LAS float*)lds;
#pragma unroll
    for (int e = 0; e < 4; ++e) pl[(kh * 64 + 16 * tt + 4 * g + e) * 16 + fr] = c[e];
    __syncthreads();
    for (int i = tid; i < 64 * 16; i += NWAVES * 64) {
        const int t = i >> 4; const size_t row = (size_t)64 * grp + t;
        float s = 0.f;
#pragma unroll
        for (int q = 0; q < 4; ++q) s += sum4(*(const GAS f32x4*)(RSQ + row * 16 + 4 * q));
        GA[row * 16 + (i & 15)] = (pl[i] + pl[1024 + i]) * rsqrtf(s * (1.0f / 1024.0f) + EPS);
    }
    __syncthreads();
}

constexpr int RING_BYTES = 131072, LDSCTL_OFF = RING_BYTES, MISC_OFF = 163840 - 512, LDSX_OFF = RING_BYTES + 1024, RSTD_OFF = RING_BYTES + 5120, PAR_OFF = RING_BYTES + 13312, LDS_BYTES = 163840;
constexpr int NPHASE = 1 + 8 * DEPTH;
struct Args { const float* in[21]; float* out; unsigned char* ws; int ph_lo, ph_hi, li, pad; };

#define GIN(i) ((const GAS float*)inp[i])
#define MIXW_ITEM(e_, kind_, r_) do { const int _e = (e_), _r = (r_); \
        if ((kind_) == 0) conv_block_item(lds, GIN(3) + (size_t)_e * D * EV_N, nullptr, EV_N, D, EV_N, GIN(1) + (size_t)(2 * _e) * D, (GAS bf16_t*)(ws + WS_WMIX + OFF_EVIN) + (size_t)_e * EV_N * D, 1, _r, tid); \
        else if ((kind_) == 1) conv_block_item(lds, GIN(10) + (size_t)_e * D * D, nullptr, D, D, D, nullptr, (GAS bf16_t*)(ws + WS_WMIX + OFF_EVOUT) + (size_t)_e * D * D, 0, _r, tid); \
        else if ((kind_) == 2) conv_block_item(lds, GIN(11) + (size_t)_e * D * OD_NSRC, nullptr, OD_NSRC, D, OD_N, GIN(1) + (size_t)(2 * _e + 1) * D, (GAS bf16_t*)(ws + WS_WMIX + OFF_ODIN) + (size_t)_e * OD_N * D, 0, _r, tid); \
        else conv_block_item(lds, GIN(15) + (size_t)_e * D * D, nullptr, D, D, D, nullptr, (GAS bf16_t*)(ws + WS_WMIX + OFF_ODOUT) + (size_t)_e * D * D, 0, _r, tid); } while (0)
constexpr int MIXW_EVIN = 8 * (EV_N / 128), MIXW_SQ = 64, MIXW_ODIN = 8 * (OD_N / 128);
__global__ void __launch_bounds__(NWAVES * 64, 2) mega(Args args) {
    extern __shared__ __attribute__((aligned(16))) unsigned char lds_raw[];
    LAS unsigned char* lds = (LAS unsigned char*)lds_raw;
    volatile LAS unsigned* MISC = (volatile LAS unsigned*)(lds + MISC_OFF);
    const int Gk = gridDim.x;
    unsigned* ctl = (unsigned*)(args.ws + WS_CTL);
    for (int u = threadIdx.x; u < (LDS_BYTES - LDSCTL_OFF) / 4; u += NWAVES * 64) ((LAS unsigned*)(lds + LDSCTL_OFF))[u] = 0u;
    __syncthreads();
    XcdBarrier bar = xcd_barrier_post(ctl + CW_BAR + args.li * XCD_BAR_WORDS, MISC + 8);
    if (threadIdx.x == 0) { MISC[12] = bar.x; MISC[13] = xb_add(ctl + CW_CENSUS + 64 * bar.x, 1u); }
    __syncthreads();
    int vb = blockIdx.x; bool vb_done = false, local_ok = false;

    typedef const float* cfp_t;
    const __attribute__((address_space(4))) cfp_t* inp0 = (const __attribute__((address_space(4))) cfp_t*)__builtin_amdgcn_kernarg_segment_ptr();

    bool first = true;
    for (int ph = args.ph_lo; ph < args.ph_hi; ++ph) {
        if (ph > 0) { const int L_ = (ph - 1) >> 3, sub_ = (ph - 1) & 7; if (sub_ == 6 || ((L_ & 1) == 0 && sub_ == 3)) continue; }
        if (!first) {
            PROBE_T0(30);
            const int sub_b = (ph - 1) & 7;
            if (local_ok && (sub_b == 5 || sub_b == 7 || (sub_b == 0 && ph > 1) || (Gk == 256 && (sub_b == 4 || (sub_b == 2 && ((((ph - 1) >> 3) & 1) == 0)))))) xcd_local_barrier(bar);
            else xcd_barrier(bar);
            PROBE_T1(30);
            if (!vb_done) {
                if (threadIdx.x == 0) {
                    bool ok = (Gk % 8) == 0;
                    for (int j = 0; j < 8; ++j) ok = ok && (xb_ld(ctl + CW_CENSUS + 64 * j) == (unsigned)(Gk / 8));
                    MISC[14] = ok ? 1u : 0u; MISC[15] = ok ? (MISC[13] * 8u + MISC[12]) : (unsigned)blockIdx.x;
                }
                __syncthreads();
                vb = (int)MISC[15]; local_ok = MISC[14] != 0u; vb_done = true;
            }
        }
        first = false;
        const __attribute__((address_space(4))) cfp_t* inp = inp0; asm volatile("" : "+s"(inp));
        unsigned char* ws = args.ws; asm volatile("" : "+s"(ws));
        int G = Gk; asm volatile("" : "+s"(G));
        int bid = blockIdx.x; asm volatile("" : "+s"(bid));
        int tid = threadIdx.x; asm volatile("" : "+v"(tid));
        const int lane = tid & 63, wave = __builtin_amdgcn_readfirstlane(tid >> 6);
        const int gw = bid * NWAVES + wave, NGW = G * NWAVES;
        LAS float* scr = (LAS float*)(lds + wave * 16384);
        GAS float* X = (GAS float*)args.out; asm volatile("" : "+s"(X));
        GAS bf16_t* XB = (GAS bf16_t*)(ws + WS_XB); GAS bf16_t* Z = (GAS bf16_t*)(ws + WS_Z);
        GAS float* RSQ = (GAS float*)(ws + WS_RSQ); GAS float* LNP = (GAS float*)(ws + WS_LNP);
        GAS float* DCCP = (GAS float*)((GAS unsigned char*)X + 50 * MiB);
        GAS float* HALO = (GAS float*)(ws + WS_HALO); GAS float* FIXP = (GAS float*)(ws + WS_FIXP); GAS float* FIXU = (GAS float*)(ws + WS_FIXU);
#define WBUF(l_) (((l_) & 1) ? (GAS bf16_t*)(ws + WS_WFFN) : (GAS bf16_t*)((GAS unsigned char*)X + 32 * MiB))
        const int Lcur = (ph > 0) ? ((ph - 1) >> 3) : 0;
        GAS bf16_t* WGU = WBUF(Lcur); GAS bf16_t* WDN = WGU + (size_t)GU_N * D;
        PROBE_T0(ph == 0 ? 0 : ((((ph - 1) >> 3) & 1) ? 20 : 10) + ((ph - 1) & 7));
        if (ph == 0) {
            for (int it = bid; it < MIXW_EVIN + MIXW_ODIN; it += G) { if (it < MIXW_EVIN) MIXW_ITEM(0, 0, it); else MIXW_ITEM(0, 2, it - MIXW_EVIN); }
            for (int i = bid * (NWAVES * 64) + tid; i < 2 * 8 * 128 * 128; i += G * NWAVES * 64) {
                const int tt = (i >> 7) & 127, ss = i & 127;
                ((GAS bf16_t*)(ws + WS_SMALLW))[i] = (bf16_t)((ss <= tt) ? f2bf(GIN(6)[i]) : 0u);
            }
            for (int i = bid * (NWAVES * 64) + tid; i < 2 * 16 * 1024; i += G * NWAVES * 64) {
                const int o = i >> 14, j = (i >> 10) & 15, k = i & 1023;
                ((GAS bf16_t*)(ws + WS_SMALLW + 512 * 1024))[i] = (bf16_t)f2bf(GIN(11)[((size_t)o * D + k) * OD_NSRC + 3072 + j] * GIN(1)[(size_t)(2 * o + 1) * D + k]);
            }
            for (int m = gw; m < M; m += NGW) {
                const f32x4* xr = (const f32x4*)(GIN(0) + (size_t)m * D) + lane; f32x4 v[4]; float s = 0.f;
#pragma unroll
                for (int j = 0; j < 4; ++j) { v[j] = xr[64 * j]; s += dot4(v[j]); }
#pragma unroll
                for (int o = 1; o < 64; o <<= 1) s += __shfl_xor(s, o);
                u32x2* o8 = (u32x2*)(XB + (size_t)m * D) + lane;
#pragma unroll
                for (int j = 0; j < 4; ++j) { u32x2 w; w.x = pk2(v[j][0], v[j][1]); w.y = pk2(v[j][2], v[j][3]); o8[64 * j] = w; }
                if (lane < 16) RSQ[(size_t)m * 16 + lane] = (lane == 0) ? s : 0.f;
            }
        } else {
            const int L = (ph - 1) >> 3, sub = (ph - 1) & 7, e = L >> 1; const bool even = (L & 1) == 0;
            if (sub == 0) {
                pg8::StaticOrder S;
                if (even) {
                    pg8::Gemm g{(const bf16_t*)XB, (const bf16_t*)(ws + WS_WMIX + OFF_EVIN) + (size_t)e * EV_N * D, M, EV_N, D, D}; S.init(M, EV_N, G, vb);
                    stage_rstd(lds, RSQ, tid, vb);
                    if (tid < 128) ((LAS float*)(lds + PAR_OFF))[tid] = (tid < 64) ? GIN(8)[e * 64 + tid] * (0.125f * 1.4426950408889634f) : GIN(9)[e * 64 + tid - 64];
                    __syncthreads();
                    EpiEvenIn E{Z, (const LAS float*)(lds + RSTD_OFF), LNP, (const LAS float*)(lds + PAR_OFF)};
                    pg8::gemm_phase<EpiEvenIn>(lds, g, S, E, tid);
                    {
                        Unit tu; int nun = 0; while (S.next(nun, tu)) ++nun;
                        int nshort = 0, myrank = -1;
                        const int umax = (640 + G - 1) / G, full = 640 - (umax - 1) * G;
                        if (umax * G != 640) { nshort = G - full; myrank = (nun < umax) ? (vb - full) : -1; }
                        if (nshort == 0) { nshort = G; myrank = bid; }
                        if (myrank >= 0) {
                            constexpr int I_GU = 8 * (GU_N / 128), I_DN = (FF / 128) * 8;
                            const GAS float* wg = GIN(16) + (size_t)L * D * FF; const GAS float* wu = GIN(17) + (size_t)L * D * FF; const GAS float* wd = GIN(20) + (size_t)L * FF * D;
                            if (L == 0) {
                                for (int it = myrank; it < I_GU + I_DN + MIXW_SQ; it += nshort) {
                                    if (it < I_GU) conv_block_item(lds, wg, wu, FF, D, GU_N, GIN(2) + (size_t)L * D, WGU, 2, it, tid);
                                    else if (it < I_GU + I_DN) conv_block_item(lds, wd, nullptr, D, FF, D, nullptr, WDN, 0, it - I_GU, tid);
                                    else MIXW_ITEM(0, 1, it - I_GU - I_DN);
                                }
                            } else {
                                for (int it = myrank; it < MIXW_ODIN + MIXW_SQ; it += nshort) { if (it < MIXW_ODIN) MIXW_ITEM(1, 2, it); else MIXW_ITEM(1, 3, it - MIXW_ODIN); }
                            }
                        }
                    }
                } else {
                    pg8::Gemm g{(const bf16_t*)XB, (const bf16_t*)(ws + WS_WMIX + OFF_ODIN) + (size_t)e * OD_N * D, M, OD_N, D, D}; S.init(M, OD_N, G, vb);
                    stage_rstd(lds, RSQ, tid, vb);
                    __syncthreads();
                    EpiOddIn E{Z, (const LAS float*)(lds + RSTD_OFF)};
                    pg8::gemm_phase<EpiOddIn>(lds, g, S, E, tid);
                    for (int grp = 32 * (vb & 7) + (vb >> 3); grp < M / 64; grp += G) ga_group(lds, XB, RSQ, (const GAS bf16_t*)(ws + WS_SMALLW + 512 * 1024) + (size_t)e * 16 * D, (GAS float*)(ws + WS_GA), grp, tid);
                }
            } else if (sub == 1) {
                if (even) {
                    GAS bf16_t* P1 = (GAS bf16_t*)(ws + WS_AUX); GAS bf16_t* P2 = (GAS bf16_t*)(ws + WS_AUX + 16 * MiB); GAS float* L1 = (GAS float*)(ws + WS_AUX + 32 * MiB); GAS float* L2 = L1 + (size_t)M * 8;
                    const bool sm = local_ok && G == 256;
                    const int xmap = sm ? (vb & 7) : -1, jmap = vb >> 3;
                    const int cnt = sm ? 4 : (1024 - bid + G - 1) / G;
                    attn_run<false>(lds, Z, 0, bid, cnt, G, xmap, jmap, P1, L1, nullptr, nullptr, nullptr, nullptr, tid);
                    attn_run<false>(lds, Z, 2, bid, cnt, G, xmap, jmap, P2, L2, nullptr, nullptr, nullptr, nullptr, tid);
                    gmlp_run(lds, Z, LNP, GIN(4) + e * 512, GIN(5) + e * 512, (const GAS bf16_t*)(ws + WS_SMALLW) + (size_t)e * 8 * 128 * 128, GIN(7) + e * 8 * 128, cnt,
                             [=](const int i) { const int q = jmap + 32 * i; return sm ? (16 * xmap + (q >> 3)) * 8 + (q & 7) : bid + i * G; }, tid);
                } else {
                    for (int it = bid; it < 256; it += G) gla_g1_group(lds, Z, (const GAS float*)(ws + WS_GA), GIN(12) + (size_t)e * 16 * 512, GIN(13) + e * 512, (GAS bf16_t*)(ws + WS_AUX), DCCP, DCCP + 131072, (GAS bf16_t*)X, it, tid);
                }
            } else if (sub == 2 && even) {
                const GAS bf16_t* P1 = (const GAS bf16_t*)(ws + WS_AUX); const GAS bf16_t* P2 = (const GAS bf16_t*)(ws + WS_AUX + 16 * MiB); const GAS float* L1 = (const GAS float*)(ws + WS_AUX + 32 * MiB); const GAS float* L2 = L1 + (size_t)M * 8;
                const bool sm = local_ok && G == 256;
                attn_run<true>(lds, Z, 4, bid, sm ? 4 : (1024 - bid + G - 1) / G, G, sm ? (vb & 7) : -1, vb >> 3, nullptr, nullptr, P1, P2, L1, L2, tid);
                if (sm) done_arrive(ctl + CW_DONE + 64 * (L * 8 + (vb & 7)));
            } else if (sub == 2) {
                gla_scan((GAS bf16_t*)(ws + WS_AUX), DCCP + 131072, tid, G);
            } else if (sub == 3) {
                if (local_ok && G == 256) {
                    const int x = vb & 7, j = vb >> 3;
                    gla_g3_group(lds, Z, (const GAS bf16_t*)X, (const GAS bf16_t*)(ws + WS_AUX), DCCP, GIN(14) + e * 256, (((x >> 1) * 4 + (j >> 3)) << 4) + 8 * (x & 1) + (j & 7), tid);
                    if (L == DEPTH - 1) done_arrive(ctl + CW_DONE + 64 * 32);
                } else
                for (int it = bid; it < 256; it += G) gla_g3_group(lds, Z, (const GAS bf16_t*)X, (const GAS bf16_t*)(ws + WS_AUX), DCCP, GIN(14) + e * 256, it, tid);
            } else if (sub == 4 || sub == 7) {
                pg8::StaticOrder S; S.init(M, D, G, vb);
                if (sub == 7 && L == DEPTH - 1 && local_ok && G == 256) done_wait(ctl + CW_DONE + 64 * 32, 256u);
                if (sub == 7) {
                    const GAS float* cw = GIN(18) + (size_t)L * 3 * FF; Unit fu;
                    for (int i = 0; S.next(i, fu); ++i) {
                        const int pm = fu.pm; if ((pm & 15) == 0) continue;
                        const bool xc = (pm & 7) == 0;
                        if (xc) {
                            if (tid == 0) { unsigned* cw_ = ctl + CW_HCNT + L * 4096 + 64 * (pm - 1); unsigned sp_ = 0;
                                while (__hip_atomic_load(cw_, __ATOMIC_RELAXED, __HIP_MEMORY_SCOPE_AGENT) < (unsigned)(GU_N / 256)) { __builtin_amdgcn_s_sleep(2); if (++sp_ > (1u << 22)) break; }
                                __builtin_amdgcn_fence(__ATOMIC_ACQUIRE, "agent"); asm volatile("s_waitcnt vmcnt(0)" ::: "memory"); }
                            __syncthreads();
                        }
                        for (int idx = tid; idx < 2 * FF; idx += NWAVES * 64) {
                            const int j = idx / FF, c = idx % FF;
                            float h1, h0;
                            if (xc) { h1 = __builtin_bit_cast(float, __hip_atomic_load((const GAS unsigned*)(HALO + ((size_t)(pm - 1) * 2 + 1) * FF + c), __ATOMIC_RELAXED, __HIP_MEMORY_SCOPE_AGENT));
                                      h0 = __builtin_bit_cast(float, __hip_atomic_load((const GAS unsigned*)(HALO + ((size_t)(pm - 1) * 2 + 0) * FF + c), __ATOMIC_RELAXED, __HIP_MEMORY_SCOPE_AGENT)); }
                            else { h1 = HALO[((size_t)(pm - 1) * 2 + 1) * FF + c]; h0 = HALO[((size_t)(pm - 1) * 2 + 0) * FF + c]; }
                            float pre = FIXP[((size_t)pm * 2 + j) * FF + c];
                            if (j == 0) pre += cw[FF + c] * h1 + cw[c] * h0; else pre += cw[c] * h1;
                            Z[(size_t)(pm * 256 + j) * ZLD + c] = (bf16_t)f2bf(silu_f(pre) * FIXU[((size_t)pm * 2 + j) * FF + c]);
                        }
                    }
                    asm volatile("s_waitcnt vmcnt(0)" ::: "memory"); __syncthreads();
                }
                pg8::Gemm g;
                if (sub == 7) g = pg8::Gemm{(const bf16_t*)Z, (const bf16_t*)WDN, M, D, FF, ZLD};
                else if (even) g = pg8::Gemm{(const bf16_t*)Z, (const bf16_t*)(ws + WS_WMIX + OFF_EVOUT) + (size_t)e * D * D, M, D, D, ZLD};
                else g = pg8::Gemm{(const bf16_t*)(Z + 1024), (const bf16_t*)(ws + WS_WMIX + OFF_ODOUT) + (size_t)e * D * D, M, D, D, OD_N};
                const bool first_upd = (L == 0 && sub == 4), last_upd = (L == DEPTH - 1 && sub == 7);
                EpiRes E{first_upd ? GIN(0) : (const GAS float*)nullptr, (const GAS bf16_t*)XB, last_upd ? X : (GAS float*)nullptr, XB, RSQ};
                pg8::gemm_phase<EpiRes>(lds, g, S, E, tid);
            } else if (sub == 5) {
                if (even && local_ok && G == 256 && (vb & 1) == 0) done_wait(ctl + CW_DONE + 64 * (L * 8 + (vb & 7) + 1), 32u);
                pg8::StaticOrder S; S.init(M, GU_N, G, vb);
                pg8::Gemm g{(const bf16_t*)XB, (const bf16_t*)WGU, M, GU_N, D, D};
                stage_rstd(lds, RSQ, tid, vb);
                {
                    const GAS float* cw = GIN(18) + (size_t)L * 3 * FF; const GAS float* cb = GIN(19) + (size_t)L * FF; Unit pu;
                    for (int i = 0; S.next(i, pu); ++i) { const int arr = tid >> 7, j = tid & 127; ((LAS float*)(lds + PAR_OFF))[i * 512 + tid] = (arr < 3) ? cw[arr * FF + 128 * pu.pn + j] : cb[128 * pu.pn + j]; }
                }
                __syncthreads();
                EpiF1 E{Z, (const LAS float*)(lds + RSTD_OFF), (const LAS float*)(lds + PAR_OFF), HALO, FIXP, FIXU, (LAS float*)(lds + LDSX_OFF), ctl + CW_HCNT + L * 4096};
                pg8::gemm_phase<EpiF1>(lds, g, S, E, tid);
                if (L + 1 < DEPTH) {
                    constexpr int NT = (M / 256) * (GU_N / 256);
                    Unit tu; int nun = 0; while (S.next(nun, tu)) ++nun;
                    const int umax = (NT + G - 1) / G, full = NT - (umax - 1) * G;
                    int nshort = G, myrank = bid;
                    if (umax * G != NT) { nshort = G - full; myrank = (nun < umax) ? (vb - full) : -1; }
                    if (myrank >= 0) {
                        constexpr int I_GU = 8 * (GU_N / 128), I_DN = (FF / 128) * 8;
                        const int Ln = L + 1;
                        const GAS float* wg = GIN(16) + (size_t)Ln * D * FF; const GAS float* wu = GIN(17) + (size_t)Ln * D * FF; const GAS float* wd = GIN(20) + (size_t)Ln * FF * D;
                        GAS bf16_t* ngu = WBUF(Ln); GAS bf16_t* ndn = ngu + (size_t)GU_N * D;
                        const int extra = (L == 0) ? MIXW_SQ + MIXW_EVIN : (L == 1) ? MIXW_SQ : 0;
                        for (int it = myrank; it < I_GU + I_DN + extra; it += nshort) {
                            if (it < I_GU) conv_block_item(lds, wg, wu, FF, D, GU_N, GIN(2) + (size_t)Ln * D, ngu, 2, it, tid);
                            else if (it < I_GU + I_DN) conv_block_item(lds, wd, nullptr, D, FF, D, nullptr, ndn, 0, it - I_GU, tid);
                            else if (L == 1) MIXW_ITEM(1, 1, it - I_GU - I_DN);
                            else if (it < I_GU + I_DN + MIXW_SQ) MIXW_ITEM(0, 3, it - I_GU - I_DN);
                            else MIXW_ITEM(1, 0, it - I_GU - I_DN - MIXW_SQ);
                        }
                    }
                }
            }
        }
        PROBE_T1(ph == 0 ? 0 : ((((ph - 1) >> 3) & 1) ? 20 : 10) + ((ph - 1) & 7));
    }
    if (PROBE_ID >= 0 && blockIdx.x == 0 && threadIdx.x == 0) {
        const unsigned long long dt = *(volatile LAS unsigned long long*)(probe_lds), t0 = __builtin_amdgcn_s_memrealtime();
        while (__builtin_amdgcn_s_memrealtime() - t0 < PROBE_K * dt) __builtin_amdgcn_s_sleep(8);
    }
}

extern "C" void kernel_launch(void* const* d_in, const int* in_sizes, int n_in, void* d_out, int out_size, void* d_ws, size_t ws_size, hipStream_t stream) {
    static int grid = 0;
    if (grid == 0) {
        if (n_in != 21 || out_size != M * D || ws_size < WS_END) { fprintf(stderr, "kernel_launch: unexpected shapes (n_in %d out %d ws %zu)\n", n_in, out_size, ws_size); grid = -1; return; }
        int dev = 0, cus = 0, per_cu = 0;
        hipGetDevice(&dev); hipDeviceGetAttribute(&cus, hipDeviceAttributeMultiprocessorCount, dev);
        hipFuncSetAttribute((const void*)mega, hipFuncAttributeMaxDynamicSharedMemorySize, LDS_BYTES);
        hipOccupancyMaxActiveBlocksPerMultiprocessor(&per_cu, (const void*)mega, NWAVES * 64, LDS_BYTES);
        (void)hipGetLastError();
        if (per_cu < 1) per_cu = 1;
        if (per_cu > 1) per_cu = 1;
        grid = cus * per_cu;
        fprintf(stderr, "kernel_launch: grid %d (cus %d), ws %zu\n", grid, cus, ws_size);
    }
    if (grid < 0) return;
    hipMemsetAsync((char*)d_ws + WS_CTL, 0, CTL_ZERO_BYTES, stream);
    Args a{};
    for (int i = 0; i < 21; ++i) a.in[i] = (const float*)d_in[i];
    a.out = (float*)d_out; a.ws = (unsigned char*)d_ws;
    a.ph_lo = 0; a.ph_hi = NPHASE; a.li = 0;
    void* kargs[] = {&a};
    hipError_t le = hipLaunchCooperativeKernel((const void*)mega, dim3(grid), dim3(NWAVES * 64), kargs, LDS_BYTES, stream);
    if (le != hipSuccess) fprintf(stderr, "cooperative launch failed: %s\n", hipGetErrorString(le));
}
```

```cpp
#include <hip/hip_runtime.h>
#include <cstdio>
#include <cstdint>

#define LAS __attribute__((address_space(3)))
#define GAS __attribute__((address_space(1)))
typedef unsigned short bf16_t;
typedef short bf16x8 __attribute__((ext_vector_type(8)));
typedef float f32x4 __attribute__((ext_vector_type(4)));
typedef float f32x2 __attribute__((ext_vector_type(2)));
typedef unsigned u32x4 __attribute__((ext_vector_type(4)));
typedef unsigned u32x2 __attribute__((ext_vector_type(2)));

constexpr int D = 1024, BATCH = 4, SEQ = 4096, M = BATCH * SEQ, DEPTH = 4;
constexpr int EV_N = 2560, OD_N = 3072, OD_NSRC = 3088, FF = 2816, GU_N = 2 * FF;
constexpr int ZLD = 3072;
constexpr float EPS = 1e-6f;

constexpr size_t MiB = 1u << 20;
constexpr size_t WS_CTL = 0, CTL_ZERO_BYTES = 192 * 1024;
constexpr size_t WS_RSQ = 1 * MiB;
constexpr size_t WS_LNP = 2 * MiB;
constexpr size_t WS_GA = 3 * MiB;
constexpr size_t WS_HALO = 4 * MiB;
constexpr size_t WS_FIXP = 6 * MiB;
constexpr size_t WS_FIXU = 8 * MiB;
constexpr size_t WS_SMALLW = 10 * MiB;
constexpr size_t WS_WMIX = 12 * MiB;
constexpr size_t OFF_EVIN = 0, OFF_EVOUT = 10 * MiB, OFF_ODIN = 14 * MiB, OFF_ODOUT = 26 * MiB;
constexpr size_t WS_WFFN = 42 * MiB;
constexpr size_t OFF_WDOWN = 11 * MiB;
constexpr size_t WS_XB = 60 * MiB;
constexpr size_t WS_Z = 92 * MiB;
constexpr size_t WS_AUX = 188 * MiB;
constexpr size_t WS_END = 252 * MiB;
constexpr int CW_BAR = 4096, CW_CENSUS = 2048, CW_HCNT = 16384, CW_DONE = 40960;

constexpr int NWAVES = 8;
#define probe_lds ((LAS unsigned char*)(163840 - 512 + 64))
constexpr int RSTD_OFF_ = 131072 + 5120, PAR_OFF_ = 131072 + 13312;
#ifndef PROBE_ID
#define PROBE_ID -1
#endif
#ifndef PROBE_K
#define PROBE_K 8
#endif
#define PROBE_T0(id) do { if ((id) == PROBE_ID && blockIdx.x == 0 && threadIdx.x == 0) { *(volatile LAS unsigned long long*)(probe_lds + 8) = __builtin_amdgcn_s_memrealtime(); } } while (0)
#define PROBE_T1(id) do { if ((id) == PROBE_ID && blockIdx.x == 0 && threadIdx.x == 0) { *(volatile LAS unsigned long long*)(probe_lds) += __builtin_amdgcn_s_memrealtime() - *(volatile LAS unsigned long long*)(probe_lds + 8); } } while (0)
__device__ __forceinline__ unsigned f2bf(float f) { unsigned u = __builtin_bit_cast(unsigned, f); return (u + 0x7fffu + ((u >> 16) & 1u)) >> 16; }
__device__ __forceinline__ unsigned pk2(float lo, float hi) { return f2bf(lo) | (f2bf(hi) << 16); }
__device__ __forceinline__ float bf2f(unsigned short h) { return __builtin_bit_cast(float, (unsigned)h << 16); }
typedef __bf16 bf2_t __attribute__((ext_vector_type(2)));
__device__ __forceinline__ unsigned cvt_pk_bf16(float lo, float hi) { const bf2_t r = __builtin_convertvector((f32x2){lo, hi}, bf2_t); return __builtin_bit_cast(unsigned, r); }
__device__ __forceinline__ float silu_f(float x) { return x * __builtin_amdgcn_rcpf(1.0f + __expf(-x)); }
__device__ __forceinline__ f32x2 gelu_pk(f32x2 v) {
    const f32x2 z0 = v * 0.70710678118f;
    f32x2 z; z.x = __builtin_amdgcn_fmed3f(z0.x, -3.0f, 3.0f); z.y = __builtin_amdgcn_fmed3f(z0.y, -3.0f, 3.0f);
    const f32x2 sv = (z * z) * 0.22222222222f + (-1.0f);
    f32x2 p = sv * 0.0065809390507638454f + (-0.01773315854370594f);
    p = p * sv + 0.024549897760152817f; p = p * sv + (-0.039930570870637894f); p = p * sv + 0.0718911811709404f; p = p * sv + (-0.11105967313051224f);
    p = p * sv + 0.15764106810092926f; p = p * sv + (-0.22873686254024506f); p = p * sv + 0.4701276421546936f;
    const f32x2 e = p * z, hx = v * 0.5f;
    return e * hx + hx;
}
__device__ __forceinline__ f32x4 gelu4(f32x4 v) { f32x2 a = gelu_pk((f32x2){v[0], v[1]}), b = gelu_pk((f32x2){v[2], v[3]}); return (f32x4){a.x, a.y, b.x, b.y}; }
__device__ __forceinline__ float sum4(f32x4 v) { return (v[0] + v[1]) + (v[2] + v[3]); }
__device__ __forceinline__ float dot4(f32x4 v) { return (v[0] * v[0] + v[1] * v[1]) + (v[2] * v[2] + v[3] * v[3]); }
__device__ __forceinline__ u32x4 pack8(f32x4 a, f32x4 b) { u32x4 w; w.x = cvt_pk_bf16(a[0], a[1]); w.y = cvt_pk_bf16(a[2], a[3]); w.z = cvt_pk_bf16(b[0], b[1]); w.w = cvt_pk_bf16(b[2], b[3]); return w; }

namespace pg8 {
constexpr int BM = 256, BK = 64, HALF = 128, HTB = HALF * BK * 2, STAGE_BYTES = 8 * HTB, NXCD = 8, WGM = 8;
__host__ __device__ __forceinline__ int lds_byte(int r, int c) { const int st = (r >> 4) * 2 + (c >> 5), rr = r & 15, cc = c & 31, ob = rr * 64 + cc * 2; return st * 1024 + (ob ^ (((ob >> 9) & 1) << 5)); }
__host__ __device__ __forceinline__ void stage_rc(int b, int& R, int& C) { const int st = b / 1024, sb = b % 1024, swz = sb ^ (((sb >> 9) & 1) << 5); R = (st >> 1) * 16 + swz / 64; C = (st & 1) * 32 + (swz % 64) / 2; }
__host__ __device__ __forceinline__ int perm32(int rho) { const int n = rho >> 4, i = rho & 15; return 8 * (i >> 2) + 4 * n + (i & 3); }
struct Unit { int pm, pn, ui; };
struct Gemm { const bf16_t* A; const bf16_t* Bt; int M, N, K, lda; };
struct StaticOrder {
    int nM, nN, nwg, G, c;
    __device__ void init(int M_, int N_, int G_, int c_) { nM = M_ / BM; nN = N_ / BM; nwg = nM * nN; G = G_; c = c_; }
    __device__ bool next(int i, Unit& u) const {
        const long L = (long)i * G + c; if (L >= nwg) return false;
        int wgid = (int)L; { const int q = nwg / NXCD, r = nwg % NXCD, xcd = wgid % NXCD, off = wgid / NXCD; wgid = (xcd < r ? xcd * (q + 1) : r * (q + 1) + (xcd - r) * q) + off; }
        const int nig = WGM * nN, gid = wgid / nig, fm = gid * WGM, gsz = (nM - fm) < WGM ? (nM - fm) : WGM;
        u.pm = fm + ((wgid % nig) % gsz); u.pn = (wgid % nig) / gsz; u.ui = i; return true;
    }
};
template <class Epi>
__device__ __forceinline__ void gemm_phase(LAS unsigned char* lds, const Gemm g, const StaticOrder& S, const Epi& E, const int tid) {
    const int wid = __builtin_amdgcn_readfirstlane(tid >> 6), lane = tid & 63, wr = wid >> 2, wc = wid & 3, fr = lane & 15, fq = lane >> 4;
    const int K = g.K, nt = K / BK, lda = g.lda;
    unsigned voffA[2], voffB[2];
#pragma unroll
    for (int i = 0; i < 2; ++i) { int R, C; stage_rc(tid * 16 + i * 8192, R, C); const int Rb = (R & ~31) + perm32(R & 31);
        voffA[i] = (unsigned)(R * lda + C) * 2u; voffB[i] = (unsigned)(Rb * K + C) * 2u; }
    const size_t kstep = (size_t)(BK * 2);
    const size_t hstepA = (size_t)HALF * lda * 2, hstepB = (size_t)HALF * K * 2;
    const size_t tstepA = 2 * hstepA, tstepB = 2 * hstepB;
    const unsigned ldsw = (unsigned)wid * 1024u;
    const int aoff = lds_byte(wr * 64 + fr, fq * 8), boff = lds_byte(wc * 32 + fr, fq * 8);
#define PG8_SA(b, h) (((b) * 2 + (h)) * HTB)
#define PG8_SB(b, h) ((4 + (b) * 2 + (h)) * HTB)
#define PG8_STAGE(bufoff, gbase, voff) do { _Pragma("unroll") for (int _i = 0; _i < 2; ++_i) \
        __builtin_amdgcn_global_load_lds((const unsigned*)((const char*)(gbase) + (voff)[_i]), (LAS unsigned*)(lds + (bufoff) + ldsw + _i * 8192), 16, 0, 0); } while (0)
#define PG8_LDA(dst, b, h) do { _Pragma("unroll") for (int m = 0; m < 4; ++m) _Pragma("unroll") for (int k = 0; k < 2; ++k) dst[m][k] = *(const LAS bf16x8*)(lds + PG8_SA(b, h) + aoff + m * 2048 + k * 1024); } while (0)
#define PG8_LDB(dst, b, h) do { _Pragma("unroll") for (int n = 0; n < 2; ++n) _Pragma("unroll") for (int k = 0; k < 2; ++k) dst[n][k] = *(const LAS bf16x8*)(lds + PG8_SB(b, h) + boff + n * 2048 + k * 1024); } while (0)
#define PG8_MMA(ai, bj, At, Bt) do { __builtin_amdgcn_s_setprio(1); _Pragma("unroll") for (int m = 0; m < 4; ++m) _Pragma("unroll") for (int n = 0; n < 2; ++n) _Pragma("unroll") for (int k = 0; k < 2; ++k) \
        acc[ai][bj][m][n] = __builtin_amdgcn_mfma_f32_16x16x32_bf16(Bt[n][k], At[m][k], acc[ai][bj][m][n], 0, 0, 0); __builtin_amdgcn_s_setprio(0); } while (0)
#define PG8_WAIT_V(n) asm volatile("s_waitcnt vmcnt(" #n ")" ::: "memory")
#define PG8_WAIT_L(n) asm volatile("s_waitcnt lgkmcnt(" #n ")" ::: "memory")
#define PG8_BAR __builtin_amdgcn_s_barrier()
#define PG8_SCHED __builtin_amdgcn_sched_barrier(0)
    Unit cur, nxt; int ui = 0;
    if (!S.next(0, cur)) return;
    f32x4 acc[2][2][4][2];
    E.init(acc, cur, wr, wc, fr, fq);
    bf16x8 At[4][2], B0[2][2], B1[2][2];
    const char* cA = (const char*)g.A + (size_t)cur.pm * tstepA; const char* cB = (const char*)g.Bt + (size_t)cur.pn * tstepB;
    PG8_STAGE(PG8_SB(0, 0), cB, voffB); PG8_STAGE(PG8_SB(0, 1), cB + hstepB, voffB); PG8_STAGE(PG8_SA(0, 0), cA, voffA); PG8_STAGE(PG8_SA(0, 1), cA + hstepA, voffA);
    if (wr == 1) PG8_BAR;
    PG8_WAIT_V(2); PG8_BAR;
    PG8_STAGE(PG8_SB(1, 0), cB + kstep, voffB); PG8_STAGE(PG8_SA(1, 0), cA + kstep, voffA); PG8_STAGE(PG8_SB(1, 1), cB + hstepB + kstep, voffB);
    PG8_WAIT_V(6); PG8_BAR;
    for (;;) {
        const bool has_next = S.next(ui + 1, nxt);
        const char* nA = has_next ? (const char*)g.A + (size_t)nxt.pm * tstepA : cA; const char* nB = has_next ? (const char*)g.Bt + (size_t)nxt.pn * tstepB : cB;
        for (int t = 0; t < nt; t += 2) {
            const bool last = (t == nt - 2);
            const char* a1 = cA + (size_t)(t + 1) * kstep;
            const char* a2 = last ? nA : cA + (size_t)(t + 2) * kstep; const char* b2 = last ? nB : cB + (size_t)(t + 2) * kstep;
            const char* a3 = a2 + kstep; const char* b3 = b2 + kstep;
            PG8_LDB(B0, 0, 0); PG8_LDB(B1, 0, 1); PG8_SCHED; PG8_LDA(At, 0, 0); PG8_STAGE(PG8_SA(1, 1), a1 + hstepA, voffA);
            PG8_WAIT_V(8); PG8_WAIT_L(0); PG8_BAR; PG8_MMA(0, 0, At, B0); PG8_MMA(0, 1, At, B1); PG8_BAR; PG8_SCHED;
            PG8_LDA(At, 0, 1); PG8_STAGE(PG8_SB(0, 0), b2, voffB); PG8_STAGE(PG8_SB(0, 1), b2 + hstepB, voffB); PG8_STAGE(PG8_SA(0, 0), a2, voffA);
            PG8_WAIT_V(8); PG8_WAIT_L(0); PG8_BAR; PG8_MMA(1, 0, At, B0); PG8_MMA(1, 1, At, B1); PG8_BAR; PG8_SCHED;
            PG8_LDB(B0, 1, 0); PG8_LDB(B1, 1, 1); PG8_SCHED; PG8_LDA(At, 1, 0); PG8_STAGE(PG8_SA(0, 1), a2 + hstepA, voffA);
            PG8_WAIT_V(8); PG8_WAIT_L(0); PG8_BAR; PG8_MMA(0, 0, At, B0); PG8_MMA(0, 1, At, B1); PG8_BAR; PG8_SCHED;
            PG8_LDA(At, 1, 1); PG8_STAGE(PG8_SB(1, 0), b3, voffB); PG8_STAGE(PG8_SB(1, 1), b3 + hstepB, voffB); PG8_STAGE(PG8_SA(1, 0), a3, voffA);
            PG8_WAIT_V(8); PG8_WAIT_L(0); PG8_BAR; PG8_MMA(1, 0, At, B0); PG8_MMA(1, 1, At, B1); PG8_BAR; PG8_SCHED;
        }
        if (wr == 0) PG8_BAR;
        E(acc, cur, wr, wc, fr, fq);
        if (!has_next) break;
        E.init(acc, nxt, wr, wc, fr, fq);
        cur = nxt; cA = nA; cB = nB; ++ui;
        if (wr == 1) PG8_BAR;
    }
    PG8_WAIT_V(0);
    PG8_BAR;
#undef PG8_SA
#undef PG8_SB
#undef PG8_STAGE
#undef PG8_LDA
#undef PG8_LDB
#undef PG8_MMA
#undef PG8_WAIT_V
#undef PG8_WAIT_L
#undef PG8_BAR
#undef PG8_SCHED
}
}
using pg8::Unit;

__device__ __forceinline__ void row_rstd(const LAS float* rstd, int lrow, float (&rs)[2][4]) {
#pragma unroll
    for (int ai = 0; ai < 2; ++ai)
#pragma unroll
        for (int m = 0; m < 4; ++m) rs[ai][m] = rstd[lrow + ai * 128 + m * 16];
}
__device__ __forceinline__ void stage_rstd(LAS unsigned char* lds, const GAS float* rsq, const int tid, const int vbx) {
    LAS float* out = (LAS float*)(lds + RSTD_OFF_);
    const size_t r0 = (size_t)2048 * (vbx & 7);
    f32x4 p[4][4];
#pragma unroll
    for (int j = 0; j < 4; ++j)
#pragma unroll
        for (int q = 0; q < 4; ++q) p[j][q] = *(const GAS f32x4*)(rsq + (r0 + tid + 512 * j) * 16 + 4 * q);
#pragma unroll
    for (int j = 0; j < 4; ++j) out[tid + 512 * j] = rsqrtf(((sum4(p[j][0]) + sum4(p[j][1])) + (sum4(p[j][2]) + sum4(p[j][3]))) * (1.0f / 1024.0f) + EPS);
}

struct EpiEvenIn {
    __device__ __forceinline__ void init(f32x4 (&acc)[2][2][4][2], const Unit&, int, int, int, int) const {
#pragma unroll
        for (int a = 0; a < 2; ++a)
#pragma unroll
            for (int b = 0; b < 2; ++b)
#pragma unroll
                for (int m = 0; m < 4; ++m)
#pragma unroll
                    for (int n = 0; n < 2; ++n) acc[a][b][m][n] = (f32x4){0.f, 0.f, 0.f, 0.f};
    }
    GAS bf16_t* Z; const LAS float* rstd; GAS float* lnp; const LAS float* qkg;
    __device__ __forceinline__ void operator()(const f32x4 (&acc)[2][2][4][2], const Unit& u, int wr, int wc, int fr, int fq) const {
        asm volatile("" : "+v"(fr), "+v"(fq));
        const int rowb = u.pm * 256 + wr * 64 + fr, kind = u.pn >> 1;
        float rs[2][4]; row_rstd(rstd, (u.pm & 7) * 256 + wr * 64 + fr, rs);
        if (kind == 1 || kind == 3) {
            const LAS float* g = qkg + ((kind == 1) ? 0 : 64);
            f32x4 gv[2][2];
#pragma unroll
            for (int bj = 0; bj < 2; ++bj)
#pragma unroll
                for (int n = 0; n < 2; ++n) gv[bj][n] = *(const LAS f32x4*)(g + 32 * bj + 8 * fq + 4 * n);
#pragma unroll
            for (int ai = 0; ai < 2; ++ai)
#pragma unroll
                for (int m = 0; m < 4; ++m) {
                    float ss = 0.f;
#pragma unroll
                    for (int bj = 0; bj < 2; ++bj)
#pragma unroll
                        for (int n = 0; n < 2; ++n) ss += dot4(acc[ai][bj][m][n]);
                    ss += __shfl_xor(ss, 16); ss += __shfl_xor(ss, 32);
                    const float r = rs[ai][m], rh = rsqrtf(ss * r * r * (1.0f / 64.0f) + EPS) * r;
                    GAS bf16_t* rowp = Z + (size_t)(rowb + ai * 128 + m * 16) * ZLD + u.pn * 256 + 64 * wc + 8 * fq;
#pragma unroll
                    for (int bj = 0; bj < 2; ++bj) *(GAS u32x4*)(rowp + 32 * bj) = pack8(acc[ai][bj][m][0] * rh * gv[bj][0], acc[ai][bj][m][1] * rh * gv[bj][1]);
                }
        } else {
#pragma unroll
            for (int ai = 0; ai < 2; ++ai)
#pragma unroll
                for (int m = 0; m < 4; ++m) {
                    const float r = rs[ai][m]; const int row = rowb + ai * 128 + m * 16;
                    GAS bf16_t* rowp = Z + (size_t)row * ZLD + u.pn * 256 + 32 * wc + 8 * fq;
                    float s1 = 0.f, s2 = 0.f;
#pragma unroll
                    for (int bj = 0; bj < 2; ++bj) {
                        f32x4 v0 = acc[ai][bj][m][0] * r, v1 = acc[ai][bj][m][1] * r;
                        if (kind != 4) { v0 = gelu4(v0); v1 = gelu4(v1); }
                        if (kind == 2) { s1 += sum4(v0) + sum4(v1); s2 += dot4(v0) + dot4(v1); }
                        *(GAS u32x4*)(rowp + 128 * bj) = pack8(v0, v1);
                    }
                    if (kind == 2) {
                        s1 += __shfl_xor(s1, 16); s1 += __shfl_xor(s1, 32); s2 += __shfl_xor(s2, 16); s2 += __shfl_xor(s2, 32);
                        if (fq == 0) *(GAS f32x2*)(lnp + ((size_t)row * 8 + (u.pn & 1) * 4 + wc) * 2) = (f32x2){s1, s2};
                    }
                }
        }
    }
};

struct EpiOddIn {
    __device__ __forceinline__ void init(f32x4 (&acc)[2][2][4][2], const Unit&, int, int, int, int) const {
#pragma unroll
        for (int a = 0; a < 2; ++a)
#pragma unroll
            for (int b = 0; b < 2; ++b)
#pragma unroll
                for (int m = 0; m < 4; ++m)
#pragma unroll
                    for (int n = 0; n < 2; ++n) acc[a][b][m][n] = (f32x4){0.f, 0.f, 0.f, 0.f};
    }
    GAS bf16_t* Z; const LAS float* rstd;
    __device__ __forceinline__ void operator()(const f32x4 (&acc)[2][2][4][2], const Unit& u, int wr, int wc, int fr, int fq) const {
        asm volatile("" : "+v"(fr), "+v"(fq));
        const int rowb = u.pm * 256 + wr * 64 + fr;
        float rs[2][4]; row_rstd(rstd, (u.pm & 7) * 256 + wr * 64 + fr, rs);
        const float sc = (u.pn < 2) ? 0.08838834764831845f : 1.0f; const bool act = (u.pn >= 8);
#pragma unroll
        for (int ai = 0; ai < 2; ++ai)
#pragma unroll
            for (int m = 0; m < 4; ++m) {
                const float r = rs[ai][m] * sc;
                GAS bf16_t* rowp = Z + (size_t)(rowb + ai * 128 + m * 16) * OD_N + u.pn * 256 + 32 * wc + 8 * fq;
#pragma unroll
                for (int bj = 0; bj < 2; ++bj) {
                    f32x4 v0 = acc[ai][bj][m][0] * r, v1 = acc[ai][bj][m][1] * r;
                    if (act) {
#pragma unroll
                        for (int e = 0; e < 4; ++e) { v0[e] = silu_f(v0[e]); v1[e] = silu_f(v1[e]); }
                    }
                    *(GAS u32x4*)(rowp + 128 * bj) = pack8(v0, v1);
                }
            }
    }
};

struct EpiRes {
    const GAS float* xin_f32; const GAS bf16_t* xin_bf; GAS float* xout_f32; GAS bf16_t* xb; GAS float* rsq;
    __device__ __forceinline__ void init(f32x4 (&acc)[2][2][4][2], const Unit& u, int wr, int wc, int fr, int fq) const {
        const int rowb = u.pm * 256 + wr * 64 + fr;
#pragma unroll
        for (int ai = 0; ai < 2; ++ai)
#pragma unroll
            for (int m = 0; m < 4; ++m) {
                const size_t off = (size_t)(rowb + ai * 128 + m * 16) * D + u.pn * 256 + 32 * wc + 8 * fq;
#pragma unroll
                for (int bj = 0; bj < 2; ++bj) {
                    if (xin_f32) { acc[ai][bj][m][0] = *(const GAS f32x4*)(xin_f32 + off + 128 * bj); acc[ai][bj][m][1] = *(const GAS f32x4*)(xin_f32 + off + 128 * bj + 4); }
                    else { const u32x4 r = *(const GAS u32x4*)(xin_bf + off + 128 * bj);
                        acc[ai][bj][m][0] = (f32x4){__builtin_bit_cast(float, r.x << 16), __builtin_bit_cast(float, r.x & 0xffff0000u), __builtin_bit_cast(float, r.y << 16), __builtin_bit_cast(float, r.y & 0xffff0000u)};
                        acc[ai][bj][m][1] = (f32x4){__builtin_bit_cast(float, r.z << 16), __builtin_bit_cast(float, r.z & 0xffff0000u), __builtin_bit_cast(float, r.w << 16), __builtin_bit_cast(float, r.w & 0xffff0000u)}; }
                }
            }
    }
    __device__ __forceinline__ void operator()(const f32x4 (&acc)[2][2][4][2], const Unit& u, int wr, int wc, int fr, int fq) const {
        asm volatile("" : "+v"(fr), "+v"(fq));
        const int rowb = u.pm * 256 + wr * 64 + fr;
#pragma unroll
        for (int ai = 0; ai < 2; ++ai)
#pragma unroll
            for (int m = 0; m < 4; ++m) {
                const int row = rowb + ai * 128 + m * 16; const size_t off = (size_t)row * D + u.pn * 256 + 32 * wc + 8 * fq;
                float ss = 0.f;
#pragma unroll
                for (int bj = 0; bj < 2; ++bj) {
                    const f32x4 o0 = acc[ai][bj][m][0], o1 = acc[ai][bj][m][1];
                    if (xout_f32) { *(GAS f32x4*)(xout_f32 + off + 128 * bj) = o0; *(GAS f32x4*)(xout_f32 + off + 128 * bj + 4) = o1; }
                    else *(GAS u32x4*)(xb + off + 128 * bj) = pack8(o0, o1);
                    ss += dot4(o0) + dot4(o1);
                }
                ss += __shfl_xor(ss, 16); ss += __shfl_xor(ss, 32);
                if (fq == 0) rsq[(size_t)row * 16 + u.pn * 4 + wc] = ss;
            }
    }
};

#define DPP_MOV(old, src, ctrl, bc) __builtin_bit_cast(float, __builtin_amdgcn_update_dpp(__builtin_bit_cast(int, (float)(old)), __builtin_bit_cast(int, (float)(src)), (ctrl), 0xf, 0xf, (bc)))

struct EpiF1 {
    __device__ __forceinline__ void init(f32x4 (&acc)[2][2][4][2], const Unit&, int, int, int, int) const {
#pragma unroll
        for (int a = 0; a < 2; ++a)
#pragma unroll
            for (int b = 0; b < 2; ++b)
#pragma unroll
                for (int m = 0; m < 4; ++m)
#pragma unroll
                    for (int n = 0; n < 2; ++n) acc[a][b][m][n] = (f32x4){0.f, 0.f, 0.f, 0.f};
    }
    GAS bf16_t* H; const LAS float* rstd; const LAS float* par; GAS float* halo; GAS float* fixp; GAS float* fixu; LAS float* ldsx; unsigned* hcnt;
    __device__ __forceinline__ void operator()(const f32x4 (&acc)[2][2][4][2], const Unit& u, int wr, int wc, int fr, int fq) const {
        asm volatile("" : "+v"(fr), "+v"(fq));
        const int rowb = u.pm * 256 + wr * 64 + fr, ch0 = u.pn * 128 + 32 * wc + 8 * fq, lc = 32 * wc + 8 * fq;
        float rs[2][4]; row_rstd(rstd, (u.pm & 7) * 256 + wr * 64 + fr, rs);
        f32x4 w0[2], w1[2], w2[2], bb[2];
        const LAS float* pp = par + u.ui * 512 + lc;
#pragma unroll
        for (int n = 0; n < 2; ++n) { w0[n] = *(const LAS f32x4*)(pp + 4 * n); w1[n] = *(const LAS f32x4*)(pp + 128 + 4 * n); w2[n] = *(const LAS f32x4*)(pp + 256 + 4 * n); bb[n] = *(const LAS f32x4*)(pp + 384 + 4 * n); }
        const bool xpub = (u.pm & 15) == 7;
        if (fr >= 14) {
#pragma unroll
            for (int ai = 0; ai < 2; ++ai)
#pragma unroll
                for (int n = 0; n < 2; ++n) {
                    const f32x4 gvl = acc[ai][0][3][n] * rs[ai][3];
                    *(LAS f32x4*)(ldsx + ((ai * 2 + wr) * 2 + (fr - 14)) * 128 + lc + 4 * n) = gvl;
                    if (ai == 1 && wr == 1) {
                        GAS float* hp = halo + ((size_t)u.pm * 2 + (fr - 14)) * FF + ch0 + 4 * n;
                        if (xpub) asm volatile("global_store_dwordx4 %0, %1, off sc1" :: "v"(hp), "v"(gvl) : "memory");
                        else *(GAS f32x4*)hp = gvl;
                    }
                }
        }
        if (xpub) asm volatile("s_waitcnt vmcnt(0)" ::: "memory");
        asm volatile("s_waitcnt lgkmcnt(0)" ::: "memory"); __builtin_amdgcn_s_barrier(); asm volatile("" ::: "memory");
        if (xpub && wr == 0 && wc == 0 && fr == 0 && fq == 0) __hip_atomic_fetch_add(hcnt + 64 * u.pm, 1u, __ATOMIC_RELAXED, __HIP_MEMORY_SCOPE_AGENT);
        const bool fix = (u.pm & 15) != 0;
#pragma unroll
        for (int ai = 0; ai < 2; ++ai) {
            const int blk = ai * 2 + wr;
            f32x4 pv[2];
#pragma unroll
            for (int n = 0; n < 2; ++n) {
                pv[n] = (f32x4){0.f, 0.f, 0.f, 0.f};
                if (blk > 0 && fr >= 14) pv[n] = *(const LAS f32x4*)(ldsx + ((blk - 1) * 2 + (fr - 14)) * 128 + lc + 4 * n);
            }
#pragma unroll
            for (int m = 0; m < 4; ++m) {
                const float r = rs[ai][m]; const int row = rowb + ai * 128 + m * 16;
                f32x4 hv[2], pre[2], upv[2], cur[2];
#pragma unroll
                for (int n = 0; n < 2; ++n) {
                    cur[n] = acc[ai][0][m][n] * r; upv[n] = acc[ai][1][m][n] * r;
#pragma unroll
                    for (int e = 0; e < 4; ++e) {
                        const float c = cur[n][e], p = pv[n][e];
                        const float t1 = DPP_MOV(0.f, p, 0x10F, true);
                        const float g1 = DPP_MOV(t1, c, 0x111, false);
                        const float t2 = DPP_MOV(0.f, p, 0x10E, true);
                        const float g2 = DPP_MOV(t2, c, 0x112, false);
                        const float pr = bb[n][e] + w2[n][e] * c + w1[n][e] * g1 + w0[n][e] * g2;
                        pre[n][e] = pr; hv[n][e] = silu_f(pr) * upv[n][e];
                    }
                }
                *(GAS u32x4*)(H + (size_t)row * ZLD + ch0) = pack8(hv[0], hv[1]);
                if (fix && blk == 0 && m == 0 && fr < 2) {
#pragma unroll
                    for (int n = 0; n < 2; ++n) { *(GAS f32x4*)(fixp + ((size_t)u.pm * 2 + fr) * FF + ch0 + 4 * n) = pre[n]; *(GAS f32x4*)(fixu + ((size_t)u.pm * 2 + fr) * FF + ch0 + 4 * n) = upv[n]; }
                }
                pv[0] = cur[0]; pv[1] = cur[1];
            }
        }
    }
};

#define XB_TMO      128
#define XB_XCNT(j)  (256  + 64 * (j))
#define XB_XSUB(j)  (1280 + 64 * (j))
#define XB_XGEN(j)  (2304 + 64 * (j))
#define XB_TOP      3328
#define XB_TOPGEN   3392
#define XCD_BAR_WORDS 3456
#define XB_SPIN_CAP (1u << 18)
__device__ __forceinline__ unsigned xb_ld(unsigned* p)              { return __hip_atomic_load(p, __ATOMIC_RELAXED, __HIP_MEMORY_SCOPE_AGENT); }
__device__ __forceinline__ unsigned xb_add(unsigned* p, unsigned v) { return __hip_atomic_fetch_add(p, v, __ATOMIC_RELAXED, __HIP_MEMORY_SCOPE_AGENT); }
__device__ __forceinline__ unsigned xb_xcc_id() { return (unsigned)__builtin_amdgcn_s_getreg((3 << 11) | 20) & 0xFu; }
#define XB_SPIN(cond, bar) do { unsigned _sp = 0; while (cond) { __builtin_amdgcn_s_sleep(1); \
    if ((++_sp & 255u) == 0u) { if (xb_ld(&(bar)[XB_TMO])) break; if (_sp > XB_SPIN_CAP) { atomicAdd(&(bar)[XB_TMO], 1u); break; } } } } while (0)
struct XcdBarrier { unsigned* bar; unsigned x; volatile LAS unsigned* st; };
__device__ __forceinline__ XcdBarrier xcd_barrier_post(unsigned* bar, volatile LAS unsigned* st) {
    XcdBarrier b; b.bar = bar; b.x = xb_xcc_id(); b.st = st;
    if (threadIdx.x == 0) (void)xb_add(&bar[XB_XCNT(b.x)], 1u);
    return b;
}
__device__ __forceinline__ void xcd_barrier_complete(unsigned* bar, unsigned x, unsigned& nloc, unsigned& nx) {
    const unsigned G = gridDim.x * gridDim.y * gridDim.z;
    unsigned sum, cnt, mine, sp = 0u;
    for (;;) {
        sum = 0u; cnt = 0u; mine = 0u;
#pragma unroll
        for (unsigned j = 0; j < 16; ++j) { const unsigned c = xb_ld(&bar[XB_XCNT(j)]); sum += c; cnt += (c > 0u) ? 1u : 0u; mine = (j == x) ? c : mine; }
        if (sum == G) break;
        __builtin_amdgcn_s_sleep(1);
        if ((++sp & 255u) == 0u) { if (xb_ld(&bar[XB_TMO])) break; if (sp > XB_SPIN_CAP) { atomicAdd(&bar[XB_TMO], 1u); break; } }
    }
    nloc = mine > 0u ? mine : 1u; nx = cnt > 0u ? cnt : 1u;
}
__device__ __forceinline__ void xcd_barrier(const XcdBarrier& b) {
    asm volatile("s_waitcnt vmcnt(0)" ::: "memory");
    __syncthreads();
    if (threadIdx.x == 0) {
        unsigned* bar = b.bar;
        __builtin_amdgcn_s_waitcnt(0);
        unsigned nloc = b.st[0], nx = b.st[1];
        if (nloc == 0u) { xcd_barrier_complete(bar, b.x, nloc, nx); b.st[0] = nloc; b.st[1] = nx; }
        const unsigned old = xb_add(&bar[XB_XSUB(b.x)], 1u);
        const unsigned gen = old / nloc;
        if (old + 1u == (gen + 1u) * nloc) {
            __builtin_amdgcn_fence(__ATOMIC_RELEASE, "agent");
            asm volatile("s_waitcnt vmcnt(0)" ::: "memory");
            const unsigned og = xb_add(&bar[XB_TOP], 1u);
            const unsigned tg = og / nx;
            if (og + 1u == (tg + 1u) * nx) xb_add(&bar[XB_TOPGEN], 1u);
            else XB_SPIN(xb_ld(&bar[XB_TOPGEN]) == tg, bar);
            xb_add(&bar[XB_XGEN(b.x)], 1u);
            __builtin_amdgcn_fence(__ATOMIC_ACQUIRE, "agent");
            asm volatile("s_waitcnt vmcnt(0)" ::: "memory");
        } else {
            XB_SPIN(xb_ld(&bar[XB_XGEN(b.x)]) == gen, bar);
            __builtin_amdgcn_fence(__ATOMIC_ACQUIRE, "agent");
            asm volatile("s_waitcnt vmcnt(0)" ::: "memory");
        }
    }
    __syncthreads();
}

__device__ __forceinline__ void done_arrive(unsigned* c) { asm volatile("s_waitcnt vmcnt(0)" ::: "memory"); __syncthreads(); if (threadIdx.x == 0) (void)xb_add(c, 1u); }
__device__ __forceinline__ void done_wait(unsigned* c, const unsigned target) {
    if (threadIdx.x == 0) { unsigned sp = 0; while (xb_ld(c) < target && ++sp < XB_SPIN_CAP) __builtin_amdgcn_s_sleep(1); }
    __syncthreads();
}
__device__ __forceinline__ void xcd_local_barrier(const XcdBarrier& b) {
    asm volatile("s_waitcnt vmcnt(0)" ::: "memory");
    __syncthreads();
    if (threadIdx.x == 0) {
        unsigned* bar = b.bar;
        asm volatile("buffer_inv sc1" ::: "memory");
        const unsigned nloc = b.st[0];
        const unsigned old = xb_add(&bar[XB_XSUB(b.x)], 1u);
        const unsigned gen = old / nloc;
        if (old + 1u == (gen + 1u) * nloc) xb_add(&bar[XB_XGEN(b.x)], 1u);
        else XB_SPIN(xb_ld(&bar[XB_XGEN(b.x)]) == gen, bar);
        asm volatile("s_waitcnt vmcnt(0)" ::: "memory");
    }
    __syncthreads();
}

__device__ __forceinline__ int conv_srccol(const int map, const int nd, bool& second) {
    const int nb = nd >> 5, r = nd & 31; second = false;
    if (map == 1) {
        const int pn = nb >> 3, j = nb & 7, bj = j >> 2, wc = j & 3, kind = pn >> 1, zc = 256 * pn + 64 * wc + 32 * bj;
        if (kind == 1) return 1024 + (zc - 512) + r;
        if (kind == 2) return 512 + (nd - 1024);
        if (kind == 3) return zc + r;
        return nd;
    } else if (map == 2) {
        const int pn = nb >> 3, j = nb & 7; second = (j >> 2) != 0;
        return 128 * pn + 32 * (j & 3) + r;
    }
    return nd;
}
constexpr int CV_STR = 65;
__device__ __forceinline__ void conv_block_item(LAS unsigned char* lds, const GAS float* W, const GAS float* W2, const int ldw, const int K, const int Ndst, const GAS float* gk, GAS bf16_t* WT, const int map, const int item, const int tid) {
    const int nblk = Ndst >> 7, kb = item / nblk, nb = item % nblk, k0 = kb << 7, n0 = nb << 7;
    const int l32 = tid & 31, rg = tid >> 5;
    bool second; const int sc = conv_srccol(map, n0 + 4 * l32, second);
    const GAS float* src = (second ? W2 : W) + (size_t)(k0 + 8 * rg) * ldw + sc;
    f32x4 v[8];
#pragma unroll
    for (int i = 0; i < 8; ++i) v[i] = *(const GAS f32x4*)(src + (size_t)i * ldw);
    if (gk) {
        const f32x4 g0 = *(const GAS f32x4*)(gk + k0 + 8 * rg), g1 = *(const GAS f32x4*)(gk + k0 + 8 * rg + 4);
#pragma unroll
        for (int i = 0; i < 4; ++i) { v[i] = v[i] * g0[i]; v[4 + i] = v[4 + i] * g1[i]; }
    }
    LAS unsigned* T = (LAS unsigned*)lds;
#pragma unroll
    for (int i = 0; i < 4; ++i)
#pragma unroll
        for (int e = 0; e < 4; ++e) T[(4 * l32 + e) * CV_STR + 4 * rg + i] = cvt_pk_bf16(v[2 * i][e], v[2 * i + 1][e]);
    __syncthreads();
    const int c = tid & 15;
#pragma unroll
    for (int p = 0; p < 4; ++p) {
        const int n = (tid >> 4) + 32 * p; const LAS unsigned* r = T + n * CV_STR + 4 * c;
        u32x4 o; o.x = r[0]; o.y = r[1]; o.z = r[2]; o.w = r[3];
        *(GAS u32x4*)(WT + (size_t)(n0 + n) * K + k0 + 8 * c) = o;
    }
    __syncthreads();
}

__device__ __forceinline__ void ph_gmlp_simple(LAS unsigned char* lds, bf16_t* Z, const float* LNP, const float* ln_g, const float* ln_b, const float* wsp, const float* bsp, int tid, int G) {
    LAS float* vn = (LAS float*)lds;
    for (int item = blockIdx.x; item < (M / 128) * 8; item += G) {
        const int chunk = item >> 3, g = item & 7, m0 = chunk * 128;
        for (int idx = tid; idx < 128 * 64; idx += NWAVES * 64) {
            const int s = idx >> 6, c = idx & 63; const size_t row = m0 + s;
            float s1 = 0.f, s2 = 0.f;
            for (int k = 0; k < 8; ++k) { s1 += LNP[(row * 8 + k) * 2]; s2 += LNP[(row * 8 + k) * 2 + 1]; }
            const float mean = s1 * (1.f / 512.f), var = s2 * (1.f / 512.f) - mean * mean, rstd = rsqrtf(var + EPS);
            const float gv = bf2f(Z[row * ZLD + 1024 + 64 * g + c]);
            vn[idx] = (gv - mean) * rstd * ln_g[64 * g + c] + ln_b[64 * g + c];
        }
        __syncthreads();
        for (int idx = tid; idx < 128 * 64; idx += NWAVES * 64) {
            const int t = idx >> 6, c = idx & 63; const size_t row = m0 + t;
            float a = bsp[g * 128 + t];
            const float* wr = wsp + ((size_t)g * 128 + t) * 128;
            for (int s2 = 0; s2 <= t; ++s2) a += wr[s2] * vn[s2 * 64 + c];
            const float gu = bf2f(Z[row * ZLD + 64 * g + c]);
            Z[row * ZLD + 64 * g + c] = (bf16_t)f2bf(gu * a);
        }
        __syncthreads();
    }
}
__device__ __forceinline__ void ph_attn_simple(bf16_t* Z, int gw, int NGW, int lane) {
    for (int wv = gw; wv < M * 8; wv += NGW) {
        const int m = wv >> 3, h = wv & 7, t = m & (SEQ - 1), mb = m - t;
        const float q = bf2f(Z[(size_t)m * ZLD + 512 + 64 * h + lane]);
        float ms[3], ls[3], os[3];
#pragma unroll
        for (int r = 0; r < 3; ++r) {
            const int dil = (r == 0) ? 1 : (r == 1) ? 4 : 16;
            float mx = -1e30f, l = 0.f, o = 0.f;
            for (int j = 0; j <= 128; ++j) {
                const int tk = t - j * dil; if (tk < 0) break;
                const size_t kr = (size_t)(mb + tk) * ZLD;
                float sc = q * bf2f(Z[kr + 1536 + 64 * h + lane]);
#pragma unroll
                for (int o2 = 1; o2 < 64; o2 <<= 1) sc += __shfl_xor(sc, o2);
                const float mn = fmaxf(mx, sc), al = __expf(mx - mn), p = __expf(sc - mn);
                l = l * al + p; o = o * al + p * bf2f(Z[kr + 2048 + 64 * h + lane]); mx = mn;
            }
            ms[r] = mx; ls[r] = l; os[r] = o / l;
        }
        const float l0 = ms[0] + __logf(ls[0]), l1 = ms[1] + __logf(ls[1]), l2 = ms[2] + __logf(ls[2]);
        const float mm = fmaxf(l0, fmaxf(l1, l2)), e0 = __expf(l0 - mm), e1 = __expf(l1 - mm), e2 = __expf(l2 - mm), inv = 1.f / (e0 + e1 + e2);
        Z[(size_t)m * ZLD + 512 + 64 * h + lane] = (bf16_t)f2bf((e0 * os[0] + e1 * os[1] + e2 * os[2]) * inv);
    }
}
__device__ __forceinline__ void ph_ga_simple(const float* X, const float* RSQ, const float* gmix, const float* w_in, float* GA, int gw, int NGW, int lane) {
    for (int m = gw; m < M; m += NGW) {
        float acc[16];
#pragma unroll
        for (int j = 0; j < 16; ++j) acc[j] = 0.f;
        for (int i = 0; i < 16; ++i) {
            const int k = i * 64 + lane; const float xv = X[(size_t)m * D + k] * gmix[k];
            const f32x4* wr = (const f32x4*)(w_in + (size_t)k * OD_NSRC + 3072);
#pragma unroll
            for (int j4 = 0; j4 < 4; ++j4) { const f32x4 w = wr[j4]; acc[4 * j4] += xv * w[0]; acc[4 * j4 + 1] += xv * w[1]; acc[4 * j4 + 2] += xv * w[2]; acc[4 * j4 + 3] += xv * w[3]; }
        }
        float s = 0.f;
        for (int j = 0; j < 16; ++j) s += RSQ[(size_t)m * 16 + j];
        const float rstd = rsqrtf(s * (1.f / 1024.f) + EPS);
#pragma unroll
        for (int j = 0; j < 16; ++j) {
            float v = acc[j];
#pragma unroll
            for (int o = 1; o < 64; o <<= 1) v += __shfl_xor(v, o);
            if (lane == j) GA[(size_t)m * 16 + j] = v * rstd;
        }
    }
}
__device__ __forceinline__ void ph_gla_simple(LAS unsigned char* lds, const bf16_t* Z, const float* GA, const float* w_a2, const float* b_a, float* ORAW, int tid, int G) {
    LAS float* sa = (LAS float*)lds; LAS float* sk = sa + 256; LAS float* sq = sk + 256;
    for (int item = blockIdx.x; item < 16; item += G) {
        const int b = item >> 2, h = item & 3, v = tid;
        float S[128];
#pragma unroll
        for (int k = 0; k < 128; ++k) S[k] = 0.f;
        float wa[16]; float ba = 0.f;
#pragma unroll
        for (int j = 0; j < 16; ++j) wa[j] = 0.f;
        if (v < 128) {
#pragma unroll
            for (int j = 0; j < 16; ++j) wa[j] = w_a2[j * 512 + h * 128 + v];
            ba = b_a[h * 128 + v]; }
        for (int t = 0; t < SEQ; ++t) {
            const size_t m = (size_t)b * SEQ + t; const int buf = (t & 1) * 128;
            if (v < 128) {
                float xg = ba;
#pragma unroll
                for (int j = 0; j < 16; ++j) xg += GA[m * 16 + j] * wa[j];
                const float ls = fminf(xg, 0.f) - log1pf(__expf(-fabsf(xg)));
                sa[buf + v] = __expf(ls * (1.f / 16.f));
                sk[buf + v] = bf2f(Z[m * OD_N + 512 + 128 * h + v]);
                sq[buf + v] = bf2f(Z[m * OD_N + 128 * h + v]);
            }
            __syncthreads();
            if (v < 256) {
                const float vv = bf2f(Z[m * OD_N + 1024 + 256 * h + v]);
                float o = 0.f;
#pragma unroll
                for (int k = 0; k < 128; ++k) { S[k] = sa[buf + k] * S[k] + sk[buf + k] * vv; o += sq[buf + k] * S[k]; }
                ORAW[m * 1024 + 256 * h + v] = o;
            }
        }
        __syncthreads();
    }
}
__device__ __forceinline__ void ph_gla_post_simple(bf16_t* Z, const float* ORAW, const float* head_g, int gw, int NGW, int lane) {
    for (int wv = gw; wv < M * 4; wv += NGW) {
        const int m = wv >> 2, h = wv & 3;
        const f32x4 o = *(const f32x4*)(ORAW + (size_t)m * 1024 + 256 * h + 4 * lane);
        float ss = dot4(o);
#pragma unroll
        for (int k = 1; k < 64; k <<= 1) ss += __shfl_xor(ss, k);
        const float rstd = rsqrtf(ss * (1.f / 256.f) + EPS);
        const f32x4 hg = *(const f32x4*)(head_g + 4 * lane);
        bf16_t* sr = Z + (size_t)m * OD_N + 2048 + 256 * h + 4 * lane;
        bf16_t* dst = Z + (size_t)m * OD_N + 1024 + 256 * h + 4 * lane;
        u32x2 w; w.x = pk2(o[0] * rstd * hg[0] * bf2f(sr[0]), o[1] * rstd * hg[1] * bf2f(sr[1])); w.y = pk2(o[2] * rstd * hg[2] * bf2f(sr[2]), o[3] * rstd * hg[3] * bf2f(sr[3]));
        *(u32x2*)dst = w;
    }
}


typedef short s16x4 __attribute__((ext_vector_type(4)));
__device__ __forceinline__ bf16x8 tr_pair(const LAS unsigned char* p0, const LAS unsigned char* p1) {
    const s16x4 lo = __builtin_amdgcn_ds_read_tr16_b64_v4i16((LAS s16x4*)p0), hi = __builtin_amdgcn_ds_read_tr16_b64_v4i16((LAS s16x4*)p1);
    return __builtin_shufflevector(lo, hi, 0, 1, 2, 3, 4, 5, 6, 7);
}
constexpr int AT_KSTR = 144, AT_VSTR = 160, AT_VOFF = 256 * AT_KSTR;
struct AttnPre { u32x4 k[4], v[4]; bf16x8 q0, q1; };
__device__ __forceinline__ void attn_load(const GAS bf16_t* Z, const int dlog, const int idx, const int tid, AttnPre& P) {
    const int lane = tid & 63, w = tid >> 6, fr = lane & 15, g = lane >> 4;
    const int nbl = 5 - dlog, bh = idx >> 5, b = bh >> 3, h = bh & 7, rn = idx & 31, r = rn >> nbl, n = rn & ((1 << nbl) - 1);
    const size_t mb = (size_t)b * SEQ;
#pragma unroll
    for (int pass = 0; pass < 4; ++pass) {
        const int row = pass * 64 + (tid >> 3), ch = tid & 7, tok = (((128 * (n - 1) + row)) << dlog) + r;
        P.k[pass] = (u32x4){0u, 0u, 0u, 0u}; P.v[pass] = (u32x4){0u, 0u, 0u, 0u};
        if (tok >= 0) { const GAS bf16_t* src = Z + (mb + tok) * ZLD + 64 * h + 8 * ch; P.k[pass] = *(const GAS u32x4*)(src + 1536); P.v[pass] = *(const GAS u32x4*)(src + 2048); }
    }
    const int tq = ((128 * n + 16 * w + fr) << dlog) + r;
    const GAS bf16_t* qp = Z + (mb + tq) * ZLD + 512 + 64 * h;
    P.q0 = *(const GAS bf16x8*)(qp + 8 * g); P.q1 = *(const GAS bf16x8*)(qp + 32 + 8 * g);
}
__device__ __forceinline__ int attn_item_idx(const int dlog, const int xmap, const int j, const int idx0, const int stride, const int it) {
    if (xmap < 0) return idx0 + it * stride;
    const int q = j + 32 * it, h = q >> 4, b = xmap >> 1, hf = xmap & 1;
    int rn;
    if (dlog == 0) rn = 16 * hf + (q & 15);
    else if (dlog == 2) rn = ((q >> 2) & 3) * 8 + 4 * hf + (q & 3);
    else rn = (q & 15) * 2 + hf;
    return (b * 8 + h) * 32 + rn;
}
template <bool FINAL>
__device__ __forceinline__ void attn_run(LAS unsigned char* lds, GAS bf16_t* Z, const int dlog, const int idx0, const int count, const int stride, const int xmap, const int jmap, GAS bf16_t* Pout, GAS float* Lout,
                                         const GAS bf16_t* P1, const GAS bf16_t* P2, const GAS float* L1, const GAS float* L2, const int tid) {
    constexpr bool final = FINAL;
    const int lane = tid & 63, w = __builtin_amdgcn_readfirstlane(tid >> 6), fr = lane & 15, g = lane >> 4;
    AttnPre P;
    constexpr int AT_IMG = 256 * AT_KSTR + 256 * AT_VSTR;
    bf16x8 q0 = (bf16x8){0, 0, 0, 0, 0, 0, 0, 0}, q1 = q0;
    if (count > 0) {
        attn_load(Z, dlog, attn_item_idx(dlog, xmap, jmap, idx0, stride, 0), tid, P);
#pragma unroll
        for (int pass = 0; pass < 4; ++pass) {
            const int row = pass * 64 + (tid >> 3), ch = tid & 7;
            *(LAS u32x4*)(lds + row * AT_KSTR + 16 * ch) = P.k[pass];
            *(LAS u32x4*)(lds + AT_VOFF + row * AT_VSTR + 16 * ch) = P.v[pass];
        }
        q0 = P.q0; q1 = P.q1;
        __syncthreads();
    }
    for (int it_ = 0; it_ < count; ++it_) {
    const int idx = attn_item_idx(dlog, xmap, jmap, idx0, stride, it_);
    const int nbl = 5 - dlog, bh = idx >> 5, b = bh >> 3, h = bh & 7, rn = idx & 31, r = rn >> nbl, n = rn & ((1 << nbl) - 1);
    const size_t mb = (size_t)b * SEQ;
    const LAS unsigned char* img = lds + (it_ & 1) * AT_IMG;
    const int tq = ((128 * n + 16 * w + fr) << dlog) + r;
    if (it_ + 1 < count) attn_load(Z, dlog, attn_item_idx(dlog, xmap, jmap, idx0, stride, it_ + 1), tid, P);
    u32x2 mp1[4], mp2[4]; float ml1 = 0.f, ml2 = 0.f;
    if (final) {
        const GAS bf16_t* p1 = P1 + (mb + tq) * 512 + 64 * h + 4 * g; const GAS bf16_t* p2 = P2 + (mb + tq) * 512 + 64 * h + 4 * g;
#pragma unroll
        for (int dt = 0; dt < 4; ++dt) { mp1[dt] = *(const GAS u32x2*)(p1 + 16 * dt); mp2[dt] = *(const GAS u32x2*)(p2 + 16 * dt); }
        ml1 = L1[(mb + tq) * 8 + h]; ml2 = L2[(mb + tq) * 8 + h];
    }
    f32x4 st[9];
#pragma unroll
    for (int kt = 0; kt < 9; ++kt) {
        const LAS unsigned char* kr = img + (16 * w + 16 * kt + fr) * AT_KSTR + 16 * g;
        const bf16x8 a0 = *(const LAS bf16x8*)kr, a1 = *(const LAS bf16x8*)(kr + 64);
        f32x4 c = (f32x4){0.f, 0.f, 0.f, 0.f};
        c = __builtin_amdgcn_mfma_f32_16x16x32_bf16(a0, q0, c, 0, 0, 0);
        c = __builtin_amdgcn_mfma_f32_16x16x32_bf16(a1, q1, c, 0, 0, 0);
        st[kt] = c;
    }
    float mx = -1e30f;
#pragma unroll
    for (int kt = 0; kt < 9; ++kt) {
        const bool tv = (n > 0) || (kt >= 8 - w);
#pragma unroll
        for (int e = 0; e < 4; ++e) {
            const int jj = 4 * g + e;
            bool ok = tv; if (kt == 0) ok = ok && (jj >= fr); if (kt == 8) ok = ok && (jj <= fr);
            const float sv = ok ? st[kt][e] : -1e30f; st[kt][e] = sv; mx = fmaxf(mx, sv);
        }
    }
    mx = fmaxf(mx, __shfl_xor(mx, 16)); mx = fmaxf(mx, __shfl_xor(mx, 32));
    f32x4 lacc = (f32x4){0.f, 0.f, 0.f, 0.f};
#pragma unroll
    for (int kt = 0; kt < 9; ++kt) {
        const f32x4 d = st[kt] - mx; f32x4 p;
#pragma unroll
        for (int e = 0; e < 4; ++e) p[e] = __builtin_amdgcn_exp2f(d[e]);
        st[kt] = p; lacc += p;
    }
    float l = (lacc[0] + lacc[1]) + (lacc[2] + lacc[3]);
    l += __shfl_xor(l, 16); l += __shfl_xor(l, 32);
    f32x4 ot[4];
#pragma unroll
    for (int dt = 0; dt < 4; ++dt) ot[dt] = (f32x4){0.f, 0.f, 0.f, 0.f};
    const int qq = fr >> 2, pp = fr & 3;
#pragma unroll
    for (int ks2 = 0; ks2 < 5; ++ks2) {
        const int T0 = 2 * ks2, T1 = (ks2 < 4) ? 2 * ks2 + 1 : 2 * ks2;
        u32x4 pb; pb.x = cvt_pk_bf16(st[T0][0], st[T0][1]); pb.y = cvt_pk_bf16(st[T0][2], st[T0][3]);
        if (ks2 < 4) { pb.z = cvt_pk_bf16(st[T1][0], st[T1][1]); pb.w = cvt_pk_bf16(st[T1][2], st[T1][3]); } else { pb.z = 0u; pb.w = 0u; }
        const bf16x8 bfrag = __builtin_bit_cast(bf16x8, pb);
        const LAS unsigned char* v0 = img + AT_VOFF + (16 * w + 16 * T0 + 4 * g + qq) * AT_VSTR + 8 * pp;
        const LAS unsigned char* v1 = img + AT_VOFF + (16 * w + 16 * T1 + 4 * g + qq) * AT_VSTR + 8 * pp;
#pragma unroll
        for (int dt = 0; dt < 4; ++dt) ot[dt] = __builtin_amdgcn_mfma_f32_16x16x32_bf16(tr_pair(v0 + 32 * dt, v1 + 32 * dt), bfrag, ot[dt], 0, 0, 0);
    }
    const float inv = 1.0f / l, lse = mx + __builtin_amdgcn_logf(l);
    if (!final) {
        GAS bf16_t* op = Pout + (mb + tq) * 512 + 64 * h + 4 * g;
#pragma unroll
        for (int dt = 0; dt < 4; ++dt) { u32x2 o; o.x = cvt_pk_bf16(ot[dt][0] * inv, ot[dt][1] * inv); o.y = cvt_pk_bf16(ot[dt][2] * inv, ot[dt][3] * inv); *(GAS u32x2*)(op + 16 * dt) = o; }
        if (g == 0) Lout[(mb + tq) * 8 + h] = lse;
    } else {
        const float l1 = ml1, l2 = ml2;
        const float mm = fmaxf(lse, fmaxf(l1, l2)), e0 = __builtin_amdgcn_exp2f(lse - mm), e1 = __builtin_amdgcn_exp2f(l1 - mm), e2 = __builtin_amdgcn_exp2f(l2 - mm), rs = 1.0f / (e0 + e1 + e2);
        const float w0 = e0 * rs * inv, w1 = e1 * rs, w2 = e2 * rs;
        GAS bf16_t* op = Z + (mb + tq) * ZLD + 512 + 64 * h + 4 * g;
#pragma unroll
        for (int dt = 0; dt < 4; ++dt) {
            const u32x2 a = mp1[dt], c = mp2[dt];
            const float r0 = w0 * ot[dt][0] + w1 * bf2f((unsigned short)(a.x & 0xffffu)) + w2 * bf2f((unsigned short)(c.x & 0xffffu));
            const float r1 = w0 * ot[dt][1] + w1 * bf2f((unsigned short)(a.x >> 16)) + w2 * bf2f((unsigned short)(c.x >> 16));
            const float r2 = w0 * ot[dt][2] + w1 * bf2f((unsigned short)(a.y & 0xffffu)) + w2 * bf2f((unsigned short)(c.y & 0xffffu));
            const float r3 = w0 * ot[dt][3] + w1 * bf2f((unsigned short)(a.y >> 16)) + w2 * bf2f((unsigned short)(c.y >> 16));
            u32x2 o; o.x = cvt_pk_bf16(r0, r1); o.y = cvt_pk_bf16(r2, r3); *(GAS u32x2*)(op + 16 * dt) = o;
        }
    }
    if (it_ + 1 < count) {
        LAS unsigned char* nimg = lds + ((it_ + 1) & 1) * AT_IMG;
#pragma unroll
        for (int pass = 0; pass < 4; ++pass) {
            const int row = pass * 64 + (tid >> 3), ch = tid & 7;
            *(LAS u32x4*)(nimg + row * AT_KSTR + 16 * ch) = P.k[pass];
            *(LAS u32x4*)(nimg + AT_VOFF + row * AT_VSTR + 16 * ch) = P.v[pass];
        }
        q0 = P.q0; q1 = P.q1;
    }
    __syncthreads();
    }
}
constexpr int GM_STR = 160;
constexpr int GM_TILE = 128 * GM_STR, GM_LNP = 2 * GM_TILE;
struct GmPre { bf16x8 wfr[4]; u32x2 guv[4]; f32x4 lnp[4]; u32x4 raw[2]; float bias; };
__device__ __forceinline__ void gmlp_load(const GAS bf16_t* Z, const GAS float* LNP, const GAS bf16_t* Wbf, const GAS float* bs, const int item, const int tid, GmPre& P) {
    const int lane = tid & 63, w = __builtin_amdgcn_readfirstlane(tid >> 6), fr = lane & 15, g4 = lane >> 4;
    const int chunk = item >> 3, g = item & 7, m0 = chunk * 128, t = 16 * w + fr;
    const GAS bf16_t* wrow = Wbf + ((size_t)g * 128 + t) * 128 + 8 * g4;
    const GAS bf16_t* up = Z + (size_t)(m0 + t) * ZLD + 64 * g + 4 * g4;
#pragma unroll
    for (int ks = 0; ks < 4; ++ks) P.wfr[ks] = *(const GAS bf16x8*)(wrow + 32 * ks);
#pragma unroll
    for (int ct = 0; ct < 4; ++ct) P.guv[ct] = *(const GAS u32x2*)(up + 16 * ct);
    P.bias = bs[g * 128 + t];
    const int s = tid >> 2, c0 = (tid & 3) * 16; const size_t row = m0 + s;
#pragma unroll
    for (int k = 0; k < 4; ++k) P.lnp[k] = *(const GAS f32x4*)(LNP + row * 16 + 4 * k);
    const GAS bf16_t* gp = Z + row * ZLD + 1024 + 64 * g + c0;
#pragma unroll
    for (int hh = 0; hh < 2; ++hh) P.raw[hh] = *(const GAS u32x4*)(gp + 8 * hh);
}
template <class ItemFn>
__device__ __forceinline__ void gmlp_run(LAS unsigned char* lds, GAS bf16_t* Z, const GAS float* LNP, const GAS float* ln_g, const GAS float* ln_b, const GAS bf16_t* Wbf, const GAS float* bs, const int count, const ItemFn itemf, const int tid) {
    const int lane = tid & 63, w = __builtin_amdgcn_readfirstlane(tid >> 6), fr = lane & 15, g4 = lane >> 4;
    const int t = 16 * w + fr, qq = fr >> 2, pp = fr & 3;
    if (count <= 0) return;
    GmPre P;
    gmlp_load(Z, LNP, Wbf, bs, itemf(0), tid, P);
    ((LAS float*)(lds + GM_LNP))[tid] = ln_g[tid]; ((LAS float*)(lds + GM_LNP))[512 + tid] = ln_b[tid];
    __syncthreads();
    for (int i = 0; i < count; ++i) {
        const int item = itemf(i), chunk = item >> 3, g = item & 7, m0 = chunk * 128;
        LAS unsigned char* tile = lds + (i & 1) * GM_TILE;
        {
            const int s = tid >> 2, c0 = (tid & 3) * 16;
            float s1 = 0.f, s2 = 0.f;
#pragma unroll
            for (int k = 0; k < 4; ++k) { const f32x4 p = P.lnp[k]; s1 += p[0] + p[2]; s2 += p[1] + p[3]; }
            const float mean = s1 * (1.f / 512.f), var = s2 * (1.f / 512.f) - mean * mean, rstd = rsqrtf(var + EPS);
#pragma unroll
            for (int hh = 0; hh < 2; ++hh) {
                const u32x4 raw = P.raw[hh];
                const LAS float* lg = (const LAS float*)(lds + GM_LNP) + 64 * g + c0 + 8 * hh;
                const f32x4 la = *(const LAS f32x4*)lg, lb = *(const LAS f32x4*)(lg + 4), ba = *(const LAS f32x4*)(lg + 512), bb = *(const LAS f32x4*)(lg + 516);
                f32x4 x0, x1;
                x0[0] = bf2f((unsigned short)(raw.x & 0xffffu)); x0[1] = bf2f((unsigned short)(raw.x >> 16)); x0[2] = bf2f((unsigned short)(raw.y & 0xffffu)); x0[3] = bf2f((unsigned short)(raw.y >> 16));
                x1[0] = bf2f((unsigned short)(raw.z & 0xffffu)); x1[1] = bf2f((unsigned short)(raw.z >> 16)); x1[2] = bf2f((unsigned short)(raw.w & 0xffffu)); x1[3] = bf2f((unsigned short)(raw.w >> 16));
                x0 = (x0 - mean) * rstd * la + ba; x1 = (x1 - mean) * rstd * lb + bb;
                *(LAS u32x4*)(tile + s * GM_STR + (c0 + 8 * hh) * 2) = pack8(x0, x1);
            }
        }
        bf16x8 wfr[4]; u32x2 guv[4];
#pragma unroll
        for (int ks = 0; ks < 4; ++ks) wfr[ks] = P.wfr[ks];
#pragma unroll
        for (int ct = 0; ct < 4; ++ct) guv[ct] = P.guv[ct];
        const float bias = P.bias;
        if (i + 1 < count) gmlp_load(Z, LNP, Wbf, bs, itemf(i + 1), tid, P);
        __syncthreads();
        f32x4 acc[4];
#pragma unroll
        for (int ct = 0; ct < 4; ++ct) acc[ct] = (f32x4){0.f, 0.f, 0.f, 0.f};
#pragma unroll
        for (int ks = 0; ks < 4; ++ks) {
            if (32 * ks <= 16 * w + 15) {
                const bf16x8 bfr = wfr[ks];
                const LAS unsigned char* a0 = tile + (32 * ks + 8 * g4 + qq) * GM_STR + 8 * pp;
#pragma unroll
                for (int ct = 0; ct < 4; ++ct) acc[ct] = __builtin_amdgcn_mfma_f32_16x16x32_bf16(tr_pair(a0 + 32 * ct, a0 + 4 * GM_STR + 32 * ct), bfr, acc[ct], 0, 0, 0);
            }
        }
        GAS bf16_t* up = Z + (size_t)(m0 + t) * ZLD + 64 * g + 4 * g4;
#pragma unroll
        for (int ct = 0; ct < 4; ++ct) {
            const u32x2 a = guv[ct];
            u32x2 o; o.x = cvt_pk_bf16(bf2f((unsigned short)(a.x & 0xffffu)) * (acc[ct][0] + bias), bf2f((unsigned short)(a.x >> 16)) * (acc[ct][1] + bias));
            o.y = cvt_pk_bf16(bf2f((unsigned short)(a.y & 0xffffu)) * (acc[ct][2] + bias), bf2f((unsigned short)(a.y >> 16)) * (acc[ct][3] + bias));
            *(GAS u32x2*)(up + 16 * ct) = o;
        }
    }
    __syncthreads();
}


constexpr int GL_GAL = 0, GL_SEG = 4096, GL_A = 8192;
constexpr int G1_KSSTR = 144, G1_V = GL_A + 128 * G1_KSSTR, GL_VSTR = 544;
constexpr int G3_QSTR = 272, G3_KT = GL_A + 64 * G3_QSTR, G3_V = G3_KT + 64 * G3_QSTR, G3_SSQ = G3_V + 64 * GL_VSTR;
__device__ __forceinline__ void gla_decay(LAS unsigned char* lds, const GAS float* GA, const GAS float* w_a2, const GAS float* b_a, const int h, const size_t m0, const int tid, float (&bl)[2][8], float (&tot)[2]) {
    LAS float* gal = (LAS float*)(lds + GL_GAL); LAS float* seg = (LAS float*)(lds + GL_SEG);
    const int kp = tid & 63, s8 = tid >> 6;
    if (tid < 256) *(LAS f32x4*)(gal + 4 * tid) = *(const GAS f32x4*)(GA + m0 * 16 + 4 * tid);
    float wa[2][16], ba[2];
#pragma unroll
    for (int c = 0; c < 2; ++c) {
#pragma unroll
        for (int j = 0; j < 16; ++j) wa[c][j] = w_a2[j * 512 + 128 * h + 2 * kp + c];
        ba[c] = b_a[128 * h + 2 * kp + c]; }
    __syncthreads();
    float run[2] = {0.f, 0.f};
#pragma unroll
    for (int i = 0; i < 8; ++i) {
        const LAS f32x4* gr = (const LAS f32x4*)(gal + (8 * s8 + i) * 16);
        const f32x4 g0 = gr[0], g1 = gr[1], g2 = gr[2], g3 = gr[3];
#pragma unroll
        for (int c = 0; c < 2; ++c) {
            float x = ba[c];
#pragma unroll
            for (int j = 0; j < 4; ++j) x += g0[j] * wa[c][j] + g1[j] * wa[c][4 + j] + g2[j] * wa[c][8 + j] + g3[j] * wa[c][12 + j];
            const float ls = fminf(x, 0.f) - __logf(1.0f + __expf(-fabsf(x)));
            run[c] += ls * (1.0f / 16.0f); bl[c][i] = run[c];
        }
    }
    *(LAS f32x2*)(seg + s8 * 128 + 2 * kp) = (f32x2){run[0], run[1]};
    __syncthreads();
    float pre[2] = {0.f, 0.f}; tot[0] = 0.f; tot[1] = 0.f;
#pragma unroll
    for (int q = 0; q < 8; ++q) { const f32x2 sv = *(const LAS f32x2*)(seg + q * 128 + 2 * kp); if (q < s8) { pre[0] += sv.x; pre[1] += sv.y; } tot[0] += sv.x; tot[1] += sv.y; }
#pragma unroll
    for (int i = 0; i < 8; ++i) { bl[0][i] += pre[0]; bl[1][i] += pre[1]; }
}
__device__ __forceinline__ void gla_stage_v(LAS unsigned char* vl, const GAS bf16_t* Z, const int h, const size_t m0, const int tid) {
#pragma unroll
    for (int p = 0; p < 4; ++p) { const int idx = p * 512 + tid, t = idx >> 5, ch = idx & 31;
        *(LAS u32x4*)(vl + t * GL_VSTR + 16 * ch) = *(const GAS u32x4*)(Z + (m0 + t) * OD_N + 1024 + 256 * h + 8 * ch); }
}
constexpr int G1_DEC = G1_V + 64 * GL_VSTR;
__device__ __forceinline__ void gla_g1_group(LAS unsigned char* lds, const GAS bf16_t* Z, const GAS float* GA, const GAS float* w_a2, const GAS float* b_a, GAS bf16_t* KVT, GAS float* DCC, GAS float* DG, GAS bf16_t* QK, const int item, const int tid) {
    const int lane = tid & 63, w = __builtin_amdgcn_readfirstlane(tid >> 6), fr = lane & 15, g = lane >> 4;
    const int bh = item >> 4, grp = item & 15, h = bh & 3; const size_t mbase = (size_t)(bh >> 2) * SEQ + 256 * grp;
    const int kp = tid & 63, s8 = tid >> 6;
    LAS float* gal = (LAS float*)(lds + GL_GAL); LAS float* seg = (LAS float*)(lds + GL_SEG); LAS float* decs = (LAS float*)(lds + G1_DEC);
    float wa[2][16], ba[2];
#pragma unroll
    for (int c = 0; c < 2; ++c) {
#pragma unroll
        for (int j = 0; j < 16; ++j) wa[c][j] = w_a2[j * 512 + 128 * h + 2 * kp + c];
        ba[c] = b_a[128 * h + 2 * kp + c]; }
    f32x4 acc[16];
#pragma unroll
    for (int vt = 0; vt < 16; ++vt) acc[vt] = (f32x4){0.f, 0.f, 0.f, 0.f};
    float cum[2] = {0.f, 0.f};
    const int qq = fr >> 2, pp = fr & 3;
    f32x4 pga = (f32x4){0.f, 0.f, 0.f, 0.f};
    if (tid < 256) pga = *(const GAS f32x4*)(GA + mbase * 16 + 4 * tid);
    for (int cc = 0; cc < 4; ++cc) {
        const size_t m0 = mbase + 64 * cc; const int chunk = bh * 64 + 4 * grp + cc;
        if (tid < 256) *(LAS f32x4*)(gal + 4 * tid) = pga;
        unsigned qraw[8], kraw[8];
#pragma unroll
        for (int i = 0; i < 8; ++i) { const GAS bf16_t* zr = Z + (m0 + 8 * s8 + i) * OD_N + 128 * h + 2 * kp; qraw[i] = *(const GAS unsigned*)zr; kraw[i] = *(const GAS unsigned*)(zr + 512); }
        __syncthreads();
        if (cc < 3 && tid < 256) pga = *(const GAS f32x4*)(GA + (m0 + 64) * 16 + 4 * tid);
        float bl[2][8], run[2] = {0.f, 0.f};
#pragma unroll
        for (int i = 0; i < 8; ++i) {
            const LAS f32x4* gr = (const LAS f32x4*)(gal + (8 * s8 + i) * 16);
            const f32x4 g0 = gr[0], g1 = gr[1], g2 = gr[2], g3 = gr[3];
#pragma unroll
            for (int c = 0; c < 2; ++c) {
                float x = ba[c];
#pragma unroll
                for (int j = 0; j < 4; ++j) x += g0[j] * wa[c][j] + g1[j] * wa[c][4 + j] + g2[j] * wa[c][8 + j] + g3[j] * wa[c][12 + j];
                const float ls = fminf(x, 0.f) - __logf(1.0f + __expf(-fabsf(x)));
                run[c] += ls * (1.0f / 16.0f); bl[c][i] = run[c];
            }
        }
        *(LAS f32x2*)(seg + s8 * 128 + 2 * kp) = (f32x2){run[0], run[1]};
        __syncthreads();
        u32x4 pv[4];
#pragma unroll
        for (int p = 0; p < 4; ++p) { const int idx = p * 512 + tid, t = idx >> 5, ch = idx & 31; pv[p] = *(const GAS u32x4*)(Z + (m0 + t) * OD_N + 1024 + 256 * h + 8 * ch); }
        float pre[2] = {0.f, 0.f}, tot[2] = {0.f, 0.f};
#pragma unroll
        for (int q = 0; q < 8; ++q) { const f32x2 sv = *(const LAS f32x2*)(seg + q * 128 + 2 * kp); if (q < s8) { pre[0] += sv.x; pre[1] += sv.y; } tot[0] += sv.x; tot[1] += sv.y; }
        float ks[2][8]; const float et0 = __expf(tot[0]), et1 = __expf(tot[1]);
#pragma unroll
        for (int i = 0; i < 8; ++i) {
            const float b0 = bl[0][i] + pre[0], b1 = bl[1][i] + pre[1];
            const float k0 = bf2f((unsigned short)(kraw[i] & 0xffffu)), k1 = bf2f((unsigned short)(kraw[i] >> 16));
            const float kt0 = k0 * __expf(-b0), kt1 = k1 * __expf(-b1);
            ks[0][i] = kt0 * et0; ks[1][i] = kt1 * et1;
            GAS bf16_t* qr = QK + (m0 + 8 * s8 + i) * 1024 + 128 * h + 2 * kp;
            *(GAS unsigned*)qr = cvt_pk_bf16(bf2f((unsigned short)(qraw[i] & 0xffffu)) * __expf(b0), bf2f((unsigned short)(qraw[i] >> 16)) * __expf(b1));
            *(GAS unsigned*)(qr + 512) = cvt_pk_bf16(kt0, kt1);
        }
#pragma unroll
        for (int c = 0; c < 2; ++c)
            *(LAS u32x4*)(lds + GL_A + (2 * kp + c) * G1_KSSTR + 16 * s8) = pack8((f32x4){ks[c][0], ks[c][1], ks[c][2], ks[c][3]}, (f32x4){ks[c][4], ks[c][5], ks[c][6], ks[c][7]});
#pragma unroll
        for (int p = 0; p < 4; ++p) { const int idx = p * 512 + tid, t = idx >> 5, ch = idx & 31; *(LAS u32x4*)(lds + G1_V + t * GL_VSTR + 16 * ch) = pv[p]; }
        if (s8 == 0) {
            *(LAS f32x2*)(decs + 2 * kp) = (f32x2){et0, et1};
            *(GAS f32x2*)(DCC + (size_t)chunk * 128 + 2 * kp) = (f32x2){et0, et1};
        }
        cum[0] += tot[0]; cum[1] += tot[1];
        __syncthreads();
        const LAS unsigned char* ar = lds + GL_A + (16 * w + fr) * G1_KSSTR + 16 * g;
        const bf16x8 a0 = *(const LAS bf16x8*)ar, a1 = *(const LAS bf16x8*)(ar + 64);
        const f32x4 dcv = *(const LAS f32x4*)(decs + 16 * w + 4 * g);
        const LAS unsigned char* vb = lds + G1_V + (8 * g + qq) * GL_VSTR + 8 * pp;
#pragma unroll
        for (int vt = 0; vt < 16; ++vt) {
            f32x4 c = acc[vt];
            c = c * dcv;
            c = __builtin_amdgcn_mfma_f32_16x16x32_bf16(a0, tr_pair(vb + 32 * vt, vb + 4 * GL_VSTR + 32 * vt), c, 0, 0, 0);
            c = __builtin_amdgcn_mfma_f32_16x16x32_bf16(a1, tr_pair(vb + 32 * GL_VSTR + 32 * vt, vb + 36 * GL_VSTR + 32 * vt), c, 0, 0, 0);
            acc[vt] = c;
        }
        __syncthreads();
    }
    {
        GAS bf16_t* outp = KVT + (size_t)(bh * 64 + 4 * grp) * 32768 + (size_t)w * 4096 + fr * 16 + 4 * g;
#pragma unroll
        for (int vt = 0; vt < 16; ++vt) { u32x2 o; o.x = cvt_pk_bf16(acc[vt][0], acc[vt][1]); o.y = cvt_pk_bf16(acc[vt][2], acc[vt][3]); *(GAS u32x2*)(outp + vt * 256) = o; }
        if (s8 == 0) *(GAS f32x2*)(DG + (size_t)item * 128 + 2 * kp) = (f32x2){__expf(cum[0]), __expf(cum[1])};
    }
}
__device__ __forceinline__ void gla_scan(GAS bf16_t* KVT, const GAS float* DG, const int tid, const int G) {
    for (int gid = blockIdx.x * (NWAVES * 64) + tid; gid < 16 * 8192; gid += G * NWAVES * 64) {
        const int bh = gid >> 13, off = (gid & 8191) * 4, kq = 16 * (off >> 12) + (off & 15);
        GAS bf16_t* p = KVT + (size_t)bh * 64 * 32768 + off; const GAS float* dp = DG + (size_t)bh * 16 * 128 + kq;
        float z_ = 0.f; asm volatile("" : "+v"(z_));
        f32x4 S = (f32x4){z_, z_, z_, z_};
        u32x2 kv[16]; f32x4 dc[16];
#pragma unroll
        for (int i = 0; i < 16; ++i) { kv[i] = *(const GAS u32x2*)(p + (size_t)(4 * i) * 32768); dc[i] = *(const GAS f32x4*)(dp + i * 128); }
#pragma unroll
        for (int i = 0; i < 16; ++i) {
            u32x2 o; o.x = cvt_pk_bf16(S[0], S[1]); o.y = cvt_pk_bf16(S[2], S[3]);
            *(GAS u32x2*)(p + (size_t)(4 * i) * 32768) = o;
            S[0] = dc[i][0] * S[0] + bf2f((unsigned short)(kv[i].x & 0xffffu)); S[1] = dc[i][1] * S[1] + bf2f((unsigned short)(kv[i].x >> 16));
            S[2] = dc[i][2] * S[2] + bf2f((unsigned short)(kv[i].y & 0xffffu)); S[3] = dc[i][3] * S[3] + bf2f((unsigned short)(kv[i].y >> 16));
        }
    }
}
__device__ __forceinline__ void gla_g3_group(LAS unsigned char* lds, GAS bf16_t* Z, const GAS bf16_t* QK, const GAS bf16_t* KVT, const GAS float* DCC, const GAS float* head_g, const int gitem, const int tid) {
    const int lane = tid & 63, w = __builtin_amdgcn_readfirstlane(tid >> 6); int fr = lane & 15, g = lane >> 4;
    const int bh = gitem >> 4, grp = gitem & 15, h = bh & 3; const size_t mbase = (size_t)(bh >> 2) * SEQ + 256 * grp;
    constexpr int G3_DCC = G3_SSQ + 2048;
    constexpr int G3_ST = 81920;
    const f32x4 hg0 = *(const GAS f32x4*)(head_g + 32 * w + 4 * g), hg1 = *(const GAS f32x4*)(head_g + 32 * w + 16 + 4 * g);
    u32x4 pq[2], pk_[2], pv[4];
#define G3_LOAD(m0_) do { int tl_ = tid; asm volatile("" : "+v"(tl_)); _Pragma("unroll") for (int p = 0; p < 2; ++p) { const int idx = p * 512 + tl_, t = idx >> 4, ch = idx & 15; const GAS bf16_t* src = QK + ((m0_) + t) * 1024 + 128 * h + 8 * ch; pq[p] = *(const GAS u32x4*)src; pk_[p] = *(const GAS u32x4*)(src + 512); } \
        _Pragma("unroll") for (int p = 0; p < 4; ++p) { const int idx = p * 512 + tl_, t = idx >> 5, ch = idx & 31; pv[p] = *(const GAS u32x4*)(Z + ((m0_) + t) * OD_N + 1024 + 256 * h + 8 * ch); } } while (0)
    G3_LOAD(mbase);
    {
        const GAS u32x4* gp = (const GAS u32x4*)(KVT + (size_t)(bh * 64 + 4 * grp) * 32768) + tid; u32x4 sg[8];
#pragma unroll
        for (int i = 0; i < 8; ++i) sg[i] = gp[512 * i];
#pragma unroll
        for (int i = 0; i < 8; ++i) *(LAS u32x4*)(lds + G3_ST + 16 * (tid + 512 * i)) = sg[i];
    }
    for (int cc = 0; cc < 4; ++cc) {
    const size_t m0 = mbase + 64 * cc; const int item = bh * 64 + 4 * grp + cc;
    asm volatile("" : "+v"(fr), "+v"(g));
    const int qq = fr >> 2, pp = fr & 3;
    const int so0 = 2 * ((g >> 1) * 4096 + (32 * w + fr) * 16 + 8 * (g & 1));
    PROBE_T0(50);
#pragma unroll
    for (int p = 0; p < 2; ++p) { const int idx = p * 512 + tid, t = idx >> 4, ch = idx & 15;
        *(LAS u32x4*)(lds + GL_A + t * G3_QSTR + 16 * ch) = pq[p]; *(LAS u32x4*)(lds + G3_KT + t * G3_QSTR + 16 * ch) = pk_[p]; }
#pragma unroll
    for (int p = 0; p < 4; ++p) { const int idx = p * 512 + tid, t = idx >> 5, ch = idx & 31; *(LAS u32x4*)(lds + G3_V + t * GL_VSTR + 16 * ch) = pv[p]; }
    if (tid < 32) *(LAS f32x4*)(lds + G3_DCC + 16 * tid) = *(const GAS f32x4*)(DCC + (size_t)item * 128 + 4 * tid);
    __syncthreads();
    PROBE_T1(50); PROBE_T0(51);
    u32x2 srv[4][2];
#pragma unroll
    for (int tt = 0; tt < 4; ++tt)
#pragma unroll
        for (int vi = 0; vi < 2; ++vi) srv[tt][vi] = *(const GAS u32x2*)(Z + (m0 + 16 * tt + fr) * OD_N + 2048 + 256 * h + 32 * w + 16 * vi + 4 * g);
    __builtin_amdgcn_sched_barrier(0);
    u32x4 pb[4][2];
#pragma unroll
    for (int tt = 0; tt < 4; ++tt) {
        bf16x8 qf[4];
#pragma unroll
        for (int ks = 0; ks < 4; ++ks) qf[ks] = *(const LAS bf16x8*)(lds + GL_A + (16 * tt + fr) * G3_QSTR + 64 * ks + 16 * g);
        u32x2 pk[4];
#pragma unroll
        for (int jt = 0; jt < 4; ++jt) {
            if (jt <= tt) {
                f32x4 c = (f32x4){0.f, 0.f, 0.f, 0.f};
#pragma unroll
                for (int ks = 0; ks < 4; ++ks) c = __builtin_amdgcn_mfma_f32_16x16x32_bf16(*(const LAS bf16x8*)(lds + G3_KT + (16 * jt + fr) * G3_QSTR + 64 * ks + 16 * g), qf[ks], c, 0, 0, 0);
                if (jt == tt) {
#pragma unroll
                    for (int e = 0; e < 4; ++e) c[e] = (4 * g + e <= fr) ? c[e] : 0.f;
                }
                pk[jt].x = cvt_pk_bf16(c[0], c[1]); pk[jt].y = cvt_pk_bf16(c[2], c[3]);
            } else { pk[jt].x = 0u; pk[jt].y = 0u; }
        }
        pb[tt][0] = (u32x4){pk[0].x, pk[0].y, pk[1].x, pk[1].y}; pb[tt][1] = (u32x4){pk[2].x, pk[2].y, pk[3].x, pk[3].y};
    }
    PROBE_T1(51); PROBE_T0(52);
    __builtin_amdgcn_sched_barrier(0);
    f32x4 acc[2][4];
    float ssq[4] = {0.f, 0.f, 0.f, 0.f};
    bf16x8 sf[2][4], va[2], vc[2];
#pragma unroll
    for (int vi = 0; vi < 2; ++vi) {
#pragma unroll
        for (int ks = 0; ks < 4; ++ks) sf[vi][ks] = *(const LAS bf16x8*)(lds + G3_ST + so0 + 512 * vi + 16384 * ks);
        const LAS unsigned char* vb = lds + G3_V + (4 * g + qq) * GL_VSTR + 32 * (2 * w + vi) + 8 * pp;
        va[vi] = tr_pair(vb, vb + 16 * GL_VSTR); vc[vi] = tr_pair(vb + 32 * GL_VSTR, vb + 48 * GL_VSTR);
    }
#pragma unroll
    for (int tt = 0; tt < 4; ++tt) {
        bf16x8 qf[4];
#pragma unroll
        for (int ks = 0; ks < 4; ++ks) qf[ks] = *(const LAS bf16x8*)(lds + GL_A + (16 * tt + fr) * G3_QSTR + 64 * ks + 16 * g);
#pragma unroll
        for (int vi = 0; vi < 2; ++vi) {
            f32x4 c = (f32x4){0.f, 0.f, 0.f, 0.f};
#pragma unroll
            for (int ks = 0; ks < 4; ++ks) c = __builtin_amdgcn_mfma_f32_16x16x32_bf16(sf[vi][ks], qf[ks], c, 0, 0, 0);
            c = __builtin_amdgcn_mfma_f32_16x16x32_bf16(va[vi], __builtin_bit_cast(bf16x8, pb[tt][0]), c, 0, 0, 0);
            if (tt >= 2) c = __builtin_amdgcn_mfma_f32_16x16x32_bf16(vc[vi], __builtin_bit_cast(bf16x8, pb[tt][1]), c, 0, 0, 0);
            acc[vi][tt] = c; ssq[tt] += dot4(c);
        }
    }
    PROBE_T1(52); PROBE_T0(53);
    LAS float* sl = (LAS float*)(lds + G3_SSQ);
#pragma unroll
    for (int tt = 0; tt < 4; ++tt) { float v = ssq[tt]; v += __shfl_xor(v, 16); v += __shfl_xor(v, 32); if (g == 0) sl[w * 64 + 16 * tt + fr] = v; }
    __syncthreads();
    if (cc < 3) G3_LOAD(m0 + 64);
#pragma unroll
    for (int tt = 0; tt < 4; ++tt) {
        float tsum = 0.f;
#pragma unroll
        for (int q = 0; q < 8; ++q) tsum += sl[q * 64 + 16 * tt + fr];
        const float rstd = rsqrtf(tsum * (1.0f / 256.0f) + EPS);
#pragma unroll
        for (int vi = 0; vi < 2; ++vi) {
            const f32x4 hg = (vi == 0) ? hg0 : hg1;
            GAS bf16_t* row = Z + (m0 + 16 * tt + fr) * OD_N + 256 * h + 32 * w + 16 * vi + 4 * g;
            const u32x2 sr = srv[tt][vi];
            const f32x4 c = acc[vi][tt];
            u32x2 o; o.x = cvt_pk_bf16(c[0] * rstd * hg[0] * bf2f((unsigned short)(sr.x & 0xffffu)), c[1] * rstd * hg[1] * bf2f((unsigned short)(sr.x >> 16)));
            o.y = cvt_pk_bf16(c[2] * rstd * hg[2] * bf2f((unsigned short)(sr.y & 0xffffu)), c[3] * rstd * hg[3] * bf2f((unsigned short)(sr.y >> 16)));
            *(GAS u32x2*)(row + 1024) = o;
        }
    }
    if (cc < 3) {
        __builtin_amdgcn_sched_barrier(0);
        const LAS unsigned char* vb = lds + G3_V + (8 * g + qq) * GL_VSTR + 8 * pp;
        bf16x8 vlo[2], vhi[2];
#pragma unroll
        for (int vi = 0; vi < 2; ++vi) { const int vt = 2 * w + vi; vlo[vi] = tr_pair(vb + 32 * vt, vb + 4 * GL_VSTR + 32 * vt); vhi[vi] = tr_pair(vb + 32 * GL_VSTR + 32 * vt, vb + 36 * GL_VSTR + 32 * vt); }
        const LAS unsigned char* ka = lds + G3_KT + (8 * g + qq) * G3_QSTR + 8 * pp;
        LAS unsigned char* stp = lds + G3_ST + 2 * ((32 * w + fr) * 16 + 4 * g);
#pragma unroll
        for (int kt = 0; kt < 8; ++kt) {
            const bf16x8 a0 = tr_pair(ka + 32 * kt, ka + 4 * G3_QSTR + 32 * kt), a1 = tr_pair(ka + 32 * G3_QSTR + 32 * kt, ka + 36 * G3_QSTR + 32 * kt);
            const f32x4 dcv = *(const LAS f32x4*)(lds + G3_DCC + 4 * (16 * kt + 4 * g));
#pragma unroll
            for (int vi = 0; vi < 2; ++vi) {
                LAS unsigned char* sp_ = stp + 8192 * kt + 512 * vi;
                const u32x2 ov = *(const LAS u32x2*)sp_;
                f32x4 c = (f32x4){bf2f((unsigned short)(ov.x & 0xffffu)), bf2f((unsigned short)(ov.x >> 16)), bf2f((unsigned short)(ov.y & 0xffffu)), bf2f((unsigned short)(ov.y >> 16))};
                c = __builtin_amdgcn_mfma_f32_16x16x32_bf16(a0, vlo[vi], c, 0, 0, 0);
                c = __builtin_amdgcn_mfma_f32_16x16x32_bf16(a1, vhi[vi], c, 0, 0, 0);
                c = c * dcv;
                u32x2 o; o.x = cvt_pk_bf16(c[0], c[1]); o.y = cvt_pk_bf16(c[2], c[3]);
                *(LAS u32x2*)sp_ = o;
            }
        }
    }
    __syncthreads();
    PROBE_T1(53);
    }
#undef G3_LOAD
}
__device__ __forceinline__ void ga_group(LAS unsigned char* lds, const GAS bf16_t* XB, const GAS float* RSQ, const GAS bf16_t* WGA, GAS float* GA, const int grp, const int tid) {
    const int lane = tid & 63, w = __builtin_amdgcn_readfirstlane(tid >> 6), fr = lane & 15, g = lane >> 4, tt = w & 3, kh = w >> 2;
    const GAS bf16_t* ap = XB + (size_t)(64 * grp + 16 * tt + fr) * D + 512 * kh + 8 * g; const GAS bf16_t* bp = WGA + (size_t)fr * D + 512 * kh + 8 * g;
    f32x4 c = (f32x4){0.f, 0.f, 0.f, 0.f};
#pragma unroll 4
    for (int ks = 0; ks < 16; ++ks) c = __builtin_amdgcn_mfma_f32_16x16x32_bf16(*(const GAS bf16x8*)(ap + 32 * ks), *(const GAS bf16x8*)(bp + 32 * ks), c, 0, 0, 0);
    LAS float* pl = (LAS float*)lds;
#pragma unroll
    for (int e = 0; e < 4; ++e) pl[(kh * 64 + 16 * tt + 4 * g + e) * 16 + fr] = c[e];
    __syncthreads();
    for (int i = tid; i < 64 * 16; i += NWAVES * 64) {
        const int t = i >> 4; const size_t row = (size_t)64 * grp + t;
        float s = 0.f;
#pragma unroll
        for (int q = 0; q < 4; ++q) s += sum4(*(const GAS f32x4*)(RSQ + row * 16 + 4 * q));
        GA[row * 16 + (i & 15)] = (pl[i] + pl[1024 + i]) * rsqrtf(s * (1.0f / 1024.0f) + EPS);
    }
    __syncthreads();
}

constexpr int RING_BYTES = 131072, LDSCTL_OFF = RING_BYTES, MISC_OFF = 163840 - 512, LDSX_OFF = RING_BYTES + 1024, RSTD_OFF = RING_BYTES + 5120, PAR_OFF = RING_BYTES + 13312, LDS_BYTES = 163840;
constexpr int NPHASE = 1 + 8 * DEPTH;
struct Args { const float* in[21]; float* out; unsigned char* ws; int ph_lo, ph_hi, li, pad; };

#define GIN(i) ((const GAS float*)inp[i])
#define MIXW_ITEM(e_, kind_, r_) do { const int _e = (e_), _r = (r_); \
        if ((kind_) == 0) conv_block_item(lds, GIN(3) + (size_t)_e * D * EV_N, nullptr, EV_N, D, EV_N, GIN(1) + (size_t)(2 * _e) * D, (GAS bf16_t*)(ws + WS_WMIX + OFF_EVIN) + (size_t)_e * EV_N * D, 1, _r, tid); \
        else if ((kind_) == 1) conv_block_item(lds, GIN(10) + (size_t)_e * D * D, nullptr, D, D, D, nullptr, (GAS bf16_t*)(ws + WS_WMIX + OFF_EVOUT) + (size_t)_e * D * D, 0, _r, tid); \
        else if ((kind_) == 2) conv_block_item(lds, GIN(11) + (size_t)_e * D * OD_NSRC, nullptr, OD_NSRC, D, OD_N, GIN(1) + (size_t)(2 * _e + 1) * D, (GAS bf16_t*)(ws + WS_WMIX + OFF_ODIN) + (size_t)_e * OD_N * D, 0, _r, tid); \
        else conv_block_item(lds, GIN(15) + (size_t)_e * D * D, nullptr, D, D, D, nullptr, (GAS bf16_t*)(ws + WS_WMIX + OFF_ODOUT) + (size_t)_e * D * D, 0, _r, tid); } while (0)
constexpr int MIXW_EVIN = 8 * (EV_N / 128), MIXW_SQ = 64, MIXW_ODIN = 8 * (OD_N / 128);
__global__ void __launch_bounds__(NWAVES * 64, 2) mega(Args args) {
    extern __shared__ __attribute__((aligned(16))) unsigned char lds_raw[];
    LAS unsigned char* lds = (LAS unsigned char*)lds_raw;
    volatile LAS unsigned* MISC = (volatile LAS unsigned*)(lds + MISC_OFF);
    const int Gk = gridDim.x;
    unsigned* ctl = (unsigned*)(args.ws + WS_CTL);
    for (int u = threadIdx.x; u < (LDS_BYTES - LDSCTL_OFF) / 4; u += NWAVES * 64) ((LAS unsigned*)(lds + LDSCTL_OFF))[u] = 0u;
    __syncthreads();
    XcdBarrier bar = xcd_barrier_post(ctl + CW_BAR + args.li * XCD_BAR_WORDS, MISC + 8);
    if (threadIdx.x == 0) { MISC[12] = bar.x; MISC[13] = xb_add(ctl + CW_CENSUS + 64 * bar.x, 1u); }
    __syncthreads();
    int vb = blockIdx.x; bool vb_done = false, local_ok = false;

    typedef const float* cfp_t;
    const __attribute__((address_space(4))) cfp_t* inp0 = (const __attribute__((address_space(4))) cfp_t*)__builtin_amdgcn_kernarg_segment_ptr();

    bool first = true;
    for (int ph = args.ph_lo; ph < args.ph_hi; ++ph) {
        if (ph > 0) { const int L_ = (ph - 1) >> 3, sub_ = (ph - 1) & 7; if (sub_ == 6 || ((L_ & 1) == 0 && sub_ == 3)) continue; }
        if (!first) {
            PROBE_T0(30);
            const int sub_b = (ph - 1) & 7;
            if (local_ok && (sub_b == 5 || sub_b == 7 || (sub_b == 0 && ph > 1) || (Gk == 256 && (sub_b == 4 || (sub_b == 2 && ((((ph - 1) >> 3) & 1) == 0)))))) xcd_local_barrier(bar);
            else xcd_barrier(bar);
            PROBE_T1(30);
            if (!vb_done) {
                if (threadIdx.x == 0) {
                    bool ok = (Gk % 8) == 0;
                    for (int j = 0; j < 8; ++j) ok = ok && (xb_ld(ctl + CW_CENSUS + 64 * j) == (unsigned)(Gk / 8));
                    MISC[14] = ok ? 1u : 0u; MISC[15] = ok ? (MISC[13] * 8u + MISC[12]) : (unsigned)blockIdx.x;
                }
                __syncthreads();
                vb = (int)MISC[15]; local_ok = MISC[14] != 0u; vb_done = true;
            }
        }
        first = false;
        const __attribute__((address_space(4))) cfp_t* inp = inp0; asm volatile("" : "+s"(inp));
        unsigned char* ws = args.ws; asm volatile("" : "+s"(ws));
        int G = Gk; asm volatile("" : "+s"(G));
        int bid = blockIdx.x; asm volatile("" : "+s"(bid));
        int tid = threadIdx.x; asm volatile("" : "+v"(tid));
        const int lane = tid & 63, wave = __builtin_amdgcn_readfirstlane(tid >> 6);
        const int gw = bid * NWAVES + wave, NGW = G * NWAVES;
        LAS float* scr = (LAS float*)(lds + wave * 16384);
        GAS float* X = (GAS float*)args.out; asm volatile("" : "+s"(X));
        GAS bf16_t* XB = (GAS bf16_t*)(ws + WS_XB); GAS bf16_t* Z = (GAS bf16_t*)(ws + WS_Z);
        GAS float* RSQ = (GAS float*)(ws + WS_RSQ); GAS float* LNP = (GAS float*)(ws + WS_LNP);
        GAS float* DCCP = (GAS float*)((GAS unsigned char*)X + 50 * MiB);
        GAS float* HALO = (GAS float*)(ws + WS_HALO); GAS float* FIXP = (GAS float*)(ws + WS_FIXP); GAS float* FIXU = (GAS float*)(ws + WS_FIXU);
#define WBUF(l_) (((l_) & 1) ? (GAS bf16_t*)(ws + WS_WFFN) : (GAS bf16_t*)((GAS unsigned char*)X + 32 * MiB))
        const int Lcur = (ph > 0) ? ((ph - 1) >> 3) : 0;
        GAS bf16_t* WGU = WBUF(Lcur); GAS bf16_t* WDN = WGU + (size_t)GU_N * D;
        PROBE_T0(ph == 0 ? 0 : ((((ph - 1) >> 3) & 1) ? 20 : 10) + ((ph - 1) & 7));
        if (ph == 0) {
            for (int it = bid; it < MIXW_EVIN + MIXW_ODIN; it += G) { if (it < MIXW_EVIN) MIXW_ITEM(0, 0, it); else MIXW_ITEM(0, 2, it - MIXW_EVIN); }
            for (int i = bid * (NWAVES * 64) + tid; i < 2 * 8 * 128 * 128; i += G * NWAVES * 64) {
                const int tt = (i >> 7) & 127, ss = i & 127;
                ((GAS bf16_t*)(ws + WS_SMALLW))[i] = (bf16_t)((ss <= tt) ? f2bf(GIN(6)[i]) : 0u);
            }
            for (int i = bid * (NWAVES * 64) + tid; i < 2 * 16 * 1024; i += G * NWAVES * 64) {
                const int o = i >> 14, j = (i >> 10) & 15, k = i & 1023;
                ((GAS bf16_t*)(ws + WS_SMALLW + 512 * 1024))[i] = (bf16_t)f2bf(GIN(11)[((size_t)o * D + k) * OD_NSRC + 3072 + j] * GIN(1)[(size_t)(2 * o + 1) * D + k]);
            }
            for (int m = gw; m < M; m += NGW) {
                const f32x4* xr = (const f32x4*)(GIN(0) + (size_t)m * D) + lane; f32x4 v[4]; float s = 0.f;
#pragma unroll
                for (int j = 0; j < 4; ++j) { v[j] = xr[64 * j]; s += dot4(v[j]); }
#pragma unroll
                for (int o = 1; o < 64; o <<= 1) s += __shfl_xor(s, o);
                u32x2* o8 = (u32x2*)(XB + (size_t)m * D) + lane;
#pragma unroll
                for (int j = 0; j < 4; ++j) { u32x2 w; w.x = pk2(v[j][0], v[j][1]); w.y = pk2(v[j][2], v[j][3]); o8[64 * j] = w; }
                if (lane < 16) RSQ[(size_t)m * 16 + lane] = (lane == 0) ? s : 0.f;
            }
        } else {
            const int L = (ph - 1) >> 3, sub = (ph - 1) & 7, e = L >> 1; const bool even = (L & 1) == 0;
            if (sub == 0) {
                pg8::StaticOrder S;
                if (even) {
                    pg8::Gemm g{(const bf16_t*)XB, (const bf16_t*)(ws + WS_WMIX + OFF_EVIN) + (size_t)e * EV_N * D, M, EV_N, D, D}; S.init(M, EV_N, G, vb);
                    stage_rstd(lds, RSQ, tid, vb);
                    if (tid < 128) ((LAS float*)(lds + PAR_OFF))[tid] = (tid < 64) ? GIN(8)[e * 64 + tid] * (0.125f * 1.4426950408889634f) : GIN(9)[e * 64 + tid - 64];
                    __syncthreads();
                    EpiEvenIn E{Z, (const LAS float*)(lds + RSTD_OFF), LNP, (const LAS float*)(lds + PAR_OFF)};
                    pg8::gemm_phase<EpiEvenIn>(lds, g, S, E, tid);
                    {
                        Unit tu; int nun = 0; while (S.next(nun, tu)) ++nun;
                        int nshort = 0, myrank = -1;
                        const int umax = (640 + G - 1) / G, full = 640 - (umax - 1) * G;
                        if (umax * G != 640) { nshort = G - full; myrank = (nun < umax) ? (vb - full) : -1; }
                        if (nshort == 0) { nshort = G; myrank = bid; }
                        if (myrank >= 0) {
                            constexpr int I_GU = 8 * (GU_N / 128), I_DN = (FF / 128) * 8;
                            const GAS float* wg = GIN(16) + (size_t)L * D * FF; const GAS float* wu = GIN(17) + (size_t)L * D * FF; const GAS float* wd = GIN(20) + (size_t)L * FF * D;
                            if (L == 0) {
                                for (int it = myrank; it < I_GU + I_DN + MIXW_SQ; it += nshort) {
                                    if (it < I_GU) conv_block_item(lds, wg, wu, FF, D, GU_N, GIN(2) + (size_t)L * D, WGU, 2, it, tid);
                                    else if (it < I_GU + I_DN) conv_block_item(lds, wd, nullptr, D, FF, D, nullptr, WDN, 0, it - I_GU, tid);
                                    else MIXW_ITEM(0, 1, it - I_GU - I_DN);
                                }
                            } else {
                                for (int it = myrank; it < MIXW_ODIN + MIXW_SQ; it += nshort) { if (it < MIXW_ODIN) MIXW_ITEM(1, 2, it); else MIXW_ITEM(1, 3, it - MIXW_ODIN); }
                            }
                        }
                    }
                } else {
                    pg8::Gemm g{(const bf16_t*)XB, (const bf16_t*)(ws + WS_WMIX + OFF_ODIN) + (size_t)e * OD_N * D, M, OD_N, D, D}; S.init(M, OD_N, G, vb);
                    stage_rstd(lds, RSQ, tid, vb);
                    __syncthreads();
                    EpiOddIn E{Z, (const LAS float*)(lds + RSTD_OFF)};
                    pg8::gemm_phase<EpiOddIn>(lds, g, S, E, tid);
                    for (int grp = 32 * (vb & 7) + (vb >> 3); grp < M / 64; grp += G) ga_group(lds, XB, RSQ, (const GAS bf16_t*)(ws + WS_SMALLW + 512 * 1024) + (size_t)e * 16 * D, (GAS float*)(ws + WS_GA), grp, tid);
                }
            } else if (sub == 1) {
                if (even) {
                    GAS bf16_t* P1 = (GAS bf16_t*)(ws + WS_AUX); GAS bf16_t* P2 = (GAS bf16_t*)(ws + WS_AUX + 16 * MiB); GAS float* L1 = (GAS float*)(ws + WS_AUX + 32 * MiB); GAS float* L2 = L1 + (size_t)M * 8;
                    const bool sm = local_ok && G == 256;
                    const int xmap = sm ? (vb & 7) : -1, jmap = vb >> 3;
                    const int cnt = sm ? 4 : (1024 - bid + G - 1) / G;
                    attn_run<false>(lds, Z, 0, bid, cnt, G, xmap, jmap, P1, L1, nullptr, nullptr, nullptr, nullptr, tid);
                    attn_run<false>(lds, Z, 2, bid, cnt, G, xmap, jmap, P2, L2, nullptr, nullptr, nullptr, nullptr, tid);
                    gmlp_run(lds, Z, LNP, GIN(4) + e * 512, GIN(5) + e * 512, (const GAS bf16_t*)(ws + WS_SMALLW) + (size_t)e * 8 * 128 * 128, GIN(7) + e * 8 * 128, cnt,
                             [=](const int i) { const int q = jmap + 32 * i; return sm ? (16 * xmap + (q >> 3)) * 8 + (q & 7) : bid + i * G; }, tid);
                } else {
                    for (int it = bid; it < 256; it += G) gla_g1_group(lds, Z, (const GAS float*)(ws + WS_GA), GIN(12) + (size_t)e * 16 * 512, GIN(13) + e * 512, (GAS bf16_t*)(ws + WS_AUX), DCCP, DCCP + 131072, (GAS bf16_t*)X, it, tid);
                }
            } else if (sub == 2 && even) {
                const GAS bf16_t* P1 = (const GAS bf16_t*)(ws + WS_AUX); const GAS bf16_t* P2 = (const GAS bf16_t*)(ws + WS_AUX + 16 * MiB); const GAS float* L1 = (const GAS float*)(ws + WS_AUX + 32 * MiB); const GAS float* L2 = L1 + (size_t)M * 8;
                const bool sm = local_ok && G == 256;
                attn_run<true>(lds, Z, 4, bid, sm ? 4 : (1024 - bid + G - 1) / G, G, sm ? (vb & 7) : -1, vb >> 3, nullptr, nullptr, P1, P2, L1, L2, tid);
                if (sm) done_arrive(ctl + CW_DONE + 64 * (L * 8 + (vb & 7)));
            } else if (sub == 2) {
                gla_scan((GAS bf16_t*)(ws + WS_AUX), DCCP + 131072, tid, G);
            } else if (sub == 3) {
                if (local_ok && G == 256) {
                    const int x = vb & 7, j = vb >> 3;
                    gla_g3_group(lds, Z, (const GAS bf16_t*)X, (const GAS bf16_t*)(ws + WS_AUX), DCCP, GIN(14) + e * 256, (((x >> 1) * 4 + (j >> 3)) << 4) + 8 * (x & 1) + (j & 7), tid);
                    if (L == DEPTH - 1) done_arrive(ctl + CW_DONE + 64 * 32);
                } else
                for (int it = bid; it < 256; it += G) gla_g3_group(lds, Z, (const GAS bf16_t*)X, (const GAS bf16_t*)(ws + WS_AUX), DCCP, GIN(14) + e * 256, it, tid);
            } else if (sub == 4 || sub == 7) {
                pg8::StaticOrder S; S.init(M, D, G, vb);
                if (sub == 7 && L == DEPTH - 1 && local_ok && G == 256) done_wait(ctl + CW_DONE + 64 * 32, 256u);
                if (sub == 7) {
                    const GAS float* cw = GIN(18) + (size_t)L * 3 * FF; Unit fu;
                    for (int i = 0; S.next(i, fu); ++i) {
                        const int pm = fu.pm; if ((pm & 15) == 0) continue;
                        const bool xc = (pm & 7) == 0;
                        if (xc) {
                            if (tid == 0) { unsigned* cw_ = ctl + CW_HCNT + L * 4096 + 64 * (pm - 1); unsigned sp_ = 0;
                                while (__hip_atomic_load(cw_, __ATOMIC_RELAXED, __HIP_MEMORY_SCOPE_AGENT) < (unsigned)(GU_N / 256)) { __builtin_amdgcn_s_sleep(2); if (++sp_ > (1u << 22)) break; }
                                __builtin_amdgcn_fence(__ATOMIC_ACQUIRE, "agent"); asm volatile("s_waitcnt vmcnt(0)" ::: "memory"); }
                            __syncthreads();
                        }
                        for (int idx = tid; idx < 2 * FF; idx += NWAVES * 64) {
                            const int j = idx / FF, c = idx % FF;
                            float h1, h0;
                            if (xc) { h1 = __builtin_bit_cast(float, __hip_atomic_load((const GAS unsigned*)(HALO + ((size_t)(pm - 1) * 2 + 1) * FF + c), __ATOMIC_RELAXED, __HIP_MEMORY_SCOPE_AGENT));
                                      h0 = __builtin_bit_cast(float, __hip_atomic_load((const GAS unsigned*)(HALO + ((size_t)(pm - 1) * 2 + 0) * FF + c), __ATOMIC_RELAXED, __HIP_MEMORY_SCOPE_AGENT)); }
                            else { h1 = HALO[((size_t)(pm - 1) * 2 + 1) * FF + c]; h0 = HALO[((size_t)(pm - 1) * 2 + 0) * FF + c]; }
                            float pre = FIXP[((size_t)pm * 2 + j) * FF + c];
                            if (j == 0) pre += cw[FF + c] * h1 + cw[c] * h0; else pre += cw[c] * h1;
                            Z[(size_t)(pm * 256 + j) * ZLD + c] = (bf16_t)f2bf(silu_f(pre) * FIXU[((size_t)pm * 2 + j) * FF + c]);
                        }
                    }
                    asm volatile("s_waitcnt vmcnt(0)" ::: "memory"); __syncthreads();
                }
                pg8::Gemm g;
                if (sub == 7) g = pg8::Gemm{(const bf16_t*)Z, (const bf16_t*)WDN, M, D, FF, ZLD};
                else if (even) g = pg8::Gemm{(const bf16_t*)Z, (const bf16_t*)(ws + WS_WMIX + OFF_EVOUT) + (size_t)e * D * D, M, D, D, ZLD};
                else g = pg8::Gemm{(const bf16_t*)(Z + 1024), (const bf16_t*)(ws + WS_WMIX + OFF_ODOUT) + (size_t)e * D * D, M, D, D, OD_N};
                const bool first_upd = (L == 0 && sub == 4), last_upd = (L == DEPTH - 1 && sub == 7);
                EpiRes E{first_upd ? GIN(0) : (const GAS float*)nullptr, (const GAS bf16_t*)XB, last_upd ? X : (GAS float*)nullptr, XB, RSQ};
                pg8::gemm_phase<EpiRes>(lds, g, S, E, tid);
            } else if (sub == 5) {
                if (even && local_ok && G == 256 && (vb & 1) == 0) done_wait(ctl + CW_DONE + 64 * (L * 8 + (vb & 7) + 1), 32u);
                pg8::StaticOrder S; S.init(M, GU_N, G, vb);
                pg8::Gemm g{(const bf16_t*)XB, (const bf16_t*)WGU, M, GU_N, D, D};
                stage_rstd(lds, RSQ, tid, vb);
                {
                    const GAS float* cw = GIN(18) + (size_t)L * 3 * FF; const GAS float* cb = GIN(19) + (size_t)L * FF; Unit pu;
                    for (int i = 0; S.next(i, pu); ++i) { const int arr = tid >> 7, j = tid & 127; ((LAS float*)(lds + PAR_OFF))[i * 512 + tid] = (arr < 3) ? cw[arr * FF + 128 * pu.pn + j] : cb[128 * pu.pn + j]; }
                }
                __syncthreads();
                EpiF1 E{Z, (const LAS float*)(lds + RSTD_OFF), (const LAS float*)(lds + PAR_OFF), HALO, FIXP, FIXU, (LAS float*)(lds + LDSX_OFF), ctl + CW_HCNT + L * 4096};
                pg8::gemm_phase<EpiF1>(lds, g, S, E, tid);
                if (L + 1 < DEPTH) {
                    constexpr int NT = (M / 256) * (GU_N / 256);
                    Unit tu; int nun = 0; while (S.next(nun, tu)) ++nun;
                    const int umax = (NT + G - 1) / G, full = NT - (umax - 1) * G;
                    int nshort = G, myrank = bid;
                    if (umax * G != NT) { nshort = G - full; myrank = (nun < umax) ? (vb - full) : -1; }
                    if (myrank >= 0) {
                        constexpr int I_GU = 8 * (GU_N / 128), I_DN = (FF / 128) * 8;
                        const int Ln = L + 1;
                        const GAS float* wg = GIN(16) + (size_t)Ln * D * FF; const GAS float* wu = GIN(17) + (size_t)Ln * D * FF; const GAS float* wd = GIN(20) + (size_t)Ln * FF * D;
                        GAS bf16_t* ngu = WBUF(Ln); GAS bf16_t* ndn = ngu + (size_t)GU_N * D;
                        const int extra = (L == 0) ? MIXW_SQ + MIXW_EVIN : (L == 1) ? MIXW_SQ : 0;
                        for (int it = myrank; it < I_GU + I_DN + extra; it += nshort) {
                            if (it < I_GU) conv_block_item(lds, wg, wu, FF, D, GU_N, GIN(2) + (size_t)Ln * D, ngu, 2, it, tid);
                            else if (it < I_GU + I_DN) conv_block_item(lds, wd, nullptr, D, FF, D, nullptr, ndn, 0, it - I_GU, tid);
                            else if (L == 1) MIXW_ITEM(1, 1, it - I_GU - I_DN);
                            else if (it < I_GU + I_DN + MIXW_SQ) MIXW_ITEM(0, 3, it - I_GU - I_DN);
                            else MIXW_ITEM(1, 0, it - I_GU - I_DN - MIXW_SQ);
                        }
                    }
                }
            }
        }
        PROBE_T1(ph == 0 ? 0 : ((((ph - 1) >> 3) & 1) ? 20 : 10) + ((ph - 1) & 7));
    }
    if (PROBE_ID >= 0 && blockIdx.x == 0 && threadIdx.x == 0) {
        const unsigned long long dt = *(volatile LAS unsigned long long*)(probe_lds), t0 = __builtin_amdgcn_s_memrealtime();
        while (__builtin_amdgcn_s_memrealtime() - t0 < PROBE_K * dt) __builtin_amdgcn_s_sleep(8);
    }
}

extern "C" void kernel_launch(void* const* d_in, const int* in_sizes, int n_in, void* d_out, int out_size, void* d_ws, size_t ws_size, hipStream_t stream) {
    static int grid = 0;
    if (grid == 0) {
        if (n_in != 21 || out_size != M * D || ws_size < WS_END) { fprintf(stderr, "kernel_launch: unexpected shapes (n_in %d out %d ws %zu)\n", n_in, out_size, ws_size); grid = -1; return; }
        int dev = 0, cus = 0, per_cu = 0;
        hipGetDevice(&dev); hipDeviceGetAttribute(&cus, hipDeviceAttributeMultiprocessorCount, dev);
        hipFuncSetAttribute((const void*)mega, hipFuncAttributeMaxDynamicSharedMemorySize, LDS_BYTES);
        hipOccupancyMaxActiveBlocksPerMultiprocessor(&per_cu, (const void*)mega, NWAVES * 64, LDS_BYTES);
        (void)hipGetLastError();
        if (per_cu < 1) per_cu = 1;
        if (per_cu > 1) per_cu = 1;
        grid = cus * per_cu;
        fprintf(stderr, "kernel_launch: grid %d (cus %d), ws %zu\n", grid, cus, ws_size);
    }
    if (grid < 0) return;
    hipMemsetAsync((char*)d_ws + WS_CTL, 0, CTL_ZERO_BYTES, stream);
    Args a{};
    for (int i = 0; i < 21; ++i) a.in[i] = (const float*)d_in[i];
    a.out = (float*)d_out; a.ws = (unsigned char*)d_ws;
    a.ph_lo = 0; a.ph_hi = NPHASE; a.li = 0;
    void* kargs[] = {&a};
    hipError_t le = hipLaunchCooperativeKernel((const void*)mega, dim3(grid), dim3(NWAVES * 64), kargs, LDS_BYTES, stream);
    if (le != hipSuccess) fprintf(stderr, "cooperative launch failed: %s\n", hipGetErrorString(le));
}
```

```cpp
#include <hip/hip_runtime.h>
#include <cstdio>
#include <cstdint>

#define LAS __attribute__((address_space(3)))
#define GAS __attribute__((address_space(1)))
typedef unsigned short bf16_t;
typedef short bf16x8 __attribute__((ext_vector_type(8)));
typedef float f32x4 __attribute__((ext_vector_type(4)));
typedef float f32x2 __attribute__((ext_vector_type(2)));
typedef unsigned u32x4 __attribute__((ext_vector_type(4)));
typedef unsigned u32x2 __attribute__((ext_vector_type(2)));

constexpr int D = 1024, BATCH = 4, SEQ = 4096, M = BATCH * SEQ, DEPTH = 4;
constexpr int EV_N = 2560, OD_N = 3072, OD_NSRC = 3088, FF = 2816, GU_N = 2 * FF;
constexpr int ZLD = 3072;
constexpr float EPS = 1e-6f;

constexpr size_t MiB = 1u << 20;
constexpr size_t WS_CTL = 0, CTL_ZERO_BYTES = 256 * 1024;
constexpr size_t WS_RSQ = 1 * MiB;
constexpr size_t WS_LNP = 2 * MiB;
constexpr size_t WS_GA = 3 * MiB;
constexpr size_t WS_HALO = 4 * MiB;
constexpr size_t WS_FIXP = 6 * MiB;
constexpr size_t WS_FIXU = 8 * MiB;
constexpr size_t WS_SMALLW = 10 * MiB;
constexpr size_t WS_WMIX = 12 * MiB;
constexpr size_t OFF_EVIN = 0, OFF_EVOUT = 10 * MiB, OFF_ODIN = 14 * MiB, OFF_ODOUT = 26 * MiB;
constexpr size_t WS_WFFN = 42 * MiB;
constexpr size_t OFF_WDOWN = 11 * MiB;
constexpr size_t WS_XB = 60 * MiB;
constexpr size_t WS_Z = 92 * MiB;
constexpr size_t WS_AUX = 188 * MiB;
constexpr size_t WS_END = 252 * MiB;
constexpr int CW_CONV = 49152, CW_F2DONE = 49152 + 64 * 8, CW_E1DONE = 49152 + 64 * 16, CW_UVDONE = 49152 + 64 * 32;
constexpr int CW_BAR = 4096, CW_CENSUS = 2048, CW_HCNT = 16384, CW_DONE = 40960, CW_GLA1 = 45056, CW_GLA2 = 47104;

constexpr int NWAVES = 8;
#define probe_lds ((LAS unsigned char*)(163840 - 512 + 64))
constexpr int RSTD_OFF_ = 131072 + 5120, PAR_OFF_ = 131072 + 13312;
#ifndef PROBE_ID
#define PROBE_ID -1
#endif
#ifndef PROBE_K
#define PROBE_K 8
#endif
#define PROBE_T0(id) do { if ((id) == PROBE_ID && blockIdx.x == 0 && threadIdx.x == 0) { *(volatile LAS unsigned long long*)(probe_lds + 8) = __builtin_amdgcn_s_memrealtime(); } } while (0)
#define PROBE_T1(id) do { if ((id) == PROBE_ID && blockIdx.x == 0 && threadIdx.x == 0) { *(volatile LAS unsigned long long*)(probe_lds) += __builtin_amdgcn_s_memrealtime() - *(volatile LAS unsigned long long*)(probe_lds + 8); } } while (0)
__device__ __forceinline__ unsigned f2bf(float f) { unsigned u = __builtin_bit_cast(unsigned, f); return (u + 0x7fffu + ((u >> 16) & 1u)) >> 16; }
__device__ __forceinline__ unsigned pk2(float lo, float hi) { return f2bf(lo) | (f2bf(hi) << 16); }
__device__ __forceinline__ float bf2f(unsigned short h) { return __builtin_bit_cast(float, (unsigned)h << 16); }
typedef __bf16 bf2_t __attribute__((ext_vector_type(2)));
__device__ __forceinline__ unsigned cvt_pk_bf16(float lo, float hi) { const bf2_t r = __builtin_convertvector((f32x2){lo, hi}, bf2_t); return __builtin_bit_cast(unsigned, r); }
__device__ __forceinline__ float silu_f(float x) { return x * __builtin_amdgcn_rcpf(1.0f + __expf(-x)); }
__device__ __forceinline__ f32x4 silu4(f32x4 x) {
    f32x4 t = x * (-1.4426950408889634f);
    t[0] = __builtin_amdgcn_exp2f(t[0]); t[1] = __builtin_amdgcn_exp2f(t[1]); t[2] = __builtin_amdgcn_exp2f(t[2]); t[3] = __builtin_amdgcn_exp2f(t[3]);
    t = t + 1.0f;
    t[0] = __builtin_amdgcn_rcpf(t[0]); t[1] = __builtin_amdgcn_rcpf(t[1]); t[2] = __builtin_amdgcn_rcpf(t[2]); t[3] = __builtin_amdgcn_rcpf(t[3]);
    return x * t;
}
__device__ __forceinline__ f32x2 gelu_pk(f32x2 v) {
    const f32x2 z0 = v * 0.70710678118f;
    f32x2 z; z.x = __builtin_amdgcn_fmed3f(z0.x, -3.0f, 3.0f); z.y = __builtin_amdgcn_fmed3f(z0.y, -3.0f, 3.0f);
    const f32x2 sv = (z * z) * 0.22222222222f + (-1.0f);
    f32x2 p = sv * 0.0065809390507638454f + (-0.01773315854370594f);
    p = p * sv + 0.024549897760152817f; p = p * sv + (-0.039930570870637894f); p = p * sv + 0.0718911811709404f; p = p * sv + (-0.11105967313051224f);
    p = p * sv + 0.15764106810092926f; p = p * sv + (-0.22873686254024506f); p = p * sv + 0.4701276421546936f;
    const f32x2 e = p * z, hx = v * 0.5f;
    return e * hx + hx;
}
__device__ __forceinline__ f32x4 gelu4(f32x4 v) { f32x2 a = gelu_pk((f32x2){v[0], v[1]}), b = gelu_pk((f32x2){v[2], v[3]}); return (f32x4){a.x, a.y, b.x, b.y}; }
__device__ __forceinline__ float sum4(f32x4 v) { return (v[0] + v[1]) + (v[2] + v[3]); }
__device__ __forceinline__ float dot4(f32x4 v) { return (v[0] * v[0] + v[1] * v[1]) + (v[2] * v[2] + v[3] * v[3]); }
__device__ __forceinline__ u32x4 pack8(f32x4 a, f32x4 b) { u32x4 w; w.x = cvt_pk_bf16(a[0], a[1]); w.y = cvt_pk_bf16(a[2], a[3]); w.z = cvt_pk_bf16(b[0], b[1]); w.w = cvt_pk_bf16(b[2], b[3]); return w; }
typedef __amdgpu_buffer_rsrc_t rsrc_t;
__device__ __forceinline__ rsrc_t wt_rsrc(const GAS void* base) { return __builtin_amdgcn_make_buffer_rsrc((void*)base, 0, 0x7fffffff, 0x00020000); }
__device__ __forceinline__ void st_wt16(rsrc_t r, unsigned byte_off, u32x4 v) { __builtin_amdgcn_raw_buffer_store_b128(v, r, (int)byte_off, 0, 16); }

namespace pg8 {
constexpr int BM = 256, BK = 64, HALF = 128, HTB = HALF * BK * 2, STAGE_BYTES = 8 * HTB, NXCD = 8, WGM = 8;
__host__ __device__ __forceinline__ int lds_byte(int r, int c) { const int st = (r >> 4) * 2 + (c >> 5), rr = r & 15, cc = c & 31, ob = rr * 64 + cc * 2; return st * 1024 + (ob ^ (((ob >> 9) & 1) << 5)); }
__host__ __device__ __forceinline__ void stage_rc(int b, int& R, int& C) { const int st = b / 1024, sb = b % 1024, swz = sb ^ (((sb >> 9) & 1) << 5); R = (st >> 1) * 16 + swz / 64; C = (st & 1) * 32 + (swz % 64) / 2; }
__host__ __device__ __forceinline__ int perm32(int rho) { const int n = rho >> 4, i = rho & 15; return 8 * (i >> 2) + 4 * n + (i & 3); }
struct Unit { int pm, pn, ui; };
struct Gemm { const bf16_t* A; const bf16_t* Bt; int M, N, K, lda; };
struct StaticOrder {
    int nM, nN, nwg, G, c, pnx;
    __device__ __forceinline__ void init(int M_, int N_, int G_, int c_, int pnx_ = 0) { nM = M_ / BM; nN = N_ / BM; nwg = nM * nN; G = G_; c = c_; pnx = pnx_; }
    __device__ __forceinline__ bool next(int i, Unit& u) const {
        const long L = (long)i * G + c; if (L >= nwg) return false;
        int wgid = (int)L; { const int q = nwg / NXCD, r = nwg % NXCD, xcd = wgid % NXCD, off = wgid / NXCD; wgid = (xcd < r ? xcd * (q + 1) : r * (q + 1) + (xcd - r) * q) + off; }
        const int nig = WGM * nN, gid = wgid / nig, fm = gid * WGM, gsz = (nM - fm) < WGM ? (nM - fm) : WGM;
        u.pm = fm + ((wgid % nig) % gsz); u.pn = (wgid % nig) / gsz; if (u.pn < 8) u.pn ^= pnx; u.ui = i; return true;
    }
};
template <class Epi>
__device__ __forceinline__ void gemm_phase(LAS unsigned char* lds, const Gemm g, const StaticOrder& S, const Epi& E, const int tid) {
    const int wid = __builtin_amdgcn_readfirstlane(tid >> 6), lane = tid & 63, wr = wid >> 2, wc = wid & 3, fr = lane & 15, fq = lane >> 4;
    const int K = g.K, nt = K / BK, lda = g.lda;
    unsigned voffA[2], voffB[2];
#pragma unroll
    for (int i = 0; i < 2; ++i) { int R, C; stage_rc(tid * 16 + i * 8192, R, C); const int Rb = (R & ~31) + perm32(R & 31);
        voffA[i] = (unsigned)(R * lda + C) * 2u; voffB[i] = (unsigned)(Rb * K + C) * 2u; }
    const size_t kstep = (size_t)(BK * 2);
    const size_t hstepA = (size_t)HALF * lda * 2, hstepB = (size_t)HALF * K * 2;
    const size_t tstepA = 2 * hstepA, tstepB = 2 * hstepB;
    const unsigned ldsw = (unsigned)wid * 1024u;
    const int aoff = lds_byte(wr * 64 + fr, fq * 8), boff = lds_byte(wc * 32 + fr, fq * 8);
#define PG8_SA(b, h) (((b) * 2 + (h)) * HTB)
#define PG8_SB(b, h) ((4 + (b) * 2 + (h)) * HTB)
#define PG8_STAGE(bufoff, gbase, voff) do { _Pragma("unroll") for (int _i = 0; _i < 2; ++_i) \
        __builtin_amdgcn_global_load_lds((const unsigned*)((const char*)(gbase) + (voff)[_i]), (LAS unsigned*)(lds + (bufoff) + ldsw + _i * 8192), 16, 0, 0); } while (0)
#define PG8_LDA(dst, b, h) do { _Pragma("unroll") for (int m = 0; m < 4; ++m) _Pragma("unroll") for (int k = 0; k < 2; ++k) dst[m][k] = *(const LAS bf16x8*)(lds + PG8_SA(b, h) + aoff + m * 2048 + k * 1024); } while (0)
#define PG8_LDB(dst, b, h) do { _Pragma("unroll") for (int n = 0; n < 2; ++n) _Pragma("unroll") for (int k = 0; k < 2; ++k) dst[n][k] = *(const LAS bf16x8*)(lds + PG8_SB(b, h) + boff + n * 2048 + k * 1024); } while (0)
#define PG8_MMA(ai, bj, At, Bt) do { __builtin_amdgcn_s_setprio(1); _Pragma("unroll") for (int m = 0; m < 4; ++m) _Pragma("unroll") for (int n = 0; n < 2; ++n) _Pragma("unroll") for (int k = 0; k < 2; ++k) \
        acc[ai][bj][m][n] = __builtin_amdgcn_mfma_f32_16x16x32_bf16(Bt[n][k], At[m][k], acc[ai][bj][m][n], 0, 0, 0); __builtin_amdgcn_s_setprio(0); } while (0)
#define PG8_WAIT_V(n) asm volatile("s_waitcnt vmcnt(" #n ")" ::: "memory")
#define PG8_WAIT_L(n) asm volatile("s_waitcnt lgkmcnt(" #n ")" ::: "memory")
#define PG8_BAR __builtin_amdgcn_s_barrier()
#define PG8_SCHED __builtin_amdgcn_sched_barrier(0)
    Unit cur, nxt; int ui = 0;
    if (!S.next(0, cur)) return;
    f32x4 acc[2][2][4][2];
    E.init(acc, cur, wr, wc, fr, fq);
    bf16x8 At[4][2], B0[2][2], B1[2][2];
    const char* cA = (const char*)g.A + (size_t)cur.pm * tstepA; const char* cB = (const char*)g.Bt + (size_t)cur.pn * tstepB;
    PG8_STAGE(PG8_SB(0, 0), cB, voffB); PG8_STAGE(PG8_SB(0, 1), cB + hstepB, voffB); PG8_STAGE(PG8_SA(0, 0), cA, voffA); PG8_STAGE(PG8_SA(0, 1), cA + hstepA, voffA);
    if (wr == 1) PG8_BAR;
    PG8_WAIT_V(2); PG8_BAR;
    PG8_STAGE(PG8_SB(1, 0), cB + kstep, voffB); PG8_STAGE(PG8_SA(1, 0), cA + kstep, voffA); PG8_STAGE(PG8_SB(1, 1), cB + hstepB + kstep, voffB);
    PG8_WAIT_V(6); PG8_BAR;
    for (;;) {
        const bool has_next = S.next(ui + 1, nxt);
        const char* nA = has_next ? (const char*)g.A + (size_t)nxt.pm * tstepA : cA; const char* nB = has_next ? (const char*)g.Bt + (size_t)nxt.pn * tstepB : cB;
        for (int t = 0; t < nt; t += 2) {
            const bool last = (t == nt - 2);
            const char* a1 = cA + (size_t)(t + 1) * kstep;
            const char* a2 = last ? nA : cA + (size_t)(t + 2) * kstep; const char* b2 = last ? nB : cB + (size_t)(t + 2) * kstep;
            const char* a3 = a2 + kstep; const char* b3 = b2 + kstep;
            PG8_LDB(B0, 0, 0); PG8_LDB(B1, 0, 1); PG8_SCHED; PG8_LDA(At, 0, 0); PG8_STAGE(PG8_SA(1, 1), a1 + hstepA, voffA);
            PG8_WAIT_V(8); PG8_WAIT_L(0); PG8_BAR; PG8_MMA(0, 0, At, B0); PG8_MMA(0, 1, At, B1); PG8_BAR; PG8_SCHED;
            PG8_LDA(At, 0, 1); PG8_STAGE(PG8_SB(0, 0), b2, voffB); PG8_STAGE(PG8_SB(0, 1), b2 + hstepB, voffB); PG8_STAGE(PG8_SA(0, 0), a2, voffA);
            PG8_WAIT_V(8); PG8_WAIT_L(0); PG8_BAR; PG8_MMA(1, 0, At, B0); PG8_MMA(1, 1, At, B1); PG8_BAR; PG8_SCHED;
            PG8_LDB(B0, 1, 0); PG8_LDB(B1, 1, 1); PG8_SCHED; PG8_LDA(At, 1, 0); PG8_STAGE(PG8_SA(0, 1), a2 + hstepA, voffA);
            PG8_WAIT_V(8); PG8_WAIT_L(0); PG8_BAR; PG8_MMA(0, 0, At, B0); PG8_MMA(0, 1, At, B1); PG8_BAR; PG8_SCHED;
            PG8_LDA(At, 1, 1); PG8_STAGE(PG8_SB(1, 0), b3, voffB); PG8_STAGE(PG8_SB(1, 1), b3 + hstepB, voffB); PG8_STAGE(PG8_SA(1, 0), a3, voffA);
            PG8_WAIT_V(8); PG8_WAIT_L(0); PG8_BAR; PG8_MMA(1, 0, At, B0); PG8_MMA(1, 1, At, B1); PG8_BAR; PG8_SCHED;
        }
        if (wr == 0) PG8_BAR;
        E(acc, cur, wr, wc, fr, fq);
        if (!has_next) break;
        E.init(acc, nxt, wr, wc, fr, fq);
        cur = nxt; cA = nA; cB = nB; ++ui;
        if (wr == 1) PG8_BAR;
    }
    PG8_WAIT_V(0);
    PG8_BAR;
#undef PG8_SA
#undef PG8_SB
#undef PG8_STAGE
#undef PG8_LDA
#undef PG8_LDB
#undef PG8_MMA
#undef PG8_WAIT_V
#undef PG8_WAIT_L
#undef PG8_BAR
#undef PG8_SCHED
}
}
using pg8::Unit;

__device__ __forceinline__ void row_rstd(const LAS float* rstd, int lrow, float (&rs)[2][4]) {
#pragma unroll
    for (int ai = 0; ai < 2; ++ai)
#pragma unroll
        for (int m = 0; m < 4; ++m) rs[ai][m] = rstd[lrow + ai * 128 + m * 16];
}
__device__ __forceinline__ void stage_rstd(LAS unsigned char* lds, const GAS float* rsq, const int tid, const int vbx, const int pml) {
    LAS float* out = (LAS float*)(lds + RSTD_OFF_);
    const size_t r0 = (size_t)2048 * (vbx & 7);
    if (pml >= 0) {
        if (tid < 256) {
            const int r = 256 * pml + tid; f32x4 p[4];
#pragma unroll
            for (int q = 0; q < 4; ++q) p[q] = *(const GAS f32x4*)(rsq + (r0 + r) * 16 + 4 * q);
            out[r] = rsqrtf(((sum4(p[0]) + sum4(p[1])) + (sum4(p[2]) + sum4(p[3]))) * (1.0f / 1024.0f) + EPS);
        }
        return;
    }
    f32x4 p[4][4];
#pragma unroll
    for (int j = 0; j < 4; ++j)
#pragma unroll
        for (int q = 0; q < 4; ++q) p[j][q] = *(const GAS f32x4*)(rsq + (r0 + tid + 512 * j) * 16 + 4 * q);
#pragma unroll
    for (int j = 0; j < 4; ++j) out[tid + 512 * j] = rsqrtf(((sum4(p[j][0]) + sum4(p[j][1])) + (sum4(p[j][2]) + sum4(p[j][3]))) * (1.0f / 1024.0f) + EPS);
}

struct EpiEvenIn {
    __device__ __forceinline__ void init(f32x4 (&acc)[2][2][4][2], const Unit&, int, int, int, int) const {
#pragma unroll
        for (int a = 0; a < 2; ++a)
#pragma unroll
            for (int b = 0; b < 2; ++b)
#pragma unroll
                for (int m = 0; m < 4; ++m)
#pragma unroll
                    for (int n = 0; n < 2; ++n) acc[a][b][m][n] = (f32x4){0.f, 0.f, 0.f, 0.f};
    }
    GAS bf16_t* Z; const LAS float* rstd; GAS float* lnp; const LAS float* qkg;
    __device__ __forceinline__ void operator()(const f32x4 (&acc)[2][2][4][2], const Unit& u, int wr, int wc, int fr, int fq) const {
        asm volatile("" : "+v"(fr), "+v"(fq));
        const int rowb = u.pm * 256 + wr * 64 + fr, kind = u.pn >> 1;
        float rs[2][4]; row_rstd(rstd, (u.pm & 7) * 256 + wr * 64 + fr, rs);
        const rsrc_t zr = wt_rsrc(Z);
        if (kind == 1 || kind == 3) {
            const LAS float* g = qkg + ((kind == 1) ? 0 : 64);
            f32x4 gv[2][2];
#pragma unroll
            for (int bj = 0; bj < 2; ++bj)
#pragma unroll
                for (int n = 0; n < 2; ++n) gv[bj][n] = *(const LAS f32x4*)(g + 32 * bj + 8 * fq + 4 * n);
#pragma unroll
            for (int ai = 0; ai < 2; ++ai)
#pragma unroll
                for (int m = 0; m < 4; ++m) {
                    float ss = 0.f;
#pragma unroll
                    for (int bj = 0; bj < 2; ++bj)
#pragma unroll
                        for (int n = 0; n < 2; ++n) ss += dot4(acc[ai][bj][m][n]);
                    ss += __shfl_xor(ss, 16); ss += __shfl_xor(ss, 32);
                    const float r = rs[ai][m], rh = rsqrtf(ss * r * r * (1.0f / 64.0f) + EPS) * r;
                    const unsigned zo = (unsigned)((rowb + ai * 128 + m * 16) * ZLD + u.pn * 256 + 64 * wc + 8 * fq) * 2u;
#pragma unroll
                    for (int bj = 0; bj < 2; ++bj) { const u32x4 pk_ = pack8(acc[ai][bj][m][0] * rh * gv[bj][0], acc[ai][bj][m][1] * rh * gv[bj][1]);
                        if (kind == 3) st_wt16(zr, zo + 64u * bj, pk_); else *(GAS u32x4*)((GAS unsigned char*)Z + zo + 64u * bj) = pk_; }
                }
        } else {
#pragma unroll
            for (int ai = 0; ai < 2; ++ai)
#pragma unroll
                for (int m = 0; m < 4; ++m) {
                    const float r = rs[ai][m]; const int row = rowb + ai * 128 + m * 16;
                    const unsigned zo = (unsigned)(row * ZLD + u.pn * 256 + 32 * wc + 8 * fq) * 2u;
                    float s1 = 0.f, s2 = 0.f;
#pragma unroll
                    for (int bj = 0; bj < 2; ++bj) {
                        f32x4 v0 = acc[ai][bj][m][0] * r, v1 = acc[ai][bj][m][1] * r;
                        if (kind != 4) { v0 = gelu4(v0); v1 = gelu4(v1); }
                        if (kind == 2) { s1 += sum4(v0) + sum4(v1); s2 += dot4(v0) + dot4(v1); }
                        if (kind == 4) st_wt16(zr, zo + 256u * bj, pack8(v0, v1)); else *(GAS u32x4*)((GAS unsigned char*)Z + zo + 256u * bj) = pack8(v0, v1);
                    }
                    if (kind == 2) {
                        s1 += __shfl_xor(s1, 16); s1 += __shfl_xor(s1, 32); s2 += __shfl_xor(s2, 16); s2 += __shfl_xor(s2, 32);
                        if (fq == 0) *(GAS f32x2*)(lnp + ((size_t)row * 8 + (u.pn & 1) * 4 + wc) * 2) = (f32x2){s1, s2};
                    }
                }
        }
    }
};

struct EpiOddIn {
    __device__ __forceinline__ void init(f32x4 (&acc)[2][2][4][2], const Unit&, int, int, int, int) const {
#pragma unroll
        for (int a = 0; a < 2; ++a)
#pragma unroll
            for (int b = 0; b < 2; ++b)
#pragma unroll
                for (int m = 0; m < 4; ++m)
#pragma unroll
                    for (int n = 0; n < 2; ++n) acc[a][b][m][n] = (f32x4){0.f, 0.f, 0.f, 0.f};
    }
    GAS bf16_t* Z; const LAS float* rstd;
    __device__ __forceinline__ void operator()(const f32x4 (&acc)[2][2][4][2], const Unit& u, int wr, int wc, int fr, int fq) const {
        asm volatile("" : "+v"(fr), "+v"(fq));
        const int rowb = u.pm * 256 + wr * 64 + fr;
        float rs[2][4]; row_rstd(rstd, (u.pm & 7) * 256 + wr * 64 + fr, rs);
        const float sc = (u.pn < 2) ? 0.08838834764831845f : 1.0f; const bool act = (u.pn >= 8);
#pragma unroll
        for (int ai = 0; ai < 2; ++ai)
#pragma unroll
            for (int m = 0; m < 4; ++m) {
                const float r = rs[ai][m] * sc;
                GAS bf16_t* rowp = Z + (size_t)(rowb + ai * 128 + m * 16) * OD_N + u.pn * 256 + 32 * wc + 8 * fq;
#pragma unroll
                for (int bj = 0; bj < 2; ++bj) {
                    f32x4 v0 = acc[ai][bj][m][0] * r, v1 = acc[ai][bj][m][1] * r;
                    if (act) { v0 = silu4(v0); v1 = silu4(v1); }
                    *(GAS u32x4*)(rowp + 128 * bj) = pack8(v0, v1);
                }
            }
    }
};

struct EpiRes {
    const GAS float* xin_f32; const GAS bf16_t* xin_bf; GAS float* xout_f32; GAS bf16_t* xb; GAS float* rsq;
    __device__ __forceinline__ void init(f32x4 (&acc)[2][2][4][2], const Unit& u, int wr, int wc, int fr, int fq) const {
        const int rowb = u.pm * 256 + wr * 64 + fr;
#pragma unroll
        for (int ai = 0; ai < 2; ++ai)
#pragma unroll
            for (int m = 0; m < 4; ++m) {
                const size_t off = (size_t)(rowb + ai * 128 + m * 16) * D + u.pn * 256 + 32 * wc + 8 * fq;
#pragma unroll
                for (int bj = 0; bj < 2; ++bj) {
                    if (xin_f32) { acc[ai][bj][m][0] = *(const GAS f32x4*)(xin_f32 + off + 128 * bj); acc[ai][bj][m][1] = *(const GAS f32x4*)(xin_f32 + off + 128 * bj + 4); }
                    else { const u32x4 r = *(const GAS u32x4*)(xin_bf + off + 128 * bj);
                        acc[ai][bj][m][0] = (f32x4){__builtin_bit_cast(float, r.x << 16), __builtin_bit_cast(float, r.x & 0xffff0000u), __builtin_bit_cast(float, r.y << 16), __builtin_bit_cast(float, r.y & 0xffff0000u)};
                        acc[ai][bj][m][1] = (f32x4){__builtin_bit_cast(float, r.z << 16), __builtin_bit_cast(float, r.z & 0xffff0000u), __builtin_bit_cast(float, r.w << 16), __builtin_bit_cast(float, r.w & 0xffff0000u)}; }
                }
            }
    }
    __device__ __forceinline__ void operator()(const f32x4 (&acc)[2][2][4][2], const Unit& u, int wr, int wc, int fr, int fq) const {
        asm volatile("" : "+v"(fr), "+v"(fq));
        const int rowb = u.pm * 256 + wr * 64 + fr;
#pragma unroll
        for (int ai = 0; ai < 2; ++ai)
#pragma unroll
            for (int m = 0; m < 4; ++m) {
                const int row = rowb + ai * 128 + m * 16; const size_t off = (size_t)row * D + u.pn * 256 + 32 * wc + 8 * fq;
                float ss = 0.f;
#pragma unroll
                for (int bj = 0; bj < 2; ++bj) {
                    const f32x4 o0 = acc[ai][bj][m][0], o1 = acc[ai][bj][m][1];
                    if (xout_f32) { *(GAS f32x4*)(xout_f32 + off + 128 * bj) = o0; *(GAS f32x4*)(xout_f32 + off + 128 * bj + 4) = o1; }
                    else *(GAS u32x4*)(xb + off + 128 * bj) = pack8(o0, o1);
                    ss += dot4(o0) + dot4(o1);
                }
                ss += __shfl_xor(ss, 16); ss += __shfl_xor(ss, 32);
                if (fq == 0) rsq[(size_t)row * 16 + u.pn * 4 + wc] = ss;
            }
    }
};

#define DPP_MOV(old, src, ctrl, bc) __builtin_bit_cast(float, __builtin_amdgcn_update_dpp(__builtin_bit_cast(int, (float)(old)), __builtin_bit_cast(int, (float)(src)), (ctrl), 0xf, 0xf, (bc)))

struct EpiF1 {
    __device__ __forceinline__ void init(f32x4 (&acc)[2][2][4][2], const Unit&, int, int, int, int) const {
#pragma unroll
        for (int a = 0; a < 2; ++a)
#pragma unroll
            for (int b = 0; b < 2; ++b)
#pragma unroll
                for (int m = 0; m < 4; ++m)
#pragma unroll
                    for (int n = 0; n < 2; ++n) acc[a][b][m][n] = (f32x4){0.f, 0.f, 0.f, 0.f};
    }
    GAS bf16_t* H; const LAS float* rstd; const LAS float* par; GAS float* halo; GAS float* fixp; GAS float* fixu; LAS float* ldsx; unsigned* hcnt;
    __device__ __forceinline__ void operator()(const f32x4 (&acc)[2][2][4][2], const Unit& u, int wr, int wc, int fr, int fq) const {
        asm volatile("" : "+v"(fr), "+v"(fq));
        const int rowb = u.pm * 256 + wr * 64 + fr, ch0 = u.pn * 128 + 32 * wc + 8 * fq, lc = 32 * wc + 8 * fq;
        float rs[2][4]; row_rstd(rstd, (u.pm & 7) * 256 + wr * 64 + fr, rs);
        f32x4 w0[2], w1[2], w2[2], bb[2];
        const LAS float* pp = par + u.ui * 512 + lc;
#pragma unroll
        for (int n = 0; n < 2; ++n) { w0[n] = *(const LAS f32x4*)(pp + 4 * n); w1[n] = *(const LAS f32x4*)(pp + 128 + 4 * n); w2[n] = *(const LAS f32x4*)(pp + 256 + 4 * n); bb[n] = *(const LAS f32x4*)(pp + 384 + 4 * n); }
        const bool xpub = (u.pm & 15) == 7;
        if (fr >= 14) {
#pragma unroll
            for (int ai = 0; ai < 2; ++ai)
#pragma unroll
                for (int n = 0; n < 2; ++n) {
                    const f32x4 gvl = acc[ai][0][3][n] * rs[ai][3];
                    *(LAS f32x4*)(ldsx + ((ai * 2 + wr) * 2 + (fr - 14)) * 128 + lc + 4 * n) = gvl;
                    if (ai == 1 && wr == 1) {
                        GAS float* hp = halo + ((size_t)u.pm * 2 + (fr - 14)) * FF + ch0 + 4 * n;
                        if (xpub) asm volatile("global_store_dwordx4 %0, %1, off sc1" :: "v"(hp), "v"(gvl) : "memory");
                        else *(GAS f32x4*)hp = gvl;
                    }
                }
        }
        if (xpub) asm volatile("s_waitcnt vmcnt(0)" ::: "memory");
        asm volatile("s_waitcnt lgkmcnt(0)" ::: "memory"); __builtin_amdgcn_s_barrier(); asm volatile("" ::: "memory");
        if (xpub && wr == 0 && wc == 0 && fr == 0 && fq == 0) __hip_atomic_fetch_add(hcnt + 64 * u.pm, 1u, __ATOMIC_RELAXED, __HIP_MEMORY_SCOPE_AGENT);
        const bool fix = (u.pm & 15) != 0;
#pragma unroll
        for (int ai = 0; ai < 2; ++ai) {
            const int blk = ai * 2 + wr;
            f32x4 pv[2];
#pragma unroll
            for (int n = 0; n < 2; ++n) {
                pv[n] = (f32x4){0.f, 0.f, 0.f, 0.f};
                if (blk > 0 && fr >= 14) pv[n] = *(const LAS f32x4*)(ldsx + ((blk - 1) * 2 + (fr - 14)) * 128 + lc + 4 * n);
            }
#pragma unroll
            for (int m = 0; m < 4; ++m) {
                const float r = rs[ai][m]; const int row = rowb + ai * 128 + m * 16;
                f32x4 hv[2], pre[2], upv[2], cur[2];
#pragma unroll
                for (int n = 0; n < 2; ++n) {
                    cur[n] = acc[ai][0][m][n] * r; upv[n] = acc[ai][1][m][n] * r;
#pragma unroll
                    for (int e = 0; e < 4; ++e) {
                        const float c = cur[n][e], p = pv[n][e];
                        const float t1 = DPP_MOV(0.f, p, 0x10F, true);
                        const float g1 = DPP_MOV(t1, c, 0x111, false);
                        const float t2 = DPP_MOV(0.f, p, 0x10E, true);
                        const float g2 = DPP_MOV(t2, c, 0x112, false);
                        const float pr = bb[n][e] + w2[n][e] * c + w1[n][e] * g1 + w0[n][e] * g2;
                        pre[n][e] = pr;
                    }
                    hv[n] = silu4(pre[n]) * upv[n];
                }
                *(GAS u32x4*)(H + (size_t)row * ZLD + ch0) = pack8(hv[0], hv[1]);
                if (fix && blk == 0 && m == 0 && fr < 2) {
#pragma unroll
                    for (int n = 0; n < 2; ++n) { *(GAS f32x4*)(fixp + ((size_t)u.pm * 2 + fr) * FF + ch0 + 4 * n) = pre[n]; *(GAS f32x4*)(fixu + ((size_t)u.pm * 2 + fr) * FF + ch0 + 4 * n) = upv[n]; }
                }
                pv[0] = cur[0]; pv[1] = cur[1];
            }
        }
    }
};

#define XB_TMO      128
#define XB_XCNT(j)  (256  + 64 * (j))
#define XB_XSUB(j)  (1280 + 64 * (j))
#define XB_XGEN(j)  (2304 + 64 * (j))
#define XB_TOP      3328
#define XB_TOPGEN   3392
#define XCD_BAR_WORDS 3456
#define XB_SPIN_CAP (1u << 18)
__device__ __forceinline__ unsigned xb_ld(unsigned* p)              { return __hip_atomic_load(p, __ATOMIC_RELAXED, __HIP_MEMORY_SCOPE_AGENT); }
__device__ __forceinline__ unsigned xb_add(unsigned* p, unsigned v) { return __hip_atomic_fetch_add(p, v, __ATOMIC_RELAXED, __HIP_MEMORY_SCOPE_AGENT); }
__device__ __forceinline__ unsigned xb_xcc_id() { return (unsigned)__builtin_amdgcn_s_getreg((3 << 11) | 20) & 0xFu; }
#define XB_SPIN(cond, bar) do { unsigned _sp = 0; while (cond) { __builtin_amdgcn_s_sleep(1); \
    if ((++_sp & 255u) == 0u) { if (xb_ld(&(bar)[XB_TMO])) break; if (_sp > XB_SPIN_CAP) { atomicAdd(&(bar)[XB_TMO], 1u); break; } } } } while (0)
struct XcdBarrier { unsigned* bar; unsigned x; volatile LAS unsigned* st; };
__device__ __forceinline__ XcdBarrier xcd_barrier_post(unsigned* bar, volatile LAS unsigned* st) {
    XcdBarrier b; b.bar = bar; b.x = xb_xcc_id(); b.st = st;
    if (threadIdx.x == 0) (void)xb_add(&bar[XB_XCNT(b.x)], 1u);
    return b;
}
__device__ __forceinline__ void xcd_barrier_complete(unsigned* bar, unsigned x, unsigned& nloc, unsigned& nx) {
    const unsigned G = gridDim.x * gridDim.y * gridDim.z;
    unsigned sum, cnt, mine, sp = 0u;
    for (;;) {
        sum = 0u; cnt = 0u; mine = 0u;
#pragma unroll
        for (unsigned j = 0; j < 16; ++j) { const unsigned c = xb_ld(&bar[XB_XCNT(j)]); sum += c; cnt += (c > 0u) ? 1u : 0u; mine = (j == x) ? c : mine; }
        if (sum == G) break;
        __builtin_amdgcn_s_sleep(1);
        if ((++sp & 255u) == 0u) { if (xb_ld(&bar[XB_TMO])) break; if (sp > XB_SPIN_CAP) { atomicAdd(&bar[XB_TMO], 1u); break; } }
    }
    nloc = mine > 0u ? mine : 1u; nx = cnt > 0u ? cnt : 1u;
}
__device__ __forceinline__ void xcd_barrier(const XcdBarrier& b) {
    asm volatile("s_waitcnt vmcnt(0)" ::: "memory");
    __syncthreads();
    if (threadIdx.x == 0) {
        unsigned* bar = b.bar;
        __builtin_amdgcn_s_waitcnt(0);
        unsigned nloc = b.st[0], nx = b.st[1];
        if (nloc == 0u) { xcd_barrier_complete(bar, b.x, nloc, nx); b.st[0] = nloc; b.st[1] = nx; }
        const unsigned old = xb_add(&bar[XB_XSUB(b.x)], 1u);
        const unsigned gen = old / nloc;
        if (old + 1u == (gen + 1u) * nloc) {
            __builtin_amdgcn_fence(__ATOMIC_RELEASE, "agent");
            asm volatile("s_waitcnt vmcnt(0)" ::: "memory");
            const unsigned og = xb_add(&bar[XB_TOP], 1u);
            const unsigned tg = og / nx;
            if (og + 1u == (tg + 1u) * nx) xb_add(&bar[XB_TOPGEN], 1u);
            else XB_SPIN(xb_ld(&bar[XB_TOPGEN]) == tg, bar);
            xb_add(&bar[XB_XGEN(b.x)], 1u);
            __builtin_amdgcn_fence(__ATOMIC_ACQUIRE, "agent");
            asm volatile("s_waitcnt vmcnt(0)" ::: "memory");
        } else {
            XB_SPIN(xb_ld(&bar[XB_XGEN(b.x)]) == gen, bar);
            __builtin_amdgcn_fence(__ATOMIC_ACQUIRE, "agent");
            asm volatile("s_waitcnt vmcnt(0)" ::: "memory");
        }
    }
    __syncthreads();
}

__device__ __forceinline__ void done_arrive(unsigned* c) { asm volatile("s_waitcnt vmcnt(0)" ::: "memory"); __syncthreads(); if (threadIdx.x == 0) (void)xb_add(c, 1u); }
__device__ __forceinline__ void poll_ge(unsigned* c, const unsigned target) { if (threadIdx.x == 0) { unsigned sp = 0; while (xb_ld(c) < target && ++sp < XB_SPIN_CAP) __builtin_amdgcn_s_sleep(1); } }
__device__ __forceinline__ void handoff_wait(unsigned* c, const unsigned target) {
    if (threadIdx.x == 0) {
        unsigned sp = 0; while (xb_ld(c) < target && ++sp < XB_SPIN_CAP) __builtin_amdgcn_s_sleep(1);
        __builtin_amdgcn_fence(__ATOMIC_ACQUIRE, "agent");
        asm volatile("s_waitcnt vmcnt(0)" ::: "memory");
    }
    __syncthreads();
}
__device__ __forceinline__ void done_wait(unsigned* c, const unsigned target) {
    if (threadIdx.x == 0) { unsigned sp = 0; while (xb_ld(c) < target && ++sp < XB_SPIN_CAP) __builtin_amdgcn_s_sleep(1); }
    __syncthreads();
}
__device__ __forceinline__ void xcd_local_barrier(const XcdBarrier& b) {
    asm volatile("s_waitcnt vmcnt(0)" ::: "memory");
    __syncthreads();
    if (threadIdx.x == 0) {
        unsigned* bar = b.bar;
        const unsigned nloc = b.st[0];
        const unsigned old = xb_add(&bar[XB_XSUB(b.x)], 1u);
        const unsigned gen = old / nloc;
        const bool lastarr = (old + 1u == (gen + 1u) * nloc);
        if (lastarr) xb_add(&bar[XB_XGEN(b.x)], 1u);
        asm volatile("buffer_inv sc1" ::: "memory");
        if (!lastarr) XB_SPIN(xb_ld(&bar[XB_XGEN(b.x)]) == gen, bar);
        asm volatile("s_waitcnt vmcnt(0)" ::: "memory");
    }
    __syncthreads();
}

__device__ __forceinline__ int conv_srccol(const int map, const int nd, bool& second) {
    const int nb = nd >> 5, r = nd & 31; second = false;
    if (map == 1) {
        const int pn = nb >> 3, j = nb & 7, bj = j >> 2, wc = j & 3, kind = pn >> 1, zc = 256 * pn + 64 * wc + 32 * bj;
        if (kind == 1) return 1024 + (zc - 512) + r;
        if (kind == 2) return 512 + (nd - 1024);
        if (kind == 3) return zc + r;
        return nd;
    } else if (map == 2) {
        const int pn = nb >> 3, j = nb & 7; second = (j >> 2) != 0;
        return 128 * pn + 32 * (j & 3) + r;
    }
    return nd;
}
constexpr int CV_STR = 65;
__device__ __forceinline__ void conv_block_item(LAS unsigned char* lds, const GAS float* W, const GAS float* W2, const int ldw, const int K, const int Ndst, const GAS float* gk, GAS bf16_t* WT, const int map, const int item, const int tid) {
    const int nblk = Ndst >> 7, kb = item / nblk, nb = item % nblk, k0 = kb << 7, n0 = nb << 7;
    const int l32 = tid & 31, rg = tid >> 5;
    bool second; const int sc = conv_srccol(map, n0 + 4 * l32, second);
    const GAS float* src = (second ? W2 : W) + (size_t)(k0 + 8 * rg) * ldw + sc;
    f32x4 v[8];
#pragma unroll
    for (int i = 0; i < 8; ++i) v[i] = *(const GAS f32x4*)(src + (size_t)i * ldw);
    if (gk) {
        const f32x4 g0 = *(const GAS f32x4*)(gk + k0 + 8 * rg), g1 = *(const GAS f32x4*)(gk + k0 + 8 * rg + 4);
#pragma unroll
        for (int i = 0; i < 4; ++i) { v[i] = v[i] * g0[i]; v[4 + i] = v[4 + i] * g1[i]; }
    }
    LAS unsigned* T = (LAS unsigned*)lds;
#pragma unroll
    for (int i = 0; i < 4; ++i)
#pragma unroll
        for (int e = 0; e < 4; ++e) T[(4 * l32 + e) * CV_STR + 4 * rg + i] = cvt_pk_bf16(v[2 * i][e], v[2 * i + 1][e]);
    __syncthreads();
    const int c = tid & 15;
#pragma unroll
    for (int p = 0; p < 4; ++p) {
        const int n = (tid >> 4) + 32 * p; const LAS unsigned* r = T + n * CV_STR + 4 * c;
        u32x4 o; o.x = r[0]; o.y = r[1]; o.z = r[2]; o.w = r[3];
        *(GAS u32x4*)(WT + (size_t)(n0 + n) * K + k0 + 8 * c) = o;
    }
    __syncthreads();
}

struct ConvDesc { const GAS float* W; long dW2; const GAS float* gk; GAS bf16_t* WT; int ldw, K, Ndst, map, item; };
struct ConvRegs { f32x4 v[8]; f32x4 g0, g1; };
constexpr int CV_TILE = 128 * CV_STR * 4;
__device__ __forceinline__ void conv_issue(const ConvDesc& d, const int tid, ConvRegs& R) {
    const int nblk = d.Ndst >> 7, kb = d.item / nblk, nb = d.item % nblk, k0 = kb << 7, n0 = nb << 7;
    const int l32 = tid & 31, rg = tid >> 5;
    bool second; const int sc = conv_srccol(d.map, n0 + 4 * l32, second);
    const GAS float* src = d.W + (second ? d.dW2 : 0l) + (size_t)(k0 + 8 * rg) * d.ldw + sc;
#pragma unroll
    for (int i = 0; i < 8; ++i) R.v[i] = *(const GAS f32x4*)(src + (size_t)i * d.ldw);
    R.g0 = (f32x4){1.f, 1.f, 1.f, 1.f}; R.g1 = R.g0;
    if (d.gk) { R.g0 = *(const GAS f32x4*)(d.gk + k0 + 8 * rg); R.g1 = *(const GAS f32x4*)(d.gk + k0 + 8 * rg + 4); }
}
__device__ __forceinline__ void conv_finish(LAS unsigned char* tile, const ConvDesc& d, const int tid, const ConvRegs& R) {
    const int nblk = d.Ndst >> 7, kb = d.item / nblk, nb = d.item % nblk, k0 = kb << 7, n0 = nb << 7;
    const int l32 = tid & 31, rg = tid >> 5;
    LAS unsigned* T = (LAS unsigned*)tile;
#pragma unroll
    for (int i = 0; i < 4; ++i) {
        const f32x4 a = R.v[2 * i] * ((i < 2) ? R.g0[2 * i] : R.g1[2 * i - 4]), b = R.v[2 * i + 1] * ((i < 2) ? R.g0[2 * i + 1] : R.g1[2 * i - 3]);
#pragma unroll
        for (int e = 0; e < 4; ++e) T[(4 * l32 + e) * CV_STR + 4 * rg + i] = cvt_pk_bf16(a[e], b[e]);
    }
    __syncthreads();
    const int c = tid & 15; const rsrc_t wr_ = wt_rsrc(d.WT);
#pragma unroll
    for (int p = 0; p < 4; ++p) {
        const int n = (tid >> 4) + 32 * p; const LAS unsigned* r = T + n * CV_STR + 4 * c;
        u32x4 o; o.x = r[0]; o.y = r[1]; o.z = r[2]; o.w = r[3];
        st_wt16(wr_, (unsigned)((n0 + n) * d.K + k0 + 8 * c) * 2u, o);
    }
}
template <class DescFn>
__device__ __forceinline__ void conv_run(LAS unsigned char* lds, const int n, const DescFn descf, const int tid) {
    if (n <= 0) return;
    ConvRegs A, B; ConvDesc dA = descf(0), dB = dA;
    conv_issue(dA, tid, A);
    for (int i = 0; i < n; i += 2) {
        if (i + 1 < n) { dB = descf(i + 1); conv_issue(dB, tid, B); }
        conv_finish(lds, dA, tid, A);
        if (i + 2 < n) { dA = descf(i + 2); conv_issue(dA, tid, A); }
        if (i + 1 < n) conv_finish(lds + CV_TILE, dB, tid, B);
    }
    __syncthreads();
}

__device__ __forceinline__ void ph_gmlp_simple(LAS unsigned char* lds, bf16_t* Z, const float* LNP, const float* ln_g, const float* ln_b, const float* wsp, const float* bsp, int tid, int G) {
    LAS float* vn = (LAS float*)lds;
    for (int item = blockIdx.x; item < (M / 128) * 8; item += G) {
        const int chunk = item >> 3, g = item & 7, m0 = chunk * 128;
        for (int idx = tid; idx < 128 * 64; idx += NWAVES * 64) {
            const int s = idx >> 6, c = idx & 63; const size_t row = m0 + s;
            float s1 = 0.f, s2 = 0.f;
            for (int k = 0; k < 8; ++k) { s1 += LNP[(row * 8 + k) * 2]; s2 += LNP[(row * 8 + k) * 2 + 1]; }
            const float mean = s1 * (1.f / 512.f), var = s2 * (1.f / 512.f) - mean * mean, rstd = rsqrtf(var + EPS);
            const float gv = bf2f(Z[row * ZLD + 1024 + 64 * g + c]);
            vn[idx] = (gv - mean) * rstd * ln_g[64 * g + c] + ln_b[64 * g + c];
        }
        __syncthreads();
        for (int idx = tid; idx < 128 * 64; idx += NWAVES * 64) {
            const int t = idx >> 6, c = idx & 63; const size_t row = m0 + t;
            float a = bsp[g * 128 + t];
            const float* wr = wsp + ((size_t)g * 128 + t) * 128;
            for (int s2 = 0; s2 <= t; ++s2) a += wr[s2] * vn[s2 * 64 + c];
            const float gu = bf2f(Z[row * ZLD + 64 * g + c]);
            Z[row * ZLD + 64 * g + c] = (bf16_t)f2bf(gu * a);
        }
        __syncthreads();
    }
}
__device__ __forceinline__ void ph_attn_simple(bf16_t* Z, int gw, int NGW, int lane) {
    for (int wv = gw; wv < M * 8; wv += NGW) {
        const int m = wv >> 3, h = wv & 7, t = m & (SEQ - 1), mb = m - t;
        const float q = bf2f(Z[(size_t)m * ZLD + 512 + 64 * h + lane]);
        float ms[3], ls[3], os[3];
#pragma unroll
        for (int r = 0; r < 3; ++r) {
            const int dil = (r == 0) ? 1 : (r == 1) ? 4 : 16;
            float mx = -1e30f, l = 0.f, o = 0.f;
            for (int j = 0; j <= 128; ++j) {
                const int tk = t - j * dil; if (tk < 0) break;
                const size_t kr = (size_t)(mb + tk) * ZLD;
                float sc = q * bf2f(Z[kr + 1536 + 64 * h + lane]);
#pragma unroll
                for (int o2 = 1; o2 < 64; o2 <<= 1) sc += __shfl_xor(sc, o2);
                const float mn = fmaxf(mx, sc), al = __expf(mx - mn), p = __expf(sc - mn);
                l = l * al + p; o = o * al + p * bf2f(Z[kr + 2048 + 64 * h + lane]); mx = mn;
            }
            ms[r] = mx; ls[r] = l; os[r] = o / l;
        }
        const float l0 = ms[0] + __logf(ls[0]), l1 = ms[1] + __logf(ls[1]), l2 = ms[2] + __logf(ls[2]);
        const float mm = fmaxf(l0, fmaxf(l1, l2)), e0 = __expf(l0 - mm), e1 = __expf(l1 - mm), e2 = __expf(l2 - mm), inv = 1.f / (e0 + e1 + e2);
        Z[(size_t)m * ZLD + 512 + 64 * h + lane] = (bf16_t)f2bf((e0 * os[0] + e1 * os[1] + e2 * os[2]) * inv);
    }
}
__device__ __forceinline__ void ph_ga_simple(const float* X, const float* RSQ, const float* gmix, const float* w_in, float* GA, int gw, int NGW, int lane) {
    for (int m = gw; m < M; m += NGW) {
        float acc[16];
#pragma unroll
        for (int j = 0; j < 16; ++j) acc[j] = 0.f;
        for (int i = 0; i < 16; ++i) {
            const int k = i * 64 + lane; const float xv = X[(size_t)m * D + k] * gmix[k];
            const f32x4* wr = (const f32x4*)(w_in + (size_t)k * OD_NSRC + 3072);
#pragma unroll
            for (int j4 = 0; j4 < 4; ++j4) { const f32x4 w = wr[j4]; acc[4 * j4] += xv * w[0]; acc[4 * j4 + 1] += xv * w[1]; acc[4 * j4 + 2] += xv * w[2]; acc[4 * j4 + 3] += xv * w[3]; }
        }
        float s = 0.f;
        for (int j = 0; j < 16; ++j) s += RSQ[(size_t)m * 16 + j];
        const float rstd = rsqrtf(s * (1.f / 1024.f) + EPS);
#pragma unroll
        for (int j = 0; j < 16; ++j) {
            float v = acc[j];
#pragma unroll
            for (int o = 1; o < 64; o <<= 1) v += __shfl_xor(v, o);
            if (lane == j) GA[(size_t)m * 16 + j] = v * rstd;
        }
    }
}
__device__ __forceinline__ void ph_gla_simple(LAS unsigned char* lds, const bf16_t* Z, const float* GA, const float* w_a2, const float* b_a, float* ORAW, int tid, int G) {
    LAS float* sa = (LAS float*)lds; LAS float* sk = sa + 256; LAS float* sq = sk + 256;
    for (int item = blockIdx.x; item < 16; item += G) {
        const int b = item >> 2, h = item & 3, v = tid;
        float S[128];
#pragma unroll
        for (int k = 0; k < 128; ++k) S[k] = 0.f;
        float wa[16]; float ba = 0.f;
#pragma unroll
        for (int j = 0; j < 16; ++j) wa[j] = 0.f;
        if (v < 128) {
#pragma unroll
            for (int j = 0; j < 16; ++j) wa[j] = w_a2[j * 512 + h * 128 + v];
            ba = b_a[h * 128 + v]; }
        for (int t = 0; t < SEQ; ++t) {
            const size_t m = (size_t)b * SEQ + t; const int buf = (t & 1) * 128;
            if (v < 128) {
                float xg = ba;
#pragma unroll
                for (int j = 0; j < 16; ++j) xg += GA[m * 16 + j] * wa[j];
                const float ls = fminf(xg, 0.f) - log1pf(__expf(-fabsf(xg)));
                sa[buf + v] = __expf(ls * (1.f / 16.f));
                sk[buf + v] = bf2f(Z[m * OD_N + 512 + 128 * h + v]);
                sq[buf + v] = bf2f(Z[m * OD_N + 128 * h + v]);
            }
            __syncthreads();
            if (v < 256) {
                const float vv = bf2f(Z[m * OD_N + 1024 + 256 * h + v]);
                float o = 0.f;
#pragma unroll
                for (int k = 0; k < 128; ++k) { S[k] = sa[buf + k] * S[k] + sk[buf + k] * vv; o += sq[buf + k] * S[k]; }
                ORAW[m * 1024 + 256 * h + v] = o;
            }
        }
        __syncthreads();
    }
}
__device__ __forceinline__ void ph_gla_post_simple(bf16_t* Z, const float* ORAW, const float* head_g, int gw, int NGW, int lane) {
    for (int wv = gw; wv < M * 4; wv += NGW) {
        const int m = wv >> 2, h = wv & 3;
        const f32x4 o = *(const f32x4*)(ORAW + (size_t)m * 1024 + 256 * h + 4 * lane);
        float ss = dot4(o);
#pragma unroll
        for (int k = 1; k < 64; k <<= 1) ss += __shfl_xor(ss, k);
        const float rstd = rsqrtf(ss * (1.f / 256.f) + EPS);
        const f32x4 hg = *(const f32x4*)(head_g + 4 * lane);
        bf16_t* sr = Z + (size_t)m * OD_N + 2048 + 256 * h + 4 * lane;
        bf16_t* dst = Z + (size_t)m * OD_N + 1024 + 256 * h + 4 * lane;
        u32x2 w; w.x = pk2(o[0] * rstd * hg[0] * bf2f(sr[0]), o[1] * rstd * hg[1] * bf2f(sr[1])); w.y = pk2(o[2] * rstd * hg[2] * bf2f(sr[2]), o[3] * rstd * hg[3] * bf2f(sr[3]));
        *(u32x2*)dst = w;
    }
}


typedef short s16x4 __attribute__((ext_vector_type(4)));
__device__ __forceinline__ bf16x8 tr_pair(const LAS unsigned char* p0, const LAS unsigned char* p1) {
    const s16x4 lo = __builtin_amdgcn_ds_read_tr16_b64_v4i16((LAS s16x4*)p0), hi = __builtin_amdgcn_ds_read_tr16_b64_v4i16((LAS s16x4*)p1);
    return __builtin_shufflevector(lo, hi, 0, 1, 2, 3, 4, 5, 6, 7);
}
constexpr int AT_KSTR = 144, AT_VSTR = 160, AT_VOFF = 256 * AT_KSTR;
struct AttnPre { u32x4 k[4], v[4]; bf16x8 q0, q1; };
__device__ __forceinline__ void attn_load(const GAS bf16_t* Z, const int dlog, const int idx, const int tid, AttnPre& P) {
    const int lane = tid & 63, w = tid >> 6, fr = lane & 15, g = lane >> 4;
    const int nbl = 5 - dlog, bh = idx >> 5, b = bh >> 3, h = bh & 7, rn = idx & 31, r = rn >> nbl, n = rn & ((1 << nbl) - 1);
    const size_t mb = (size_t)b * SEQ;
    if (__builtin_amdgcn_readfirstlane(n) > 0) {
#pragma unroll
        for (int pass = 0; pass < 4; ++pass) {
            const int row = pass * 64 + (tid >> 3), ch = tid & 7, tok = (((128 * (n - 1) + row)) << dlog) + r;
            const GAS bf16_t* src = Z + (mb + tok) * ZLD + 64 * h + 8 * ch; P.k[pass] = *(const GAS u32x4*)(src + 1536); P.v[pass] = *(const GAS u32x4*)(src + 2048);
        }
    } else {
#pragma unroll
        for (int pass = 0; pass < 4; ++pass) {
            const int row = pass * 64 + (tid >> 3), ch = tid & 7, tok = (((128 * (n - 1) + row)) << dlog) + r;
            P.k[pass] = (u32x4){0u, 0u, 0u, 0u}; P.v[pass] = (u32x4){0u, 0u, 0u, 0u};
            if (tok >= 0) { const GAS bf16_t* src = Z + (mb + tok) * ZLD + 64 * h + 8 * ch; P.k[pass] = *(const GAS u32x4*)(src + 1536); P.v[pass] = *(const GAS u32x4*)(src + 2048); }
        }
    }
    const int tq = ((128 * n + 16 * w + fr) << dlog) + r;
    const GAS bf16_t* qp = Z + (mb + tq) * ZLD + 512 + 64 * h;
    P.q0 = *(const GAS bf16x8*)(qp + 8 * g); P.q1 = *(const GAS bf16x8*)(qp + 32 + 8 * g);
}
__device__ __forceinline__ int attn_item_idx(const int dlog, const int xmap, const int j, const int idx0, const int stride, const int it) {
    if (xmap < 0) return idx0 + it * stride;
    const int q = j + 32 * it, h = q >> 4, b = xmap >> 1, hf = xmap & 1;
    int rn;
    if (dlog == 0) rn = 16 * hf + (q & 15);
    else if (dlog == 2) rn = ((q >> 2) & 3) * 8 + 4 * hf + (q & 3);
    else rn = (q & 15) * 2 + hf;
    return (b * 8 + h) * 32 + rn;
}
template <bool FINAL>
__device__ __forceinline__ void attn_run(LAS unsigned char* lds, GAS bf16_t* Z, const int dlog, const int idx0, const int count, const int stride, const int xmap, const int jmap, GAS bf16_t* Pout, GAS float* Lout,
                                         const GAS bf16_t* P1, const GAS bf16_t* P2, const GAS float* L1, const GAS float* L2, const int tid) {
    constexpr bool final = FINAL;
    const int lane = tid & 63, w = __builtin_amdgcn_readfirstlane(tid >> 6), fr = lane & 15, g = lane >> 4;
    AttnPre P;
    constexpr int AT_IMG = 256 * AT_KSTR + 256 * AT_VSTR;
    bf16x8 q0 = (bf16x8){0, 0, 0, 0, 0, 0, 0, 0}, q1 = q0;
    if (count > 0) {
        attn_load(Z, dlog, attn_item_idx(dlog, xmap, jmap, idx0, stride, 0), tid, P);
#pragma unroll
        for (int pass = 0; pass < 4; ++pass) {
            const int row = pass * 64 + (tid >> 3), ch = tid & 7;
            *(LAS u32x4*)(lds + row * AT_KSTR + 16 * ch) = P.k[pass];
            *(LAS u32x4*)(lds + AT_VOFF + row * AT_VSTR + 16 * ch) = P.v[pass];
        }
        q0 = P.q0; q1 = P.q1;
        __syncthreads();
    }
    for (int it_ = 0; it_ < count; ++it_) {
    const int idx = attn_item_idx(dlog, xmap, jmap, idx0, stride, it_);
    const int nbl = 5 - dlog, bh = idx >> 5, b = bh >> 3, h = bh & 7, rn = idx & 31, r = rn >> nbl, n = rn & ((1 << nbl) - 1);
    const size_t mb = (size_t)b * SEQ;
    const LAS unsigned char* img = lds + (it_ & 1) * AT_IMG;
    const int tq = ((128 * n + 16 * w + fr) << dlog) + r;
    if (it_ + 1 < count) attn_load(Z, dlog, attn_item_idx(dlog, xmap, jmap, idx0, stride, it_ + 1), tid, P);
    u32x2 mp1[4], mp2[4]; float ml1 = 0.f, ml2 = 0.f;
    if (final) {
        const GAS bf16_t* p1 = P1 + (mb + tq) * 512 + 64 * h + 4 * g; const GAS bf16_t* p2 = P2 + (mb + tq) * 512 + 64 * h + 4 * g;
#pragma unroll
        for (int dt = 0; dt < 4; ++dt) { mp1[dt] = *(const GAS u32x2*)(p1 + 16 * dt); mp2[dt] = *(const GAS u32x2*)(p2 + 16 * dt); }
        ml1 = L1[(mb + tq) * 8 + h]; ml2 = L2[(mb + tq) * 8 + h];
    }
    f32x4 st[9];
#pragma unroll
    for (int kt = 0; kt < 9; ++kt) {
        const LAS unsigned char* kr = img + (16 * w + 16 * kt + fr) * AT_KSTR + 16 * g;
        const bf16x8 a0 = *(const LAS bf16x8*)kr, a1 = *(const LAS bf16x8*)(kr + 64);
        f32x4 c = (f32x4){0.f, 0.f, 0.f, 0.f};
        c = __builtin_amdgcn_mfma_f32_16x16x32_bf16(a0, q0, c, 0, 0, 0);
        c = __builtin_amdgcn_mfma_f32_16x16x32_bf16(a1, q1, c, 0, 0, 0);
        st[kt] = c;
    }
    float mx = -1e30f;
#pragma unroll
    for (int kt = 0; kt < 9; ++kt) {
        const bool tv = (n > 0) || (kt >= 8 - w);
#pragma unroll
        for (int e = 0; e < 4; ++e) {
            const int jj = 4 * g + e;
            bool ok = tv; if (kt == 0) ok = ok && (jj >= fr); if (kt == 8) ok = ok && (jj <= fr);
            const float sv = ok ? st[kt][e] : -1e30f; st[kt][e] = sv; mx = fmaxf(mx, sv);
        }
    }
    mx = fmaxf(mx, __shfl_xor(mx, 16)); mx = fmaxf(mx, __shfl_xor(mx, 32));
    f32x4 lacc = (f32x4){0.f, 0.f, 0.f, 0.f};
    const f32x2 nmx2 = (f32x2){-mx, -mx};
#pragma unroll
    for (int kt = 0; kt < 9; ++kt) {
        f32x4 d; {
            const f32x2 lo_ = (f32x2){st[kt][0], st[kt][1]}, hi_ = (f32x2){st[kt][2], st[kt][3]}; f32x2 dl_, dh_;
            asm("v_pk_add_f32 %0, %1, %2" : "=v"(dl_) : "v"(lo_), "v"(nmx2));
            asm("v_pk_add_f32 %0, %1, %2" : "=v"(dh_) : "v"(hi_), "v"(nmx2));
            d = (f32x4){dl_[0], dl_[1], dh_[0], dh_[1]}; }
        f32x4 p;
#pragma unroll
        for (int e = 0; e < 4; ++e) p[e] = __builtin_amdgcn_exp2f(d[e]);
        st[kt] = p; lacc += p;
    }
    float l = (lacc[0] + lacc[1]) + (lacc[2] + lacc[3]);
    l += __shfl_xor(l, 16); l += __shfl_xor(l, 32);
    f32x4 ot[4];
#pragma unroll
    for (int dt = 0; dt < 4; ++dt) ot[dt] = (f32x4){0.f, 0.f, 0.f, 0.f};
    const int qq = fr >> 2, pp = fr & 3;
#pragma unroll
    for (int ks2 = 0; ks2 < 5; ++ks2) {
        const int T0 = 2 * ks2, T1 = (ks2 < 4) ? 2 * ks2 + 1 : 2 * ks2;
        u32x4 pb; pb.x = cvt_pk_bf16(st[T0][0], st[T0][1]); pb.y = cvt_pk_bf16(st[T0][2], st[T0][3]);
        if (ks2 < 4) { pb.z = cvt_pk_bf16(st[T1][0], st[T1][1]); pb.w = cvt_pk_bf16(st[T1][2], st[T1][3]); } else { pb.z = 0u; pb.w = 0u; }
        const bf16x8 bfrag = __builtin_bit_cast(bf16x8, pb);
        const LAS unsigned char* v0 = img + AT_VOFF + (16 * w + 16 * T0 + 4 * g + qq) * AT_VSTR + 8 * pp;
        const LAS unsigned char* v1 = img + AT_VOFF + (16 * w + 16 * T1 + 4 * g + qq) * AT_VSTR + 8 * pp;
#pragma unroll
        for (int dt = 0; dt < 4; ++dt) ot[dt] = __builtin_amdgcn_mfma_f32_16x16x32_bf16(tr_pair(v0 + 32 * dt, v1 + 32 * dt), bfrag, ot[dt], 0, 0, 0);
    }
    const float inv = 1.0f / l, lse = mx + __builtin_amdgcn_logf(l);
    if (!final) {
        GAS bf16_t* op = Pout + (mb + tq) * 512 + 64 * h + 4 * g;
#pragma unroll
        for (int dt = 0; dt < 4; ++dt) { u32x2 o; o.x = cvt_pk_bf16(ot[dt][0] * inv, ot[dt][1] * inv); o.y = cvt_pk_bf16(ot[dt][2] * inv, ot[dt][3] * inv); *(GAS u32x2*)(op + 16 * dt) = o; }
        if (g == 0) Lout[(mb + tq) * 8 + h] = lse;
    } else {
        const float l1 = ml1, l2 = ml2;
        const float mm = fmaxf(lse, fmaxf(l1, l2)), e0 = __builtin_amdgcn_exp2f(lse - mm), e1 = __builtin_amdgcn_exp2f(l1 - mm), e2 = __builtin_amdgcn_exp2f(l2 - mm), rs = 1.0f / (e0 + e1 + e2);
        const float w0 = e0 * rs * inv, w1 = e1 * rs, w2 = e2 * rs;
        GAS bf16_t* op = Z + (mb + tq) * ZLD + 512 + 64 * h + 4 * g;
#pragma unroll
        for (int dt = 0; dt < 4; ++dt) {
            const u32x2 a = mp1[dt], c = mp2[dt];
            const f32x4 a4 = (f32x4){__builtin_bit_cast(float, a.x << 16), __builtin_bit_cast(float, a.x & 0xffff0000u), __builtin_bit_cast(float, a.y << 16), __builtin_bit_cast(float, a.y & 0xffff0000u)};
            const f32x4 c4 = (f32x4){__builtin_bit_cast(float, c.x << 16), __builtin_bit_cast(float, c.x & 0xffff0000u), __builtin_bit_cast(float, c.y << 16), __builtin_bit_cast(float, c.y & 0xffff0000u)};
            const f32x4 r4 = ot[dt] * w0 + a4 * w1 + c4 * w2;
            u32x2 o; o.x = cvt_pk_bf16(r4[0], r4[1]); o.y = cvt_pk_bf16(r4[2], r4[3]); *(GAS u32x2*)(op + 16 * dt) = o;
        }
    }
    if (it_ + 1 < count) {
        LAS unsigned char* nimg = lds + ((it_ + 1) & 1) * AT_IMG;
#pragma unroll
        for (int pass = 0; pass < 4; ++pass) {
            const int row = pass * 64 + (tid >> 3), ch = tid & 7;
            *(LAS u32x4*)(nimg + row * AT_KSTR + 16 * ch) = P.k[pass];
            *(LAS u32x4*)(nimg + AT_VOFF + row * AT_VSTR + 16 * ch) = P.v[pass];
        }
        q0 = P.q0; q1 = P.q1;
    }
    __syncthreads();
    }
}
constexpr int GM_STR = 160;
constexpr int GM_TILE = 128 * GM_STR, GM_LNP = 2 * GM_TILE;
struct GmPre { bf16x8 wfr[4]; u32x2 guv[4]; f32x4 lnp[4]; u32x4 raw[2]; float bias; };
__device__ __forceinline__ void gmlp_load(const GAS bf16_t* Z, const GAS float* LNP, const GAS bf16_t* Wbf, const GAS float* bs, const int item, const int tid, GmPre& P) {
    const int lane = tid & 63, w = __builtin_amdgcn_readfirstlane(tid >> 6), fr = lane & 15, g4 = lane >> 4;
    const int chunk = item >> 3, g = item & 7, m0 = chunk * 128, t = 16 * w + fr;
    const GAS bf16_t* wrow = Wbf + ((size_t)g * 128 + t) * 128 + 8 * g4;
    const GAS bf16_t* up = Z + (size_t)(m0 + t) * ZLD + 64 * g + 4 * g4;
#pragma unroll
    for (int ks = 0; ks < 4; ++ks) P.wfr[ks] = *(const GAS bf16x8*)(wrow + 32 * ks);
#pragma unroll
    for (int ct = 0; ct < 4; ++ct) P.guv[ct] = *(const GAS u32x2*)(up + 16 * ct);
    P.bias = bs[g * 128 + t];
    const int s = tid >> 2, c0 = (tid & 3) * 16; const size_t row = m0 + s;
#pragma unroll
    for (int k = 0; k < 4; ++k) P.lnp[k] = *(const GAS f32x4*)(LNP + row * 16 + 4 * k);
    const GAS bf16_t* gp = Z + row * ZLD + 1024 + 64 * g + c0;
#pragma unroll
    for (int hh = 0; hh < 2; ++hh) P.raw[hh] = *(const GAS u32x4*)(gp + 8 * hh);
}
template <class ItemFn>
__device__ __forceinline__ void gmlp_run(LAS unsigned char* lds, GAS bf16_t* Z, const GAS float* LNP, const GAS float* ln_g, const GAS float* ln_b, const GAS bf16_t* Wbf, const GAS float* bs, const int count, const ItemFn itemf, const int tid) {
    const int lane = tid & 63, w = __builtin_amdgcn_readfirstlane(tid >> 6), fr = lane & 15, g4 = lane >> 4;
    const int t = 16 * w + fr, qq = fr >> 2, pp = fr & 3;
    if (count <= 0) return;
    GmPre P;
    gmlp_load(Z, LNP, Wbf, bs, itemf(0), tid, P);
    ((LAS float*)(lds + GM_LNP))[tid] = ln_g[tid]; ((LAS float*)(lds + GM_LNP))[512 + tid] = ln_b[tid];
    __syncthreads();
    for (int i = 0; i < count; ++i) {
        const int item = itemf(i), chunk = item >> 3, g = item & 7, m0 = chunk * 128;
        LAS unsigned char* tile = lds + (i & 1) * GM_TILE;
        {
            const int s = tid >> 2, c0 = (tid & 3) * 16;
            float s1 = 0.f, s2 = 0.f;
#pragma unroll
            for (int k = 0; k < 4; ++k) { const f32x4 p = P.lnp[k]; s1 += p[0] + p[2]; s2 += p[1] + p[3]; }
            const float mean = s1 * (1.f / 512.f), var = s2 * (1.f / 512.f) - mean * mean, rstd = rsqrtf(var + EPS);
#pragma unroll
            for (int hh = 0; hh < 2; ++hh) {
                const u32x4 raw = P.raw[hh];
                const LAS float* lg = (const LAS float*)(lds + GM_LNP) + 64 * g + c0 + 8 * hh;
                const f32x4 la = *(const LAS f32x4*)lg, lb = *(const LAS f32x4*)(lg + 4), ba = *(const LAS f32x4*)(lg + 512), bb = *(const LAS f32x4*)(lg + 516);
                f32x4 x0, x1;
                x0[0] = bf2f((unsigned short)(raw.x & 0xffffu)); x0[1] = bf2f((unsigned short)(raw.x >> 16)); x0[2] = bf2f((unsigned short)(raw.y & 0xffffu)); x0[3] = bf2f((unsigned short)(raw.y >> 16));
                x1[0] = bf2f((unsigned short)(raw.z & 0xffffu)); x1[1] = bf2f((unsigned short)(raw.z >> 16)); x1[2] = bf2f((unsigned short)(raw.w & 0xffffu)); x1[3] = bf2f((unsigned short)(raw.w >> 16));
                x0 = (x0 - mean) * rstd * la + ba; x1 = (x1 - mean) * rstd * lb + bb;
                *(LAS u32x4*)(tile + s * GM_STR + (c0 + 8 * hh) * 2) = pack8(x0, x1);
            }
        }
        bf16x8 wfr[4]; u32x2 guv[4];
#pragma unroll
        for (int ks = 0; ks < 4; ++ks) wfr[ks] = P.wfr[ks];
#pragma unroll
        for (int ct = 0; ct < 4; ++ct) guv[ct] = P.guv[ct];
        const float bias = P.bias;
        if (i + 1 < count) gmlp_load(Z, LNP, Wbf, bs, itemf(i + 1), tid, P);
        __syncthreads();
        f32x4 acc[4];
#pragma unroll
        for (int ct = 0; ct < 4; ++ct) acc[ct] = (f32x4){0.f, 0.f, 0.f, 0.f};
#pragma unroll
        for (int ks = 0; ks < 4; ++ks) {
            if (32 * ks <= 16 * w + 15) {
                const bf16x8 bfr = wfr[ks];
                const LAS unsigned char* a0 = tile + (32 * ks + 8 * g4 + qq) * GM_STR + 8 * pp;
#pragma unroll
                for (int ct = 0; ct < 4; ++ct) acc[ct] = __builtin_amdgcn_mfma_f32_16x16x32_bf16(tr_pair(a0 + 32 * ct, a0 + 4 * GM_STR + 32 * ct), bfr, acc[ct], 0, 0, 0);
            }
        }
        GAS bf16_t* up = Z + (size_t)(m0 + t) * ZLD + 64 * g + 4 * g4;
#pragma unroll
        for (int ct = 0; ct < 4; ++ct) {
            const u32x2 a = guv[ct];
            u32x2 o; o.x = cvt_pk_bf16(bf2f((unsigned short)(a.x & 0xffffu)) * (acc[ct][0] + bias), bf2f((unsigned short)(a.x >> 16)) * (acc[ct][1] + bias));
            o.y = cvt_pk_bf16(bf2f((unsigned short)(a.y & 0xffffu)) * (acc[ct][2] + bias), bf2f((unsigned short)(a.y >> 16)) * (acc[ct][3] + bias));
            *(GAS u32x2*)(up + 16 * ct) = o;
        }
    }
    __syncthreads();
}


constexpr int GL_GAL = 0, GL_SEG = 4096, GL_A = 8192;
constexpr int G1_KSSTR = 144, G1_V = GL_A + 128 * G1_KSSTR, GL_VSTR = 544;
constexpr int G3_QSTR = 272, G3_KT = GL_A + 64 * G3_QSTR, G3_V = G3_KT + 64 * G3_QSTR, G3_SSQ = G3_V + 64 * GL_VSTR;
__device__ __forceinline__ void gla_decay(LAS unsigned char* lds, const GAS float* GA, const GAS float* w_a2, const GAS float* b_a, const int h, const size_t m0, const int tid, float (&bl)[2][8], float (&tot)[2]) {
    LAS float* gal = (LAS float*)(lds + GL_GAL); LAS float* seg = (LAS float*)(lds + GL_SEG);
    const int kp = tid & 63, s8 = tid >> 6;
    if (tid < 256) *(LAS f32x4*)(gal + 4 * tid) = *(const GAS f32x4*)(GA + m0 * 16 + 4 * tid);
    float wa[2][16], ba[2];
#pragma unroll
    for (int c = 0; c < 2; ++c) {
#pragma unroll
        for (int j = 0; j < 16; ++j) wa[c][j] = w_a2[j * 512 + 128 * h + 2 * kp + c];
        ba[c] = b_a[128 * h + 2 * kp + c]; }
    __syncthreads();
    float run[2] = {0.f, 0.f};
#pragma unroll
    for (int i = 0; i < 8; ++i) {
        const LAS f32x4* gr = (const LAS f32x4*)(gal + (8 * s8 + i) * 16);
        const f32x4 g0 = gr[0], g1 = gr[1], g2 = gr[2], g3 = gr[3];
#pragma unroll
        for (int c = 0; c < 2; ++c) {
            float x = ba[c];
#pragma unroll
            for (int j = 0; j < 4; ++j) x += g0[j] * wa[c][j] + g1[j] * wa[c][4 + j] + g2[j] * wa[c][8 + j] + g3[j] * wa[c][12 + j];
            const float ls = fminf(x, 0.f) - __logf(1.0f + __expf(-fabsf(x)));
            run[c] += ls * (1.0f / 16.0f); bl[c][i] = run[c];
        }
    }
    *(LAS f32x2*)(seg + s8 * 128 + 2 * kp) = (f32x2){run[0], run[1]};
    __syncthreads();
    float pre[2] = {0.f, 0.f}; tot[0] = 0.f; tot[1] = 0.f;
#pragma unroll
    for (int q = 0; q < 8; ++q) { const f32x2 sv = *(const LAS f32x2*)(seg + q * 128 + 2 * kp); if (q < s8) { pre[0] += sv.x; pre[1] += sv.y; } tot[0] += sv.x; tot[1] += sv.y; }
#pragma unroll
    for (int i = 0; i < 8; ++i) { bl[0][i] += pre[0]; bl[1][i] += pre[1]; }
}
__device__ __forceinline__ void gla_stage_v(LAS unsigned char* vl, const GAS bf16_t* Z, const int h, const size_t m0, const int tid) {
#pragma unroll
    for (int p = 0; p < 4; ++p) { const int idx = p * 512 + tid, t = idx >> 5, ch = idx & 31;
        *(LAS u32x4*)(vl + t * GL_VSTR + 16 * ch) = *(const GAS u32x4*)(Z + (m0 + t) * OD_N + 1024 + 256 * h + 8 * ch); }
}
constexpr int G1_DEC = G1_V + 64 * GL_VSTR;
__device__ __forceinline__ void gla_g1_group(LAS unsigned char* lds, const GAS bf16_t* Z, const GAS float* GA, const GAS float* w_a2, const GAS float* b_a, GAS bf16_t* KVT, GAS float* DCC, GAS float* DG, GAS bf16_t* QK, const int item, const int tid) {
    const int lane = tid & 63, w = __builtin_amdgcn_readfirstlane(tid >> 6), fr = lane & 15, g = lane >> 4;
    const int bh = item >> 4, grp = item & 15, h = bh & 3; const size_t mbase = (size_t)(bh >> 2) * SEQ + 256 * grp;
    const int kp = tid & 63, s8 = tid >> 6;
    LAS float* gal = (LAS float*)(lds + GL_GAL); LAS float* seg = (LAS float*)(lds + GL_SEG); LAS float* decs = (LAS float*)(lds + G1_DEC);
    f32x2 wa2[16];
#pragma unroll
    for (int j = 0; j < 16; ++j) wa2[j] = *(const GAS f32x2*)(w_a2 + j * 512 + 128 * h + 2 * kp);
    const f32x2 ba2 = *(const GAS f32x2*)(b_a + 128 * h + 2 * kp);
    f32x4 acc[16];
#pragma unroll
    for (int vt = 0; vt < 16; ++vt) acc[vt] = (f32x4){0.f, 0.f, 0.f, 0.f};
    float cum[2] = {0.f, 0.f};
    const int qq = fr >> 2, pp = fr & 3;
    f32x4 pga = (f32x4){0.f, 0.f, 0.f, 0.f};
    if (tid < 256) pga = *(const GAS f32x4*)(GA + mbase * 16 + 4 * tid);
    for (int cc = 0; cc < 4; ++cc) {
        const size_t m0 = mbase + 64 * cc; const int chunk = bh * 64 + 4 * grp + cc;
        if (tid < 256) *(LAS f32x4*)(gal + 4 * tid) = pga;
        unsigned qraw[8], kraw[8];
#pragma unroll
        for (int i = 0; i < 8; ++i) { const GAS bf16_t* zr = Z + (m0 + 8 * s8 + i) * OD_N + 128 * h + 2 * kp; qraw[i] = *(const GAS unsigned*)zr; kraw[i] = *(const GAS unsigned*)(zr + 512); }
        __syncthreads();
        if (cc < 3 && tid < 256) pga = *(const GAS f32x4*)(GA + (m0 + 64) * 16 + 4 * tid);
        float bl[2][8], run[2] = {0.f, 0.f};
#pragma unroll
        for (int i = 0; i < 8; ++i) {
            const LAS f32x4* gr = (const LAS f32x4*)(gal + (8 * s8 + i) * 16);
            const f32x4 g0 = gr[0], g1 = gr[1], g2 = gr[2], g3 = gr[3];
            f32x2 xa = ba2, xb = (f32x2){0.f, 0.f};
#pragma unroll
            for (int j = 0; j < 4; ++j) { xa = wa2[j] * g0[j] + xa; xb = wa2[4 + j] * g1[j] + xb; xa = wa2[8 + j] * g2[j] + xa; xb = wa2[12 + j] * g3[j] + xb; }
            const f32x2 x2 = xa + xb;
#pragma unroll
            for (int c = 0; c < 2; ++c) {
                const float x = x2[c];
                const float ls = fminf(x, 0.f) - __logf(1.0f + __expf(-fabsf(x)));
                run[c] += ls * (1.0f / 16.0f); bl[c][i] = run[c];
            }
        }
        *(LAS f32x2*)(seg + s8 * 128 + 2 * kp) = (f32x2){run[0], run[1]};
        __syncthreads();
        u32x4 pv[4];
#pragma unroll
        for (int p = 0; p < 4; ++p) { const int idx = p * 512 + tid, t = idx >> 5, ch = idx & 31; pv[p] = *(const GAS u32x4*)(Z + (m0 + t) * OD_N + 1024 + 256 * h + 8 * ch); }
        float pre[2] = {0.f, 0.f}, tot[2] = {0.f, 0.f};
#pragma unroll
        for (int q = 0; q < 8; ++q) { const f32x2 sv = *(const LAS f32x2*)(seg + q * 128 + 2 * kp); if (q < s8) { pre[0] += sv.x; pre[1] += sv.y; } tot[0] += sv.x; tot[1] += sv.y; }
        float ks[2][8]; const float et0 = __expf(tot[0]), et1 = __expf(tot[1]);
#pragma unroll
        for (int i = 0; i < 8; ++i) {
            const float b0 = bl[0][i] + pre[0], b1 = bl[1][i] + pre[1];
            const float k0 = bf2f((unsigned short)(kraw[i] & 0xffffu)), k1 = bf2f((unsigned short)(kraw[i] >> 16));
            const float kt0 = k0 * __expf(-b0), kt1 = k1 * __expf(-b1);
            ks[0][i] = kt0 * et0; ks[1][i] = kt1 * et1;
            GAS bf16_t* qr = QK + (m0 + 8 * s8 + i) * 1024 + 128 * h + 2 * kp;
            *(GAS unsigned*)qr = cvt_pk_bf16(bf2f((unsigned short)(qraw[i] & 0xffffu)) * __expf(b0), bf2f((unsigned short)(qraw[i] >> 16)) * __expf(b1));
            *(GAS unsigned*)(qr + 512) = cvt_pk_bf16(kt0, kt1);
        }
#pragma unroll
        for (int c = 0; c < 2; ++c)
            *(LAS u32x4*)(lds + GL_A + (2 * kp + c) * G1_KSSTR + 16 * s8) = pack8((f32x4){ks[c][0], ks[c][1], ks[c][2], ks[c][3]}, (f32x4){ks[c][4], ks[c][5], ks[c][6], ks[c][7]});
#pragma unroll
        for (int p = 0; p < 4; ++p) { const int idx = p * 512 + tid, t = idx >> 5, ch = idx & 31; *(LAS u32x4*)(lds + G1_V + t * GL_VSTR + 16 * ch) = pv[p]; }
        if (s8 == 0) {
            *(LAS f32x2*)(decs + 2 * kp) = (f32x2){et0, et1};
            *(GAS f32x2*)(DCC + (size_t)chunk * 128 + 2 * kp) = (f32x2){et0, et1};
        }
        cum[0] += tot[0]; cum[1] += tot[1];
        __syncthreads();
        const LAS unsigned char* ar = lds + GL_A + (16 * w + fr) * G1_KSSTR + 16 * g;
        const bf16x8 a0 = *(const LAS bf16x8*)ar, a1 = *(const LAS bf16x8*)(ar + 64);
        const f32x4 dcv = *(const LAS f32x4*)(decs + 16 * w + 4 * g);
        const LAS unsigned char* vb = lds + G1_V + (8 * g + qq) * GL_VSTR + 8 * pp;
#pragma unroll
        for (int vt = 0; vt < 16; ++vt) {
            f32x4 c = acc[vt];
            c = c * dcv;
            c = __builtin_amdgcn_mfma_f32_16x16x32_bf16(a0, tr_pair(vb + 32 * vt, vb + 4 * GL_VSTR + 32 * vt), c, 0, 0, 0);
            c = __builtin_amdgcn_mfma_f32_16x16x32_bf16(a1, tr_pair(vb + 32 * GL_VSTR + 32 * vt, vb + 36 * GL_VSTR + 32 * vt), c, 0, 0, 0);
            acc[vt] = c;
        }
        __syncthreads();
    }
    {
        GAS bf16_t* outp = KVT + (size_t)(bh * 16 + grp) * 32768 + (size_t)w * 4096 + fr * 16 + 4 * g;
#pragma unroll
        for (int vt = 0; vt < 16; ++vt) { const unsigned lo = cvt_pk_bf16(acc[vt][0], acc[vt][1]), hi = cvt_pk_bf16(acc[vt][2], acc[vt][3]);
            __hip_atomic_store((GAS unsigned long long*)(outp + vt * 256), ((unsigned long long)hi << 32) | lo, __ATOMIC_RELAXED, __HIP_MEMORY_SCOPE_AGENT); }
        if (s8 == 0) { const float d0 = __expf(cum[0]), d1 = __expf(cum[1]);
            __hip_atomic_store((GAS unsigned long long*)(DG + (size_t)item * 128 + 2 * kp), ((unsigned long long)__float_as_uint(d1) << 32) | __float_as_uint(d0), __ATOMIC_RELAXED, __HIP_MEMORY_SCOPE_AGENT); }
    }
}
__device__ __forceinline__ void gla_scan(GAS bf16_t* KVT, const GAS float* DG, const int tid, const int G) {
    for (int gid = blockIdx.x * (NWAVES * 64) + tid; gid < 16 * 8192; gid += G * NWAVES * 64) {
        const int bh = gid >> 13, off = (gid & 8191) * 4, kq = 16 * (off >> 12) + (off & 15);
        GAS bf16_t* p = KVT + (size_t)bh * 16 * 32768 + off; const GAS float* dp = DG + (size_t)bh * 16 * 128 + kq;
        float z_ = 0.f; asm volatile("" : "+v"(z_));
        f32x4 S = (f32x4){z_, z_, z_, z_};
        u32x2 kv[16]; f32x4 dc[16];
#pragma unroll
        for (int i = 0; i < 16; ++i) { kv[i] = *(const GAS u32x2*)(p + (size_t)i * 32768); dc[i] = *(const GAS f32x4*)(dp + i * 128); }
#pragma unroll
        for (int i = 0; i < 16; ++i) {
            u32x2 o; o.x = cvt_pk_bf16(S[0], S[1]); o.y = cvt_pk_bf16(S[2], S[3]);
            *(GAS u32x2*)(p + (size_t)i * 32768) = o;
            S[0] = dc[i][0] * S[0] + bf2f((unsigned short)(kv[i].x & 0xffffu)); S[1] = dc[i][1] * S[1] + bf2f((unsigned short)(kv[i].x >> 16));
            S[2] = dc[i][2] * S[2] + bf2f((unsigned short)(kv[i].y & 0xffffu)); S[3] = dc[i][3] * S[3] + bf2f((unsigned short)(kv[i].y >> 16));
        }
    }
}
__device__ __forceinline__ void gla_scan_slice(GAS bf16_t* KVT, const GAS float* DG, const int bh, const int part, const int tid) {
    const int off = (part * 512 + tid) * 4, kq = 16 * (off >> 12) + (off & 15);
    GAS bf16_t* p = KVT + (size_t)bh * 16 * 32768 + off; const GAS float* dp = DG + (size_t)bh * 16 * 128 + kq;
    float z_ = 0.f; asm volatile("" : "+v"(z_));
    f32x4 S = (f32x4){z_, z_, z_, z_};
    u32x2 kv[16]; f32x4 dc[16];
#pragma unroll
    for (int i = 0; i < 16; ++i) { kv[i] = *(const GAS u32x2*)(p + (size_t)i * 32768); dc[i] = *(const GAS f32x4*)(dp + i * 128); }
#pragma unroll
    for (int i = 0; i < 16; ++i) {
        const unsigned lo = cvt_pk_bf16(S[0], S[1]), hi = cvt_pk_bf16(S[2], S[3]);
        __hip_atomic_store((GAS unsigned long long*)(p + (size_t)i * 32768), ((unsigned long long)hi << 32) | lo, __ATOMIC_RELAXED, __HIP_MEMORY_SCOPE_AGENT);
        S[0] = dc[i][0] * S[0] + bf2f((unsigned short)(kv[i].x & 0xffffu)); S[1] = dc[i][1] * S[1] + bf2f((unsigned short)(kv[i].x >> 16));
        S[2] = dc[i][2] * S[2] + bf2f((unsigned short)(kv[i].y & 0xffffu)); S[3] = dc[i][3] * S[3] + bf2f((unsigned short)(kv[i].y >> 16));
    }
}
__device__ __forceinline__ void gla_g3_group(LAS unsigned char* lds, GAS bf16_t* Z, const GAS bf16_t* QK, const GAS bf16_t* KVT, const GAS float* DCC, const GAS float* head_g, const int gitem, const int tid, unsigned* cwait = nullptr) {
    const int lane = tid & 63, w = __builtin_amdgcn_readfirstlane(tid >> 6); int fr = lane & 15, g = lane >> 4;
    const int bh = gitem >> 4, grp = gitem & 15, h = bh & 3; const size_t mbase = (size_t)(bh >> 2) * SEQ + 256 * grp;
    constexpr int G3_DCC = G3_SSQ + 2048;
    constexpr int G3_ST = 81920;
    const f32x4 hg0 = *(const GAS f32x4*)(head_g + 32 * w + 4 * g), hg1 = *(const GAS f32x4*)(head_g + 32 * w + 16 + 4 * g);
    u32x4 pq[2], pk_[2], pv[4];
#define G3_LOAD(m0_) do { int tl_ = tid; asm volatile("" : "+v"(tl_)); _Pragma("unroll") for (int p = 0; p < 2; ++p) { const int idx = p * 512 + tl_, t = idx >> 4, ch = idx & 15; const GAS bf16_t* src = QK + ((m0_) + t) * 1024 + 128 * h + 8 * ch; pq[p] = *(const GAS u32x4*)src; pk_[p] = *(const GAS u32x4*)(src + 512); } \
        _Pragma("unroll") for (int p = 0; p < 4; ++p) { const int idx = p * 512 + tl_, t = idx >> 5, ch = idx & 31; pv[p] = *(const GAS u32x4*)(Z + ((m0_) + t) * OD_N + 1024 + 256 * h + 8 * ch); } } while (0)
    G3_LOAD(mbase);
    if (cwait) handoff_wait(cwait, 16u);
    {
        const GAS u32x4* gp = (const GAS u32x4*)(KVT + (size_t)(bh * 16 + grp) * 32768) + tid; u32x4 sg[8];
#pragma unroll
        for (int i = 0; i < 8; ++i) sg[i] = gp[512 * i];
#pragma unroll
        for (int i = 0; i < 8; ++i) *(LAS u32x4*)(lds + G3_ST + 16 * (tid + 512 * i)) = sg[i];
    }
    for (int cc = 0; cc < 4; ++cc) {
    const size_t m0 = mbase + 64 * cc; const int item = bh * 64 + 4 * grp + cc;
    asm volatile("" : "+v"(fr), "+v"(g));
    const int qq = fr >> 2, pp = fr & 3;
    const int so0 = 2 * ((g >> 1) * 4096 + (32 * w + fr) * 16 + 8 * (g & 1));
    PROBE_T0(50);
#pragma unroll
    for (int p = 0; p < 2; ++p) { const int idx = p * 512 + tid, t = idx >> 4, ch = idx & 15;
        *(LAS u32x4*)(lds + GL_A + t * G3_QSTR + 16 * ch) = pq[p]; *(LAS u32x4*)(lds + G3_KT + t * G3_QSTR + 16 * ch) = pk_[p]; }
#pragma unroll
    for (int p = 0; p < 4; ++p) { const int idx = p * 512 + tid, t = idx >> 5, ch = idx & 31; *(LAS u32x4*)(lds + G3_V + t * GL_VSTR + 16 * ch) = pv[p]; }
    if (tid < 32) *(LAS f32x4*)(lds + G3_DCC + 16 * tid) = *(const GAS f32x4*)(DCC + (size_t)item * 128 + 4 * tid);
    __syncthreads();
    PROBE_T1(50); PROBE_T0(51);
    u32x2 srv[4][2];
#pragma unroll
    for (int tt = 0; tt < 4; ++tt)
#pragma unroll
        for (int vi = 0; vi < 2; ++vi) srv[tt][vi] = *(const GAS u32x2*)(Z + (m0 + 16 * tt + fr) * OD_N + 2048 + 256 * h + 32 * w + 16 * vi + 4 * g);
    __builtin_amdgcn_sched_barrier(0);
    u32x4 pb[4][2];
#pragma unroll
    for (int tt = 0; tt < 4; ++tt) {
        bf16x8 qf[4];
#pragma unroll
        for (int ks = 0; ks < 4; ++ks) qf[ks] = *(const LAS bf16x8*)(lds + GL_A + (16 * tt + fr) * G3_QSTR + 64 * ks + 16 * g);
        u32x2 pk[4];
#pragma unroll
        for (int jt = 0; jt < 4; ++jt) {
            if (jt <= tt) {
                f32x4 c = (f32x4){0.f, 0.f, 0.f, 0.f};
#pragma unroll
                for (int ks = 0; ks < 4; ++ks) c = __builtin_amdgcn_mfma_f32_16x16x32_bf16(*(const LAS bf16x8*)(lds + G3_KT + (16 * jt + fr) * G3_QSTR + 64 * ks + 16 * g), qf[ks], c, 0, 0, 0);
                if (jt == tt) {
#pragma unroll
                    for (int e = 0; e < 4; ++e) c[e] = (4 * g + e <= fr) ? c[e] : 0.f;
                }
                pk[jt].x = cvt_pk_bf16(c[0], c[1]); pk[jt].y = cvt_pk_bf16(c[2], c[3]);
            } else { pk[jt].x = 0u; pk[jt].y = 0u; }
        }
        pb[tt][0] = (u32x4){pk[0].x, pk[0].y, pk[1].x, pk[1].y}; pb[tt][1] = (u32x4){pk[2].x, pk[2].y, pk[3].x, pk[3].y};
    }
    PROBE_T1(51); PROBE_T0(52);
    __builtin_amdgcn_sched_barrier(0);
    f32x4 acc[2][4];
    float ssq[4] = {0.f, 0.f, 0.f, 0.f};
    bf16x8 sf[2][4], va[2], vc[2];
#pragma unroll
    for (int vi = 0; vi < 2; ++vi) {
#pragma unroll
        for (int ks = 0; ks < 4; ++ks) sf[vi][ks] = *(const LAS bf16x8*)(lds + G3_ST + so0 + 512 * vi + 16384 * ks);
        const LAS unsigned char* vb = lds + G3_V + (4 * g + qq) * GL_VSTR + 32 * (2 * w + vi) + 8 * pp;
        va[vi] = tr_pair(vb, vb + 16 * GL_VSTR); vc[vi] = tr_pair(vb + 32 * GL_VSTR, vb + 48 * GL_VSTR);
    }
#pragma unroll
    for (int tt = 0; tt < 4; ++tt) {
        bf16x8 qf[4];
#pragma unroll
        for (int ks = 0; ks < 4; ++ks) qf[ks] = *(const LAS bf16x8*)(lds + GL_A + (16 * tt + fr) * G3_QSTR + 64 * ks + 16 * g);
#pragma unroll
        for (int vi = 0; vi < 2; ++vi) {
            f32x4 c = (f32x4){0.f, 0.f, 0.f, 0.f};
#pragma unroll
            for (int ks = 0; ks < 4; ++ks) c = __builtin_amdgcn_mfma_f32_16x16x32_bf16(sf[vi][ks], qf[ks], c, 0, 0, 0);
            c = __builtin_amdgcn_mfma_f32_16x16x32_bf16(va[vi], __builtin_bit_cast(bf16x8, pb[tt][0]), c, 0, 0, 0);
            if (tt >= 2) c = __builtin_amdgcn_mfma_f32_16x16x32_bf16(vc[vi], __builtin_bit_cast(bf16x8, pb[tt][1]), c, 0, 0, 0);
            acc[vi][tt] = c; ssq[tt] += dot4(c);
        }
    }
    PROBE_T1(52); PROBE_T0(53);
    LAS float* sl = (LAS float*)(lds + G3_SSQ);
#pragma unroll
    for (int tt = 0; tt < 4; ++tt) { float v = ssq[tt]; v += __shfl_xor(v, 16); v += __shfl_xor(v, 32); if (g == 0) sl[w * 64 + 16 * tt + fr] = v; }
    __syncthreads();
    if (cc < 3) G3_LOAD(m0 + 64);
#pragma unroll
    for (int tt = 0; tt < 4; ++tt) {
        float tsum = 0.f;
#pragma unroll
        for (int q = 0; q < 8; ++q) tsum += sl[q * 64 + 16 * tt + fr];
        const float rstd = rsqrtf(tsum * (1.0f / 256.0f) + EPS);
#pragma unroll
        for (int vi = 0; vi < 2; ++vi) {
            const f32x4 hg = (vi == 0) ? hg0 : hg1;
            GAS bf16_t* row = Z + (m0 + 16 * tt + fr) * OD_N + 256 * h + 32 * w + 16 * vi + 4 * g;
            const u32x2 sr = srv[tt][vi];
            const f32x4 c = acc[vi][tt];
            u32x2 o; o.x = cvt_pk_bf16(c[0] * rstd * hg[0] * bf2f((unsigned short)(sr.x & 0xffffu)), c[1] * rstd * hg[1] * bf2f((unsigned short)(sr.x >> 16)));
            o.y = cvt_pk_bf16(c[2] * rstd * hg[2] * bf2f((unsigned short)(sr.y & 0xffffu)), c[3] * rstd * hg[3] * bf2f((unsigned short)(sr.y >> 16)));
            *(GAS u32x2*)(row + 1024) = o;
        }
    }
    if (cc < 3) {
        __builtin_amdgcn_sched_barrier(0);
        const LAS unsigned char* vb = lds + G3_V + (8 * g + qq) * GL_VSTR + 8 * pp;
        bf16x8 vlo[2], vhi[2];
#pragma unroll
        for (int vi = 0; vi < 2; ++vi) { const int vt = 2 * w + vi; vlo[vi] = tr_pair(vb + 32 * vt, vb + 4 * GL_VSTR + 32 * vt); vhi[vi] = tr_pair(vb + 32 * GL_VSTR + 32 * vt, vb + 36 * GL_VSTR + 32 * vt); }
        const LAS unsigned char* ka = lds + G3_KT + (8 * g + qq) * G3_QSTR + 8 * pp;
        LAS unsigned char* stp = lds + G3_ST + 2 * ((32 * w + fr) * 16 + 4 * g);
#pragma unroll
        for (int kt = 0; kt < 8; ++kt) {
            const bf16x8 a0 = tr_pair(ka + 32 * kt, ka + 4 * G3_QSTR + 32 * kt), a1 = tr_pair(ka + 32 * G3_QSTR + 32 * kt, ka + 36 * G3_QSTR + 32 * kt);
            const f32x4 dcv = *(const LAS f32x4*)(lds + G3_DCC + 4 * (16 * kt + 4 * g));
#pragma unroll
            for (int vi = 0; vi < 2; ++vi) {
                LAS unsigned char* sp_ = stp + 8192 * kt + 512 * vi;
                const u32x2 ov = *(const LAS u32x2*)sp_;
                f32x4 c = (f32x4){bf2f((unsigned short)(ov.x & 0xffffu)), bf2f((unsigned short)(ov.x >> 16)), bf2f((unsigned short)(ov.y & 0xffffu)), bf2f((unsigned short)(ov.y >> 16))};
                c = __builtin_amdgcn_mfma_f32_16x16x32_bf16(a0, vlo[vi], c, 0, 0, 0);
                c = __builtin_amdgcn_mfma_f32_16x16x32_bf16(a1, vhi[vi], c, 0, 0, 0);
                c = c * dcv;
                u32x2 o; o.x = cvt_pk_bf16(c[0], c[1]); o.y = cvt_pk_bf16(c[2], c[3]);
                *(LAS u32x2*)sp_ = o;
            }
        }
    }
    __syncthreads();
    PROBE_T1(53);
    }
#undef G3_LOAD
}
__device__ __forceinline__ void ga_group(LAS unsigned char* lds, const GAS bf16_t* XB, const GAS float* RSQ, const GAS bf16_t* WGA, GAS float* GA, const int grp, const int tid) {
    const int lane = tid & 63, w = __builtin_amdgcn_readfirstlane(tid >> 6), fr = lane & 15, g = lane >> 4, tt = w & 3, kh = w >> 2;
    const GAS bf16_t* ap = XB + (size_t)(64 * grp + 16 * tt + fr) * D + 512 * kh + 8 * g; const GAS bf16_t* bp = WGA + (size_t)fr * D + 512 * kh + 8 * g;
    f32x4 c = (f32x4){0.f, 0.f, 0.f, 0.f};
#pragma unroll 4
    for (int ks = 0; ks < 16; ++ks) c = __builtin_amdgcn_mfma_f32_16x16x32_bf16(*(const GAS bf16x8*)(ap + 32 * ks), *(const GAS bf16x8*)(bp + 32 * ks), c, 0, 0, 0);
    LAS float* pl = (LAS float*)lds;
#pragma unroll
    for (int e = 0; e < 4; ++e) pl[(kh * 64 + 16 * tt + 4 * g + e) * 16 + fr] = c[e];
    __syncthreads();
    for (int i = tid; i < 64 * 16; i += NWAVES * 64) {
        const int t = i >> 4; const size_t row = (size_t)64 * grp + t;
        float s = 0.f;
#pragma unroll
        for (int q = 0; q < 4; ++q) s += sum4(*(const GAS f32x4*)(RSQ + row * 16 + 4 * q));
        GA[row * 16 + (i & 15)] = (pl[i] + pl[1024 + i]) * rsqrtf(s * (1.0f / 1024.0f) + EPS);
    }
    __syncthreads();
}

constexpr int RING_BYTES = 131072, LDSCTL_OFF = RING_BYTES, MISC_OFF = 163840 - 512, LDSX_OFF = RING_BYTES + 1024, RSTD_OFF = RING_BYTES + 5120, PAR_OFF = RING_BYTES + 13312, LDS_BYTES = 163840;
constexpr int NPHASE = 1 + 8 * DEPTH;
struct Args { const float* in[21]; float* out; unsigned char* ws; int ph_lo, ph_hi, li, pad; };

#define GIN(i) ((const GAS float*)inp[i])
#define CD_SET(d_, W_, W2_, gk_, WT_, ldw_, K_, N_, map_, it_) do { (d_).W = (W_); (d_).dW2 = (W2_); (d_).gk = (gk_); (d_).WT = (WT_); (d_).ldw = (ldw_); (d_).K = (K_); (d_).Ndst = (N_); (d_).map = (map_); (d_).item = (it_); } while (0)
#define CD_MIX(d_, e_, kind_, r_) do { \
        if ((kind_) == 0) CD_SET(d_, GIN(3) + (size_t)(e_) * D * EV_N, 0l, GIN(1) + (size_t)(2 * (e_)) * D, (GAS bf16_t*)(ws + WS_WMIX + OFF_EVIN) + (size_t)(e_) * EV_N * D, EV_N, D, EV_N, 1, (r_)); \
        else if ((kind_) == 1) CD_SET(d_, GIN(10) + (size_t)(e_) * D * D, 0l, (const GAS float*)nullptr, (GAS bf16_t*)(ws + WS_WMIX + OFF_EVOUT) + (size_t)(e_) * D * D, D, D, D, 0, (r_)); \
        else if ((kind_) == 2) CD_SET(d_, GIN(11) + (size_t)(e_) * D * OD_NSRC, 0l, GIN(1) + (size_t)(2 * (e_) + 1) * D, (GAS bf16_t*)(ws + WS_WMIX + OFF_ODIN) + (size_t)(e_) * OD_N * D, OD_NSRC, D, OD_N, 0, (r_)); \
        else CD_SET(d_, GIN(15) + (size_t)(e_) * D * D, 0l, (const GAS float*)nullptr, (GAS bf16_t*)(ws + WS_WMIX + OFF_ODOUT) + (size_t)(e_) * D * D, D, D, D, 0, (r_)); } while (0)
#define CD_FFN(d_, l_, dst_, it_) do { \
        if ((it_) < 8 * (GU_N / 128)) CD_SET(d_, GIN(16) + (size_t)(l_) * D * FF, (long)((GIN(17) + (size_t)(l_) * D * FF) - (GIN(16) + (size_t)(l_) * D * FF)), GIN(2) + (size_t)(l_) * D, (dst_), FF, D, GU_N, 2, (it_)); \
        else CD_SET(d_, GIN(20) + (size_t)(l_) * FF * D, 0l, (const GAS float*)nullptr, (dst_) + (size_t)GU_N * D, D, FF, D, 0, (it_) - 8 * (GU_N / 128)); } while (0)
constexpr int MIXW_EVIN = 8 * (EV_N / 128), MIXW_SQ = 64, MIXW_ODIN = 8 * (OD_N / 128);
__global__ void __launch_bounds__(NWAVES * 64, 2) mega(Args args) {
    extern __shared__ __attribute__((aligned(16))) unsigned char lds_raw[];
    LAS unsigned char* lds = (LAS unsigned char*)lds_raw;
    volatile LAS unsigned* MISC = (volatile LAS unsigned*)(lds + MISC_OFF);
    const int Gk = gridDim.x;
    unsigned* ctl = (unsigned*)(args.ws + WS_CTL);
    for (int u = threadIdx.x; u < (LDS_BYTES - LDSCTL_OFF) / 4; u += NWAVES * 64) ((LAS unsigned*)(lds + LDSCTL_OFF))[u] = 0u;
    __syncthreads();
    XcdBarrier bar = xcd_barrier_post(ctl + CW_BAR + args.li * XCD_BAR_WORDS, MISC + 8);
    if (threadIdx.x == 0) { MISC[12] = bar.x; MISC[13] = xb_add(ctl + CW_CENSUS + 64 * bar.x, 1u); }
    __syncthreads();
    int vb = blockIdx.x; bool vb_done = false, local_ok = false;

    typedef const float* cfp_t;
    const __attribute__((address_space(4))) cfp_t* inp0 = (const __attribute__((address_space(4))) cfp_t*)__builtin_amdgcn_kernarg_segment_ptr();

    bool first = true;
    for (int ph = args.ph_lo; ph < args.ph_hi; ++ph) {
        if (ph > 0) { const int L_ = (ph - 1) >> 3, sub_ = (ph - 1) & 7; if (sub_ == 6 || ((L_ & 1) == 0 && sub_ == 3) || ((L_ & 1) == 1 && (sub_ == 2 || sub_ == 3) && local_ok && Gk == 256)) continue; }
        if (!first) {
            PROBE_T0(30);
            const int sub_b = (ph - 1) & 7;
            if (local_ok && (sub_b == 5 || sub_b == 7 || (sub_b == 0 && ph > 1) || (Gk == 256 && (sub_b == 4 || sub_b == 1 || (sub_b == 2 && ((((ph - 1) >> 3) & 1) == 0)))))) xcd_local_barrier(bar);
            else xcd_barrier(bar);
            PROBE_T1(30);
            if (!vb_done) {
                if (threadIdx.x == 0) {
                    bool ok = (Gk % 8) == 0;
                    for (int j = 0; j < 8; ++j) ok = ok && (xb_ld(ctl + CW_CENSUS + 64 * j) == (unsigned)(Gk / 8));
                    MISC[14] = ok ? 1u : 0u; MISC[15] = ok ? (MISC[13] * 8u + MISC[12]) : (unsigned)blockIdx.x;
                }
                __syncthreads();
                vb = (int)MISC[15]; local_ok = MISC[14] != 0u; vb_done = true;
            }
        }
        first = false;
        const __attribute__((address_space(4))) cfp_t* inp = inp0; asm volatile("" : "+s"(inp));
        unsigned char* ws = args.ws; asm volatile("" : "+s"(ws));
        int G = Gk; asm volatile("" : "+s"(G));
        int bid = blockIdx.x; asm volatile("" : "+s"(bid));
        int tid = threadIdx.x; asm volatile("" : "+v"(tid));
        const int lane = tid & 63, wave = __builtin_amdgcn_readfirstlane(tid >> 6);
        const int gw = bid * NWAVES + wave, NGW = G * NWAVES;
        LAS float* scr = (LAS float*)(lds + wave * 16384);
        GAS float* X = (GAS float*)args.out; asm volatile("" : "+s"(X));
        GAS bf16_t* XB = (GAS bf16_t*)(ws + WS_XB); GAS bf16_t* Z = (GAS bf16_t*)(ws + WS_Z);
        GAS float* RSQ = (GAS float*)(ws + WS_RSQ); GAS float* LNP = (GAS float*)(ws + WS_LNP);
        GAS float* DCCP = (GAS float*)((GAS unsigned char*)X + 50 * MiB);
        GAS float* HALO = (GAS float*)(ws + WS_HALO); GAS float* FIXP = (GAS float*)(ws + WS_FIXP); GAS float* FIXU = (GAS float*)(ws + WS_FIXU);
#define WBUF(l_) (((l_) & 1) ? (GAS bf16_t*)(ws + WS_WFFN) : (GAS bf16_t*)((GAS unsigned char*)X + 32 * MiB))
        const int Lcur = (ph > 0) ? ((ph - 1) >> 3) : 0;
        GAS bf16_t* WGU = WBUF(Lcur); GAS bf16_t* WDN = WGU + (size_t)GU_N * D;
        PROBE_T0(ph == 0 ? 0 : ((((ph - 1) >> 3) & 1) ? 20 : 10) + ((ph - 1) & 7));
        if (ph == 0) {
            conv_run(lds, (MIXW_EVIN - bid + G - 1) / G, [=](const int i) { const int it = bid + i * G; ConvDesc d; CD_MIX(d, 0, 0, it); return d; }, tid);
            for (int i = bid * (NWAVES * 64) + tid; i < 2 * 8 * 128 * 128; i += G * NWAVES * 64) {
                const int tt = (i >> 7) & 127, ss = i & 127;
                ((GAS bf16_t*)(ws + WS_SMALLW))[i] = (bf16_t)((ss <= tt) ? f2bf(GIN(6)[i]) : 0u);
            }
            for (int i = bid * (NWAVES * 64) + tid; i < 2 * 16 * 1024; i += G * NWAVES * 64) {
                const int o = i >> 14, j = (i >> 10) & 15, k = i & 1023;
                ((GAS bf16_t*)(ws + WS_SMALLW + 512 * 1024))[i] = (bf16_t)f2bf(GIN(11)[((size_t)o * D + k) * OD_NSRC + 3072 + j] * GIN(1)[(size_t)(2 * o + 1) * D + k]);
            }
            for (int m = gw; m < M; m += NGW) {
                const f32x4* xr = (const f32x4*)(GIN(0) + (size_t)m * D) + lane; f32x4 v[4]; float s = 0.f;
#pragma unroll
                for (int j = 0; j < 4; ++j) { v[j] = xr[64 * j]; s += dot4(v[j]); }
#pragma unroll
                for (int o = 1; o < 64; o <<= 1) s += __shfl_xor(s, o);
                u32x2* o8 = (u32x2*)(XB + (size_t)m * D) + lane;
#pragma unroll
                for (int j = 0; j < 4; ++j) { u32x2 w; w.x = pk2(v[j][0], v[j][1]); w.y = pk2(v[j][2], v[j][3]); o8[64 * j] = w; }
                if (lane < 16) RSQ[(size_t)m * 16 + lane] = (lane == 0) ? s : 0.f;
            }
        } else {
            const int L = (ph - 1) >> 3, sub = (ph - 1) & 7, e = L >> 1; const bool even = (L & 1) == 0;
            if (sub == 0) {
                pg8::StaticOrder S;
                if (even) {
                    pg8::Gemm g{(const bf16_t*)XB, (const bf16_t*)(ws + WS_WMIX + OFF_EVIN) + (size_t)e * EV_N * D, M, EV_N, D, D}; S.init(M, EV_N, G, vb, (L == 2 && local_ok && G == 256) ? 2 : 0);
                    { pg8::Unit u0; stage_rstd(lds, RSQ, tid, vb, (G == 256 && S.next(0, u0)) ? (u0.pm & 7) : -1); }
                    if (tid < 128) ((LAS float*)(lds + PAR_OFF))[tid] = (tid < 64) ? GIN(8)[e * 64 + tid] * (0.125f * 1.4426950408889634f) : GIN(9)[e * 64 + tid - 64];
                    __syncthreads();
                    EpiEvenIn E{Z, (const LAS float*)(lds + RSTD_OFF), LNP, (const LAS float*)(lds + PAR_OFF)};
                    pg8::gemm_phase<EpiEvenIn>(lds, g, S, E, tid);
                    done_arrive(ctl + CW_E1DONE + 64 * ((L >> 1) * 8 + (vb & 7)));
                    {
                        Unit tu; int nun = 0; while (S.next(nun, tu)) ++nun;
                        int nshort = 0, myrank = -1;
                        const int umax = (640 + G - 1) / G, full = 640 - (umax - 1) * G;
                        if (umax * G != 640) { nshort = G - full; myrank = (nun < umax) ? (vb - full) : -1; }
                        if (nshort == 0) { nshort = G; myrank = bid; }
                        if (myrank >= 0) {
                            constexpr int I_GU = 8 * (GU_N / 128), I_DN = (FF / 128) * 8;
                            GAS bf16_t* wdst = WGU;
                            const bool gm_here = (L == 2) && local_ok && G == 256;
                            if (gm_here) done_arrive(ctl + CW_UVDONE + 64 * (vb & 7));
                            if (L == 0) {
                                constexpr int NI = I_GU + I_DN + MIXW_SQ + MIXW_ODIN;
                                conv_run(lds, (NI - myrank + nshort - 1) / nshort, [=](const int i) { const int it = myrank + i * nshort; ConvDesc d;
                                    if (it < I_GU + I_DN) CD_FFN(d, 0, wdst, it); else if (it < I_GU + I_DN + MIXW_SQ) CD_MIX(d, 0, 1, it - I_GU - I_DN); else CD_MIX(d, 0, 2, it - I_GU - I_DN - MIXW_SQ); return d; }, tid);
                            } else {
                                constexpr int NI = MIXW_ODIN + MIXW_SQ;
                                conv_run(lds, (NI - myrank + nshort - 1) / nshort, [=](const int i) { const int it = myrank + i * nshort; ConvDesc d; if (it < MIXW_ODIN) CD_MIX(d, 1, 2, it); else CD_MIX(d, 1, 3, it - MIXW_ODIN); return d; }, tid);
                            }
                            done_arrive(ctl + CW_CONV + 64 * ((L == 0) ? 0 : 3));
                            if (gm_here) {
                                handoff_wait(ctl + CW_UVDONE + 64 * (vb & 7), 16u);
                                const int xg = vb & 7, rg_ = (vb >> 3) - 16;
                                gmlp_run(lds, Z, LNP, GIN(4) + e * 512, GIN(5) + e * 512, (const GAS bf16_t*)(ws + WS_SMALLW) + (size_t)e * 8 * 128 * 128, GIN(7) + e * 8 * 128, 8,
                                         [=](const int i) { const int q = rg_ + 16 * i; return (16 * xg + (q >> 3)) * 8 + (q & 7); }, tid);
                            }
                        }
                    }
                    if (local_ok && G == 256 && (vb & 1)) poll_ge(ctl + CW_E1DONE + 64 * ((L >> 1) * 8 + (vb & 7) - 1), 32u);
                } else {
                    pg8::Gemm g{(const bf16_t*)XB, (const bf16_t*)(ws + WS_WMIX + OFF_ODIN) + (size_t)e * OD_N * D, M, OD_N, D, D}; S.init(M, OD_N, G, vb);
                    { pg8::Unit u0; stage_rstd(lds, RSQ, tid, vb, (G == 256 && S.next(0, u0)) ? (u0.pm & 7) : -1); }
                    __syncthreads();
                    EpiOddIn E{Z, (const LAS float*)(lds + RSTD_OFF)};
                    pg8::gemm_phase<EpiOddIn>(lds, g, S, E, tid);
                    for (int grp = 32 * (vb & 7) + (vb >> 3); grp < M / 64; grp += G) ga_group(lds, XB, RSQ, (const GAS bf16_t*)(ws + WS_SMALLW + 512 * 1024) + (size_t)e * 16 * D, (GAS float*)(ws + WS_GA), grp, tid);
                }
            } else if (sub == 1) {
                if (even) {
                    GAS bf16_t* P1 = (GAS bf16_t*)(ws + WS_AUX); GAS bf16_t* P2 = (GAS bf16_t*)(ws + WS_AUX + 16 * MiB); GAS float* L1 = (GAS float*)(ws + WS_AUX + 32 * MiB); GAS float* L2 = L1 + (size_t)M * 8;
                    const bool sm = local_ok && G == 256;
                    const int xmap = sm ? (vb & 7) : -1, jmap = vb >> 3;
                    const int cnt = sm ? 4 : (1024 - bid + G - 1) / G;
                    attn_run<false>(lds, Z, 0, bid, cnt, G, xmap, jmap, P1, L1, nullptr, nullptr, nullptr, nullptr, tid);
                    attn_run<false>(lds, Z, 2, bid, cnt, G, xmap, jmap, P2, L2, nullptr, nullptr, nullptr, nullptr, tid);
                    gmlp_run(lds, Z, LNP, GIN(4) + e * 512, GIN(5) + e * 512, (const GAS bf16_t*)(ws + WS_SMALLW) + (size_t)e * 8 * 128 * 128, GIN(7) + e * 8 * 128, (sm && L == 2) ? 0 : cnt,
                             [=](const int i) { const int q = jmap + 32 * i; return sm ? (16 * xmap + (q >> 3)) * 8 + (q & 7) : bid + i * G; }, tid);
                } else {
                    if (local_ok && G == 256) {
                        const int x = vb & 7, j = vb >> 3, item = (((x >> 1) * 4 + (j >> 3)) << 4) + 8 * (x & 1) + (j & 7), bh_ = item >> 4;
                        unsigned* c1 = ctl + CW_GLA1 + ((L >> 1) * 16 + bh_) * 64; unsigned* c2 = ctl + CW_GLA2 + ((L >> 1) * 16 + bh_) * 64;
                        gla_g1_group(lds, Z, (const GAS float*)(ws + WS_GA), GIN(12) + (size_t)e * 16 * 512, GIN(13) + e * 512, (GAS bf16_t*)(ws + WS_AUX + 36 * MiB), DCCP, DCCP + 131072, (GAS bf16_t*)X, item, tid);
                        done_arrive(c1); handoff_wait(c1, 16u);
                        gla_scan_slice((GAS bf16_t*)(ws + WS_AUX + 36 * MiB), DCCP + 131072, bh_, item & 15, tid);
                        done_arrive(c2);
                        gla_g3_group(lds, Z, (const GAS bf16_t*)X, (GAS bf16_t*)(ws + WS_AUX + 36 * MiB), DCCP, GIN(14) + e * 256, item, tid, c2);
                        if (L == DEPTH - 1) done_arrive(ctl + CW_DONE + 64 * 32);
                        poll_ge(ctl + CW_CONV + 64 * ((L == 1) ? 1 : 4), 128u);
                    } else
                    for (int it = bid; it < 256; it += G) gla_g1_group(lds, Z, (const GAS float*)(ws + WS_GA), GIN(12) + (size_t)e * 16 * 512, GIN(13) + e * 512, (GAS bf16_t*)(ws + WS_AUX + 36 * MiB), DCCP, DCCP + 131072, (GAS bf16_t*)X, it, tid);
                }
            } else if (sub == 2 && even) {
                const GAS bf16_t* P1 = (const GAS bf16_t*)(ws + WS_AUX); const GAS bf16_t* P2 = (const GAS bf16_t*)(ws + WS_AUX + 16 * MiB); const GAS float* L1 = (const GAS float*)(ws + WS_AUX + 32 * MiB); const GAS float* L2 = L1 + (size_t)M * 8;
                const bool sm = local_ok && G == 256;
                attn_run<true>(lds, Z, 4, bid, sm ? 4 : (1024 - bid + G - 1) / G, G, sm ? (vb & 7) : -1, vb >> 3, nullptr, nullptr, P1, P2, L1, L2, tid);
                if (sm) done_arrive(ctl + CW_DONE + 64 * (L * 8 + (vb & 7)));
                if (sm) { poll_ge(ctl + CW_CONV + 64 * ((L == 0) ? 0 : 3), 128u); if (L == 2) poll_ge(ctl + CW_CONV + 64 * 2, 128u); }
            } else if (sub == 2) {
                gla_scan((GAS bf16_t*)(ws + WS_AUX + 36 * MiB), DCCP + 131072, tid, G);
            } else if (sub == 3) {
                if (local_ok && G == 256) {
                    const int x = vb & 7, j = vb >> 3;
                    gla_g3_group(lds, Z, (const GAS bf16_t*)X, (const GAS bf16_t*)(ws + WS_AUX + 36 * MiB), DCCP, GIN(14) + e * 256, (((x >> 1) * 4 + (j >> 3)) << 4) + 8 * (x & 1) + (j & 7), tid);
                    if (L == DEPTH - 1) done_arrive(ctl + CW_DONE + 64 * 32);
                } else
                for (int it = bid; it < 256; it += G) gla_g3_group(lds, Z, (const GAS bf16_t*)X, (const GAS bf16_t*)(ws + WS_AUX + 36 * MiB), DCCP, GIN(14) + e * 256, it, tid);
            } else if (sub == 4 || sub == 7) {
                pg8::StaticOrder S; S.init(M, D, G, vb);
                if (sub == 7 && L == DEPTH - 1 && local_ok && G == 256) done_wait(ctl + CW_DONE + 64 * 32, 256u);
                if (sub == 7) {
                    const GAS float* cw = GIN(18) + (size_t)L * 3 * FF; Unit fu;
                    for (int i = 0; S.next(i, fu); ++i) {
                        const int pm = fu.pm; if ((pm & 15) == 0) continue;
                        const bool xc = (pm & 7) == 0;
                        if (xc) {
                            if (tid == 0) { unsigned* cw_ = ctl + CW_HCNT + L * 4096 + 64 * (pm - 1); unsigned sp_ = 0;
                                while (__hip_atomic_load(cw_, __ATOMIC_RELAXED, __HIP_MEMORY_SCOPE_AGENT) < (unsigned)(GU_N / 256)) { __builtin_amdgcn_s_sleep(2); if (++sp_ > (1u << 22)) break; }
                                __builtin_amdgcn_fence(__ATOMIC_ACQUIRE, "agent"); asm volatile("s_waitcnt vmcnt(0)" ::: "memory"); }
                            __syncthreads();
                        }
                        for (int idx = tid; idx < 2 * FF; idx += NWAVES * 64) {
                            const int j = idx / FF, c = idx % FF;
                            float h1, h0;
                            if (xc) { h1 = __builtin_bit_cast(float, __hip_atomic_load((const GAS unsigned*)(HALO + ((size_t)(pm - 1) * 2 + 1) * FF + c), __ATOMIC_RELAXED, __HIP_MEMORY_SCOPE_AGENT));
                                      h0 = __builtin_bit_cast(float, __hip_atomic_load((const GAS unsigned*)(HALO + ((size_t)(pm - 1) * 2 + 0) * FF + c), __ATOMIC_RELAXED, __HIP_MEMORY_SCOPE_AGENT)); }
                            else { h1 = HALO[((size_t)(pm - 1) * 2 + 1) * FF + c]; h0 = HALO[((size_t)(pm - 1) * 2 + 0) * FF + c]; }
                            float pre = FIXP[((size_t)pm * 2 + j) * FF + c];
                            if (j == 0) pre += cw[FF + c] * h1 + cw[c] * h0; else pre += cw[c] * h1;
                            Z[(size_t)(pm * 256 + j) * ZLD + c] = (bf16_t)f2bf(silu_f(pre) * FIXU[((size_t)pm * 2 + j) * FF + c]);
                        }
                    }
                    asm volatile("s_waitcnt vmcnt(0)" ::: "memory"); __syncthreads();
                }
                pg8::Gemm g;
                if (sub == 7) g = pg8::Gemm{(const bf16_t*)Z, (const bf16_t*)WDN, M, D, FF, ZLD};
                else if (even) g = pg8::Gemm{(const bf16_t*)Z, (const bf16_t*)(ws + WS_WMIX + OFF_EVOUT) + (size_t)e * D * D, M, D, D, ZLD};
                else g = pg8::Gemm{(const bf16_t*)(Z + 1024), (const bf16_t*)(ws + WS_WMIX + OFF_ODOUT) + (size_t)e * D * D, M, D, D, OD_N};
                const bool first_upd = (L == 0 && sub == 4), last_upd = (L == DEPTH - 1 && sub == 7);
                EpiRes E{first_upd ? GIN(0) : (const GAS float*)nullptr, (const GAS bf16_t*)XB, last_upd ? X : (GAS float*)nullptr, XB, RSQ};
                pg8::gemm_phase<EpiRes>(lds, g, S, E, tid);
                if (sub == 7 && L + 1 < DEPTH) done_arrive(ctl + CW_F2DONE + 64 * L);
            } else if (sub == 5) {
                if (even && local_ok && G == 256 && (vb & 1) == 0) done_wait(ctl + CW_DONE + 64 * (L * 8 + (vb & 7) + 1), 32u);
                pg8::StaticOrder S; S.init(M, GU_N, G, vb);
                pg8::Gemm g{(const bf16_t*)XB, (const bf16_t*)WGU, M, GU_N, D, D};
                { pg8::Unit u0; stage_rstd(lds, RSQ, tid, vb, (G == 256 && S.next(0, u0)) ? (u0.pm & 7) : -1); }
                {
                    const GAS float* cw = GIN(18) + (size_t)L * 3 * FF; const GAS float* cb = GIN(19) + (size_t)L * FF; Unit pu;
                    for (int i = 0; S.next(i, pu); ++i) { const int arr = tid >> 7, j = tid & 127; ((LAS float*)(lds + PAR_OFF))[i * 512 + tid] = (arr < 3) ? cw[arr * FF + 128 * pu.pn + j] : cb[128 * pu.pn + j]; }
                }
                __syncthreads();
                EpiF1 E{Z, (const LAS float*)(lds + RSTD_OFF), (const LAS float*)(lds + PAR_OFF), HALO, FIXP, FIXU, (LAS float*)(lds + LDSX_OFF), ctl + CW_HCNT + L * 4096};
                pg8::gemm_phase<EpiF1>(lds, g, S, E, tid);
                if (L + 1 < DEPTH) {
                    constexpr int NT = (M / 256) * (GU_N / 256);
                    Unit tu; int nun = 0; while (S.next(nun, tu)) ++nun;
                    const int umax = (NT + G - 1) / G, full = NT - (umax - 1) * G;
                    int nshort = G, myrank = bid;
                    if (umax * G != NT) { nshort = G - full; myrank = (nun < umax) ? (vb - full) : -1; }
                    if (myrank >= 0) {
                        constexpr int I_GU = 8 * (GU_N / 128), I_DN = (FF / 128) * 8;
                        const int Ln = L + 1;
                        const GAS float* wg = GIN(16) + (size_t)Ln * D * FF; const GAS float* wu = GIN(17) + (size_t)Ln * D * FF; const GAS float* wd = GIN(20) + (size_t)Ln * FF * D;
                        GAS bf16_t* ngu = WBUF(Ln); GAS bf16_t* ndn = ngu + (size_t)GU_N * D;
                        const int extra = (L == 0) ? MIXW_SQ + MIXW_EVIN : (L == 1) ? MIXW_SQ : 0;
                        const int Lc = L;
                        if (L >= 1) done_wait(ctl + CW_F2DONE + 64 * (L - 1), (unsigned)G);
                        conv_run(lds, (I_GU + I_DN + extra - myrank + nshort - 1) / nshort, [=](const int i) { const int it = myrank + i * nshort;
                            ConvDesc d; if (it < I_GU + I_DN) CD_FFN(d, Ln, ngu, it); else if (Lc == 1) CD_MIX(d, 1, 1, it - I_GU - I_DN); else if (it < I_GU + I_DN + MIXW_SQ) CD_MIX(d, 0, 3, it - I_GU - I_DN); else CD_MIX(d, 1, 0, it - I_GU - I_DN - MIXW_SQ); return d; }, tid);
                        done_arrive(ctl + CW_CONV + 64 * ((L == 0) ? 1 : (L == 1) ? 2 : 4));
                    }
                }
            }
        }
        PROBE_T1(ph == 0 ? 0 : ((((ph - 1) >> 3) & 1) ? 20 : 10) + ((ph - 1) & 7));
    }
    if (PROBE_ID >= 0 && blockIdx.x == 0 && threadIdx.x == 0) {
        const unsigned long long dt = *(volatile LAS unsigned long long*)(probe_lds), t0 = __builtin_amdgcn_s_memrealtime();
        while (__builtin_amdgcn_s_memrealtime() - t0 < PROBE_K * dt) __builtin_amdgcn_s_sleep(8);
    }
}

extern "C" void kernel_launch(void* const* d_in, const int* in_sizes, int n_in, void* d_out, int out_size, void* d_ws, size_t ws_size, hipStream_t stream) {
    static int grid = 0;
    if (grid == 0) {
        if (n_in != 21 || out_size != M * D || ws_size < WS_END) { fprintf(stderr, "kernel_launch: unexpected shapes (n_in %d out %d ws %zu)\n", n_in, out_size, ws_size); grid = -1; return; }
        int dev = 0, cus = 0, per_cu = 0;
        hipGetDevice(&dev); hipDeviceGetAttribute(&cus, hipDeviceAttributeMultiprocessorCount, dev);
        hipFuncSetAttribute((const void*)mega, hipFuncAttributeMaxDynamicSharedMemorySize, LDS_BYTES);
        hipOccupancyMaxActiveBlocksPerMultiprocessor(&per_cu, (const void*)mega, NWAVES * 64, LDS_BYTES);
        (void)hipGetLastError();
        if (per_cu < 1) per_cu = 1;
        if (per_cu > 1) per_cu = 1;
        grid = cus * per_cu;
        fprintf(stderr, "kernel_launch: grid %d (cus %d), ws %zu\n", grid, cus, ws_size);
    }
    if (grid < 0) return;
    hipMemsetAsync((char*)d_ws + WS_CTL, 0, CTL_ZERO_BYTES, stream);
    Args a{};
    for (int i = 0; i < 21; ++i) a.in[i] = (const float*)d_in[i];
    a.out = (float*)d_out; a.ws = (unsigned char*)d_ws;
    a.ph_lo = 0; a.ph_hi = NPHASE; a.li = 0;
    void* kargs[] = {&a};
    hipError_t le = hipLaunchCooperativeKernel((const void*)mega, dim3(grid), dim3(NWAVES * 64), kargs, LDS_BYTES, stream);
    if (le != hipSuccess) fprintf(stderr, "cooperative launch failed: %s\n", hipGetErrorString(le));
}
```
